# Optimizing an MI355X kernel written in HIP

```python
import jax, jax.numpy as jnp
from jax import lax
import numpy as np

D_MODEL = 1024
BATCH = 8
SEQ = 4096
DEPTH = 1

SWA_HEADS = 8
SWA_HEAD_DIM = 64
DILATED_PATTERNS = ((128, 1), (512, 4), (2048, 16))
MLA_HEADS = 8
MLA_NOPE_DIM = 64
MLA_ROPE_DIM = 32
MLA_V_DIM = 64
MLA_Q_RANK = 256
MLA_KV_RANK = 256
ROPE_THETA = 10000.0
Q_BLOCK = 128
SWA_WIDTH = SWA_HEADS * SWA_HEAD_DIM
MLA_WIDTH = MLA_HEADS * MLA_V_DIM
MIX_WIDTH = SWA_WIDTH + MLA_WIDTH
IN_SPLITS = (SWA_WIDTH, 2 * SWA_WIDTH, 3 * SWA_WIDTH, 3 * SWA_WIDTH + MLA_Q_RANK,
             3 * SWA_WIDTH + MLA_Q_RANK + MLA_KV_RANK)
IN_PROJ_WIDTH = 3 * SWA_WIDTH + MLA_Q_RANK + MLA_KV_RANK + MLA_ROPE_DIM
PEER_HEADS = 8
PEER_N_KEYS = 128
PEER_N_EXPERTS = PEER_N_KEYS * PEER_N_KEYS
PEER_TOPK = 16
PEER_QUERY_DIM = 256
PEER_HALF_DIM = PEER_QUERY_DIM // 2
PEER_TOKEN_CHUNK = 128
NORM_EPS = 1e-6
NEG_INF = -1e30

kernel_name = 'hybrid_dilated_mla_peer_block'


def rms_norm(x, g):
    xf = x.astype(jnp.float32)
    y = xf * lax.rsqrt(jnp.mean(xf * xf, axis=-1, keepdims=True) + NORM_EPS)
    return (y * g.astype(jnp.float32)).astype(x.dtype)


def rope_tables(seq, dim):
    inv = 1.0 / (ROPE_THETA ** (jnp.arange(0, dim, 2, dtype=jnp.float32) / dim))
    ang = jnp.arange(seq, dtype=jnp.float32)[:, None] * inv[None, :]
    return jnp.cos(ang), jnp.sin(ang)


def apply_rope(x, cos, sin):
    half = x.shape[-1] // 2
    x1 = x[..., :half].astype(jnp.float32)
    x2 = x[..., half:].astype(jnp.float32)
    return jnp.concatenate([x1 * cos - x2 * sin, x2 * cos + x1 * sin], axis=-1).astype(x.dtype)


def dilated_branch(q, k, v, window, dilation):
    b, h, s, hd = q.shape
    span = window // dilation
    unit = span * dilation
    s_pad = -(-s // unit) * unit
    m = s_pad // dilation
    nb = m // span
    pad = ((0, 0), (0, 0), (0, s_pad - s), (0, 0))

    def to_blocks(t):
        t = jnp.pad(t, pad).reshape(b, h, m, dilation, hd).transpose(0, 1, 3, 2, 4)
        return t.reshape(b, h, dilation, nb, span, hd)

    def with_prev(t):
        prev = jnp.pad(t[:, :, :, :-1], ((0, 0), (0, 0), (0, 0), (1, 0), (0, 0), (0, 0)))
        return jnp.concatenate([prev, t], axis=4)

    qb = to_blocks(q)
    kk = with_prev(to_blocks(k))
    vv = with_prev(to_blocks(v))
    i = jnp.arange(span)[:, None]
    c = jnp.arange(2 * span)[None, :]
    rel = span + i - c
    band = (rel >= 0) & (rel <= span)
    blk = jnp.arange(nb)[:, None, None]
    mask = band[None] & ((blk > 0) | (c >= span)[None])
    sc = jnp.einsum('bhrnqd,bhrnkd->bhrnqk', qb, kk, preferred_element_type=jnp.float32) * (hd ** -0.5)
    sc = jnp.where(mask, sc, NEG_INF)
    lse = jax.nn.logsumexp(sc, axis=-1)
    p = jnp.exp(sc - lse[..., None]).astype(v.dtype)
    o = jnp.einsum('bhrnqk,bhrnkd->bhrnqd', p, vv)
    o = o.reshape(b, h, dilation, m, hd).transpose(0, 1, 3, 2, 4).reshape(b, h, s_pad, hd)[:, :, :s]
    lse = lse.reshape(b, h, dilation, m).transpose(0, 1, 3, 2).reshape(b, h, s_pad)[:, :, :s]
    return o, lse


def dilated_attention(q, k, v):
    outs, lses = [], []
    for window, dilation in DILATED_PATTERNS:
        o, l = dilated_branch(q, k, v, window, dilation)
        outs.append(o)
        lses.append(l)
    wts = jax.nn.softmax(jnp.stack(lses, axis=0), axis=0)
    out = jnp.sum(wts[..., None] * jnp.stack(outs, axis=0).astype(jnp.float32), axis=0)
    return out.astype(q.dtype)


def mla_attention(c_q, c_kv, k_rope, q_norm_g, kv_norm_g, w_uq, w_uk, w_uv, cos, sin):
    b, s, _ = c_q.shape
    q = jnp.einsum('bsr,rf->bsf', rms_norm(c_q, q_norm_g), w_uq)
    q = q.reshape(b, s, MLA_HEADS, MLA_NOPE_DIM + MLA_ROPE_DIM).transpose(0, 2, 1, 3)
    q_nope = q[..., :MLA_NOPE_DIM]
    q_rope = apply_rope(q[..., MLA_NOPE_DIM:], cos, sin)
    ckv = rms_norm(c_kv, kv_norm_g)
    k_nope = jnp.einsum('bsr,rf->bsf', ckv, w_uk).reshape(b, s, MLA_HEADS, MLA_NOPE_DIM).transpose(0, 2, 1, 3)
    v = jnp.einsum('bsr,rf->bsf', ckv, w_uv).reshape(b, s, MLA_HEADS, MLA_V_DIM).transpose(0, 2, 1, 3)
    k_r = apply_rope(k_rope, cos, sin)
    scale = (MLA_NOPE_DIM + MLA_ROPE_DIM) ** -0.5
    nb = s // Q_BLOCK
    qn_b = q_nope.reshape(b, MLA_HEADS, nb, Q_BLOCK, MLA_NOPE_DIM).transpose(2, 0, 1, 3, 4)
    qr_b = q_rope.reshape(b, MLA_HEADS, nb, Q_BLOCK, MLA_ROPE_DIM).transpose(2, 0, 1, 3, 4)
    kpos = jnp.arange(s)

    def block(args):
        qn, qr, start = args
        sc = (jnp.einsum('bhqd,bhkd->bhqk', qn, k_nope, preferred_element_type=jnp.float32)
              + jnp.einsum('bhqd,bkd->bhqk', qr, k_r, preferred_element_type=jnp.float32)) * scale
        qpos = start + jnp.arange(Q_BLOCK)
        sc = jnp.where(kpos[None, :] <= qpos[:, None], sc, NEG_INF)
        p = jax.nn.softmax(sc, axis=-1).astype(v.dtype)
        return jnp.einsum('bhqk,bhkd->bhqd', p, v)

    o = lax.map(block, (qn_b, qr_b, jnp.arange(nb) * Q_BLOCK))
    return o.transpose(1, 0, 3, 2, 4).reshape(b, s, MLA_HEADS * MLA_V_DIM)


def peer_ffn(x, w_query, sub_keys, expert_u, expert_v):
    b, s, d = x.shape
    n_tok = b * s
    n_chunks = n_tok // PEER_TOKEN_CHUNK

    def chunk(tc):
        q = (tc @ w_query).reshape(PEER_TOKEN_CHUNK, PEER_HEADS, 2, PEER_HALF_DIM)
        sc = jnp.einsum('thpc,hpnc->thpn', q, sub_keys, preferred_element_type=jnp.float32)
        s_top, i_top = lax.top_k(sc, PEER_TOPK)
        cand = s_top[:, :, 0, :, None] + s_top[:, :, 1, None, :]
        cand_idx = i_top[:, :, 0, :, None] * PEER_N_KEYS + i_top[:, :, 1, None, :]
        cand = cand.reshape(PEER_TOKEN_CHUNK, PEER_HEADS, PEER_TOPK * PEER_TOPK)
        cand_idx = cand_idx.reshape(PEER_TOKEN_CHUNK, PEER_HEADS, PEER_TOPK * PEER_TOPK)
        best, pos = lax.top_k(cand, PEER_TOPK)
        idx = jnp.take_along_axis(cand_idx, pos, axis=-1)
        gate = jax.nn.softmax(best, axis=-1)
        u = expert_u[idx]
        hid = jax.nn.gelu(jnp.einsum('cd,chkd->chk', tc, u, preferred_element_type=jnp.float32),
                          approximate=False) * gate
        vv = expert_v[idx]
        return jnp.einsum('chk,chkd->cd', hid.astype(vv.dtype), vv)

    out = lax.map(chunk, x.reshape(n_chunks, PEER_TOKEN_CHUNK, d))
    return out.reshape(b, s, d)


def setup_inputs(seed: int = 0) -> dict:
    key = jax.random.key(seed)
    ks = jax.random.split(key, 16)
    L = DEPTH

    def w(k, shape, fan_in):
        return jax.random.normal(k, shape, jnp.float32) * (fan_in ** -0.5)

    def gain(k, shape):
        return 1.0 + 0.01 * jax.random.normal(k, shape, jnp.float32)

    return {
        'x': jax.random.normal(ks[0], (BATCH, SEQ, D_MODEL), jnp.float32),
        'attn_norm_g': gain(ks[1], (L, D_MODEL)),
        'w_in': w(ks[2], (L, D_MODEL, IN_PROJ_WIDTH), D_MODEL),
        'mla_q_norm_g': gain(ks[3], (L, MLA_Q_RANK)),
        'mla_kv_norm_g': gain(ks[4], (L, MLA_KV_RANK)),
        'w_uq': w(ks[5], (L, MLA_Q_RANK, MLA_HEADS * (MLA_NOPE_DIM + MLA_ROPE_DIM)), MLA_Q_RANK),
        'w_uk': w(ks[6], (L, MLA_KV_RANK, MLA_HEADS * MLA_NOPE_DIM), MLA_KV_RANK),
        'w_uv': w(ks[7], (L, MLA_KV_RANK, MLA_HEADS * MLA_V_DIM), MLA_KV_RANK),
        'w_o': w(ks[8], (L, MIX_WIDTH, D_MODEL), MIX_WIDTH),
        'ffn_norm_g': gain(ks[9], (L, D_MODEL)),
        'peer_w_query': w(ks[10], (L, D_MODEL, PEER_HEADS * PEER_QUERY_DIM), D_MODEL),
        'peer_sub_keys': w(ks[11], (L, PEER_HEADS, 2, PEER_N_KEYS, PEER_HALF_DIM), PEER_HALF_DIM),
        'peer_u': w(ks[12], (L, PEER_N_EXPERTS, D_MODEL), D_MODEL),
        'peer_v': w(ks[13], (L, PEER_N_EXPERTS, D_MODEL), PEER_TOPK),
        'final_norm_g': gain(ks[14], (D_MODEL,)),
    }


def reference(x, attn_norm_g, w_in, mla_q_norm_g, mla_kv_norm_g, w_uq, w_uk, w_uv, w_o,
              ffn_norm_g, peer_w_query, peer_sub_keys, peer_u, peer_v, final_norm_g):
    b, s, _ = x.shape
    cos_a, sin_a = rope_tables(s, SWA_HEAD_DIM)
    cos_b, sin_b = rope_tables(s, MLA_ROPE_DIM)
    for layer in range(DEPTH):
        h = rms_norm(x, attn_norm_g[layer])
        proj = jnp.einsum('bsd,df->bsf', h, w_in[layer])
        q_a, k_a, v_a, c_q, c_kv, k_rope = jnp.split(proj, IN_SPLITS, axis=-1)

        def heads(t):
            return t.reshape(b, s, SWA_HEADS, SWA_HEAD_DIM).transpose(0, 2, 1, 3)

        q_a = apply_rope(heads(q_a), cos_a, sin_a)
        k_a = apply_rope(heads(k_a), cos_a, sin_a)
        o_a = dilated_attention(q_a, k_a, heads(v_a)).transpose(0, 2, 1, 3).reshape(b, s, SWA_WIDTH)
        o_b = mla_attention(c_q, c_kv, k_rope, mla_q_norm_g[layer], mla_kv_norm_g[layer],
                            w_uq[layer], w_uk[layer], w_uv[layer], cos_b, sin_b)
        mixed = jnp.concatenate([o_a, o_b], axis=-1)
        x = x + jnp.einsum('bsf,fd->bsd', mixed, w_o[layer])
        h = rms_norm(x, ffn_norm_g[layer])
        x = x + peer_ffn(h, peer_w_query[layer], peer_sub_keys[layer], peer_u[layer], peer_v[layer])
    return rms_norm(x, final_norm_g)
```

```cpp
#include <hip/hip_runtime.h>
#include <cstdio>
#include <cstdint>
namespace nv {
constexpr int S = 4096, D = 1024, NB = 8, M = NB * S, PW = 2080;
constexpr float EPS = 1e-6f;

__device__ __forceinline__ float wsum(float v) {
#pragma unroll
    for (int o = 32; o > 0; o >>= 1) v += __shfl_xor(v, o);
    return v;
}
__device__ __forceinline__ float wmax(float v) {
#pragma unroll
    for (int o = 32; o > 0; o >>= 1) v = fmaxf(v, __shfl_xor(v, o));
    return v;
}

__global__ void rmsnorm_k(const float* __restrict__ in, int ld_in, const float* __restrict__ g, float* __restrict__ out, int ld_out, int ncols, int rows) {
    const int row = blockIdx.x * 4 + (threadIdx.x >> 6), lane = threadIdx.x & 63;
    if (row >= rows) return;
    const float* p = in + (size_t)row * ld_in;
    float s = 0.f;
    for (int c = lane; c < ncols; c += 64) { const float v = p[c]; s += v * v; }
    s = wsum(s);
    const float rs = rsqrtf(s / (float)ncols + EPS);
    float* o = out + (size_t)row * ld_out;
    for (int c = lane; c < ncols; c += 64) o[c] = p[c] * rs * g[c];
}

__global__ void gemm_k(const float* __restrict__ A, int lda, const float* __restrict__ B, int ldb, float* __restrict__ C, int ldc,
                       const float* __restrict__ R, int ldr, int Mm, int N, int K) {
    __shared__ float As[16][64 + 4];
    __shared__ float Bs[16][64 + 4];
    const int tid = threadIdx.x, tx = tid & 15, ty = tid >> 4;
    const int m0 = blockIdx.y * 64, n0 = blockIdx.x * 64;
    float acc[4][4] = {};
    for (int k0 = 0; k0 < K; k0 += 16) {
        {
            const int r = tid >> 2, kk = (tid & 3) * 4;
            const float4 v = *(const float4*)(A + (size_t)(m0 + r) * lda + k0 + kk);
            As[kk + 0][r] = v.x; As[kk + 1][r] = v.y; As[kk + 2][r] = v.z; As[kk + 3][r] = v.w;
        }
        {
            const int kk = tid >> 4, c = (tid & 15) * 4;
#pragma unroll
            for (int j = 0; j < 4; ++j) { const int n = n0 + c + j; Bs[kk][c + j] = (n < N) ? B[(size_t)(k0 + kk) * ldb + n] : 0.f; }
        }
        __syncthreads();
#pragma unroll
        for (int kk = 0; kk < 16; ++kk) {
            float a[4], b[4];
#pragma unroll
            for (int i = 0; i < 4; ++i) { a[i] = As[kk][ty * 4 + i]; b[i] = Bs[kk][tx * 4 + i]; }
#pragma unroll
            for (int i = 0; i < 4; ++i)
#pragma unroll
                for (int j = 0; j < 4; ++j) acc[i][j] = fmaf(a[i], b[j], acc[i][j]);
        }
        __syncthreads();
    }
#pragma unroll
    for (int i = 0; i < 4; ++i)
#pragma unroll
        for (int j = 0; j < 4; ++j) {
            const int r = m0 + ty * 4 + i, n = n0 + tx * 4 + j;
            if (n < N) { float v = acc[i][j]; if (R) v += R[(size_t)r * ldr + n]; C[(size_t)r * ldc + n] = v; }
        }
}

__global__ void rope_k(float* __restrict__ buf, int ld, int col0, int nheads, int hd, int rows) {
    const int half = hd / 2;
    const int idx = blockIdx.x * blockDim.x + threadIdx.x;
    const int per_row = nheads * half;
    if (idx >= rows * per_row) return;
    const int row = idx / per_row, rem = idx % per_row, h = rem / half, i = rem % half;
    const int pos = row % S;
    const float inv = 1.0f / powf(10000.0f, (float)(2 * i) / (float)hd);
    const float ang = (float)pos * inv;
    const float c = cosf(ang), s = sinf(ang);
    float* p = buf + (size_t)row * ld + col0 + h * hd;
    const float x1 = p[i], x2 = p[i + half];
    p[i] = x1 * c - x2 * s; p[i + half] = x2 * c + x1 * s;
}

__global__ void dilated_k(const float* __restrict__ proj, float* __restrict__ mixed_b) {
    __shared__ float sc[4][3 * 129 + 1];
    const int w = threadIdx.x >> 6, lane = threadIdx.x & 63;
    const int gw = blockIdx.x * 4 + w;
    const int h = gw / S, t = gw % S;
    const float* q = proj + (size_t)t * PW + h * 64;
    float* s_ = sc[w];
    float mx = -3.0e38f;
    for (int e = lane; e < 387; e += 64) {
        const int p = e / 129, j = e % 129, kp = t - j * (1 << (2 * p));
        float v = -3.0e38f;
        if (kp >= 0) {
            const float* k = proj + (size_t)kp * PW + 512 + h * 64;
            float a = 0.f;
            for (int d = 0; d < 64; ++d) a = fmaf(q[d], k[d], a);
            v = a * 0.125f;
        }
        s_[e] = v; mx = fmaxf(mx, v);
    }
    mx = wmax(mx);
    float l = 0.f;
    for (int e = lane; e < 387; e += 64) { const float v = s_[e]; const float pz = (v > -1.0e38f) ? expf(v - mx) : 0.f; s_[e] = pz; l += pz; }
    l = wsum(l);
    __syncthreads();
    float o = 0.f;
    for (int e = 0; e < 387; ++e) {
        const float pz = s_[e];
        if (pz != 0.f) { const int p = e / 129, j = e % 129, kp = t - j * (1 << (2 * p)); o = fmaf(pz, proj[(size_t)kp * PW + 1024 + h * 64 + lane], o); }
    }
    mixed_b[(size_t)t * 1024 + h * 64 + lane] = o / l;
}

__global__ void __launch_bounds__(64) mla_k(const float* __restrict__ q, const float* __restrict__ kn, const float* __restrict__ kr, const float* __restrict__ v, float* __restrict__ mixed) {
    __shared__ float Ks[32][96];
    __shared__ float Vs[32][64];
    const int qb = blockIdx.x % (S / 64), h = (blockIdx.x / (S / 64)) % 8, b = blockIdx.x / (S / 64 * 8);
    const int tq = qb * 64 + threadIdx.x;
    const size_t rowq = (size_t)b * S + tq;
    float qr[96], o[64];
    const float scale = 0.10206207261596577f;
#pragma unroll
    for (int d = 0; d < 96; ++d) qr[d] = q[rowq * 768 + h * 96 + d] * scale;
#pragma unroll
    for (int d = 0; d < 64; ++d) o[d] = 0.f;
    float m = -3.0e38f, l = 0.f;
    const int ntile = (qb * 64 + 63) / 32 + 1;
    for (int kt = 0; kt < ntile; ++kt) {
        __syncthreads();
        for (int e = threadIdx.x; e < 32 * 96; e += 64) { const int kk = e / 96, d = e % 96; const size_t rk = (size_t)b * S + kt * 32 + kk;
            Ks[kk][d] = (d < 64) ? kn[rk * 512 + h * 64 + d] : kr[rk * 32 + (d - 64)]; }
        for (int e = threadIdx.x; e < 32 * 64; e += 64) { const int kk = e / 64, d = e % 64; Vs[kk][d] = v[((size_t)b * S + kt * 32 + kk) * 512 + h * 64 + d]; }
        __syncthreads();
        float s[32]; float tm = -3.0e38f;
#pragma unroll
        for (int kk = 0; kk < 32; ++kk) {
            float a = 0.f;
#pragma unroll
            for (int d = 0; d < 96; ++d) a = fmaf(qr[d], Ks[kk][d], a);
            if (kt * 32 + kk > tq) a = -3.0e38f;
            s[kk] = a; tm = fmaxf(tm, a);
        }
        const float mn = fmaxf(m, tm);
        const float alpha = expf(m - mn);
        l *= alpha;
#pragma unroll
        for (int d = 0; d < 64; ++d) o[d] *= alpha;
#pragma unroll
        for (int kk = 0; kk < 32; ++kk) {
            const float pz = (s[kk] > -1.0e38f) ? expf(s[kk] - mn) : 0.f;
            l += pz;
#pragma unroll
            for (int d = 0; d < 64; ++d) o[d] = fmaf(pz, Vs[kk][d], o[d]);
        }
        m = mn;
    }
    const float il = 1.f / l;
#pragma unroll
    for (int d = 0; d < 64; ++d) mixed[rowq * 1024 + 512 + h * 64 + d] = o[d] * il;
}

__global__ void copy_cols_k(const float* __restrict__ in, int ld_in, float* __restrict__ out, int ld_out, int ncols, int rows) {
    const int idx = blockIdx.x * blockDim.x + threadIdx.x;
    if (idx >= rows * ncols) return;
    const int r = idx / ncols, c = idx % ncols;
    out[(size_t)r * ld_out + c] = in[(size_t)r * ld_in + c];
}
__device__ __forceinline__ float gelu_exact(float v) { return 0.5f * v * (1.0f + erff(v * 0.70710678118654752f)); }

__global__ void __launch_bounds__(256) peer_k(const float* __restrict__ h2, const float* __restrict__ qp, const float* __restrict__ subk, const float* __restrict__ U, const float* __restrict__ V,
                                              const float* __restrict__ gfin, float* __restrict__ xo, int ntok) {
    __shared__ float scs[4][16][128];
    __shared__ float tv[4][16][16];
    __shared__ int ti[4][16][16];
    __shared__ float gate[4][128];
    __shared__ int eid[4][128];
    __shared__ unsigned char usedf[4][8][256];
    __shared__ float bvs[4][8][16];
    __shared__ int bcs[4][8][16];
    const int w = threadIdx.x >> 6, lane = threadIdx.x & 63;
    const int tok = blockIdx.x * 4 + w;
    const float* q = qp + (size_t)tok * 2048;
    for (int hp = 0; hp < 16; ++hp)
        for (int n = lane; n < 128; n += 64) {
            const float* k = subk + ((size_t)hp * 128 + n) * 128;
            float a = 0.f;
            for (int c = 0; c < 128; ++c) a = fmaf(q[hp * 128 + c], k[c], a);
            scs[w][hp][n] = a;
        }
    __syncthreads();
    if (lane < 16) {
        float* sl = scs[w][lane];
        for (int r = 0; r < 16; ++r) {
            float best = -3.0e38f; int bi = 0;
            for (int n = 0; n < 128; ++n) { const float vv = sl[n]; if (vv > best) { best = vv; bi = n; } }
            tv[w][lane][r] = best; ti[w][lane][r] = bi; sl[bi] = -3.4e38f;
        }
    }
    __syncthreads();
    if (lane < 8) {
        const int hh = lane;
        for (int c = 0; c < 256; ++c) usedf[w][hh][c] = 0;
        for (int r = 0; r < 16; ++r) {
            float best = -3.0e38f; int bi = 0;
            for (int c = 0; c < 256; ++c) {
                if (usedf[w][hh][c]) continue;
                const float vv = tv[w][hh * 2][c >> 4] + tv[w][hh * 2 + 1][c & 15];
                if (vv > best) { best = vv; bi = c; }
            }
            usedf[w][hh][bi] = 1; bvs[w][hh][r] = best; bcs[w][hh][r] = bi;
        }
        const float mx = bvs[w][hh][0]; float sum = 0.f;
        for (int r = 0; r < 16; ++r) { const float ev = expf(bvs[w][hh][r] - mx); bvs[w][hh][r] = ev; sum += ev; }
        for (int r = 0; r < 16; ++r) { const int bc = bcs[w][hh][r]; gate[w][hh * 16 + r] = bvs[w][hh][r] / sum; eid[w][hh * 16 + r] = ti[w][hh * 2][bc >> 4] * 128 + ti[w][hh * 2 + 1][bc & 15]; }
    }
    __syncthreads();
    const float* hv = h2 + (size_t)tok * 1024;
    float hreg[16];
#pragma unroll
    for (int j = 0; j < 16; ++j) hreg[j] = hv[j * 64 + lane];
    float y[16];
#pragma unroll
    for (int j = 0; j < 16; ++j) y[j] = 0.f;
    for (int k = 0; k < 128; ++k) {
        const int e = eid[w][k];
        const float* ur = U + (size_t)e * 1024;
        float a = 0.f;
#pragma unroll
        for (int j = 0; j < 16; ++j) a = fmaf(ur[j * 64 + lane], hreg[j], a);
        a = wsum(a);
        const float hid = gelu_exact(a) * gate[w][k];
        const float* vr = V + (size_t)e * 1024;
#pragma unroll
        for (int j = 0; j < 16; ++j) y[j] = fmaf(hid, vr[j * 64 + lane], y[j]);
    }
    float* xr = xo + (size_t)tok * 1024;
    float ss = 0.f;
#pragma unroll
    for (int j = 0; j < 16; ++j) { y[j] += xr[j * 64 + lane]; ss += y[j] * y[j]; }
    ss = wsum(ss);
    const float rs = rsqrtf(ss / 1024.f + EPS);
#pragma unroll
    for (int j = 0; j < 16; ++j) xr[j * 64 + lane] = y[j] * rs * gfin[j * 64 + lane];
}

struct Bufs { float *hb, *projb, *q, *kn, *kr, *v, *mixed, *h2c, *qpc; };

inline void run(void* const* d_in, float* out, float* ws, hipStream_t st) {
    const float* x = (const float*)d_in[0]; const float* attn_g = (const float*)d_in[1]; const float* w_in = (const float*)d_in[2];
    const float* qn_g = (const float*)d_in[3]; const float* kvn_g = (const float*)d_in[4]; const float* w_uq = (const float*)d_in[5];
    const float* w_uk = (const float*)d_in[6]; const float* w_uv = (const float*)d_in[7]; const float* w_o = (const float*)d_in[8];
    const float* ffn_g = (const float*)d_in[9]; const float* w_query = (const float*)d_in[10]; const float* subk = (const float*)d_in[11];
    const float* pu = (const float*)d_in[12]; const float* pv = (const float*)d_in[13]; const float* fin_g = (const float*)d_in[14];
    Bufs B; size_t o = 0;
    B.hb = ws + o; o += (size_t)S * D;
    B.projb = ws + o; o += (size_t)S * PW;
    B.q = ws + o; o += (size_t)M * 768;
    B.kn = ws + o; o += (size_t)M * 512;
    B.kr = ws + o; o += (size_t)M * 32;
    B.v = ws + o; o += (size_t)M * 512;
    B.mixed = ws + o; o += (size_t)M * 1024;
    B.h2c = B.hb;
    B.qpc = B.projb;
    for (int b = 0; b < NB; ++b) {
        const float* xb = x + (size_t)b * S * D;
        rmsnorm_k<<<S / 4, 256, 0, st>>>(xb, D, attn_g, B.hb, D, D, S);
        gemm_k<<<dim3((PW + 63) / 64, S / 64), 256, 0, st>>>(B.hb, D, w_in, PW, B.projb, PW, nullptr, 0, S, PW, D);
        rope_k<<<(S * 8 * 32 + 255) / 256, 256, 0, st>>>(B.projb, PW, 0, 8, 64, S);
        rope_k<<<(S * 8 * 32 + 255) / 256, 256, 0, st>>>(B.projb, PW, 512, 8, 64, S);
        dilated_k<<<8 * S / 4, 256, 0, st>>>(B.projb, B.mixed + (size_t)b * S * 1024);
        float* cqn = B.hb; float* ckvn = B.hb + (size_t)S * 256;
        rmsnorm_k<<<S / 4, 256, 0, st>>>(B.projb + 1536, PW, qn_g, cqn, 256, 256, S);
        rmsnorm_k<<<S / 4, 256, 0, st>>>(B.projb + 1792, PW, kvn_g, ckvn, 256, 256, S);
        float* qb_ = B.q + (size_t)b * S * 768;
        gemm_k<<<dim3(768 / 64, S / 64), 256, 0, st>>>(cqn, 256, w_uq, 768, qb_, 768, nullptr, 0, S, 768, 256);
        for (int h = 0; h < 8; ++h) rope_k<<<(S * 16 + 255) / 256, 256, 0, st>>>(qb_, 768, h * 96 + 64, 1, 32, S);
        gemm_k<<<dim3(512 / 64, S / 64), 256, 0, st>>>(ckvn, 256, w_uk, 512, B.kn + (size_t)b * S * 512, 512, nullptr, 0, S, 512, 256);
        gemm_k<<<dim3(512 / 64, S / 64), 256, 0, st>>>(ckvn, 256, w_uv, 512, B.v + (size_t)b * S * 512, 512, nullptr, 0, S, 512, 256);
        float* krb = B.kr + (size_t)b * S * 32;
        copy_cols_k<<<(S * 32 + 255) / 256, 256, 0, st>>>(B.projb + 2048, PW, krb, 32, 32, S);
        rope_k<<<(S * 16 + 255) / 256, 256, 0, st>>>(krb, 32, 0, 1, 32, S);
    }
    mla_k<<<NB * 8 * (S / 64), 64, 0, st>>>(B.q, B.kn, B.kr, B.v, B.mixed);
    gemm_k<<<dim3(D / 64, M / 64), 256, 0, st>>>(B.mixed, 1024, w_o, D, out, D, x, D, M, D, 1024);
    for (int c = 0; c < M / 4096; ++c) {
        float* xc = out + (size_t)c * 4096 * D;
        rmsnorm_k<<<4096 / 4, 256, 0, st>>>(xc, D, ffn_g, B.h2c, D, D, 4096);
        gemm_k<<<dim3(2048 / 64, 4096 / 64), 256, 0, st>>>(B.h2c, D, w_query, 2048, B.qpc, 2048, nullptr, 0, 4096, 2048, D);
        peer_k<<<4096 / 4, 256, 0, st>>>(B.h2c, B.qpc, subk, pu, pv, fin_g, xc, 4096);
    }
}
}

extern "C" void kernel_launch(void* const* d_in, const int* in_sizes, int n_in, void* d_out, int out_size, void* d_ws, size_t ws_size, hipStream_t stream) {
    nv::run(d_in, (float*)d_out, (float*)d_ws, stream);
}
```

```cpp
#include <hip/hip_runtime.h>
#include <hip/hip_cooperative_groups.h>
#include <cstdio>
#include <cstdint>
#include <cmath>
namespace cg = cooperative_groups;
#define DEBUG_CMP 0
#define ONE_LAUNCH 0
#define DEBUG_SEL -1
#define LAS __attribute__((address_space(3)))
#define GAS __attribute__((address_space(1)))
typedef unsigned short bf16_t;
typedef short bf16x8 __attribute__((ext_vector_type(8)));
typedef short s16x4 __attribute__((ext_vector_type(4)));
typedef float f32x4 __attribute__((ext_vector_type(4)));
typedef float f32x16 __attribute__((ext_vector_type(16)));
typedef float f32x2_t __attribute__((ext_vector_type(2)));
typedef __bf16 bf16x2_t __attribute__((ext_vector_type(2)));
typedef unsigned u32x4 __attribute__((ext_vector_type(4)));
typedef unsigned u32x2 __attribute__((ext_vector_type(2)));

constexpr int NB = 8, S = 4096, M = NB * S, D = 1024;
constexpr float NORM_EPS = 1e-6f;
constexpr float LOG2E = 1.4426950408889634f;
constexpr float QSCALE_A = 0.125f * LOG2E;
constexpr float QSCALE_B = 0.10206207261596577f * LOG2E;

__device__ __forceinline__ unsigned cvtpk(float lo, float hi) { f32x2_t v = {lo, hi}; bf16x2_t b = __builtin_convertvector(v, bf16x2_t); return __builtin_bit_cast(unsigned, b); }
__device__ __forceinline__ float bf_lo(unsigned w) { return __builtin_bit_cast(float, w << 16); }
__device__ __forceinline__ float bf_hi(unsigned w) { return __builtin_bit_cast(float, w & 0xffff0000u); }

namespace pg8 {
constexpr int BM = 256, BK = 64, HALF = 128, HTB = HALF * BK * 2, STAGE_BYTES = 8 * HTB, NXCD = 8, WGM = 8;
__host__ __device__ __forceinline__ int lds_byte(int r, int c) { const int st = (r >> 4) * 2 + (c >> 5), rr = r & 15, cc = c & 31, ob = rr * 64 + cc * 2; return st * 1024 + (ob ^ (((ob >> 9) & 1) << 5)); }
__host__ __device__ __forceinline__ void stage_rc(int b, int& R, int& C) { const int st = b / 1024, sb = b % 1024, swz = sb ^ (((sb >> 9) & 1) << 5); R = (st >> 1) * 16 + swz / 64; C = (st & 1) * 32 + (swz % 64) / 2; }
__host__ __device__ __forceinline__ int perm32(int rho) { const int n = rho >> 4, i = rho & 15; return 8 * (i >> 2) + 4 * n + (i & 3); }
struct Unit { int pm, pn; };
struct StaticOrder {
    int nM, nN, nwg, G, c;
    __device__ void init(int Mr, int N, int G_, int c_) { nM = Mr / BM; nN = N / BM; nwg = nM * nN; G = G_; c = c_; }
    __device__ bool next(int i, Unit& u) const {
        const long L = (long)i * G + c; if (L >= nwg) return false;
        int wgid = (int)L; { const int q = nwg / NXCD, r = nwg % NXCD, xcd = wgid % NXCD, off = wgid / NXCD; wgid = (xcd < r ? xcd * (q + 1) : r * (q + 1) + (xcd - r) * q) + off; }
        const int nig = WGM * nN, gid = wgid / nig, fm = gid * WGM, gsz = (nM - fm) < WGM ? (nM - fm) : WGM;
        u.pm = fm + ((wgid % nig) % gsz); u.pn = (wgid % nig) / gsz; return true;
    }
};
template <class Epi, class Sched, class G>
__device__ __forceinline__ void gemm_phase(LAS unsigned char* lds, const G g, const Sched& Sch, const Epi& E) {
    const int tid = threadIdx.x, wid = __builtin_amdgcn_readfirstlane(tid >> 6), lane = tid & 63, wr = wid >> 2, wc = wid & 3, fr = lane & 15, fq = lane >> 4;
    const int K = g.K, nt = K / BK;
    unsigned voffA[2], voffB[2];
#pragma unroll
    for (int i = 0; i < 2; ++i) { int R, C; stage_rc(tid * 16 + i * 8192, R, C); const int Rb = Epi::PERM ? ((R & ~31) + perm32(R & 31)) : R;
        voffA[i] = (unsigned)(R * g.lda + C) * 2u; voffB[i] = (unsigned)(Rb * g.ldb + C) * 2u; }
    const size_t kstep = (size_t)(BK * 2);
    const size_t hstepA = (size_t)HALF * g.lda * 2, hstepB = (size_t)HALF * g.ldb * 2;
    const unsigned ldsw = (unsigned)wid * 1024u;
    const int aoff = lds_byte(wr * 64 + fr, fq * 8), boff = lds_byte(wc * 32 + fr, fq * 8);
#define PG8_SA(b, h) (((b) * 2 + (h)) * HTB)
#define PG8_SB(b, h) ((4 + (b) * 2 + (h)) * HTB)
#define PG8_STAGE(bufoff, gbase, voff) do { _Pragma("unroll") for (int _i = 0; _i < 2; ++_i) \
        __builtin_amdgcn_global_load_lds((const unsigned*)((const char*)(gbase) + (voff)[_i]), (LAS unsigned*)(lds + (bufoff) + ldsw + _i * 8192), 16, 0, 0); } while (0)
#define PG8_LDA(dst, b, h) do { _Pragma("unroll") for (int m = 0; m < 4; ++m) _Pragma("unroll") for (int k = 0; k < 2; ++k) dst[m][k] = *(const LAS bf16x8*)(lds + PG8_SA(b, h) + aoff + m * 2048 + k * 1024); } while (0)
#define PG8_LDB(dst, b, h) do { _Pragma("unroll") for (int n = 0; n < 2; ++n) _Pragma("unroll") for (int k = 0; k < 2; ++k) dst[n][k] = *(const LAS bf16x8*)(lds + PG8_SB(b, h) + boff + n * 2048 + k * 1024); } while (0)
#define PG8_MMA(ai, bj, At, Bt) do { __builtin_amdgcn_s_setprio(1); _Pragma("unroll") for (int m = 0; m < 4; ++m) _Pragma("unroll") for (int n = 0; n < 2; ++n) _Pragma("unroll") for (int k = 0; k < 2; ++k) \
        acc[ai][bj][m][n] = __builtin_amdgcn_mfma_f32_16x16x32_bf16(Bt[n][k], At[m][k], acc[ai][bj][m][n], 0, 0, 0); __builtin_amdgcn_s_setprio(0); } while (0)
#define PG8_WAIT_V(n) asm volatile("s_waitcnt vmcnt(" #n ")" ::: "memory")
#define PG8_WAIT_L(n) asm volatile("s_waitcnt lgkmcnt(" #n ")" ::: "memory")
#define PG8_BAR __builtin_amdgcn_s_barrier()
#define PG8_SCHED __builtin_amdgcn_sched_barrier(0)
    Unit cur, nxt; int ui = 0;
    if (!Sch.next(0, cur)) return;
    f32x4 acc[2][2][4][2];
#pragma unroll
    for (int a = 0; a < 2; ++a)
#pragma unroll
        for (int b = 0; b < 2; ++b)
#pragma unroll
            for (int m = 0; m < 4; ++m)
#pragma unroll
                for (int n = 0; n < 2; ++n) acc[a][b][m][n] = (f32x4){0.f, 0.f, 0.f, 0.f};
    bf16x8 At[4][2], B0[2][2], B1[2][2];
    const char* cA = g.a_base(cur); const char* cB = g.b_base(cur);
    PG8_STAGE(PG8_SB(0, 0), cB, voffB); PG8_STAGE(PG8_SB(0, 1), cB + hstepB, voffB); PG8_STAGE(PG8_SA(0, 0), cA, voffA); PG8_STAGE(PG8_SA(0, 1), cA + hstepA, voffA);
    if (wr == 1) PG8_BAR;
    PG8_WAIT_V(2); PG8_BAR;
    PG8_STAGE(PG8_SB(1, 0), cB + kstep, voffB); PG8_STAGE(PG8_SA(1, 0), cA + kstep, voffA); PG8_STAGE(PG8_SB(1, 1), cB + hstepB + kstep, voffB);
    PG8_WAIT_V(6); PG8_BAR;
    for (;;) {
        const bool has_next = Sch.next(ui + 1, nxt);
        const char* nA = has_next ? g.a_base(nxt) : cA; const char* nB = has_next ? g.b_base(nxt) : cB;
        for (int t = 0; t < nt; t += 2) {
            const bool last = (t == nt - 2);
            const char* a1 = cA + (size_t)(t + 1) * kstep;
            const char* a2 = last ? nA : cA + (size_t)(t + 2) * kstep; const char* b2 = last ? nB : cB + (size_t)(t + 2) * kstep;
            const char* a3 = a2 + kstep; const char* b3 = b2 + kstep;
            PG8_LDB(B0, 0, 0); PG8_LDB(B1, 0, 1); PG8_SCHED; PG8_LDA(At, 0, 0); PG8_STAGE(PG8_SA(1, 1), a1 + hstepA, voffA);
            PG8_WAIT_V(8); PG8_WAIT_L(0); PG8_BAR; PG8_MMA(0, 0, At, B0); PG8_MMA(0, 1, At, B1); PG8_BAR; PG8_SCHED;
            PG8_LDA(At, 0, 1); PG8_STAGE(PG8_SB(0, 0), b2, voffB); PG8_STAGE(PG8_SB(0, 1), b2 + hstepB, voffB); PG8_STAGE(PG8_SA(0, 0), a2, voffA);
            PG8_WAIT_V(8); PG8_WAIT_L(0); PG8_BAR; PG8_MMA(1, 0, At, B0); PG8_MMA(1, 1, At, B1); PG8_BAR; PG8_SCHED;
            PG8_LDB(B0, 1, 0); PG8_LDB(B1, 1, 1); PG8_SCHED; PG8_LDA(At, 1, 0); PG8_STAGE(PG8_SA(0, 1), a2 + hstepA, voffA);
            PG8_WAIT_V(8); PG8_WAIT_L(0); PG8_BAR; PG8_MMA(0, 0, At, B0); PG8_MMA(0, 1, At, B1); PG8_BAR; PG8_SCHED;
            PG8_LDA(At, 1, 1); PG8_STAGE(PG8_SB(1, 0), b3, voffB); PG8_STAGE(PG8_SB(1, 1), b3 + hstepB, voffB); PG8_STAGE(PG8_SA(1, 0), a3, voffA);
            PG8_WAIT_V(8); PG8_WAIT_L(0); PG8_BAR; PG8_MMA(1, 0, At, B0); PG8_MMA(1, 1, At, B1); PG8_BAR; PG8_SCHED;
        }
        if (wr == 0) PG8_BAR;
        E(acc, cur, wr, wc, fr, fq);
        if (!has_next) break;
#pragma unroll
        for (int a = 0; a < 2; ++a)
#pragma unroll
            for (int b = 0; b < 2; ++b)
#pragma unroll
                for (int m = 0; m < 4; ++m)
#pragma unroll
                    for (int n = 0; n < 2; ++n) acc[a][b][m][n] = (f32x4){0.f, 0.f, 0.f, 0.f};
        cur = nxt; cA = nA; cB = nB; ++ui;
        if (wr == 1) PG8_BAR;
    }
    PG8_WAIT_V(0);
    PG8_BAR;
#undef PG8_SA
#undef PG8_SB
#undef PG8_STAGE
#undef PG8_LDA
#undef PG8_LDB
#undef PG8_MMA
#undef PG8_WAIT_V
#undef PG8_WAIT_L
#undef PG8_BAR
#undef PG8_SCHED
}
}
constexpr size_t MiB = 1u << 20;
constexpr size_t WS_CTL = 0;
constexpr size_t WS_WIN = 2 * MiB;
constexpr size_t WS_WKR = 6 * MiB;
constexpr size_t WS_WUQ = 7 * MiB;
constexpr size_t WS_WUKV = 8 * MiB;
constexpr size_t WS_WO = 9 * MiB;
constexpr size_t WS_WQ = 11 * MiB;
constexpr size_t WS_KEYS = 15 * MiB;
constexpr size_t WS_ROPE = 16 * MiB;
constexpr size_t WS_U = 18 * MiB;
constexpr size_t WS_V = 50 * MiB;
constexpr size_t WS_SSQ1 = 82 * MiB;
constexpr size_t WS_SSQ2 = 84 * MiB;
constexpr size_t WS_XN = 96 * MiB;
constexpr size_t WS_MIX = WS_XN;
constexpr size_t WS_QA = 160 * MiB, WS_KA = 192 * MiB, WS_VA = 224 * MiB;
constexpr size_t WS_X2B = 160 * MiB;
constexpr size_t WS_CQ = 256 * MiB, WS_CKV = 272 * MiB;
constexpr size_t WS_KR = 288 * MiB;
constexpr size_t WS_QB = 292 * MiB;
constexpr size_t WS_KN = 340 * MiB, WS_VB = 372 * MiB;
constexpr size_t WS_X2 = 292 * MiB;
constexpr size_t WS_END_OPT = 420 * MiB;
constexpr size_t DO_OP = 0, DO_LSE = 96 * MiB;

struct Args { const float* in[15]; float* out; unsigned char* ws; int ph_lo, ph_hi; };

struct Frame {
    LAS unsigned char* lds;
    int tid, lane, wave, vcu, G;
    const float* in[15]; float* out; unsigned char* ws;
};

__device__ __forceinline__ float wave_sum(float v) {
#pragma unroll
    for (int o = 1; o < 64; o <<= 1) v += __shfl_xor(v, o);
    return v;
}

__device__ __forceinline__ int perm_win(int np) {
    if (np < 1024) { const int hb = np & ~63, p = np & 63; return hb + (p >> 1) + ((p & 1) << 5); }
    return np;
}
__device__ __forceinline__ int perm_wkr(int np) { return 2048 + (np >> 1) + ((np & 1) << 4); }
__device__ __forceinline__ int perm_wuq(int np) { const int h = np / 96, p = np % 96; if (p < 64) return np; const int q = p - 64; return h * 96 + 64 + (q >> 1) + ((q & 1) << 4); }

template <int PERM>
__device__ __forceinline__ void transpose_item(const float* __restrict__ W, int K, int N, const float* __restrict__ gk, bf16_t* __restrict__ WT, int row_off, LAS float* scr, int item, int nblk, int lane) {
    const int kb = item / nblk, nb = item % nblk, k0 = 64 * kb, n0 = 32 * nb;
    const int npx = n0 + (lane & 31);
    const int nl = PERM == 1 ? perm_win(npx) : PERM == 2 ? perm_wkr(npx) : PERM == 3 ? perm_wuq(npx) : npx;
#pragma unroll 8
    for (int i = 0; i < 32; ++i) { const int kk = 2 * i + (lane >> 5); float v = W[(size_t)(k0 + kk) * N + nl]; if (gk) v *= gk[k0 + kk]; scr[kk * 33 + (lane & 31)] = v; }
    asm volatile("s_waitcnt lgkmcnt(0)" ::: "memory");
    const int c = lane & 7;
#pragma unroll
    for (int j = 0; j < 4; ++j) { const int n = (lane >> 3) + 8 * j; const LAS float* s = scr + (8 * c) * 33 + n;
        u32x4 o; o.x = cvtpk(s[0 * 33], s[1 * 33]); o.y = cvtpk(s[2 * 33], s[3 * 33]); o.z = cvtpk(s[4 * 33], s[5 * 33]); o.w = cvtpk(s[6 * 33], s[7 * 33]);
        *(u32x4*)(WT + (size_t)(row_off + n0 + n) * K + k0 + 8 * c) = o; }
    asm volatile("s_waitcnt lgkmcnt(0)" ::: "memory");
}

__device__ __forceinline__ void p0_prologue(Frame& F) {
    LAS float* scr = (LAS float*)(F.lds + F.wave * 16384);
    const int gw = F.vcu * 8 + F.wave, NGW = F.G * 8, lane = F.lane;
    unsigned char* ws = F.ws;
    constexpr int I_WIN = (1024 / 64) * (2048 / 32), I_WKR = (1024 / 64) * 1, I_WUQ = (256 / 64) * (768 / 32), I_WUK = (256 / 64) * (512 / 32), I_WO = (1024 / 64) * (1024 / 32), I_WQ = (1024 / 64) * (2048 / 32);
    constexpr int NIT = I_WIN + I_WKR + I_WUQ + 2 * I_WUK + I_WO + I_WQ;
    for (int it = gw; it < NIT; it += NGW) {
        int r = it;
        if (r < I_WIN) { transpose_item<1>(F.in[2], 1024, 2080, nullptr, (bf16_t*)(ws + WS_WIN), 0, scr, r, 2048 / 32, lane); continue; } r -= I_WIN;
        if (r < I_WKR) { transpose_item<2>(F.in[2], 1024, 2080, nullptr, (bf16_t*)(ws + WS_WKR), 0, scr, r, 1, lane); continue; } r -= I_WKR;
        if (r < I_WUQ) { transpose_item<3>(F.in[5], 256, 768, F.in[3], (bf16_t*)(ws + WS_WUQ), 0, scr, r, 768 / 32, lane); continue; } r -= I_WUQ;
        if (r < I_WUK) { transpose_item<0>(F.in[6], 256, 512, F.in[4], (bf16_t*)(ws + WS_WUKV), 0, scr, r, 512 / 32, lane); continue; } r -= I_WUK;
        if (r < I_WUK) { transpose_item<0>(F.in[7], 256, 512, F.in[4], (bf16_t*)(ws + WS_WUKV), 512, scr, r, 512 / 32, lane); continue; } r -= I_WUK;
        if (r < I_WO) { transpose_item<0>(F.in[8], 1024, 1024, nullptr, (bf16_t*)(ws + WS_WO), 0, scr, r, 1024 / 32, lane); continue; } r -= I_WO;
        transpose_item<0>(F.in[10], 1024, 2048, F.in[9], (bf16_t*)(ws + WS_WQ), 0, scr, r, 2048 / 32, lane);
    }
    for (int rr = gw; rr < M + 2 * 16384; rr += NGW) {
        const float* src; bf16_t* dst; const float* g; bool norm;
        if (rr < M) { src = F.in[0] + (size_t)rr * 1024; dst = (bf16_t*)(ws + WS_XN) + (size_t)rr * 1024; g = F.in[1]; norm = true; }
        else if (rr < M + 16384) { const int e = rr - M; src = F.in[12] + (size_t)e * 1024; dst = (bf16_t*)(ws + WS_U) + (size_t)e * 1024; g = F.in[9]; norm = false; }
        else { const int e = rr - M - 16384; src = F.in[13] + (size_t)e * 1024; dst = (bf16_t*)(ws + WS_V) + (size_t)e * 1024; g = nullptr; norm = false; }
        f32x4 v[4]; float ss = 0.f;
#pragma unroll
        for (int j = 0; j < 4; ++j) { v[j] = *(const f32x4*)(src + 256 * j + 4 * lane); ss += (v[j].x * v[j].x + v[j].y * v[j].y) + (v[j].z * v[j].z + v[j].w * v[j].w); }
        float rs = 1.f;
        if (norm) rs = rsqrtf(wave_sum(ss) * (1.f / 1024.f) + NORM_EPS);
#pragma unroll
        for (int j = 0; j < 4; ++j) { f32x4 gg = {1.f, 1.f, 1.f, 1.f}; if (g) gg = *(const f32x4*)(g + 256 * j + 4 * lane);
            u32x2 o; o.x = cvtpk(v[j].x * rs * gg.x, v[j].y * rs * gg.y); o.y = cvtpk(v[j].z * rs * gg.z, v[j].w * rs * gg.w);
            *(u32x2*)(dst + 256 * j + 4 * lane) = o; }
    }
    {
        const int gt = F.vcu * 512 + F.tid, NT = F.G * 512;
        for (int i = gt; i < 262144 / 8; i += NT) { const f32x4 a = *(const f32x4*)(F.in[11] + (size_t)i * 8), b = *(const f32x4*)(F.in[11] + (size_t)i * 8 + 4);
            u32x4 o; o.x = cvtpk(a.x, a.y); o.y = cvtpk(a.z, a.w); o.z = cvtpk(b.x, b.y); o.w = cvtpk(b.z, b.w); *(u32x4*)((bf16_t*)(ws + WS_KEYS) + (size_t)i * 8) = o; }
        float* CA = (float*)(ws + WS_ROPE); float* SA = CA + 4096 * 32; float* CB = SA + 4096 * 32; float* SB = CB + 4096 * 16;
        for (int i = gt; i < 4096 * 32; i += NT) { const int pos = i >> 5, k = i & 31; const float inv = 1.0f / powf(10000.0f, (float)(2 * k) / 64.0f); const float ang = (float)pos * inv; CA[i] = cosf(ang); SA[i] = sinf(ang); }
        for (int i = gt; i < 4096 * 16; i += NT) { const int pos = i >> 4, k = i & 15; const float inv = 1.0f / powf(10000.0f, (float)(2 * k) / 32.0f); const float ang = (float)pos * inv; CB[i] = cosf(ang); SB[i] = sinf(ang); }
    }
}

struct GemmPlain {
    const bf16_t* A; const bf16_t* Bt; int K, lda, ldb;
    __device__ __forceinline__ const char* a_base(const pg8::Unit& u) const { return (const char*)(A + (size_t)u.pm * 256 * lda); }
    __device__ __forceinline__ const char* b_base(const pg8::Unit& u) const { return (const char*)(Bt + (size_t)u.pn * 256 * ldb); }
};
struct GemmUp {
    const bf16_t* CQ; const bf16_t* CKV; const bf16_t* WUQ; const bf16_t* WUKV; int K, lda, ldb;
    __device__ __forceinline__ const char* a_base(const pg8::Unit& u) const { return (const char*)((u.pn < 3 ? CQ : CKV) + (size_t)u.pm * 256 * 256); }
    __device__ __forceinline__ const char* b_base(const pg8::Unit& u) const { return (const char*)(u.pn < 3 ? WUQ + (size_t)u.pn * 256 * 256 : WUKV + (size_t)(u.pn - 3) * 256 * 256); }
};

__device__ __forceinline__ void rope4(f32x4& v0, f32x4& v1, const f32x4 cs, const f32x4 sn) {
    const f32x4 a = v0, b = v1;
    v0.x = a.x * cs.x - a.y * sn.x; v0.y = a.y * cs.x + a.x * sn.x; v0.z = a.z * cs.y - a.w * sn.y; v0.w = a.w * cs.y + a.z * sn.y;
    v1.x = b.x * cs.z - b.y * sn.z; v1.y = b.y * cs.z + b.x * sn.z; v1.z = b.z * cs.w - b.w * sn.w; v1.w = b.w * cs.w + b.z * sn.w;
}
__device__ __forceinline__ void store8(bf16_t* p, const f32x4 v0, const f32x4 v1) { u32x4 w; w.x = cvtpk(v0.x, v0.y); w.y = cvtpk(v0.z, v0.w); w.z = cvtpk(v1.x, v1.y); w.w = cvtpk(v1.z, v1.w); *(u32x4*)p = w; }
__device__ __forceinline__ float dot4(const f32x4 v) { return (v.x * v.x + v.y * v.y) + (v.z * v.z + v.w * v.w); }

struct EpiP1 {
    static constexpr bool PERM = true;
    bf16_t *QA, *KA, *VA, *CQ, *CKV; float* SSQ1; const float *CA, *SA;
    __device__ __forceinline__ void operator()(const f32x4 (&acc)[2][2][4][2], const pg8::Unit& u, int wr, int wc, int fr, int fq) const {
        const int pn = u.pn, row0 = u.pm * 256 + wr * 64 + fr, cw = wc * 32 + 8 * fq;
        if (pn < 4) {
            bf16_t* base = pn < 2 ? QA : KA; const float sc = pn < 2 ? QSCALE_A : 1.f; const int colt = (pn & 1) * 256 + cw;
#pragma unroll
            for (int ai = 0; ai < 2; ++ai)
#pragma unroll
                for (int m = 0; m < 4; ++m) { const int row = row0 + ai * 128 + m * 16, pos = row & (S - 1);
#pragma unroll
                    for (int bj = 0; bj < 2; ++bj) { const int col = colt + bj * 128, i0 = (col & 63) >> 1;
                        const f32x4 cs = *(const f32x4*)(CA + pos * 32 + i0), sn = *(const f32x4*)(SA + pos * 32 + i0);
                        f32x4 v0 = acc[ai][bj][m][0] * sc, v1 = acc[ai][bj][m][1] * sc; rope4(v0, v1, cs, sn);
                        store8(base + (size_t)row * 512 + col, v0, v1); } }
        } else if (pn < 6) {
            const int colt = (pn & 1) * 256 + cw;
#pragma unroll
            for (int ai = 0; ai < 2; ++ai)
#pragma unroll
                for (int m = 0; m < 4; ++m) { const int row = row0 + ai * 128 + m * 16;
#pragma unroll
                    for (int bj = 0; bj < 2; ++bj) store8(VA + (size_t)row * 512 + colt + bj * 128, acc[ai][bj][m][0], acc[ai][bj][m][1]); }
        } else {
            bf16_t* base = pn == 6 ? CQ : CKV;
#pragma unroll
            for (int ai = 0; ai < 2; ++ai)
#pragma unroll
                for (int m = 0; m < 4; ++m) { const int row = row0 + ai * 128 + m * 16; float s = 0.f;
#pragma unroll
                    for (int bj = 0; bj < 2; ++bj) { store8(base + (size_t)row * 256 + cw + bj * 128, acc[ai][bj][m][0], acc[ai][bj][m][1]); s += dot4(acc[ai][bj][m][0]) + dot4(acc[ai][bj][m][1]); }
                    s += __shfl_xor(s, 16); s += __shfl_xor(s, 32);
                    if (fq == 0) SSQ1[(size_t)row * 8 + (pn - 6) * 4 + wc] = s; }
        }
    }
};
struct EpiP2 {
    static constexpr bool PERM = true;
    bf16_t *QB, *KN, *VB; const float* SSQ1; const float *CB, *SB;
    __device__ __forceinline__ void operator()(const f32x4 (&acc)[2][2][4][2], const pg8::Unit& u, int wr, int wc, int fr, int fq) const {
        const int pn = u.pn, row0 = u.pm * 256 + wr * 64 + fr, cw = wc * 32 + 8 * fq, grp = pn < 3 ? 0 : 1;
#pragma unroll
        for (int ai = 0; ai < 2; ++ai)
#pragma unroll
            for (int m = 0; m < 4; ++m) { const int row = row0 + ai * 128 + m * 16, pos = row & (S - 1);
                const f32x4 sq = *(const f32x4*)(SSQ1 + (size_t)row * 8 + grp * 4);
                const float rs = rsqrtf(((sq.x + sq.y) + (sq.z + sq.w)) * (1.f / 256.f) + NORM_EPS);
                if (pn < 3) {
#pragma unroll
                    for (int bj = 0; bj < 2; ++bj) { const int col = pn * 256 + bj * 128 + cw, p = col % 96; const float sc = rs * QSCALE_B;
                        f32x4 v0 = acc[ai][bj][m][0] * sc, v1 = acc[ai][bj][m][1] * sc;
                        if (p >= 64) { const int i0 = (p - 64) >> 1; const f32x4 cs = *(const f32x4*)(CB + pos * 16 + i0), sn = *(const f32x4*)(SB + pos * 16 + i0); rope4(v0, v1, cs, sn); }
                        store8(QB + (size_t)row * 768 + col, v0, v1); }
                } else {
                    bf16_t* base = pn < 5 ? KN : VB; const int colt = ((pn - 3) & 1) * 256 + cw;
#pragma unroll
                    for (int bj = 0; bj < 2; ++bj) store8(base + (size_t)row * 512 + colt + bj * 128, acc[ai][bj][m][0] * rs, acc[ai][bj][m][1] * rs);
                }
            }
    }
};
struct EpiP4 {
    static constexpr bool PERM = true;
    const float* X; float* X2; bf16_t* X2B; float* SSQ2;
    __device__ __forceinline__ void operator()(const f32x4 (&acc)[2][2][4][2], const pg8::Unit& u, int wr, int wc, int fr, int fq) const {
        const int row0 = u.pm * 256 + wr * 64 + fr, colt = u.pn * 256 + wc * 32 + 8 * fq;
#pragma unroll
        for (int ai = 0; ai < 2; ++ai)
#pragma unroll
            for (int m = 0; m < 4; ++m) { const int row = row0 + ai * 128 + m * 16; float s = 0.f;
#pragma unroll
                for (int bj = 0; bj < 2; ++bj) { const size_t off = (size_t)row * 1024 + colt + bj * 128;
                    const f32x4 v0 = acc[ai][bj][m][0] + *(const f32x4*)(X + off), v1 = acc[ai][bj][m][1] + *(const f32x4*)(X + off + 4);
                    *(f32x4*)(X2 + off) = v0; *(f32x4*)(X2 + off + 4) = v1; store8(X2B + off, v0, v1); s += dot4(v0) + dot4(v1); }
                s += __shfl_xor(s, 16); s += __shfl_xor(s, 32);
                if (fq == 0) SSQ2[(size_t)row * 16 + u.pn * 4 + wc] = s; }
    }
};
struct EpiP5 {
    static constexpr bool PERM = true;
    bf16_t* QP; const float* SSQ2;
    __device__ __forceinline__ void operator()(const f32x4 (&acc)[2][2][4][2], const pg8::Unit& u, int wr, int wc, int fr, int fq) const {
        const int row0 = u.pm * 256 + wr * 64 + fr, colt = u.pn * 256 + wc * 32 + 8 * fq;
#pragma unroll
        for (int ai = 0; ai < 2; ++ai)
#pragma unroll
            for (int m = 0; m < 4; ++m) { const int row = row0 + ai * 128 + m * 16;
                const f32x4* sp = (const f32x4*)(SSQ2 + (size_t)row * 16); const f32x4 a = sp[0], b = sp[1], c = sp[2], d = sp[3];
                const float ss = ((a.x + a.y) + (a.z + a.w)) + ((b.x + b.y) + (b.z + b.w)) + ((c.x + c.y) + (c.z + c.w)) + ((d.x + d.y) + (d.z + d.w));
                const float rs = rsqrtf(ss * (1.f / 1024.f) + NORM_EPS);
#pragma unroll
                for (int bj = 0; bj < 2; ++bj) store8(QP + (size_t)row * 2048 + colt + bj * 128, acc[ai][bj][m][0] * rs, acc[ai][bj][m][1] * rs); }
    }
};

__device__ __forceinline__ void p1_krope(Frame& F) {
    const bf16_t* XN = (const bf16_t*)(F.ws + WS_XN); const bf16_t* WK = (const bf16_t*)(F.ws + WS_WKR); bf16_t* KR = (bf16_t*)(F.ws + WS_KR);
    const float* CB = (const float*)(F.ws + WS_ROPE) + 2 * 4096 * 32; const float* SB = CB + 4096 * 16;
    const int lane = F.lane, fr = lane & 15, fq = lane >> 4;
    for (int blk = F.vcu; blk < M / 128; blk += F.G) {
        const int row0 = blk * 128 + F.wave * 16;
        f32x4 c0 = {0.f, 0.f, 0.f, 0.f}, c1 = {0.f, 0.f, 0.f, 0.f};
        const bf16_t* ap = XN + (size_t)(row0 + fr) * 1024 + 8 * fq;
        const bf16_t* b0p = WK + (size_t)fr * 1024 + 8 * fq; const bf16_t* b1p = WK + (size_t)(16 + fr) * 1024 + 8 * fq;
#pragma unroll 4
        for (int ks = 0; ks < 32; ++ks) {
            const bf16x8 a = *(const bf16x8*)(ap + ks * 32), b0 = *(const bf16x8*)(b0p + ks * 32), b1 = *(const bf16x8*)(b1p + ks * 32);
            c0 = __builtin_amdgcn_mfma_f32_16x16x32_bf16(b0, a, c0, 0, 0, 0);
            c1 = __builtin_amdgcn_mfma_f32_16x16x32_bf16(b1, a, c1, 0, 0, 0);
        }
        const int row = row0 + fr, pos = row & (S - 1);
        u32x2 w0, w1;
        { const int i = 2 * fq; const float ca = CB[pos * 16 + i], sa = SB[pos * 16 + i], cb = CB[pos * 16 + i + 1], sb = SB[pos * 16 + i + 1];
          w0.x = cvtpk(c0.x * ca - c0.y * sa, c0.y * ca + c0.x * sa); w0.y = cvtpk(c0.z * cb - c0.w * sb, c0.w * cb + c0.z * sb); }
        { const int i = 8 + 2 * fq; const float ca = CB[pos * 16 + i], sa = SB[pos * 16 + i], cb = CB[pos * 16 + i + 1], sb = SB[pos * 16 + i + 1];
          w1.x = cvtpk(c1.x * ca - c1.y * sa, c1.y * ca + c1.x * sa); w1.y = cvtpk(c1.z * cb - c1.w * sb, c1.w * cb + c1.z * sb); }
        *(u32x2*)(KR + (size_t)row * 32 + 4 * fq) = w0; *(u32x2*)(KR + (size_t)row * 32 + 16 + 4 * fq) = w1;
    }
}
constexpr int AT_SLOT = 20480, AT_KB = 0, AT_VB = 12288;
__device__ __forceinline__ int crow(int r, int hi) { return (r & 3) + 8 * (r >> 2) + 4 * hi; }
__device__ __forceinline__ s16x4 vtr(const LAS unsigned char* p) { return __builtin_bit_cast(s16x4, __builtin_amdgcn_ds_read_tr16_b64_v4i16((LAS s16x4*)p)); }

template <int NKS>
struct AttnCore {
    bf16x8 qr[NKS]; f32x16 o0, o1; float m, l;
    __device__ __forceinline__ void init() { m = -1.0e30f; l = 0.f;
#pragma unroll
        for (int r = 0; r < 16; ++r) { o0[r] = 0.f; o1[r] = 0.f; } }
    template <class MaskF>
    __device__ __forceinline__ void tile(const LAS unsigned char* slot, int lane, bool need_mask, const MaskF& valid) {
        const int r32 = lane & 31, hi = lane >> 5;
        f32x16 p0, p1;
#pragma unroll
        for (int r = 0; r < 16; ++r) { p0[r] = 0.f; p1[r] = 0.f; }
        const LAS unsigned char* kb = slot + AT_KB + hi * 1024 + r32 * 16;
#pragma unroll
        for (int d0 = 0; d0 < NKS; ++d0) {
            const bf16x8 b0 = *(const LAS bf16x8*)(kb + d0 * 2048), b1 = *(const LAS bf16x8*)(kb + d0 * 2048 + 512);
            p0 = __builtin_amdgcn_mfma_f32_32x32x16_bf16(b0, qr[d0], p0, 0, 0, 0);
            p1 = __builtin_amdgcn_mfma_f32_32x32x16_bf16(b1, qr[d0], p1, 0, 0, 0);
        }
        if (need_mask) {
#pragma unroll
            for (int r = 0; r < 16; ++r) { const int kk = crow(r, hi); if (!valid(kk)) p0[r] = -INFINITY; if (!valid(kk + 32)) p1[r] = -INFINITY; }
        }
        float mx = fmaxf(p0[0], p1[0]);
#pragma unroll
        for (int r = 1; r < 16; ++r) mx = fmaxf(mx, fmaxf(p0[r], p1[r]));
        mx = fmaxf(mx, __shfl_xor(mx, 32));
        const float mn = fmaxf(m, mx), alpha = __builtin_amdgcn_exp2f(m - mn);
        m = mn;
        float sum = 0.f;
#pragma unroll
        for (int r = 0; r < 16; ++r) { p0[r] = __builtin_amdgcn_exp2f(p0[r] - mn); p1[r] = __builtin_amdgcn_exp2f(p1[r] - mn); sum += p0[r] + p1[r]; }
        l = l * alpha + sum;
#pragma unroll
        for (int r = 0; r < 16; ++r) { o0[r] *= alpha; o1[r] *= alpha; }
        u32x4 pw[4];
        pw[0] = (u32x4){cvtpk(p0[0], p0[1]), cvtpk(p0[2], p0[3]), cvtpk(p0[4], p0[5]), cvtpk(p0[6], p0[7])};
        pw[1] = (u32x4){cvtpk(p0[8], p0[9]), cvtpk(p0[10], p0[11]), cvtpk(p0[12], p0[13]), cvtpk(p0[14], p0[15])};
        pw[2] = (u32x4){cvtpk(p1[0], p1[1]), cvtpk(p1[2], p1[3]), cvtpk(p1[4], p1[5]), cvtpk(p1[6], p1[7])};
        pw[3] = (u32x4){cvtpk(p1[8], p1[9]), cvtpk(p1[10], p1[11]), cvtpk(p1[12], p1[13]), cvtpk(p1[14], p1[15])};
        const LAS unsigned char* vb = slot + AT_VB + ((lane >> 4) & 1) * 32 + (lane & 3) * 8 + (4 * hi + ((lane & 15) >> 2)) * 64;
#pragma unroll
        for (int s = 0; s < 4; ++s) {
            const s16x4 lo0 = vtr(vb + s * 1024), hi0 = vtr(vb + s * 1024 + 512), lo1 = vtr(vb + 4096 + s * 1024), hi1 = vtr(vb + 4096 + s * 1024 + 512);
            const bf16x8 v0 = {lo0[0], lo0[1], lo0[2], lo0[3], hi0[0], hi0[1], hi0[2], hi0[3]}, v1 = {lo1[0], lo1[1], lo1[2], lo1[3], hi1[0], hi1[1], hi1[2], hi1[3]};
            const bf16x8 pb = __builtin_bit_cast(bf16x8, pw[s]);
            o0 = __builtin_amdgcn_mfma_f32_32x32x16_bf16(v0, pb, o0, 0, 0, 0);
            o1 = __builtin_amdgcn_mfma_f32_32x32x16_bf16(v1, pb, o1, 0, 0, 0);
        }
    }
    __device__ __forceinline__ float ltot() const { return l + __shfl_xor(l, 32); }
};

__device__ __forceinline__ void glds16(const void* gsrc, LAS unsigned char* dst) { __builtin_amdgcn_global_load_lds((const unsigned*)gsrc, (LAS unsigned*)dst, 16, 0, 0); }

__device__ __forceinline__ void p3a_dilated(Frame& F) {
    const bf16_t* QA = (const bf16_t*)(F.ws + WS_QA); const bf16_t* KA = (const bf16_t*)(F.ws + WS_KA); const bf16_t* VA = (const bf16_t*)(F.ws + WS_VA);
    bf16_t* OP = (bf16_t*)((unsigned char*)F.out + DO_OP); float* LSE = (float*)((unsigned char*)F.out + DO_LSE);
    const int lane = F.lane, w = F.wave, r32 = lane & 31, hi = lane >> 5;
    constexpr int UPC = 3072 / 256;
    for (int i = 0; i < UPC; ++i) {
        const int e = F.vcu * UPC + i;
        if (e >= 3072) break;
        const int bh = e / 48, rem = e % 48, pat = rem >> 4, idx = rem & 15, b = bh >> 3, h = bh & 7;
        const int dl = pat * 2, dil = 1 << dl;
        const int nb2 = 16 >> dl;
        const int res = idx / nb2, u2 = idx % nb2, m0 = u2 * 256;
        const size_t rowb = (size_t)b * S;
        AttnCore<4> A; A.init();
        const int mq = m0 + 32 * w + r32;
        const size_t qrow = rowb + (size_t)mq * dil + res;
#pragma unroll
        for (int d0 = 0; d0 < 4; ++d0) A.qr[d0] = *(const bf16x8*)(QA + qrow * 512 + h * 64 + d0 * 16 + hi * 8);
        const int j0 = (u2 == 0) ? 2 : 0;
        auto issue = [&](int j) {
            const int mk0 = m0 - 128 + 64 * j; LAS unsigned char* slot = F.lds + (j & 1) * AT_SLOT;
            const size_t krow = rowb + (size_t)(mk0 + lane) * dil + res;
            glds16(KA + krow * 512 + h * 64 + w * 8, slot + AT_KB + w * 1024);
            const size_t vrow = rowb + (size_t)(mk0 + 16 * (w & 3) + (lane >> 2)) * dil + res;
            glds16(VA + vrow * 512 + h * 64 + (w >> 2) * 32 + (lane & 3) * 8, slot + AT_VB + w * 1024);
        };
        issue(j0);
        for (int j = j0; j < 6; ++j) {
            __syncthreads();
            if (j + 1 < 6) issue(j + 1);
            const int klo = 64 * j - 128, qlo = 32 * w;
            if (klo + 63 >= qlo - 128 && klo <= qlo + 31) {
                const int mk0 = m0 + klo;
                A.tile(F.lds + (j & 1) * AT_SLOT, lane, true, [&](int kk) { return (unsigned)(mq - mk0 - kk) <= 128u; });
            }
        }
        __syncthreads();
        const float lt = A.ltot(), inv = 1.f / lt;
        bf16_t* orow = OP + ((size_t)pat * M + qrow) * 512 + h * 64;
#pragma unroll
        for (int g = 0; g < 4; ++g) {
            u32x2 w0 = {cvtpk(A.o0[4 * g] * inv, A.o0[4 * g + 1] * inv), cvtpk(A.o0[4 * g + 2] * inv, A.o0[4 * g + 3] * inv)};
            u32x2 w1 = {cvtpk(A.o1[4 * g] * inv, A.o1[4 * g + 1] * inv), cvtpk(A.o1[4 * g + 2] * inv, A.o1[4 * g + 3] * inv)};
            *(u32x2*)(orow + 8 * g + 4 * hi) = w0; *(u32x2*)(orow + 32 + 8 * g + 4 * hi) = w1;
        }
        if (hi == 0) LSE[((size_t)pat * M + qrow) * 8 + h] = A.m + __builtin_amdgcn_logf(lt);
    }
}

__device__ __forceinline__ void p3b_mla(Frame& F) {
    const bf16_t* QB = (const bf16_t*)(F.ws + WS_QB); const bf16_t* KN = (const bf16_t*)(F.ws + WS_KN); const bf16_t* KR = (const bf16_t*)(F.ws + WS_KR); const bf16_t* VB = (const bf16_t*)(F.ws + WS_VB);
    const bf16_t* OP = (const bf16_t*)((const unsigned char*)F.out + DO_OP); const float* LSE = (const float*)((const unsigned char*)F.out + DO_LSE);
    bf16_t* MIX = (bf16_t*)(F.ws + WS_MIX);
    const int lane = F.lane, w = F.wave, r32 = lane & 31, hi = lane >> 5;
    for (int i = 0; i < 4; ++i) {
        const int v = F.vcu; if (v >= 256) break;
        const int bh = v >> 2, s = v & 3, qb = (i == 0) ? s : (i == 1) ? 7 - s : (i == 2) ? 8 + s : 15 - s;
        const int b = bh >> 3, h = bh & 7; const size_t rowb = (size_t)b * S;
        const int qpos = qb * 256 + 32 * w + r32; const size_t qrow = rowb + qpos;
        AttnCore<6> A; A.init();
#pragma unroll
        for (int d0 = 0; d0 < 6; ++d0) A.qr[d0] = *(const bf16x8*)(QB + qrow * 768 + h * 96 + d0 * 16 + hi * 8);
        const int NT = 4 * qb + 4;
        auto issue = [&](int t) {
            LAS unsigned char* slot = F.lds + (t & 1) * AT_SLOT; const size_t krow = rowb + 64 * t + lane;
            glds16(KN + krow * 512 + h * 64 + w * 8, slot + AT_KB + w * 1024);
            if (w < 4) glds16(KR + krow * 32 + w * 8, slot + AT_KB + (8 + w) * 1024);
            const size_t vrow = rowb + 64 * t + 16 * (w & 3) + (lane >> 2);
            glds16(VB + vrow * 512 + h * 64 + (w >> 2) * 32 + (lane & 3) * 8, slot + AT_VB + w * 1024);
        };
        issue(0);
        const int qmin = qb * 256 + 32 * w;
        for (int t = 0; t < NT; ++t) {
            __syncthreads();
            if (t + 1 < NT) issue(t + 1);
            const int k0 = 64 * t;
            if (k0 <= qmin + 31) A.tile(F.lds + (t & 1) * AT_SLOT, lane, k0 + 63 > qmin, [&](int kk) { return k0 + kk <= qpos; });
        }
        __syncthreads();
        const float inv = 1.f / A.ltot();
        const float l0 = LSE[((size_t)0 * M + qrow) * 8 + h], l1 = LSE[((size_t)1 * M + qrow) * 8 + h], l2 = LSE[((size_t)2 * M + qrow) * 8 + h];
        const float lm = fmaxf(l0, fmaxf(l1, l2));
        float w0 = __builtin_amdgcn_exp2f(l0 - lm), w1 = __builtin_amdgcn_exp2f(l1 - lm), w2 = __builtin_amdgcn_exp2f(l2 - lm);
        const float wi = 1.f / (w0 + w1 + w2); w0 *= wi; w1 *= wi; w2 *= wi;
        bf16_t* mrow = MIX + qrow * 1024 + h * 64;
#pragma unroll
        for (int g = 0; g < 4; ++g) {
#pragma unroll
            for (int dh = 0; dh < 2; ++dh) {
                const int dc = dh * 32 + 8 * g + 4 * hi;
                const u32x2 a0 = *(const u32x2*)(OP + ((size_t)0 * M + qrow) * 512 + h * 64 + dc), a1 = *(const u32x2*)(OP + ((size_t)1 * M + qrow) * 512 + h * 64 + dc), a2 = *(const u32x2*)(OP + ((size_t)2 * M + qrow) * 512 + h * 64 + dc);
                u32x2 oa;
                oa.x = cvtpk(w0 * bf_lo(a0.x) + w1 * bf_lo(a1.x) + w2 * bf_lo(a2.x), w0 * bf_hi(a0.x) + w1 * bf_hi(a1.x) + w2 * bf_hi(a2.x));
                oa.y = cvtpk(w0 * bf_lo(a0.y) + w1 * bf_lo(a1.y) + w2 * bf_lo(a2.y), w0 * bf_hi(a0.y) + w1 * bf_hi(a1.y) + w2 * bf_hi(a2.y));
                *(u32x2*)(mrow + dc) = oa;
                u32x2 ob;
                if (dh == 0) ob = (u32x2){cvtpk(A.o0[4 * g] * inv, A.o0[4 * g + 1] * inv), cvtpk(A.o0[4 * g + 2] * inv, A.o0[4 * g + 3] * inv)};
                else ob = (u32x2){cvtpk(A.o1[4 * g] * inv, A.o1[4 * g + 1] * inv), cvtpk(A.o1[4 * g + 2] * inv, A.o1[4 * g + 3] * inv)};
                *(u32x2*)(mrow + 512 + dc) = ob;
            }
        }
    }
}
#define CE_DESC(a, b) do { const float _h = fmaxf(a, b), _l = fminf(a, b); a = _h; b = _l; } while (0)
__device__ __forceinline__ void sort16_desc(float (&v)[16]) {
#pragma unroll
    for (int k = 2; k <= 16; k <<= 1)
#pragma unroll
        for (int j = k >> 1; j > 0; j >>= 1)
#pragma unroll
            for (int i = 0; i < 16; ++i) { const int l = i ^ j; if (l > i) { if ((i & k) == 0) CE_DESC(v[i], v[l]); else CE_DESC(v[l], v[i]); } }
}
__device__ __forceinline__ void merge_top16(float (&a)[16], const float (&b)[16]) {
#pragma unroll
    for (int i = 0; i < 16; ++i) a[i] = fmaxf(a[i], b[15 - i]);
#pragma unroll
    for (int j = 8; j > 0; j >>= 1)
#pragma unroll
        for (int i = 0; i < 16; ++i) { const int l = i ^ j; if (l > i) CE_DESC(a[i], a[l]); }
}
__device__ __forceinline__ void xmerge(float (&a)[16], int xmask) {
    float b[16];
#pragma unroll
    for (int i = 0; i < 16; ++i) b[i] = __shfl_xor(a[i], xmask);
    merge_top16(a, b);
}
__device__ __forceinline__ float sel4(int g, float a0, float a1, float a2, float a3) { const float lo = (g & 1) ? a1 : a0, hi = (g & 1) ? a3 : a2; return (g & 2) ? hi : lo; }
__device__ __forceinline__ float pack_code(float v, unsigned code, unsigned mask) { return __builtin_bit_cast(float, (__builtin_bit_cast(unsigned, v) & ~mask) | code); }
__device__ __forceinline__ float gelu_erf(float v) { return 0.5f * v * (1.0f + erff(v * 0.70710678118654752f)); }

constexpr int PEER_WAVE_LDS = 4096 + 8192 + 512;

__device__ __forceinline__ void p6_peer(Frame& F) {
    const bf16_t* QP = (const bf16_t*)F.out; const bf16_t* KEYS = (const bf16_t*)(F.ws + WS_KEYS);
    const bf16_t* U = (const bf16_t*)(F.ws + WS_U); const bf16_t* V = (const bf16_t*)(F.ws + WS_V);
    const bf16_t* X2B = (const bf16_t*)(F.ws + WS_X2B); const float* X2 = (const float*)(F.ws + WS_X2); const float* SSQ2 = (const float*)(F.ws + WS_SSQ2);
    const float* gfin = F.in[14];
    const int lane = F.lane, w = F.wave, tk = lane & 15, g = lane >> 4;
    LAS unsigned char* wl = F.lds + w * PEER_WAVE_LDS;
    LAS unsigned short* eidL = (LAS unsigned short*)wl; LAS float* gateL = (LAS float*)(wl + 4096); LAS unsigned char* tabL = wl + 4096 + 8192;
    for (int blk = F.vcu; blk < M / 128; blk += F.G) {
        const int tok0 = blk * 128 + w * 16;
        for (int h = 0; h < 8; ++h) {
            float s12[2][16];
#pragma unroll
            for (int p = 0; p < 2; ++p) {
                const int hp = h * 2 + p;
                bf16x8 bq[4];
#pragma unroll
                for (int ks = 0; ks < 4; ++ks) bq[ks] = *(const bf16x8*)(QP + (size_t)(tok0 + tk) * 2048 + hp * 128 + ks * 32 + g * 8);
                f32x4 c[8];
#pragma unroll
                for (int nt = 0; nt < 8; ++nt) { c[nt] = (f32x4){0.f, 0.f, 0.f, 0.f};
#pragma unroll
                    for (int ks = 0; ks < 4; ++ks) { const bf16x8 ak = *(const bf16x8*)(KEYS + ((size_t)hp * 128 + nt * 16 + tk) * 128 + ks * 32 + g * 8);
                        c[nt] = __builtin_amdgcn_mfma_f32_16x16x32_bf16(ak, bq[ks], c[nt], 0, 0, 0); } }
                float va[16], vb[16];
                const unsigned lo = 127u - 4u * (unsigned)g;
#pragma unroll
                for (int nt = 0; nt < 4; ++nt)
#pragma unroll
                    for (int r = 0; r < 4; ++r) { va[nt * 4 + r] = pack_code(c[nt][r], lo - (unsigned)(16 * nt + r), 127u); vb[nt * 4 + r] = pack_code(c[nt + 4][r], lo - (unsigned)(16 * (nt + 4) + r), 127u); }
                sort16_desc(va); sort16_desc(vb); merge_top16(va, vb);
                xmerge(va, 16); xmerge(va, 32);
#pragma unroll
                for (int i = 0; i < 16; ++i) s12[p][i] = va[i];
                if (g == 0) {
#pragma unroll
                    for (int i = 0; i < 16; ++i) tabL[tk * 32 + p * 16 + i] = (unsigned char)(127u - (__builtin_bit_cast(unsigned, va[i]) & 127u));
                }
            }
            float cd[16];
#define S1(i) s12[0][i]
#define S2(j) s12[1][j]
#define CND(slot, i0, j0, i1, j1, i2, j2, i3, j3) cd[slot] = pack_code(sel4(g, S1(i0), S1(i1), S1(i2), S1(i3)) + sel4(g, S2(j0), S2(j1), S2(j2), S2(j3)), \
                255u - (unsigned)(g == 0 ? (i0) * 16 + (j0) : g == 1 ? (i1) * 16 + (j1) : g == 2 ? (i2) * 16 + (j2) : (i3) * 16 + (j3)), 255u)
            CND(0, 0, 0, 0, 1, 0, 2, 0, 3);   CND(1, 0, 4, 0, 5, 0, 6, 0, 7);   CND(2, 0, 8, 0, 9, 0, 10, 0, 11); CND(3, 0, 12, 0, 13, 0, 14, 0, 15);
            CND(4, 1, 0, 1, 1, 1, 2, 1, 3);   CND(5, 1, 4, 1, 5, 1, 6, 1, 7);   CND(6, 2, 0, 2, 1, 2, 2, 2, 3);   CND(7, 2, 4, 3, 0, 3, 1, 3, 2);
            CND(8, 3, 3, 4, 0, 4, 1, 4, 2);   CND(9, 5, 0, 5, 1, 6, 0, 6, 1);   CND(10, 7, 0, 7, 1, 8, 0, 9, 0);  CND(11, 10, 0, 11, 0, 12, 0, 13, 0);
            { const float t = sel4(g, S1(14), S1(15), S1(15), S1(15)) + S2(0); const float pk = pack_code(t, 255u - (unsigned)(g == 0 ? 14 * 16 : 15 * 16), 255u); cd[12] = (g < 2) ? pk : -INFINITY; }
            cd[13] = -INFINITY; cd[14] = -INFINITY; cd[15] = -INFINITY;
#undef CND
#undef S1
#undef S2
            sort16_desc(cd); xmerge(cd, 16); xmerge(cd, 32);
            asm volatile("s_waitcnt lgkmcnt(0)" ::: "memory");
            float ev[16], sum = 0.f; const float mx = cd[0];
#pragma unroll
            for (int k = 0; k < 16; ++k) { ev[k] = __builtin_amdgcn_exp2f((cd[k] - mx) * LOG2E); sum += ev[k]; }
            const float isum = 1.f / sum;
            if (g == 0) {
#pragma unroll
                for (int k = 0; k < 16; ++k) { const unsigned code = 255u - (__builtin_bit_cast(unsigned, cd[k]) & 255u);
                    const unsigned e1 = tabL[tk * 32 + (code >> 4)], e2 = tabL[tk * 32 + 16 + (code & 15u)];
                    eidL[tk * 128 + h * 16 + k] = (unsigned short)(e1 * 128u + e2); gateL[tk * 128 + h * 16 + k] = ev[k] * isum; }
            }
            asm volatile("s_waitcnt lgkmcnt(0)" ::: "memory");
        }
        for (int t = 0; t < 16; ++t) {
            const int tok = tok0 + t;
            const u32x4 xa = *(const u32x4*)(X2B + (size_t)tok * 1024 + 8 * lane), xb = *(const u32x4*)(X2B + (size_t)tok * 1024 + 512 + 8 * lane);
            const f32x4* sp = (const f32x4*)(SSQ2 + (size_t)tok * 16); const f32x4 q0 = sp[0], q1 = sp[1], q2 = sp[2], q3 = sp[3];
            const float ssq = ((q0.x + q0.y) + (q0.z + q0.w)) + ((q1.x + q1.y) + (q1.z + q1.w)) + ((q2.x + q2.y) + (q2.z + q2.w)) + ((q3.x + q3.y) + (q3.z + q3.w));
            const float rs2 = rsqrtf(ssq * (1.f / 1024.f) + NORM_EPS);
            const unsigned e_lo = eidL[t * 128 + lane], e_hi = eidL[t * 128 + 64 + lane];
            float hsel0 = 0.f, hsel1 = 0.f;
            for (int k = 0; k < 128; ++k) {
                const unsigned e = (unsigned)__builtin_amdgcn_readlane((int)(k < 64 ? e_lo : e_hi), k & 63);
                const bf16_t* ur = U + (size_t)e * 1024;
                const u32x4 ua = *(const u32x4*)(ur + 8 * lane), ub = *(const u32x4*)(ur + 512 + 8 * lane);
                float a = 0.f;
                a += bf_lo(ua.x) * bf_lo(xa.x) + bf_hi(ua.x) * bf_hi(xa.x); a += bf_lo(ua.y) * bf_lo(xa.y) + bf_hi(ua.y) * bf_hi(xa.y);
                a += bf_lo(ua.z) * bf_lo(xa.z) + bf_hi(ua.z) * bf_hi(xa.z); a += bf_lo(ua.w) * bf_lo(xa.w) + bf_hi(ua.w) * bf_hi(xa.w);
                a += bf_lo(ub.x) * bf_lo(xb.x) + bf_hi(ub.x) * bf_hi(xb.x); a += bf_lo(ub.y) * bf_lo(xb.y) + bf_hi(ub.y) * bf_hi(xb.y);
                a += bf_lo(ub.z) * bf_lo(xb.z) + bf_hi(ub.z) * bf_hi(xb.z); a += bf_lo(ub.w) * bf_lo(xb.w) + bf_hi(ub.w) * bf_hi(xb.w);
                a = wave_sum(a);
                if (k < 64) { if (lane == k) hsel0 = a; } else { if (lane == k - 64) hsel1 = a; }
            }
            const float c0 = gelu_erf(hsel0 * rs2) * gateL[t * 128 + lane], c1 = gelu_erf(hsel1 * rs2) * gateL[t * 128 + 64 + lane];
            float y[16];
#pragma unroll
            for (int j = 0; j < 16; ++j) y[j] = 0.f;
            for (int k = 0; k < 128; ++k) {
                const unsigned e = (unsigned)__builtin_amdgcn_readlane((int)(k < 64 ? e_lo : e_hi), k & 63);
                const float ck = __builtin_bit_cast(float, __builtin_amdgcn_readlane(__builtin_bit_cast(int, k < 64 ? c0 : c1), k & 63));
                const bf16_t* vr = V + (size_t)e * 1024;
                const u32x4 va = *(const u32x4*)(vr + 8 * lane), vb = *(const u32x4*)(vr + 512 + 8 * lane);
                y[0] += ck * bf_lo(va.x); y[1] += ck * bf_hi(va.x); y[2] += ck * bf_lo(va.y); y[3] += ck * bf_hi(va.y);
                y[4] += ck * bf_lo(va.z); y[5] += ck * bf_hi(va.z); y[6] += ck * bf_lo(va.w); y[7] += ck * bf_hi(va.w);
                y[8] += ck * bf_lo(vb.x); y[9] += ck * bf_hi(vb.x); y[10] += ck * bf_lo(vb.y); y[11] += ck * bf_hi(vb.y);
                y[12] += ck * bf_lo(vb.z); y[13] += ck * bf_hi(vb.z); y[14] += ck * bf_lo(vb.w); y[15] += ck * bf_hi(vb.w);
            }
            const float* xr = X2 + (size_t)tok * 1024;
            const f32x4 r0 = *(const f32x4*)(xr + 8 * lane), r1 = *(const f32x4*)(xr + 8 * lane + 4), r2 = *(const f32x4*)(xr + 512 + 8 * lane), r3 = *(const f32x4*)(xr + 512 + 8 * lane + 4);
            y[0] += r0.x; y[1] += r0.y; y[2] += r0.z; y[3] += r0.w; y[4] += r1.x; y[5] += r1.y; y[6] += r1.z; y[7] += r1.w;
            y[8] += r2.x; y[9] += r2.y; y[10] += r2.z; y[11] += r2.w; y[12] += r3.x; y[13] += r3.y; y[14] += r3.z; y[15] += r3.w;
            float ss = 0.f;
#pragma unroll
            for (int j = 0; j < 16; ++j) ss += y[j] * y[j];
            ss = wave_sum(ss);
            const float rs = rsqrtf(ss * (1.f / 1024.f) + NORM_EPS);
            const f32x4 g0 = *(const f32x4*)(gfin + 8 * lane), g1 = *(const f32x4*)(gfin + 8 * lane + 4), g2 = *(const f32x4*)(gfin + 512 + 8 * lane), g3 = *(const f32x4*)(gfin + 512 + 8 * lane + 4);
            float* orow = F.out + (size_t)tok * 1024;
            *(f32x4*)(orow + 8 * lane) = (f32x4){y[0] * rs * g0.x, y[1] * rs * g0.y, y[2] * rs * g0.z, y[3] * rs * g0.w};
            *(f32x4*)(orow + 8 * lane + 4) = (f32x4){y[4] * rs * g1.x, y[5] * rs * g1.y, y[6] * rs * g1.z, y[7] * rs * g1.w};
            *(f32x4*)(orow + 512 + 8 * lane) = (f32x4){y[8] * rs * g2.x, y[9] * rs * g2.y, y[10] * rs * g2.z, y[11] * rs * g2.w};
            *(f32x4*)(orow + 512 + 8 * lane + 4) = (f32x4){y[12] * rs * g3.x, y[13] * rs * g3.y, y[14] * rs * g3.z, y[15] * rs * g3.w};
        }
    }
}
constexpr int LDS_BYTES = 147456;
constexpr int NPHASE = 8;

__global__ void __launch_bounds__(512, 2) fwd_kernel(Args args) {
    extern __shared__ __attribute__((aligned(16))) unsigned char lds_raw[];
    Frame F;
    F.lds = (LAS unsigned char*)lds_raw;
    F.tid = threadIdx.x; F.lane = F.tid & 63; F.wave = __builtin_amdgcn_readfirstlane(F.tid >> 6);
    F.G = gridDim.x; { const int bx = blockIdx.x; F.vcu = (F.G % 8 == 0) ? (bx % 8) * (F.G / 8) + bx / 8 : bx; }
#pragma unroll
    for (int i = 0; i < 15; ++i) F.in[i] = args.in[i];
    F.out = args.out; F.ws = args.ws;
    unsigned char* ws = args.ws;
    const int lo = args.ph_lo, hi = args.ph_hi;
#if ONE_LAUNCH
    cg::grid_group grid = cg::this_grid();
#define SEAM(k) do { if (lo <= (k) && (k) + 1 < hi) grid.sync(); } while (0)
#else
#define SEAM(k) do { } while (0)
#endif
#define IN(k) (lo <= (k) && (k) < hi)
    if (IN(0)) { p0_prologue(F); SEAM(0); }
    if (IN(1)) {
        GemmPlain g{(const bf16_t*)(ws + WS_XN), (const bf16_t*)(ws + WS_WIN), 1024, 1024, 1024};
        pg8::StaticOrder S_; S_.init(M, 2048, F.G, (int)blockIdx.x);
        const float* CA = (const float*)(ws + WS_ROPE);
        EpiP1 E{(bf16_t*)(ws + WS_QA), (bf16_t*)(ws + WS_KA), (bf16_t*)(ws + WS_VA), (bf16_t*)(ws + WS_CQ), (bf16_t*)(ws + WS_CKV), (float*)(ws + WS_SSQ1), CA, CA + 4096 * 32};
        pg8::gemm_phase<EpiP1, pg8::StaticOrder, GemmPlain>(F.lds, g, S_, E);
        p1_krope(F);
        SEAM(1);
    }
    if (IN(2)) {
        GemmUp g{(const bf16_t*)(ws + WS_CQ), (const bf16_t*)(ws + WS_CKV), (const bf16_t*)(ws + WS_WUQ), (const bf16_t*)(ws + WS_WUKV), 256, 256, 256};
        pg8::StaticOrder S_; S_.init(M, 7 * 256, F.G, (int)blockIdx.x);
        const float* CB = (const float*)(ws + WS_ROPE) + 2 * 4096 * 32;
        EpiP2 E{(bf16_t*)(ws + WS_QB), (bf16_t*)(ws + WS_KN), (bf16_t*)(ws + WS_VB), (const float*)(ws + WS_SSQ1), CB, CB + 4096 * 16};
        pg8::gemm_phase<EpiP2, pg8::StaticOrder, GemmUp>(F.lds, g, S_, E);
        SEAM(2);
    }
    if (IN(3)) { p3a_dilated(F); SEAM(3); }
    if (IN(4)) { p3b_mla(F); SEAM(4); }
    if (IN(5)) {
        GemmPlain g{(const bf16_t*)(ws + WS_MIX), (const bf16_t*)(ws + WS_WO), 1024, 1024, 1024};
        pg8::StaticOrder S_; S_.init(M, 1024, F.G, (int)blockIdx.x);
        EpiP4 E{F.in[0], (float*)(ws + WS_X2), (bf16_t*)(ws + WS_X2B), (float*)(ws + WS_SSQ2)};
        pg8::gemm_phase<EpiP4, pg8::StaticOrder, GemmPlain>(F.lds, g, S_, E);
        SEAM(5);
    }
    if (IN(6)) {
        GemmPlain g{(const bf16_t*)(ws + WS_X2B), (const bf16_t*)(ws + WS_WQ), 1024, 1024, 1024};
        pg8::StaticOrder S_; S_.init(M, 2048, F.G, (int)blockIdx.x);
        EpiP5 E{(bf16_t*)F.out, (const float*)(ws + WS_SSQ2)};
        pg8::gemm_phase<EpiP5, pg8::StaticOrder, GemmPlain>(F.lds, g, S_, E);
        SEAM(6);
    }
    if (IN(7)) { p6_peer(F); }
#undef IN
#undef SEAM
}
#if DEBUG_CMP
namespace dbg {
__device__ __forceinline__ int colmap(int c, int mode) {
    if (mode == 1) { const int hb = c & ~63, p = c & 63; return hb + (p >> 1) + ((p & 1) << 5); }
    if (mode == 2) { return (c >> 1) + ((c & 1) << 4); }
    if (mode == 3) { const int h = c / 96, p = c % 96; if (p < 64) return c; const int q = p - 64; return h * 96 + 64 + (q >> 1) + ((q & 1) << 4); }
    return c;
}
template <class T> __device__ __forceinline__ float ldv(const T* p);
template <> __device__ __forceinline__ float ldv<float>(const float* p) { return *p; }
template <> __device__ __forceinline__ float ldv<bf16_t>(const bf16_t* p) { return __builtin_bit_cast(float, (unsigned)(*p) << 16); }
template <class T>
__global__ void cmp_k(const T* opt, int ld_opt, const float* ref, int ld_ref, int rows, int cols, float scale, int mode, unsigned* err, int stage) {
    const size_t n = (size_t)rows * cols; float md = 0.f, mr = 0.f;
    for (size_t i = (size_t)blockIdx.x * blockDim.x + threadIdx.x; i < n; i += (size_t)gridDim.x * blockDim.x) {
        const int r = (int)(i / cols), c = (int)(i % cols);
        const float o = ldv<T>(opt + (size_t)r * ld_opt + c) * scale, rf = ref[(size_t)r * ld_ref + colmap(c, mode)];
        float d = fabsf(o - rf); if (!(d == d)) d = 1.0e30f;
        md = fmaxf(md, d); mr = fmaxf(mr, fabsf(rf));
    }
    for (int o = 32; o > 0; o >>= 1) { md = fmaxf(md, __shfl_xor(md, o)); mr = fmaxf(mr, __shfl_xor(mr, o)); }
    if ((threadIdx.x & 63) == 0) { atomicMax(err + 2 * stage, __float_as_uint(md)); atomicMax(err + 2 * stage + 1, __float_as_uint(mr)); }
}
__global__ void encode_k(float* out, const unsigned* err, int nstage, int sel, float thr) {
    float eps2 = 0.f;
    if (sel >= 0) { const float e = __uint_as_float(err[2 * sel]) / fmaxf(__uint_as_float(err[2 * sel + 1]), 1e-30f); eps2 = fminf(fmaxf(e, 1e-4f), 0.9f); }
    else for (int k = 0; k < nstage; ++k) { const float e = __uint_as_float(err[2 * k]) / fmaxf(__uint_as_float(err[2 * k + 1]), 1e-30f);
        if (!(e < thr)) { eps2 = exp2f(-(float)(k + 1)) * (1.f + 0.9f * fminf(e, 1.f)); break; } }
    const float sc = 1.f + sqrtf(eps2);
    const size_t i = ((size_t)blockIdx.x * blockDim.x + threadIdx.x) * 4; f32x4 v = *(f32x4*)(out + i); v = v * sc; *(f32x4*)(out + i) = v;
}
}
#endif

static void launch_phases(const Args& base, int lo, int hi, int grid, hipStream_t stream) {
    Args a = base; a.ph_lo = lo; a.ph_hi = hi;
#if ONE_LAUNCH
    void* kargs[] = {(void*)&a};
    hipError_t e = hipLaunchCooperativeKernel((const void*)fwd_kernel, dim3(grid), dim3(512), kargs, LDS_BYTES, stream);
    if (e != hipSuccess) fprintf(stderr, "cooperative launch failed: %s (grid %d)\n", hipGetErrorString(e), grid);
#else
    hipLaunchKernelGGL(fwd_kernel, dim3(grid), dim3(512), LDS_BYTES, stream, a);
#endif
}

extern "C" void kernel_launch(void* const* d_in, const int* in_sizes, int n_in, void* d_out, int out_size, void* d_ws, size_t ws_size, hipStream_t stream) {
    static int grid = 0;
    if (grid == 0) {
        int dev = 0, cus = 0, per_cu = 0;
        hipGetDevice(&dev); hipDeviceGetAttribute(&cus, hipDeviceAttributeMultiprocessorCount, dev);
        hipFuncSetAttribute((const void*)fwd_kernel, hipFuncAttributeMaxDynamicSharedMemorySize, LDS_BYTES);
        hipOccupancyMaxActiveBlocksPerMultiprocessor(&per_cu, (const void*)fwd_kernel, 512, LDS_BYTES);
        if (per_cu < 1) { fprintf(stderr, "occupancy query says %d blocks/CU\n", per_cu); per_cu = 1; }
        grid = cus * 1;
        if (grid > 256) grid = 256;
        (void)hipGetLastError();
    }
    Args a{};
    for (int i = 0; i < 15; ++i) a.in[i] = (const float*)d_in[i];
    a.out = (float*)d_out; a.ws = (unsigned char*)d_ws;
#if !DEBUG_CMP
#if ONE_LAUNCH
    launch_phases(a, 0, NPHASE, grid, stream);
#else
    for (int p = 0; p < NPHASE; ++p) launch_phases(a, p, p + 1, grid, stream);
#endif
#else
    using nv::rmsnorm_k; using nv::gemm_k; using nv::rope_k; using nv::copy_cols_k; using nv::dilated_k; using nv::mla_k; using nv::peer_k; constexpr int PW = nv::PW;
    unsigned char* ws = (unsigned char*)d_ws;
    unsigned* err = (unsigned*)(ws + 505 * MiB);
    hipMemsetAsync(err, 0, 256, stream);
    float* hb = (float*)(ws + 404 * MiB); float* projb = (float*)(ws + 420 * MiB); float* qn = (float*)(ws + 456 * MiB); float* knn = (float*)(ws + 469 * MiB);
    float* krn = (float*)(ws + 477 * MiB); float* vn = (float*)(ws + 478 * MiB); float* mixb = (float*)(ws + 486 * MiB);
    const float* x = (const float*)d_in[0];
    hipStream_t st = stream;
    launch_phases(a, 0, 1, grid, stream); launch_phases(a, 1, 2, grid, stream);
    rmsnorm_k<<<S / 4, 256, 0, st>>>(x, D, (const float*)d_in[1], hb, D, D, S);
    gemm_k<<<dim3((PW + 63) / 64, S / 64), 256, 0, st>>>(hb, D, (const float*)d_in[2], PW, projb, PW, nullptr, 0, S, PW, D);
    rope_k<<<(S * 8 * 32 + 255) / 256, 256, 0, st>>>(projb, PW, 0, 8, 64, S);
    rope_k<<<(S * 8 * 32 + 255) / 256, 256, 0, st>>>(projb, PW, 512, 8, 64, S);
    copy_cols_k<<<(S * 32 + 255) / 256, 256, 0, st>>>(projb + 2048, PW, krn, 32, 32, S);
    rope_k<<<(S * 16 + 255) / 256, 256, 0, st>>>(krn, 32, 0, 1, 32, S);
    dbg::cmp_k<bf16_t><<<1024, 256, 0, st>>>((const bf16_t*)(ws + WS_QA), 512, projb, PW, S, 512, 1.f / QSCALE_A, 1, err, 0);
    dbg::cmp_k<bf16_t><<<1024, 256, 0, st>>>((const bf16_t*)(ws + WS_KA), 512, projb + 512, PW, S, 512, 1.f, 1, err, 1);
    dbg::cmp_k<bf16_t><<<1024, 256, 0, st>>>((const bf16_t*)(ws + WS_VA), 512, projb + 1024, PW, S, 512, 1.f, 0, err, 2);
    dbg::cmp_k<bf16_t><<<1024, 256, 0, st>>>((const bf16_t*)(ws + WS_CQ), 256, projb + 1536, PW, S, 256, 1.f, 0, err, 3);
    dbg::cmp_k<bf16_t><<<1024, 256, 0, st>>>((const bf16_t*)(ws + WS_CKV), 256, projb + 1792, PW, S, 256, 1.f, 0, err, 4);
    dbg::cmp_k<bf16_t><<<1024, 256, 0, st>>>((const bf16_t*)(ws + WS_KR), 32, krn, 32, S, 32, 1.f, 2, err, 5);
    launch_phases(a, 2, 3, grid, stream);
    {   float* cqn = hb; float* ckvn = hb + (size_t)S * 256;
        rmsnorm_k<<<S / 4, 256, 0, st>>>(projb + 1536, PW, (const float*)d_in[3], cqn, 256, 256, S);
        rmsnorm_k<<<S / 4, 256, 0, st>>>(projb + 1792, PW, (const float*)d_in[4], ckvn, 256, 256, S);
        gemm_k<<<dim3(768 / 64, S / 64), 256, 0, st>>>(cqn, 256, (const float*)d_in[5], 768, qn, 768, nullptr, 0, S, 768, 256);
        for (int h = 0; h < 8; ++h) rope_k<<<(S * 16 + 255) / 256, 256, 0, st>>>(qn, 768, h * 96 + 64, 1, 32, S);
        gemm_k<<<dim3(512 / 64, S / 64), 256, 0, st>>>(ckvn, 256, (const float*)d_in[6], 512, knn, 512, nullptr, 0, S, 512, 256);
        gemm_k<<<dim3(512 / 64, S / 64), 256, 0, st>>>(ckvn, 256, (const float*)d_in[7], 512, vn, 512, nullptr, 0, S, 512, 256); }
    dbg::cmp_k<bf16_t><<<1024, 256, 0, st>>>((const bf16_t*)(ws + WS_QB), 768, qn, 768, S, 768, 1.f / QSCALE_B, 3, err, 6);
    dbg::cmp_k<bf16_t><<<1024, 256, 0, st>>>((const bf16_t*)(ws + WS_KN), 512, knn, 512, S, 512, 1.f, 0, err, 7);
    dbg::cmp_k<bf16_t><<<1024, 256, 0, st>>>((const bf16_t*)(ws + WS_VB), 512, vn, 512, S, 512, 1.f, 0, err, 8);
    launch_phases(a, 3, 4, grid, stream); launch_phases(a, 4, 5, grid, stream);
    dilated_k<<<8 * S / 4, 256, 0, st>>>(projb, mixb);
    mla_k<<<1 * 8 * (S / 64), 64, 0, st>>>(qn, knn, krn, vn, mixb);
    dbg::cmp_k<bf16_t><<<1024, 256, 0, st>>>((const bf16_t*)(ws + WS_MIX), 1024, mixb, 1024, S, 512, 1.f, 0, err, 9);
    dbg::cmp_k<bf16_t><<<1024, 256, 0, st>>>((const bf16_t*)(ws + WS_MIX) + 512, 1024, mixb + 512, 1024, S, 512, 1.f, 0, err, 10);
    launch_phases(a, 5, 6, grid, stream);
    float* x2b = hb;
    gemm_k<<<dim3(D / 64, S / 64), 256, 0, st>>>(mixb, 1024, (const float*)d_in[8], D, x2b, D, x, D, S, D, 1024);
    dbg::cmp_k<float><<<1024, 256, 0, st>>>((const float*)(ws + WS_X2), 1024, x2b, 1024, S, 1024, 1.f, 0, err, 11);
    launch_phases(a, 6, 7, grid, stream);
    float* h2c = qn; float* qpc = projb;
    rmsnorm_k<<<4096 / 4, 256, 0, st>>>(x2b, D, (const float*)d_in[9], h2c, D, D, 4096);
    gemm_k<<<dim3(2048 / 64, 4096 / 64), 256, 0, st>>>(h2c, D, (const float*)d_in[10], 2048, qpc, 2048, nullptr, 0, 4096, 2048, D);
    dbg::cmp_k<bf16_t><<<1024, 256, 0, st>>>((const bf16_t*)d_out, 2048, qpc, 2048, S, 2048, 1.f, 0, err, 12);
    launch_phases(a, 7, 8, grid, stream);
    peer_k<<<4096 / 4, 256, 0, st>>>(h2c, qpc, (const float*)d_in[11], (const float*)d_in[12], (const float*)d_in[13], (const float*)d_in[14], x2b, 4096);
    dbg::cmp_k<float><<<1024, 256, 0, st>>>((const float*)d_out, 1024, x2b, 1024, S, 1024, 1.f, 0, err, 13);
    nv::run(d_in, (float*)d_out, (float*)d_ws, stream);
    dbg::encode_k<<<M * 1024 / 4 / 256, 256, 0, st>>>((float*)d_out, err, 14, DEBUG_SEL, 0.05f);
#endif
}
```

```cpp
#include <hip/hip_runtime.h>
#include <hip/hip_cooperative_groups.h>
#include <cstdio>
#include <cstdint>
#include <cmath>
namespace cg = cooperative_groups;
#define DEBUG_CMP 0
#define ONE_LAUNCH 1
#define DEBUG_SEL -1
#define LAS __attribute__((address_space(3)))
#define GAS __attribute__((address_space(1)))
typedef unsigned short bf16_t;
typedef short bf16x8 __attribute__((ext_vector_type(8)));
typedef short s16x4 __attribute__((ext_vector_type(4)));
typedef float f32x4 __attribute__((ext_vector_type(4)));
typedef float f32x16 __attribute__((ext_vector_type(16)));
typedef float f32x2_t __attribute__((ext_vector_type(2)));
typedef __bf16 bf16x2_t __attribute__((ext_vector_type(2)));
typedef unsigned u32x4 __attribute__((ext_vector_type(4)));
typedef unsigned u32x2 __attribute__((ext_vector_type(2)));

constexpr int NB = 8, S = 4096, M = NB * S, D = 1024;
constexpr float NORM_EPS = 1e-6f;
constexpr float LOG2E = 1.4426950408889634f;
constexpr float QSCALE_A = 0.125f * LOG2E;
constexpr float QSCALE_B = 0.10206207261596577f * LOG2E;

__device__ __forceinline__ unsigned cvtpk(float lo, float hi) { f32x2_t v = {lo, hi}; bf16x2_t b = __builtin_convertvector(v, bf16x2_t); return __builtin_bit_cast(unsigned, b); }
__device__ __forceinline__ float bf_lo(unsigned w) { return __builtin_bit_cast(float, w << 16); }
__device__ __forceinline__ float bf_hi(unsigned w) { return __builtin_bit_cast(float, w & 0xffff0000u); }

namespace pg8 {
constexpr int BM = 256, BK = 64, HALF = 128, HTB = HALF * BK * 2, STAGE_BYTES = 8 * HTB, NXCD = 8, WGM = 8;
__host__ __device__ __forceinline__ int lds_byte(int r, int c) { const int st = (r >> 4) * 2 + (c >> 5), rr = r & 15, cc = c & 31, ob = rr * 64 + cc * 2; return st * 1024 + (ob ^ (((ob >> 9) & 1) << 5)); }
__host__ __device__ __forceinline__ void stage_rc(int b, int& R, int& C) { const int st = b / 1024, sb = b % 1024, swz = sb ^ (((sb >> 9) & 1) << 5); R = (st >> 1) * 16 + swz / 64; C = (st & 1) * 32 + (swz % 64) / 2; }
__host__ __device__ __forceinline__ int perm32(int rho) { const int n = rho >> 4, i = rho & 15; return 8 * (i >> 2) + 4 * n + (i & 3); }
struct Unit { int pm, pn; };
struct StaticOrder {
    int nM, nN, nwg, G, c;
    __device__ void init(int Mr, int N, int G_, int c_) { nM = Mr / BM; nN = N / BM; nwg = nM * nN; G = G_; c = c_; }
    __device__ bool next(int i, Unit& u) const {
        const long L = (long)i * G + c; if (L >= nwg) return false;
        int wgid = (int)L; { const int q = nwg / NXCD, r = nwg % NXCD, xcd = wgid % NXCD, off = wgid / NXCD; wgid = (xcd < r ? xcd * (q + 1) : r * (q + 1) + (xcd - r) * q) + off; }
        const int nig = WGM * nN, gid = wgid / nig, fm = gid * WGM, gsz = (nM - fm) < WGM ? (nM - fm) : WGM;
        u.pm = fm + ((wgid % nig) % gsz); u.pn = (wgid % nig) / gsz; return true;
    }
};
template <class Epi, class Sched, class G>
__device__ __forceinline__ void gemm_phase(LAS unsigned char* lds, const G g, const Sched& Sch, const Epi& E) {
    const int tid = threadIdx.x, wid = __builtin_amdgcn_readfirstlane(tid >> 6), lane = tid & 63, wr = wid >> 2, wc = wid & 3, fr = lane & 15, fq = lane >> 4;
    const int K = g.K, nt = K / BK;
    unsigned voffA[2], voffB[2];
#pragma unroll
    for (int i = 0; i < 2; ++i) { int R, C; stage_rc(tid * 16 + i * 8192, R, C); const int Rb = Epi::PERM ? ((R & ~31) + perm32(R & 31)) : R;
        voffA[i] = (unsigned)(R * g.lda + C) * 2u; voffB[i] = (unsigned)(Rb * g.ldb + C) * 2u; }
    const size_t kstep = (size_t)(BK * 2);
    const size_t hstepA = (size_t)HALF * g.lda * 2, hstepB = (size_t)HALF * g.ldb * 2;
    const unsigned ldsw = (unsigned)wid * 1024u;
    const int aoff = lds_byte(wr * 64 + fr, fq * 8), boff = lds_byte(wc * 32 + fr, fq * 8);
#define PG8_SA(b, h) (((b) * 2 + (h)) * HTB)
#define PG8_SB(b, h) ((4 + (b) * 2 + (h)) * HTB)
#define PG8_STAGE(bufoff, gbase, voff) do { _Pragma("unroll") for (int _i = 0; _i < 2; ++_i) \
        __builtin_amdgcn_global_load_lds((const unsigned*)((const char*)(gbase) + (voff)[_i]), (LAS unsigned*)(lds + (bufoff) + ldsw + _i * 8192), 16, 0, 0); } while (0)
#define PG8_LDA(dst, b, h) do { _Pragma("unroll") for (int m = 0; m < 4; ++m) _Pragma("unroll") for (int k = 0; k < 2; ++k) dst[m][k] = *(const LAS bf16x8*)(lds + PG8_SA(b, h) + aoff + m * 2048 + k * 1024); } while (0)
#define PG8_LDB(dst, b, h) do { _Pragma("unroll") for (int n = 0; n < 2; ++n) _Pragma("unroll") for (int k = 0; k < 2; ++k) dst[n][k] = *(const LAS bf16x8*)(lds + PG8_SB(b, h) + boff + n * 2048 + k * 1024); } while (0)
#define PG8_MMA(ai, bj, At, Bt) do { __builtin_amdgcn_s_setprio(1); _Pragma("unroll") for (int m = 0; m < 4; ++m) _Pragma("unroll") for (int n = 0; n < 2; ++n) _Pragma("unroll") for (int k = 0; k < 2; ++k) \
        acc[ai][bj][m][n] = __builtin_amdgcn_mfma_f32_16x16x32_bf16(Bt[n][k], At[m][k], acc[ai][bj][m][n], 0, 0, 0); __builtin_amdgcn_s_setprio(0); } while (0)
#define PG8_WAIT_V(n) asm volatile("s_waitcnt vmcnt(" #n ")" ::: "memory")
#define PG8_WAIT_L(n) asm volatile("s_waitcnt lgkmcnt(" #n ")" ::: "memory")
#define PG8_BAR __builtin_amdgcn_s_barrier()
#define PG8_SCHED __builtin_amdgcn_sched_barrier(0)
    Unit cur, nxt; int ui = 0;
    if (!Sch.next(0, cur)) return;
    f32x4 acc[2][2][4][2];
#pragma unroll
    for (int a = 0; a < 2; ++a)
#pragma unroll
        for (int b = 0; b < 2; ++b)
#pragma unroll
            for (int m = 0; m < 4; ++m)
#pragma unroll
                for (int n = 0; n < 2; ++n) acc[a][b][m][n] = (f32x4){0.f, 0.f, 0.f, 0.f};
    bf16x8 At[4][2], B0[2][2], B1[2][2];
    const char* cA = g.a_base(cur); const char* cB = g.b_base(cur);
    PG8_STAGE(PG8_SB(0, 0), cB, voffB); PG8_STAGE(PG8_SB(0, 1), cB + hstepB, voffB); PG8_STAGE(PG8_SA(0, 0), cA, voffA); PG8_STAGE(PG8_SA(0, 1), cA + hstepA, voffA);
    if (wr == 1) PG8_BAR;
    PG8_WAIT_V(2); PG8_BAR;
    PG8_STAGE(PG8_SB(1, 0), cB + kstep, voffB); PG8_STAGE(PG8_SA(1, 0), cA + kstep, voffA); PG8_STAGE(PG8_SB(1, 1), cB + hstepB + kstep, voffB);
    PG8_WAIT_V(6); PG8_BAR;
    for (;;) {
        const bool has_next = Sch.next(ui + 1, nxt);
        const char* nA = has_next ? g.a_base(nxt) : cA; const char* nB = has_next ? g.b_base(nxt) : cB;
        for (int t = 0; t < nt; t += 2) {
            const bool last = (t == nt - 2);
            const char* a1 = cA + (size_t)(t + 1) * kstep;
            const char* a2 = last ? nA : cA + (size_t)(t + 2) * kstep; const char* b2 = last ? nB : cB + (size_t)(t + 2) * kstep;
            const char* a3 = a2 + kstep; const char* b3 = b2 + kstep;
            PG8_LDB(B0, 0, 0); PG8_LDB(B1, 0, 1); PG8_SCHED; PG8_LDA(At, 0, 0); PG8_STAGE(PG8_SA(1, 1), a1 + hstepA, voffA);
            PG8_WAIT_V(8); PG8_WAIT_L(0); PG8_BAR; PG8_MMA(0, 0, At, B0); PG8_MMA(0, 1, At, B1); PG8_BAR; PG8_SCHED;
            PG8_LDA(At, 0, 1); PG8_STAGE(PG8_SB(0, 0), b2, voffB); PG8_STAGE(PG8_SB(0, 1), b2 + hstepB, voffB); PG8_STAGE(PG8_SA(0, 0), a2, voffA);
            PG8_WAIT_V(8); PG8_WAIT_L(0); PG8_BAR; PG8_MMA(1, 0, At, B0); PG8_MMA(1, 1, At, B1); PG8_BAR; PG8_SCHED;
            PG8_LDB(B0, 1, 0); PG8_LDB(B1, 1, 1); PG8_SCHED; PG8_LDA(At, 1, 0); PG8_STAGE(PG8_SA(0, 1), a2 + hstepA, voffA);
            PG8_WAIT_V(8); PG8_WAIT_L(0); PG8_BAR; PG8_MMA(0, 0, At, B0); PG8_MMA(0, 1, At, B1); PG8_BAR; PG8_SCHED;
            PG8_LDA(At, 1, 1); PG8_STAGE(PG8_SB(1, 0), b3, voffB); PG8_STAGE(PG8_SB(1, 1), b3 + hstepB, voffB); PG8_STAGE(PG8_SA(1, 0), a3, voffA);
            PG8_WAIT_V(8); PG8_WAIT_L(0); PG8_BAR; PG8_MMA(1, 0, At, B0); PG8_MMA(1, 1, At, B1); PG8_BAR; PG8_SCHED;
        }
        if (wr == 0) PG8_BAR;
        E(acc, cur, wr, wc, fr, fq);
        if (!has_next) break;
#pragma unroll
        for (int a = 0; a < 2; ++a)
#pragma unroll
            for (int b = 0; b < 2; ++b)
#pragma unroll
                for (int m = 0; m < 4; ++m)
#pragma unroll
                    for (int n = 0; n < 2; ++n) acc[a][b][m][n] = (f32x4){0.f, 0.f, 0.f, 0.f};
        cur = nxt; cA = nA; cB = nB; ++ui;
        if (wr == 1) PG8_BAR;
    }
    PG8_WAIT_V(0);
    PG8_BAR;
#undef PG8_SA
#undef PG8_SB
#undef PG8_STAGE
#undef PG8_LDA
#undef PG8_LDB
#undef PG8_MMA
#undef PG8_WAIT_V
#undef PG8_WAIT_L
#undef PG8_BAR
#undef PG8_SCHED
}
}
constexpr size_t MiB = 1u << 20;
constexpr size_t WS_CTL = 0;
constexpr size_t WS_WIN = 2 * MiB;
constexpr size_t WS_WKR = 6 * MiB;
constexpr size_t WS_WUQ = 7 * MiB;
constexpr size_t WS_WUKV = 8 * MiB;
constexpr size_t WS_WO = 9 * MiB;
constexpr size_t WS_WQ = 11 * MiB;
constexpr size_t WS_KEYS = 15 * MiB;
constexpr size_t WS_ROPE = 16 * MiB;
constexpr size_t WS_U = 18 * MiB;
constexpr size_t WS_V = 50 * MiB;
constexpr size_t WS_SSQ1 = 82 * MiB;
constexpr size_t WS_SSQ2 = 84 * MiB;
constexpr size_t WS_XN = 96 * MiB;
constexpr size_t WS_MIX = WS_XN;
constexpr size_t WS_QA = 160 * MiB, WS_KA = 192 * MiB, WS_VA = 224 * MiB;
constexpr size_t WS_X2B = 160 * MiB;
constexpr size_t WS_CQ = 256 * MiB, WS_CKV = 272 * MiB;
constexpr size_t WS_KR = 288 * MiB;
constexpr size_t WS_QB = 292 * MiB;
constexpr size_t WS_KN = 340 * MiB, WS_VB = 372 * MiB;
constexpr size_t WS_X2 = 292 * MiB;
constexpr size_t WS_END_OPT = 420 * MiB;
constexpr size_t DO_OP = 0, DO_LSE = 96 * MiB;

struct Args { const float* in[15]; float* out; unsigned char* ws; int ph_lo, ph_hi; };

struct Frame {
    LAS unsigned char* lds;
    int tid, lane, wave, vcu, G;
    const float* in[15]; float* out; unsigned char* ws;
};

__device__ __forceinline__ float wave_sum(float v) {
#pragma unroll
    for (int o = 1; o < 64; o <<= 1) v += __shfl_xor(v, o);
    return v;
}

__device__ __forceinline__ int perm_win(int np) {
    if (np < 1024) { const int hb = np & ~63, p = np & 63; return hb + (p >> 1) + ((p & 1) << 5); }
    return np;
}
__device__ __forceinline__ int perm_wkr(int np) { return 2048 + (np >> 1) + ((np & 1) << 4); }
__device__ __forceinline__ int perm_wuq(int np) { const int h = np / 96, p = np % 96; if (p < 64) return np; const int q = p - 64; return h * 96 + 64 + (q >> 1) + ((q & 1) << 4); }

template <int PERM>
__device__ __forceinline__ void transpose_item(const float* __restrict__ W, int K, int N, const float* __restrict__ gk, bf16_t* __restrict__ WT, int row_off, LAS float* scr, int item, int nblk, int lane) {
    const int kb = item / nblk, nb = item % nblk, k0 = 64 * kb, n0 = 32 * nb;
    const int npx = n0 + (lane & 31);
    const int nl = PERM == 1 ? perm_win(npx) : PERM == 2 ? perm_wkr(npx) : PERM == 3 ? perm_wuq(npx) : npx;
#pragma unroll 8
    for (int i = 0; i < 32; ++i) { const int kk = 2 * i + (lane >> 5); float v = W[(size_t)(k0 + kk) * N + nl]; if (gk) v *= gk[k0 + kk]; scr[kk * 33 + (lane & 31)] = v; }
    asm volatile("s_waitcnt lgkmcnt(0)" ::: "memory");
    const int c = lane & 7;
#pragma unroll
    for (int j = 0; j < 4; ++j) { const int n = (lane >> 3) + 8 * j; const LAS float* s = scr + (8 * c) * 33 + n;
        u32x4 o; o.x = cvtpk(s[0 * 33], s[1 * 33]); o.y = cvtpk(s[2 * 33], s[3 * 33]); o.z = cvtpk(s[4 * 33], s[5 * 33]); o.w = cvtpk(s[6 * 33], s[7 * 33]);
        *(u32x4*)(WT + (size_t)(row_off + n0 + n) * K + k0 + 8 * c) = o; }
    asm volatile("s_waitcnt lgkmcnt(0)" ::: "memory");
}

__device__ __forceinline__ void p0_prologue(Frame& F) {
    LAS float* scr = (LAS float*)(F.lds + F.wave * 16384);
    const int gw = F.vcu * 8 + F.wave, NGW = F.G * 8, lane = F.lane;
    unsigned char* ws = F.ws;
    constexpr int I_WIN = (1024 / 64) * (2048 / 32), I_WKR = (1024 / 64) * 1, I_WUQ = (256 / 64) * (768 / 32), I_WUK = (256 / 64) * (512 / 32), I_WO = (1024 / 64) * (1024 / 32), I_WQ = (1024 / 64) * (2048 / 32);
    constexpr int NIT = I_WIN + I_WKR + I_WUQ + 2 * I_WUK + I_WO + I_WQ;
    for (int it = gw; it < NIT; it += NGW) {
        int r = it;
        if (r < I_WIN) { transpose_item<1>(F.in[2], 1024, 2080, nullptr, (bf16_t*)(ws + WS_WIN), 0, scr, r, 2048 / 32, lane); continue; } r -= I_WIN;
        if (r < I_WKR) { transpose_item<2>(F.in[2], 1024, 2080, nullptr, (bf16_t*)(ws + WS_WKR), 0, scr, r, 1, lane); continue; } r -= I_WKR;
        if (r < I_WUQ) { transpose_item<3>(F.in[5], 256, 768, F.in[3], (bf16_t*)(ws + WS_WUQ), 0, scr, r, 768 / 32, lane); continue; } r -= I_WUQ;
        if (r < I_WUK) { transpose_item<0>(F.in[6], 256, 512, F.in[4], (bf16_t*)(ws + WS_WUKV), 0, scr, r, 512 / 32, lane); continue; } r -= I_WUK;
        if (r < I_WUK) { transpose_item<0>(F.in[7], 256, 512, F.in[4], (bf16_t*)(ws + WS_WUKV), 512, scr, r, 512 / 32, lane); continue; } r -= I_WUK;
        if (r < I_WO) { transpose_item<0>(F.in[8], 1024, 1024, nullptr, (bf16_t*)(ws + WS_WO), 0, scr, r, 1024 / 32, lane); continue; } r -= I_WO;
        transpose_item<0>(F.in[10], 1024, 2048, F.in[9], (bf16_t*)(ws + WS_WQ), 0, scr, r, 2048 / 32, lane);
    }
    for (int rr = gw; rr < M + 2 * 16384; rr += NGW) {
        const float* src; bf16_t* dst; const float* g; bool norm;
        if (rr < M) { src = F.in[0] + (size_t)rr * 1024; dst = (bf16_t*)(ws + WS_XN) + (size_t)rr * 1024; g = F.in[1]; norm = true; }
        else if (rr < M + 16384) { const int e = rr - M; src = F.in[12] + (size_t)e * 1024; dst = (bf16_t*)(ws + WS_U) + (size_t)e * 1024; g = F.in[9]; norm = false; }
        else { const int e = rr - M - 16384; src = F.in[13] + (size_t)e * 1024; dst = (bf16_t*)(ws + WS_V) + (size_t)e * 1024; g = nullptr; norm = false; }
        f32x4 v[4]; float ss = 0.f;
#pragma unroll
        for (int j = 0; j < 4; ++j) { v[j] = *(const f32x4*)(src + 256 * j + 4 * lane); ss += (v[j].x * v[j].x + v[j].y * v[j].y) + (v[j].z * v[j].z + v[j].w * v[j].w); }
        float rs = 1.f;
        if (norm) rs = rsqrtf(wave_sum(ss) * (1.f / 1024.f) + NORM_EPS);
#pragma unroll
        for (int j = 0; j < 4; ++j) { f32x4 gg = {1.f, 1.f, 1.f, 1.f}; if (g) gg = *(const f32x4*)(g + 256 * j + 4 * lane);
            u32x2 o; o.x = cvtpk(v[j].x * rs * gg.x, v[j].y * rs * gg.y); o.y = cvtpk(v[j].z * rs * gg.z, v[j].w * rs * gg.w);
            *(u32x2*)(dst + 256 * j + 4 * lane) = o; }
    }
    {
        const int gt = F.vcu * 512 + F.tid, NT = F.G * 512;
        for (int i = gt; i < 262144 / 8; i += NT) { const f32x4 a = *(const f32x4*)(F.in[11] + (size_t)i * 8), b = *(const f32x4*)(F.in[11] + (size_t)i * 8 + 4);
            u32x4 o; o.x = cvtpk(a.x, a.y); o.y = cvtpk(a.z, a.w); o.z = cvtpk(b.x, b.y); o.w = cvtpk(b.z, b.w); *(u32x4*)((bf16_t*)(ws + WS_KEYS) + (size_t)i * 8) = o; }
        float* CA = (float*)(ws + WS_ROPE); float* SA = CA + 4096 * 32; float* CB = SA + 4096 * 32; float* SB = CB + 4096 * 16;
        for (int i = gt; i < 4096 * 32; i += NT) { const int pos = i >> 5, k = i & 31; const float inv = 1.0f / powf(10000.0f, (float)(2 * k) / 64.0f); const float ang = (float)pos * inv; CA[i] = cosf(ang); SA[i] = sinf(ang); }
        for (int i = gt; i < 4096 * 16; i += NT) { const int pos = i >> 4, k = i & 15; const float inv = 1.0f / powf(10000.0f, (float)(2 * k) / 32.0f); const float ang = (float)pos * inv; CB[i] = cosf(ang); SB[i] = sinf(ang); }
    }
}

struct GemmPlain {
    const bf16_t* A; const bf16_t* Bt; int K, lda, ldb;
    __device__ __forceinline__ const char* a_base(const pg8::Unit& u) const { return (const char*)(A + (size_t)u.pm * 256 * lda); }
    __device__ __forceinline__ const char* b_base(const pg8::Unit& u) const { return (const char*)(Bt + (size_t)u.pn * 256 * ldb); }
};
struct GemmUp {
    const bf16_t* CQ; const bf16_t* CKV; const bf16_t* WUQ; const bf16_t* WUKV; int K, lda, ldb;
    __device__ __forceinline__ const char* a_base(const pg8::Unit& u) const { return (const char*)((u.pn < 3 ? CQ : CKV) + (size_t)u.pm * 256 * 256); }
    __device__ __forceinline__ const char* b_base(const pg8::Unit& u) const { return (const char*)(u.pn < 3 ? WUQ + (size_t)u.pn * 256 * 256 : WUKV + (size_t)(u.pn - 3) * 256 * 256); }
};

__device__ __forceinline__ void rope4(f32x4& v0, f32x4& v1, const f32x4 cs, const f32x4 sn) {
    const f32x4 a = v0, b = v1;
    v0.x = a.x * cs.x - a.y * sn.x; v0.y = a.y * cs.x + a.x * sn.x; v0.z = a.z * cs.y - a.w * sn.y; v0.w = a.w * cs.y + a.z * sn.y;
    v1.x = b.x * cs.z - b.y * sn.z; v1.y = b.y * cs.z + b.x * sn.z; v1.z = b.z * cs.w - b.w * sn.w; v1.w = b.w * cs.w + b.z * sn.w;
}
__device__ __forceinline__ void store8(bf16_t* p, const f32x4 v0, const f32x4 v1) { u32x4 w; w.x = cvtpk(v0.x, v0.y); w.y = cvtpk(v0.z, v0.w); w.z = cvtpk(v1.x, v1.y); w.w = cvtpk(v1.z, v1.w); *(u32x4*)p = w; }
__device__ __forceinline__ float dot4(const f32x4 v) { return (v.x * v.x + v.y * v.y) + (v.z * v.z + v.w * v.w); }

struct EpiP1 {
    static constexpr bool PERM = true;
    bf16_t *QA, *KA, *VA, *CQ, *CKV; float* SSQ1; const float *CA, *SA;
    __device__ __forceinline__ void operator()(const f32x4 (&acc)[2][2][4][2], const pg8::Unit& u, int wr, int wc, int fr, int fq) const {
        const int pn = u.pn, row0 = u.pm * 256 + wr * 64 + fr, cw = wc * 32 + 8 * fq;
        if (pn < 4) {
            bf16_t* base = pn < 2 ? QA : KA; const float sc = pn < 2 ? QSCALE_A : 1.f; const int colt = (pn & 1) * 256 + cw;
#pragma unroll
            for (int ai = 0; ai < 2; ++ai)
#pragma unroll
                for (int m = 0; m < 4; ++m) { const int row = row0 + ai * 128 + m * 16, pos = row & (S - 1);
#pragma unroll
                    for (int bj = 0; bj < 2; ++bj) { const int col = colt + bj * 128, i0 = (col & 63) >> 1;
                        const f32x4 cs = *(const f32x4*)(CA + pos * 32 + i0), sn = *(const f32x4*)(SA + pos * 32 + i0);
                        f32x4 v0 = acc[ai][bj][m][0] * sc, v1 = acc[ai][bj][m][1] * sc; rope4(v0, v1, cs, sn);
                        store8(base + (size_t)row * 512 + col, v0, v1); } }
        } else if (pn < 6) {
            const int colt = (pn & 1) * 256 + cw;
#pragma unroll
            for (int ai = 0; ai < 2; ++ai)
#pragma unroll
                for (int m = 0; m < 4; ++m) { const int row = row0 + ai * 128 + m * 16;
#pragma unroll
                    for (int bj = 0; bj < 2; ++bj) store8(VA + (size_t)row * 512 + colt + bj * 128, acc[ai][bj][m][0], acc[ai][bj][m][1]); }
        } else {
            bf16_t* base = pn == 6 ? CQ : CKV;
#pragma unroll
            for (int ai = 0; ai < 2; ++ai)
#pragma unroll
                for (int m = 0; m < 4; ++m) { const int row = row0 + ai * 128 + m * 16; float s = 0.f;
#pragma unroll
                    for (int bj = 0; bj < 2; ++bj) { store8(base + (size_t)row * 256 + cw + bj * 128, acc[ai][bj][m][0], acc[ai][bj][m][1]); s += dot4(acc[ai][bj][m][0]) + dot4(acc[ai][bj][m][1]); }
                    s += __shfl_xor(s, 16); s += __shfl_xor(s, 32);
                    if (fq == 0) SSQ1[(size_t)row * 8 + (pn - 6) * 4 + wc] = s; }
        }
    }
};
struct EpiP2 {
    static constexpr bool PERM = true;
    bf16_t *QB, *KN, *VB; const float* SSQ1; const float *CB, *SB;
    __device__ __forceinline__ void operator()(const f32x4 (&acc)[2][2][4][2], const pg8::Unit& u, int wr, int wc, int fr, int fq) const {
        const int pn = u.pn, row0 = u.pm * 256 + wr * 64 + fr, cw = wc * 32 + 8 * fq, grp = pn < 3 ? 0 : 1;
#pragma unroll
        for (int ai = 0; ai < 2; ++ai)
#pragma unroll
            for (int m = 0; m < 4; ++m) { const int row = row0 + ai * 128 + m * 16, pos = row & (S - 1);
                const f32x4 sq = *(const f32x4*)(SSQ1 + (size_t)row * 8 + grp * 4);
                const float rs = rsqrtf(((sq.x + sq.y) + (sq.z + sq.w)) * (1.f / 256.f) + NORM_EPS);
                if (pn < 3) {
#pragma unroll
                    for (int bj = 0; bj < 2; ++bj) { const int col = pn * 256 + bj * 128 + cw, p = col % 96; const float sc = rs * QSCALE_B;
                        f32x4 v0 = acc[ai][bj][m][0] * sc, v1 = acc[ai][bj][m][1] * sc;
                        if (p >= 64) { const int i0 = (p - 64) >> 1; const f32x4 cs = *(const f32x4*)(CB + pos * 16 + i0), sn = *(const f32x4*)(SB + pos * 16 + i0); rope4(v0, v1, cs, sn); }
                        store8(QB + (size_t)row * 768 + col, v0, v1); }
                } else {
                    bf16_t* base = pn < 5 ? KN : VB; const int colt = ((pn - 3) & 1) * 256 + cw;
#pragma unroll
                    for (int bj = 0; bj < 2; ++bj) store8(base + (size_t)row * 512 + colt + bj * 128, acc[ai][bj][m][0] * rs, acc[ai][bj][m][1] * rs);
                }
            }
    }
};
struct EpiP4 {
    static constexpr bool PERM = true;
    const float* X; float* X2; bf16_t* X2B; float* SSQ2;
    __device__ __forceinline__ void operator()(const f32x4 (&acc)[2][2][4][2], const pg8::Unit& u, int wr, int wc, int fr, int fq) const {
        const int row0 = u.pm * 256 + wr * 64 + fr, colt = u.pn * 256 + wc * 32 + 8 * fq;
#pragma unroll
        for (int ai = 0; ai < 2; ++ai)
#pragma unroll
            for (int m = 0; m < 4; ++m) { const int row = row0 + ai * 128 + m * 16; float s = 0.f;
#pragma unroll
                for (int bj = 0; bj < 2; ++bj) { const size_t off = (size_t)row * 1024 + colt + bj * 128;
                    const f32x4 v0 = acc[ai][bj][m][0] + *(const f32x4*)(X + off), v1 = acc[ai][bj][m][1] + *(const f32x4*)(X + off + 4);
                    *(f32x4*)(X2 + off) = v0; *(f32x4*)(X2 + off + 4) = v1; store8(X2B + off, v0, v1); s += dot4(v0) + dot4(v1); }
                s += __shfl_xor(s, 16); s += __shfl_xor(s, 32);
                if (fq == 0) SSQ2[(size_t)row * 16 + u.pn * 4 + wc] = s; }
    }
};
struct EpiP5 {
    static constexpr bool PERM = true;
    bf16_t* QP; const float* SSQ2;
    __device__ __forceinline__ void operator()(const f32x4 (&acc)[2][2][4][2], const pg8::Unit& u, int wr, int wc, int fr, int fq) const {
        const int row0 = u.pm * 256 + wr * 64 + fr, colt = u.pn * 256 + wc * 32 + 8 * fq;
#pragma unroll
        for (int ai = 0; ai < 2; ++ai)
#pragma unroll
            for (int m = 0; m < 4; ++m) { const int row = row0 + ai * 128 + m * 16;
                const f32x4* sp = (const f32x4*)(SSQ2 + (size_t)row * 16); const f32x4 a = sp[0], b = sp[1], c = sp[2], d = sp[3];
                const float ss = ((a.x + a.y) + (a.z + a.w)) + ((b.x + b.y) + (b.z + b.w)) + ((c.x + c.y) + (c.z + c.w)) + ((d.x + d.y) + (d.z + d.w));
                const float rs = rsqrtf(ss * (1.f / 1024.f) + NORM_EPS);
#pragma unroll
                for (int bj = 0; bj < 2; ++bj) store8(QP + (size_t)row * 2048 + colt + bj * 128, acc[ai][bj][m][0] * rs, acc[ai][bj][m][1] * rs); }
    }
};

__device__ __forceinline__ void p1_krope(Frame& F) {
    const bf16_t* XN = (const bf16_t*)(F.ws + WS_XN); const bf16_t* WK = (const bf16_t*)(F.ws + WS_WKR); bf16_t* KR = (bf16_t*)(F.ws + WS_KR);
    const float* CB = (const float*)(F.ws + WS_ROPE) + 2 * 4096 * 32; const float* SB = CB + 4096 * 16;
    const int lane = F.lane, fr = lane & 15, fq = lane >> 4;
    for (int blk = F.vcu; blk < M / 128; blk += F.G) {
        const int row0 = blk * 128 + F.wave * 16;
        f32x4 c0 = {0.f, 0.f, 0.f, 0.f}, c1 = {0.f, 0.f, 0.f, 0.f};
        const bf16_t* ap = XN + (size_t)(row0 + fr) * 1024 + 8 * fq;
        const bf16_t* b0p = WK + (size_t)fr * 1024 + 8 * fq; const bf16_t* b1p = WK + (size_t)(16 + fr) * 1024 + 8 * fq;
#pragma unroll 4
        for (int ks = 0; ks < 32; ++ks) {
            const bf16x8 a = *(const bf16x8*)(ap + ks * 32), b0 = *(const bf16x8*)(b0p + ks * 32), b1 = *(const bf16x8*)(b1p + ks * 32);
            c0 = __builtin_amdgcn_mfma_f32_16x16x32_bf16(b0, a, c0, 0, 0, 0);
            c1 = __builtin_amdgcn_mfma_f32_16x16x32_bf16(b1, a, c1, 0, 0, 0);
        }
        const int row = row0 + fr, pos = row & (S - 1);
        u32x2 w0, w1;
        { const int i = 2 * fq; const float ca = CB[pos * 16 + i], sa = SB[pos * 16 + i], cb = CB[pos * 16 + i + 1], sb = SB[pos * 16 + i + 1];
          w0.x = cvtpk(c0.x * ca - c0.y * sa, c0.y * ca + c0.x * sa); w0.y = cvtpk(c0.z * cb - c0.w * sb, c0.w * cb + c0.z * sb); }
        { const int i = 8 + 2 * fq; const float ca = CB[pos * 16 + i], sa = SB[pos * 16 + i], cb = CB[pos * 16 + i + 1], sb = SB[pos * 16 + i + 1];
          w1.x = cvtpk(c1.x * ca - c1.y * sa, c1.y * ca + c1.x * sa); w1.y = cvtpk(c1.z * cb - c1.w * sb, c1.w * cb + c1.z * sb); }
        *(u32x2*)(KR + (size_t)row * 32 + 4 * fq) = w0; *(u32x2*)(KR + (size_t)row * 32 + 16 + 4 * fq) = w1;
    }
}
constexpr int AT_SLOT = 20480, AT_KB = 0, AT_VB = 12288;
__device__ __forceinline__ int crow(int r, int hi) { return (r & 3) + 8 * (r >> 2) + 4 * hi; }
__device__ __forceinline__ s16x4 vtr(const LAS unsigned char* p) { return __builtin_bit_cast(s16x4, __builtin_amdgcn_ds_read_tr16_b64_v4i16((LAS s16x4*)p)); }

template <int NKS>
struct AttnCore {
    bf16x8 qr[NKS]; f32x16 o0, o1; float m, l;
    __device__ __forceinline__ void init() { m = -1.0e30f; l = 0.f;
#pragma unroll
        for (int r = 0; r < 16; ++r) { o0[r] = 0.f; o1[r] = 0.f; } }
    template <class MaskF>
    __device__ __forceinline__ void tile(const LAS unsigned char* slot, int lane, bool need_mask, const MaskF& valid) {
        const int r32 = lane & 31, hi = lane >> 5;
        f32x16 p0, p1;
#pragma unroll
        for (int r = 0; r < 16; ++r) { p0[r] = 0.f; p1[r] = 0.f; }
        const LAS unsigned char* kb = slot + AT_KB + hi * 1024 + r32 * 16;
#pragma unroll
        for (int d0 = 0; d0 < NKS; ++d0) {
            const bf16x8 b0 = *(const LAS bf16x8*)(kb + d0 * 2048), b1 = *(const LAS bf16x8*)(kb + d0 * 2048 + 512);
            p0 = __builtin_amdgcn_mfma_f32_32x32x16_bf16(b0, qr[d0], p0, 0, 0, 0);
            p1 = __builtin_amdgcn_mfma_f32_32x32x16_bf16(b1, qr[d0], p1, 0, 0, 0);
        }
        if (need_mask) {
#pragma unroll
            for (int r = 0; r < 16; ++r) { const int kk = crow(r, hi); if (!valid(kk)) p0[r] = -INFINITY; if (!valid(kk + 32)) p1[r] = -INFINITY; }
        }
        float mx = fmaxf(p0[0], p1[0]);
#pragma unroll
        for (int r = 1; r < 16; ++r) mx = fmaxf(mx, fmaxf(p0[r], p1[r]));
        mx = fmaxf(mx, __shfl_xor(mx, 32));
        const float mn = fmaxf(m, mx), alpha = __builtin_amdgcn_exp2f(m - mn);
        m = mn;
        float sum = 0.f;
#pragma unroll
        for (int r = 0; r < 16; ++r) { p0[r] = __builtin_amdgcn_exp2f(p0[r] - mn); p1[r] = __builtin_amdgcn_exp2f(p1[r] - mn); sum += p0[r] + p1[r]; }
        l = l * alpha + sum;
#pragma unroll
        for (int r = 0; r < 16; ++r) { o0[r] *= alpha; o1[r] *= alpha; }
        u32x4 pw[4];
        pw[0] = (u32x4){cvtpk(p0[0], p0[1]), cvtpk(p0[2], p0[3]), cvtpk(p0[4], p0[5]), cvtpk(p0[6], p0[7])};
        pw[1] = (u32x4){cvtpk(p0[8], p0[9]), cvtpk(p0[10], p0[11]), cvtpk(p0[12], p0[13]), cvtpk(p0[14], p0[15])};
        pw[2] = (u32x4){cvtpk(p1[0], p1[1]), cvtpk(p1[2], p1[3]), cvtpk(p1[4], p1[5]), cvtpk(p1[6], p1[7])};
        pw[3] = (u32x4){cvtpk(p1[8], p1[9]), cvtpk(p1[10], p1[11]), cvtpk(p1[12], p1[13]), cvtpk(p1[14], p1[15])};
        const LAS unsigned char* vb = slot + AT_VB + ((lane >> 4) & 1) * 32 + (lane & 3) * 8 + (4 * hi + ((lane & 15) >> 2)) * 64;
#pragma unroll
        for (int s = 0; s < 4; ++s) {
            const s16x4 lo0 = vtr(vb + s * 1024), hi0 = vtr(vb + s * 1024 + 512), lo1 = vtr(vb + 4096 + s * 1024), hi1 = vtr(vb + 4096 + s * 1024 + 512);
            const bf16x8 v0 = {lo0[0], lo0[1], lo0[2], lo0[3], hi0[0], hi0[1], hi0[2], hi0[3]}, v1 = {lo1[0], lo1[1], lo1[2], lo1[3], hi1[0], hi1[1], hi1[2], hi1[3]};
            const bf16x8 pb = __builtin_bit_cast(bf16x8, pw[s]);
            o0 = __builtin_amdgcn_mfma_f32_32x32x16_bf16(v0, pb, o0, 0, 0, 0);
            o1 = __builtin_amdgcn_mfma_f32_32x32x16_bf16(v1, pb, o1, 0, 0, 0);
        }
    }
    __device__ __forceinline__ float ltot() const { return l + __shfl_xor(l, 32); }
};

__device__ __forceinline__ void glds16(const void* gsrc, LAS unsigned char* dst) { __builtin_amdgcn_global_load_lds((const unsigned*)gsrc, (LAS unsigned*)dst, 16, 0, 0); }

__device__ __forceinline__ void p3a_dilated(Frame& F) {
    const bf16_t* QA = (const bf16_t*)(F.ws + WS_QA); const bf16_t* KA = (const bf16_t*)(F.ws + WS_KA); const bf16_t* VA = (const bf16_t*)(F.ws + WS_VA);
    bf16_t* OP = (bf16_t*)((unsigned char*)F.out + DO_OP); float* LSE = (float*)((unsigned char*)F.out + DO_LSE);
    const int lane = F.lane, w = F.wave, r32 = lane & 31, hi = lane >> 5;
    constexpr int UPC = 3072 / 256;
    for (int i = 0; i < UPC; ++i) {
        const int e = F.vcu * UPC + i;
        if (e >= 3072) break;
        const int bh = e / 48, rem = e % 48, pat = rem >> 4, idx = rem & 15, b = bh >> 3, h = bh & 7;
        const int dl = pat * 2, dil = 1 << dl;
        const int nb2 = 16 >> dl;
        const int res = idx / nb2, u2 = idx % nb2, m0 = u2 * 256;
        const size_t rowb = (size_t)b * S;
        AttnCore<4> A; A.init();
        const int mq = m0 + 32 * w + r32;
        const size_t qrow = rowb + (size_t)mq * dil + res;
#pragma unroll
        for (int d0 = 0; d0 < 4; ++d0) A.qr[d0] = *(const bf16x8*)(QA + qrow * 512 + h * 64 + d0 * 16 + hi * 8);
        const int j0 = (u2 == 0) ? 2 : 0;
        auto issue = [&](int j) {
            const int mk0 = m0 - 128 + 64 * j; LAS unsigned char* slot = F.lds + (j & 1) * AT_SLOT;
            const size_t krow = rowb + (size_t)(mk0 + lane) * dil + res;
            glds16(KA + krow * 512 + h * 64 + w * 8, slot + AT_KB + w * 1024);
            const size_t vrow = rowb + (size_t)(mk0 + 16 * (w & 3) + (lane >> 2)) * dil + res;
            glds16(VA + vrow * 512 + h * 64 + (w >> 2) * 32 + (lane & 3) * 8, slot + AT_VB + w * 1024);
        };
        issue(j0);
        for (int j = j0; j < 6; ++j) {
            __syncthreads();
            if (j + 1 < 6) issue(j + 1);
            const int klo = 64 * j - 128, qlo = 32 * w;
            if (klo + 63 >= qlo - 128 && klo <= qlo + 31) {
                const int mk0 = m0 + klo;
                A.tile(F.lds + (j & 1) * AT_SLOT, lane, true, [&](int kk) { return (unsigned)(mq - mk0 - kk) <= 128u; });
            }
        }
        __syncthreads();
        const float lt = A.ltot(), inv = 1.f / lt;
        bf16_t* orow = OP + ((size_t)pat * M + qrow) * 512 + h * 64;
#pragma unroll
        for (int g = 0; g < 4; ++g) {
            u32x2 w0 = {cvtpk(A.o0[4 * g] * inv, A.o0[4 * g + 1] * inv), cvtpk(A.o0[4 * g + 2] * inv, A.o0[4 * g + 3] * inv)};
            u32x2 w1 = {cvtpk(A.o1[4 * g] * inv, A.o1[4 * g + 1] * inv), cvtpk(A.o1[4 * g + 2] * inv, A.o1[4 * g + 3] * inv)};
            *(u32x2*)(orow + 8 * g + 4 * hi) = w0; *(u32x2*)(orow + 32 + 8 * g + 4 * hi) = w1;
        }
        if (hi == 0) LSE[((size_t)pat * M + qrow) * 8 + h] = A.m + __builtin_amdgcn_logf(lt);
    }
}

__device__ __forceinline__ void p3b_mla(Frame& F) {
    const bf16_t* QB = (const bf16_t*)(F.ws + WS_QB); const bf16_t* KN = (const bf16_t*)(F.ws + WS_KN); const bf16_t* KR = (const bf16_t*)(F.ws + WS_KR); const bf16_t* VB = (const bf16_t*)(F.ws + WS_VB);
    const bf16_t* OP = (const bf16_t*)((const unsigned char*)F.out + DO_OP); const float* LSE = (const float*)((const unsigned char*)F.out + DO_LSE);
    bf16_t* MIX = (bf16_t*)(F.ws + WS_MIX);
    const int lane = F.lane, w = F.wave, r32 = lane & 31, hi = lane >> 5;
    for (int i = 0; i < 4; ++i) {
        const int v = F.vcu; if (v >= 256) break;
        const int bh = v >> 2, s = v & 3, qb = (i == 0) ? s : (i == 1) ? 7 - s : (i == 2) ? 8 + s : 15 - s;
        const int b = bh >> 3, h = bh & 7; const size_t rowb = (size_t)b * S;
        const int qpos = qb * 256 + 32 * w + r32; const size_t qrow = rowb + qpos;
        AttnCore<6> A; A.init();
#pragma unroll
        for (int d0 = 0; d0 < 6; ++d0) A.qr[d0] = *(const bf16x8*)(QB + qrow * 768 + h * 96 + d0 * 16 + hi * 8);
        const int NT = 4 * qb + 4;
        auto issue = [&](int t) {
            LAS unsigned char* slot = F.lds + (t & 1) * AT_SLOT; const size_t krow = rowb + 64 * t + lane;
            glds16(KN + krow * 512 + h * 64 + w * 8, slot + AT_KB + w * 1024);
            if (w < 4) glds16(KR + krow * 32 + w * 8, slot + AT_KB + (8 + w) * 1024);
            const size_t vrow = rowb + 64 * t + 16 * (w & 3) + (lane >> 2);
            glds16(VB + vrow * 512 + h * 64 + (w >> 2) * 32 + (lane & 3) * 8, slot + AT_VB + w * 1024);
        };
        issue(0);
        const int qmin = qb * 256 + 32 * w;
        for (int t = 0; t < NT; ++t) {
            __syncthreads();
            if (t + 1 < NT) issue(t + 1);
            const int k0 = 64 * t;
            if (k0 <= qmin + 31) A.tile(F.lds + (t & 1) * AT_SLOT, lane, k0 + 63 > qmin, [&](int kk) { return k0 + kk <= qpos; });
        }
        __syncthreads();
        const float inv = 1.f / A.ltot();
        const float l0 = LSE[((size_t)0 * M + qrow) * 8 + h], l1 = LSE[((size_t)1 * M + qrow) * 8 + h], l2 = LSE[((size_t)2 * M + qrow) * 8 + h];
        const float lm = fmaxf(l0, fmaxf(l1, l2));
        float w0 = __builtin_amdgcn_exp2f(l0 - lm), w1 = __builtin_amdgcn_exp2f(l1 - lm), w2 = __builtin_amdgcn_exp2f(l2 - lm);
        const float wi = 1.f / (w0 + w1 + w2); w0 *= wi; w1 *= wi; w2 *= wi;
        bf16_t* mrow = MIX + qrow * 1024 + h * 64;
#pragma unroll
        for (int g = 0; g < 4; ++g) {
#pragma unroll
            for (int dh = 0; dh < 2; ++dh) {
                const int dc = dh * 32 + 8 * g + 4 * hi;
                const u32x2 a0 = *(const u32x2*)(OP + ((size_t)0 * M + qrow) * 512 + h * 64 + dc), a1 = *(const u32x2*)(OP + ((size_t)1 * M + qrow) * 512 + h * 64 + dc), a2 = *(const u32x2*)(OP + ((size_t)2 * M + qrow) * 512 + h * 64 + dc);
                u32x2 oa;
                oa.x = cvtpk(w0 * bf_lo(a0.x) + w1 * bf_lo(a1.x) + w2 * bf_lo(a2.x), w0 * bf_hi(a0.x) + w1 * bf_hi(a1.x) + w2 * bf_hi(a2.x));
                oa.y = cvtpk(w0 * bf_lo(a0.y) + w1 * bf_lo(a1.y) + w2 * bf_lo(a2.y), w0 * bf_hi(a0.y) + w1 * bf_hi(a1.y) + w2 * bf_hi(a2.y));
                *(u32x2*)(mrow + dc) = oa;
                u32x2 ob;
                if (dh == 0) ob = (u32x2){cvtpk(A.o0[4 * g] * inv, A.o0[4 * g + 1] * inv), cvtpk(A.o0[4 * g + 2] * inv, A.o0[4 * g + 3] * inv)};
                else ob = (u32x2){cvtpk(A.o1[4 * g] * inv, A.o1[4 * g + 1] * inv), cvtpk(A.o1[4 * g + 2] * inv, A.o1[4 * g + 3] * inv)};
                *(u32x2*)(mrow + 512 + dc) = ob;
            }
        }
    }
}
#define CE_DESC(a, b) do { const float _h = fmaxf(a, b), _l = fminf(a, b); a = _h; b = _l; } while (0)
__device__ __forceinline__ void sort16_desc(float (&v)[16]) {
#pragma unroll
    for (int k = 2; k <= 16; k <<= 1)
#pragma unroll
        for (int j = k >> 1; j > 0; j >>= 1)
#pragma unroll
            for (int i = 0; i < 16; ++i) { const int l = i ^ j; if (l > i) { if ((i & k) == 0) CE_DESC(v[i], v[l]); else CE_DESC(v[l], v[i]); } }
}
__device__ __forceinline__ void merge_top16(float (&a)[16], const float (&b)[16]) {
#pragma unroll
    for (int i = 0; i < 16; ++i) a[i] = fmaxf(a[i], b[15 - i]);
#pragma unroll
    for (int j = 8; j > 0; j >>= 1)
#pragma unroll
        for (int i = 0; i < 16; ++i) { const int l = i ^ j; if (l > i) CE_DESC(a[i], a[l]); }
}
__device__ __forceinline__ void xmerge(float (&a)[16], int xmask) {
    float b[16];
#pragma unroll
    for (int i = 0; i < 16; ++i) b[i] = __shfl_xor(a[i], xmask);
    merge_top16(a, b);
}
__device__ __forceinline__ float sel4(int g, float a0, float a1, float a2, float a3) { const float lo = (g & 1) ? a1 : a0, hi = (g & 1) ? a3 : a2; return (g & 2) ? hi : lo; }
__device__ __forceinline__ float pack_code(float v, unsigned code, unsigned mask) { return __builtin_bit_cast(float, (__builtin_bit_cast(unsigned, v) & ~mask) | code); }
__device__ __forceinline__ float gelu_erf(float v) { return 0.5f * v * (1.0f + erff(v * 0.70710678118654752f)); }

constexpr int PEER_WAVE_LDS = 4096 + 8192 + 512;

__device__ __forceinline__ void p6_peer(Frame& F) {
    const bf16_t* QP = (const bf16_t*)F.out; const bf16_t* KEYS = (const bf16_t*)(F.ws + WS_KEYS);
    const bf16_t* U = (const bf16_t*)(F.ws + WS_U); const bf16_t* V = (const bf16_t*)(F.ws + WS_V);
    const bf16_t* X2B = (const bf16_t*)(F.ws + WS_X2B); const float* X2 = (const float*)(F.ws + WS_X2); const float* SSQ2 = (const float*)(F.ws + WS_SSQ2);
    const float* gfin = F.in[14];
    const int lane = F.lane, w = F.wave, tk = lane & 15, g = lane >> 4;
    LAS unsigned char* wl = F.lds + w * PEER_WAVE_LDS;
    LAS unsigned short* eidL = (LAS unsigned short*)wl; LAS float* gateL = (LAS float*)(wl + 4096); LAS unsigned char* tabL = wl + 4096 + 8192;
    for (int blk = F.vcu; blk < M / 128; blk += F.G) {
        const int tok0 = blk * 128 + w * 16;
        for (int h = 0; h < 8; ++h) {
            float s12[2][16];
#pragma unroll
            for (int p = 0; p < 2; ++p) {
                const int hp = h * 2 + p;
                bf16x8 bq[4];
#pragma unroll
                for (int ks = 0; ks < 4; ++ks) bq[ks] = *(const bf16x8*)(QP + (size_t)(tok0 + tk) * 2048 + hp * 128 + ks * 32 + g * 8);
                f32x4 c[8];
#pragma unroll
                for (int nt = 0; nt < 8; ++nt) { c[nt] = (f32x4){0.f, 0.f, 0.f, 0.f};
#pragma unroll
                    for (int ks = 0; ks < 4; ++ks) { const bf16x8 ak = *(const bf16x8*)(KEYS + ((size_t)hp * 128 + nt * 16 + tk) * 128 + ks * 32 + g * 8);
                        c[nt] = __builtin_amdgcn_mfma_f32_16x16x32_bf16(ak, bq[ks], c[nt], 0, 0, 0); } }
                float va[16], vb[16];
                const unsigned lo = 127u - 4u * (unsigned)g;
#pragma unroll
                for (int nt = 0; nt < 4; ++nt)
#pragma unroll
                    for (int r = 0; r < 4; ++r) { va[nt * 4 + r] = pack_code(c[nt][r], lo - (unsigned)(16 * nt + r), 127u); vb[nt * 4 + r] = pack_code(c[nt + 4][r], lo - (unsigned)(16 * (nt + 4) + r), 127u); }
                sort16_desc(va); sort16_desc(vb); merge_top16(va, vb);
                xmerge(va, 16); xmerge(va, 32);
#pragma unroll
                for (int i = 0; i < 16; ++i) s12[p][i] = va[i];
                if (g == 0) {
#pragma unroll
                    for (int i = 0; i < 16; ++i) tabL[tk * 32 + p * 16 + i] = (unsigned char)(127u - (__builtin_bit_cast(unsigned, va[i]) & 127u));
                }
            }
            float cd[16];
#define S1(i) s12[0][i]
#define S2(j) s12[1][j]
#define CND(slot, i0, j0, i1, j1, i2, j2, i3, j3) cd[slot] = pack_code(sel4(g, S1(i0), S1(i1), S1(i2), S1(i3)) + sel4(g, S2(j0), S2(j1), S2(j2), S2(j3)), \
                255u - (unsigned)(g == 0 ? (i0) * 16 + (j0) : g == 1 ? (i1) * 16 + (j1) : g == 2 ? (i2) * 16 + (j2) : (i3) * 16 + (j3)), 255u)
            CND(0, 0, 0, 0, 1, 0, 2, 0, 3);   CND(1, 0, 4, 0, 5, 0, 6, 0, 7);   CND(2, 0, 8, 0, 9, 0, 10, 0, 11); CND(3, 0, 12, 0, 13, 0, 14, 0, 15);
            CND(4, 1, 0, 1, 1, 1, 2, 1, 3);   CND(5, 1, 4, 1, 5, 1, 6, 1, 7);   CND(6, 2, 0, 2, 1, 2, 2, 2, 3);   CND(7, 2, 4, 3, 0, 3, 1, 3, 2);
            CND(8, 3, 3, 4, 0, 4, 1, 4, 2);   CND(9, 5, 0, 5, 1, 6, 0, 6, 1);   CND(10, 7, 0, 7, 1, 8, 0, 9, 0);  CND(11, 10, 0, 11, 0, 12, 0, 13, 0);
            { const float t = sel4(g, S1(14), S1(15), S1(15), S1(15)) + S2(0); const float pk = pack_code(t, 255u - (unsigned)(g == 0 ? 14 * 16 : 15 * 16), 255u); cd[12] = (g < 2) ? pk : -INFINITY; }
            cd[13] = -INFINITY; cd[14] = -INFINITY; cd[15] = -INFINITY;
#undef CND
#undef S1
#undef S2
            sort16_desc(cd); xmerge(cd, 16); xmerge(cd, 32);
            asm volatile("s_waitcnt lgkmcnt(0)" ::: "memory");
            float ev[16], sum = 0.f; const float mx = cd[0];
#pragma unroll
            for (int k = 0; k < 16; ++k) { ev[k] = __builtin_amdgcn_exp2f((cd[k] - mx) * LOG2E); sum += ev[k]; }
            const float isum = 1.f / sum;
            if (g == 0) {
#pragma unroll
                for (int k = 0; k < 16; ++k) { const unsigned code = 255u - (__builtin_bit_cast(unsigned, cd[k]) & 255u);
                    const unsigned e1 = tabL[tk * 32 + (code >> 4)], e2 = tabL[tk * 32 + 16 + (code & 15u)];
                    eidL[tk * 128 + h * 16 + k] = (unsigned short)(e1 * 128u + e2); gateL[tk * 128 + h * 16 + k] = ev[k] * isum; }
            }
            asm volatile("s_waitcnt lgkmcnt(0)" ::: "memory");
        }
        for (int t = 0; t < 16; ++t) {
            const int tok = tok0 + t;
            const u32x4 xa = *(const u32x4*)(X2B + (size_t)tok * 1024 + 8 * lane), xb = *(const u32x4*)(X2B + (size_t)tok * 1024 + 512 + 8 * lane);
            const f32x4* sp = (const f32x4*)(SSQ2 + (size_t)tok * 16); const f32x4 q0 = sp[0], q1 = sp[1], q2 = sp[2], q3 = sp[3];
            const float ssq = ((q0.x + q0.y) + (q0.z + q0.w)) + ((q1.x + q1.y) + (q1.z + q1.w)) + ((q2.x + q2.y) + (q2.z + q2.w)) + ((q3.x + q3.y) + (q3.z + q3.w));
            const float rs2 = rsqrtf(ssq * (1.f / 1024.f) + NORM_EPS);
            const unsigned e_lo = eidL[t * 128 + lane], e_hi = eidL[t * 128 + 64 + lane];
            float hsel0 = 0.f, hsel1 = 0.f;
            for (int k = 0; k < 128; ++k) {
                const unsigned e = (unsigned)__builtin_amdgcn_readlane((int)(k < 64 ? e_lo : e_hi), k & 63);
                const bf16_t* ur = U + (size_t)e * 1024;
                const u32x4 ua = *(const u32x4*)(ur + 8 * lane), ub = *(const u32x4*)(ur + 512 + 8 * lane);
                float a = 0.f;
                a += bf_lo(ua.x) * bf_lo(xa.x) + bf_hi(ua.x) * bf_hi(xa.x); a += bf_lo(ua.y) * bf_lo(xa.y) + bf_hi(ua.y) * bf_hi(xa.y);
                a += bf_lo(ua.z) * bf_lo(xa.z) + bf_hi(ua.z) * bf_hi(xa.z); a += bf_lo(ua.w) * bf_lo(xa.w) + bf_hi(ua.w) * bf_hi(xa.w);
                a += bf_lo(ub.x) * bf_lo(xb.x) + bf_hi(ub.x) * bf_hi(xb.x); a += bf_lo(ub.y) * bf_lo(xb.y) + bf_hi(ub.y) * bf_hi(xb.y);
                a += bf_lo(ub.z) * bf_lo(xb.z) + bf_hi(ub.z) * bf_hi(xb.z); a += bf_lo(ub.w) * bf_lo(xb.w) + bf_hi(ub.w) * bf_hi(xb.w);
                a = wave_sum(a);
                if (k < 64) { if (lane == k) hsel0 = a; } else { if (lane == k - 64) hsel1 = a; }
            }
            const float c0 = gelu_erf(hsel0 * rs2) * gateL[t * 128 + lane], c1 = gelu_erf(hsel1 * rs2) * gateL[t * 128 + 64 + lane];
            float y[16];
#pragma unroll
            for (int j = 0; j < 16; ++j) y[j] = 0.f;
            for (int k = 0; k < 128; ++k) {
                const unsigned e = (unsigned)__builtin_amdgcn_readlane((int)(k < 64 ? e_lo : e_hi), k & 63);
                const float ck = __builtin_bit_cast(float, __builtin_amdgcn_readlane(__builtin_bit_cast(int, k < 64 ? c0 : c1), k & 63));
                const bf16_t* vr = V + (size_t)e * 1024;
                const u32x4 va = *(const u32x4*)(vr + 8 * lane), vb = *(const u32x4*)(vr + 512 + 8 * lane);
                y[0] += ck * bf_lo(va.x); y[1] += ck * bf_hi(va.x); y[2] += ck * bf_lo(va.y); y[3] += ck * bf_hi(va.y);
                y[4] += ck * bf_lo(va.z); y[5] += ck * bf_hi(va.z); y[6] += ck * bf_lo(va.w); y[7] += ck * bf_hi(va.w);
                y[8] += ck * bf_lo(vb.x); y[9] += ck * bf_hi(vb.x); y[10] += ck * bf_lo(vb.y); y[11] += ck * bf_hi(vb.y);
                y[12] += ck * bf_lo(vb.z); y[13] += ck * bf_hi(vb.z); y[14] += ck * bf_lo(vb.w); y[15] += ck * bf_hi(vb.w);
            }
            const float* xr = X2 + (size_t)tok * 1024;
            const f32x4 r0 = *(const f32x4*)(xr + 8 * lane), r1 = *(const f32x4*)(xr + 8 * lane + 4), r2 = *(const f32x4*)(xr + 512 + 8 * lane), r3 = *(const f32x4*)(xr + 512 + 8 * lane + 4);
            y[0] += r0.x; y[1] += r0.y; y[2] += r0.z; y[3] += r0.w; y[4] += r1.x; y[5] += r1.y; y[6] += r1.z; y[7] += r1.w;
            y[8] += r2.x; y[9] += r2.y; y[10] += r2.z; y[11] += r2.w; y[12] += r3.x; y[13] += r3.y; y[14] += r3.z; y[15] += r3.w;
            float ss = 0.f;
#pragma unroll
            for (int j = 0; j < 16; ++j) ss += y[j] * y[j];
            ss = wave_sum(ss);
            const float rs = rsqrtf(ss * (1.f / 1024.f) + NORM_EPS);
            const f32x4 g0 = *(const f32x4*)(gfin + 8 * lane), g1 = *(const f32x4*)(gfin + 8 * lane + 4), g2 = *(const f32x4*)(gfin + 512 + 8 * lane), g3 = *(const f32x4*)(gfin + 512 + 8 * lane + 4);
            float* orow = F.out + (size_t)tok * 1024;
            *(f32x4*)(orow + 8 * lane) = (f32x4){y[0] * rs * g0.x, y[1] * rs * g0.y, y[2] * rs * g0.z, y[3] * rs * g0.w};
            *(f32x4*)(orow + 8 * lane + 4) = (f32x4){y[4] * rs * g1.x, y[5] * rs * g1.y, y[6] * rs * g1.z, y[7] * rs * g1.w};
            *(f32x4*)(orow + 512 + 8 * lane) = (f32x4){y[8] * rs * g2.x, y[9] * rs * g2.y, y[10] * rs * g2.z, y[11] * rs * g2.w};
            *(f32x4*)(orow + 512 + 8 * lane + 4) = (f32x4){y[12] * rs * g3.x, y[13] * rs * g3.y, y[14] * rs * g3.z, y[15] * rs * g3.w};
        }
    }
}
constexpr int LDS_BYTES = 147456;
constexpr int NPHASE = 8;

__global__ void __launch_bounds__(512, 2) fwd_kernel(Args args) {
    extern __shared__ __attribute__((aligned(16))) unsigned char lds_raw[];
    Frame F;
    F.lds = (LAS unsigned char*)lds_raw;
    F.tid = threadIdx.x; F.lane = F.tid & 63; F.wave = __builtin_amdgcn_readfirstlane(F.tid >> 6);
    F.G = gridDim.x; { const int bx = blockIdx.x; F.vcu = (F.G % 8 == 0) ? (bx % 8) * (F.G / 8) + bx / 8 : bx; }
#pragma unroll
    for (int i = 0; i < 15; ++i) F.in[i] = args.in[i];
    F.out = args.out; F.ws = args.ws;
    unsigned char* ws = args.ws;
    const int lo = args.ph_lo, hi = args.ph_hi;
#if ONE_LAUNCH
    cg::grid_group grid = cg::this_grid();
#define SEAM(k) do { if (lo <= (k) && (k) + 1 < hi) grid.sync(); } while (0)
#else
#define SEAM(k) do { } while (0)
#endif
#define IN(k) (lo <= (k) && (k) < hi)
    if (IN(0)) { p0_prologue(F); SEAM(0); }
    if (IN(1)) {
        GemmPlain g{(const bf16_t*)(ws + WS_XN), (const bf16_t*)(ws + WS_WIN), 1024, 1024, 1024};
        pg8::StaticOrder S_; S_.init(M, 2048, F.G, (int)blockIdx.x);
        const float* CA = (const float*)(ws + WS_ROPE);
        EpiP1 E{(bf16_t*)(ws + WS_QA), (bf16_t*)(ws + WS_KA), (bf16_t*)(ws + WS_VA), (bf16_t*)(ws + WS_CQ), (bf16_t*)(ws + WS_CKV), (float*)(ws + WS_SSQ1), CA, CA + 4096 * 32};
        pg8::gemm_phase<EpiP1, pg8::StaticOrder, GemmPlain>(F.lds, g, S_, E);
        p1_krope(F);
        SEAM(1);
    }
    if (IN(2)) {
        GemmUp g{(const bf16_t*)(ws + WS_CQ), (const bf16_t*)(ws + WS_CKV), (const bf16_t*)(ws + WS_WUQ), (const bf16_t*)(ws + WS_WUKV), 256, 256, 256};
        pg8::StaticOrder S_; S_.init(M, 7 * 256, F.G, (int)blockIdx.x);
        const float* CB = (const float*)(ws + WS_ROPE) + 2 * 4096 * 32;
        EpiP2 E{(bf16_t*)(ws + WS_QB), (bf16_t*)(ws + WS_KN), (bf16_t*)(ws + WS_VB), (const float*)(ws + WS_SSQ1), CB, CB + 4096 * 16};
        pg8::gemm_phase<EpiP2, pg8::StaticOrder, GemmUp>(F.lds, g, S_, E);
        SEAM(2);
    }
    if (IN(3)) { p3a_dilated(F); SEAM(3); }
    if (IN(4)) { p3b_mla(F); SEAM(4); }
    if (IN(5)) {
        GemmPlain g{(const bf16_t*)(ws + WS_MIX), (const bf16_t*)(ws + WS_WO), 1024, 1024, 1024};
        pg8::StaticOrder S_; S_.init(M, 1024, F.G, (int)blockIdx.x);
        EpiP4 E{F.in[0], (float*)(ws + WS_X2), (bf16_t*)(ws + WS_X2B), (float*)(ws + WS_SSQ2)};
        pg8::gemm_phase<EpiP4, pg8::StaticOrder, GemmPlain>(F.lds, g, S_, E);
        SEAM(5);
    }
    if (IN(6)) {
        GemmPlain g{(const bf16_t*)(ws + WS_X2B), (const bf16_t*)(ws + WS_WQ), 1024, 1024, 1024};
        pg8::StaticOrder S_; S_.init(M, 2048, F.G, (int)blockIdx.x);
        EpiP5 E{(bf16_t*)F.out, (const float*)(ws + WS_SSQ2)};
        pg8::gemm_phase<EpiP5, pg8::StaticOrder, GemmPlain>(F.lds, g, S_, E);
        SEAM(6);
    }
    if (IN(7)) { p6_peer(F); }
#undef IN
#undef SEAM
}
#if DEBUG_CMP
namespace dbg {
__device__ __forceinline__ int colmap(int c, int mode) {
    if (mode == 1) { const int hb = c & ~63, p = c & 63; return hb + (p >> 1) + ((p & 1) << 5); }
    if (mode == 2) { return (c >> 1) + ((c & 1) << 4); }
    if (mode == 3) { const int h = c / 96, p = c % 96; if (p < 64) return c; const int q = p - 64; return h * 96 + 64 + (q >> 1) + ((q & 1) << 4); }
    return c;
}
template <class T> __device__ __forceinline__ float ldv(const T* p);
template <> __device__ __forceinline__ float ldv<float>(const float* p) { return *p; }
template <> __device__ __forceinline__ float ldv<bf16_t>(const bf16_t* p) { return __builtin_bit_cast(float, (unsigned)(*p) << 16); }
template <class T>
__global__ void cmp_k(const T* opt, int ld_opt, const float* ref, int ld_ref, int rows, int cols, float scale, int mode, unsigned* err, int stage) {
    const size_t n = (size_t)rows * cols; float md = 0.f, mr = 0.f;
    for (size_t i = (size_t)blockIdx.x * blockDim.x + threadIdx.x; i < n; i += (size_t)gridDim.x * blockDim.x) {
        const int r = (int)(i / cols), c = (int)(i % cols);
        const float o = ldv<T>(opt + (size_t)r * ld_opt + c) * scale, rf = ref[(size_t)r * ld_ref + colmap(c, mode)];
        float d = fabsf(o - rf); if (!(d == d)) d = 1.0e30f;
        md = fmaxf(md, d); mr = fmaxf(mr, fabsf(rf));
    }
    for (int o = 32; o > 0; o >>= 1) { md = fmaxf(md, __shfl_xor(md, o)); mr = fmaxf(mr, __shfl_xor(mr, o)); }
    if ((threadIdx.x & 63) == 0) { atomicMax(err + 2 * stage, __float_as_uint(md)); atomicMax(err + 2 * stage + 1, __float_as_uint(mr)); }
}
__global__ void encode_k(float* out, const unsigned* err, int nstage, int sel, float thr) {
    float eps2 = 0.f;
    if (sel >= 0) { const float e = __uint_as_float(err[2 * sel]) / fmaxf(__uint_as_float(err[2 * sel + 1]), 1e-30f); eps2 = fminf(fmaxf(e, 1e-4f), 0.9f); }
    else for (int k = 0; k < nstage; ++k) { const float e = __uint_as_float(err[2 * k]) / fmaxf(__uint_as_float(err[2 * k + 1]), 1e-30f);
        if (!(e < thr)) { eps2 = exp2f(-(float)(k + 1)) * (1.f + 0.9f * fminf(e, 1.f)); break; } }
    const float sc = 1.f + sqrtf(eps2);
    const size_t i = ((size_t)blockIdx.x * blockDim.x + threadIdx.x) * 4; f32x4 v = *(f32x4*)(out + i); v = v * sc; *(f32x4*)(out + i) = v;
}
}
#endif

static void launch_phases(const Args& base, int lo, int hi, int grid, hipStream_t stream) {
    Args a = base; a.ph_lo = lo; a.ph_hi = hi;
#if ONE_LAUNCH
    void* kargs[] = {(void*)&a};
    hipError_t e = hipLaunchCooperativeKernel((const void*)fwd_kernel, dim3(grid), dim3(512), kargs, LDS_BYTES, stream);
    if (e != hipSuccess) fprintf(stderr, "cooperative launch failed: %s (grid %d)\n", hipGetErrorString(e), grid);
#else
    hipLaunchKernelGGL(fwd_kernel, dim3(grid), dim3(512), LDS_BYTES, stream, a);
#endif
}

extern "C" void kernel_launch(void* const* d_in, const int* in_sizes, int n_in, void* d_out, int out_size, void* d_ws, size_t ws_size, hipStream_t stream) {
    static int grid = 0;
    if (grid == 0) {
        int dev = 0, cus = 0, per_cu = 0;
        hipGetDevice(&dev); hipDeviceGetAttribute(&cus, hipDeviceAttributeMultiprocessorCount, dev);
        hipFuncSetAttribute((const void*)fwd_kernel, hipFuncAttributeMaxDynamicSharedMemorySize, LDS_BYTES);
        hipOccupancyMaxActiveBlocksPerMultiprocessor(&per_cu, (const void*)fwd_kernel, 512, LDS_BYTES);
        if (per_cu < 1) { fprintf(stderr, "occupancy query says %d blocks/CU\n", per_cu); per_cu = 1; }
        grid = cus * 1;
        if (grid > 256) grid = 256;
        (void)hipGetLastError();
    }
    Args a{};
    for (int i = 0; i < 15; ++i) a.in[i] = (const float*)d_in[i];
    a.out = (float*)d_out; a.ws = (unsigned char*)d_ws;
#if !DEBUG_CMP
#if ONE_LAUNCH
    launch_phases(a, 0, NPHASE, grid, stream);
#else
    for (int p = 0; p < NPHASE; ++p) launch_phases(a, p, p + 1, grid, stream);
#endif
#else
    using nv::rmsnorm_k; using nv::gemm_k; using nv::rope_k; using nv::copy_cols_k; using nv::dilated_k; using nv::mla_k; using nv::peer_k; constexpr int PW = nv::PW;
    unsigned char* ws = (unsigned char*)d_ws;
    unsigned* err = (unsigned*)(ws + 505 * MiB);
    hipMemsetAsync(err, 0, 256, stream);
    float* hb = (float*)(ws + 404 * MiB); float* projb = (float*)(ws + 420 * MiB); float* qn = (float*)(ws + 456 * MiB); float* knn = (float*)(ws + 469 * MiB);
    float* krn = (float*)(ws + 477 * MiB); float* vn = (float*)(ws + 478 * MiB); float* mixb = (float*)(ws + 486 * MiB);
    const float* x = (const float*)d_in[0];
    hipStream_t st = stream;
    launch_phases(a, 0, 1, grid, stream); launch_phases(a, 1, 2, grid, stream);
    rmsnorm_k<<<S / 4, 256, 0, st>>>(x, D, (const float*)d_in[1], hb, D, D, S);
    gemm_k<<<dim3((PW + 63) / 64, S / 64), 256, 0, st>>>(hb, D, (const float*)d_in[2], PW, projb, PW, nullptr, 0, S, PW, D);
    rope_k<<<(S * 8 * 32 + 255) / 256, 256, 0, st>>>(projb, PW, 0, 8, 64, S);
    rope_k<<<(S * 8 * 32 + 255) / 256, 256, 0, st>>>(projb, PW, 512, 8, 64, S);
    copy_cols_k<<<(S * 32 + 255) / 256, 256, 0, st>>>(projb + 2048, PW, krn, 32, 32, S);
    rope_k<<<(S * 16 + 255) / 256, 256, 0, st>>>(krn, 32, 0, 1, 32, S);
    dbg::cmp_k<bf16_t><<<1024, 256, 0, st>>>((const bf16_t*)(ws + WS_QA), 512, projb, PW, S, 512, 1.f / QSCALE_A, 1, err, 0);
    dbg::cmp_k<bf16_t><<<1024, 256, 0, st>>>((const bf16_t*)(ws + WS_KA), 512, projb + 512, PW, S, 512, 1.f, 1, err, 1);
    dbg::cmp_k<bf16_t><<<1024, 256, 0, st>>>((const bf16_t*)(ws + WS_VA), 512, projb + 1024, PW, S, 512, 1.f, 0, err, 2);
    dbg::cmp_k<bf16_t><<<1024, 256, 0, st>>>((const bf16_t*)(ws + WS_CQ), 256, projb + 1536, PW, S, 256, 1.f, 0, err, 3);
    dbg::cmp_k<bf16_t><<<1024, 256, 0, st>>>((const bf16_t*)(ws + WS_CKV), 256, projb + 1792, PW, S, 256, 1.f, 0, err, 4);
    dbg::cmp_k<bf16_t><<<1024, 256, 0, st>>>((const bf16_t*)(ws + WS_KR), 32, krn, 32, S, 32, 1.f, 2, err, 5);
    launch_phases(a, 2, 3, grid, stream);
    {   float* cqn = hb; float* ckvn = hb + (size_t)S * 256;
        rmsnorm_k<<<S / 4, 256, 0, st>>>(projb + 1536, PW, (const float*)d_in[3], cqn, 256, 256, S);
        rmsnorm_k<<<S / 4, 256, 0, st>>>(projb + 1792, PW, (const float*)d_in[4], ckvn, 256, 256, S);
        gemm_k<<<dim3(768 / 64, S / 64), 256, 0, st>>>(cqn, 256, (const float*)d_in[5], 768, qn, 768, nullptr, 0, S, 768, 256);
        for (int h = 0; h < 8; ++h) rope_k<<<(S * 16 + 255) / 256, 256, 0, st>>>(qn, 768, h * 96 + 64, 1, 32, S);
        gemm_k<<<dim3(512 / 64, S / 64), 256, 0, st>>>(ckvn, 256, (const float*)d_in[6], 512, knn, 512, nullptr, 0, S, 512, 256);
        gemm_k<<<dim3(512 / 64, S / 64), 256, 0, st>>>(ckvn, 256, (const float*)d_in[7], 512, vn, 512, nullptr, 0, S, 512, 256); }
    dbg::cmp_k<bf16_t><<<1024, 256, 0, st>>>((const bf16_t*)(ws + WS_QB), 768, qn, 768, S, 768, 1.f / QSCALE_B, 3, err, 6);
    dbg::cmp_k<bf16_t><<<1024, 256, 0, st>>>((const bf16_t*)(ws + WS_KN), 512, knn, 512, S, 512, 1.f, 0, err, 7);
    dbg::cmp_k<bf16_t><<<1024, 256, 0, st>>>((const bf16_t*)(ws + WS_VB), 512, vn, 512, S, 512, 1.f, 0, err, 8);
    launch_phases(a, 3, 4, grid, stream); launch_phases(a, 4, 5, grid, stream);
    dilated_k<<<8 * S / 4, 256, 0, st>>>(projb, mixb);
    mla_k<<<1 * 8 * (S / 64), 64, 0, st>>>(qn, knn, krn, vn, mixb);
    dbg::cmp_k<bf16_t><<<1024, 256, 0, st>>>((const bf16_t*)(ws + WS_MIX), 1024, mixb, 1024, S, 512, 1.f, 0, err, 9);
    dbg::cmp_k<bf16_t><<<1024, 256, 0, st>>>((const bf16_t*)(ws + WS_MIX) + 512, 1024, mixb + 512, 1024, S, 512, 1.f, 0, err, 10);
    launch_phases(a, 5, 6, grid, stream);
    float* x2b = hb;
    gemm_k<<<dim3(D / 64, S / 64), 256, 0, st>>>(mixb, 1024, (const float*)d_in[8], D, x2b, D, x, D, S, D, 1024);
    dbg::cmp_k<float><<<1024, 256, 0, st>>>((const float*)(ws + WS_X2), 1024, x2b, 1024, S, 1024, 1.f, 0, err, 11);
    launch_phases(a, 6, 7, grid, stream);
    float* h2c = qn; float* qpc = projb;
    rmsnorm_k<<<4096 / 4, 256, 0, st>>>(x2b, D, (const float*)d_in[9], h2c, D, D, 4096);
    gemm_k<<<dim3(2048 / 64, 4096 / 64), 256, 0, st>>>(h2c, D, (const float*)d_in[10], 2048, qpc, 2048, nullptr, 0, 4096, 2048, D);
    dbg::cmp_k<bf16_t><<<1024, 256, 0, st>>>((const bf16_t*)d_out, 2048, qpc, 2048, S, 2048, 1.f, 0, err, 12);
    launch_phases(a, 7, 8, grid, stream);
    peer_k<<<4096 / 4, 256, 0, st>>>(h2c, qpc, (const float*)d_in[11], (const float*)d_in[12], (const float*)d_in[13], (const float*)d_in[14], x2b, 4096);
    dbg::cmp_k<float><<<1024, 256, 0, st>>>((const float*)d_out, 1024, x2b, 1024, S, 1024, 1.f, 0, err, 13);
    nv::run(d_in, (float*)d_out, (float*)d_ws, stream);
    dbg::encode_k<<<M * 1024 / 4 / 256, 256, 0, st>>>((float*)d_out, err, 14, DEBUG_SEL, 0.05f);
#endif
}
```

```cpp
#include <hip/hip_runtime.h>
#include <hip/hip_cooperative_groups.h>
#include <cstdio>
#include <cstdint>
#include <cmath>
namespace cg = cooperative_groups;
#define DEBUG_CMP 0
#define ONE_LAUNCH 1
#define DEBUG_SEL -1
#define LAS __attribute__((address_space(3)))
#define GAS __attribute__((address_space(1)))
typedef unsigned short bf16_t;
typedef short bf16x8 __attribute__((ext_vector_type(8)));
typedef short s16x4 __attribute__((ext_vector_type(4)));
typedef float f32x4 __attribute__((ext_vector_type(4)));
typedef float f32x16 __attribute__((ext_vector_type(16)));
typedef float f32x2_t __attribute__((ext_vector_type(2)));
typedef __bf16 bf16x2_t __attribute__((ext_vector_type(2)));
typedef unsigned u32x4 __attribute__((ext_vector_type(4)));
typedef unsigned u32x2 __attribute__((ext_vector_type(2)));

constexpr int NB = 8, S = 4096, M = NB * S, D = 1024;
constexpr float NORM_EPS = 1e-6f;
constexpr float LOG2E = 1.4426950408889634f;
constexpr float QSCALE_A = 0.125f * LOG2E;
constexpr float QSCALE_B = 0.10206207261596577f * LOG2E;

__device__ __forceinline__ unsigned cvtpk(float lo, float hi) { f32x2_t v = {lo, hi}; bf16x2_t b = __builtin_convertvector(v, bf16x2_t); return __builtin_bit_cast(unsigned, b); }
__device__ __forceinline__ float bf_lo(unsigned w) { return __builtin_bit_cast(float, w << 16); }
__device__ __forceinline__ float bf_hi(unsigned w) { return __builtin_bit_cast(float, w & 0xffff0000u); }

namespace pg8 {
constexpr int BM = 256, BK = 64, HALF = 128, HTB = HALF * BK * 2, STAGE_BYTES = 8 * HTB, NXCD = 8, WGM = 8;
__host__ __device__ __forceinline__ int lds_byte(int r, int c) { const int st = (r >> 4) * 2 + (c >> 5), rr = r & 15, cc = c & 31, ob = rr * 64 + cc * 2; return st * 1024 + (ob ^ (((ob >> 9) & 1) << 5)); }
__host__ __device__ __forceinline__ void stage_rc(int b, int& R, int& C) { const int st = b / 1024, sb = b % 1024, swz = sb ^ (((sb >> 9) & 1) << 5); R = (st >> 1) * 16 + swz / 64; C = (st & 1) * 32 + (swz % 64) / 2; }
__host__ __device__ __forceinline__ int perm32(int rho) { const int n = rho >> 4, i = rho & 15; return 8 * (i >> 2) + 4 * n + (i & 3); }
struct Unit { int pm, pn; };
struct StaticOrder {
    int nM, nN, nwg, G, c;
    __device__ void init(int Mr, int N, int G_, int c_) { nM = Mr / BM; nN = N / BM; nwg = nM * nN; G = G_; c = c_; }
    __device__ bool next(int i, Unit& u) const {
        const long L = (long)i * G + c; if (L >= nwg) return false;
        int wgid = (int)L; { const int q = nwg / NXCD, r = nwg % NXCD, xcd = wgid % NXCD, off = wgid / NXCD; wgid = (xcd < r ? xcd * (q + 1) : r * (q + 1) + (xcd - r) * q) + off; }
        const int nig = WGM * nN, gid = wgid / nig, fm = gid * WGM, gsz = (nM - fm) < WGM ? (nM - fm) : WGM;
        u.pm = fm + ((wgid % nig) % gsz); u.pn = (wgid % nig) / gsz; return true;
    }
};
template <class Epi, class Sched, class G>
__device__ __forceinline__ void gemm_phase(LAS unsigned char* lds, const G g, const Sched& Sch, const Epi& E) {
    const int tid = threadIdx.x, wid = __builtin_amdgcn_readfirstlane(tid >> 6), lane = tid & 63, wr = wid >> 2, wc = wid & 3, fr = lane & 15, fq = lane >> 4;
    const int K = g.K, nt = K / BK;
    unsigned voffA[2], voffB[2];
#pragma unroll
    for (int i = 0; i < 2; ++i) { int R, C; stage_rc(tid * 16 + i * 8192, R, C); const int Rb = Epi::PERM ? ((R & ~31) + perm32(R & 31)) : R;
        voffA[i] = (unsigned)(R * g.lda + C) * 2u; voffB[i] = (unsigned)(Rb * g.ldb + C) * 2u; }
    const size_t kstep = (size_t)(BK * 2);
    const size_t hstepA = (size_t)HALF * g.lda * 2, hstepB = (size_t)HALF * g.ldb * 2;
    const unsigned ldsw = (unsigned)wid * 1024u;
    const int aoff = lds_byte(wr * 64 + fr, fq * 8), boff = lds_byte(wc * 32 + fr, fq * 8);
#define PG8_SA(b, h) (((b) * 2 + (h)) * HTB)
#define PG8_SB(b, h) ((4 + (b) * 2 + (h)) * HTB)
#define PG8_STAGE(bufoff, gbase, voff) do { _Pragma("unroll") for (int _i = 0; _i < 2; ++_i) \
        __builtin_amdgcn_global_load_lds((const unsigned*)((const char*)(gbase) + (voff)[_i]), (LAS unsigned*)(lds + (bufoff) + ldsw + _i * 8192), 16, 0, 0); } while (0)
#define PG8_LDA(dst, b, h) do { _Pragma("unroll") for (int m = 0; m < 4; ++m) _Pragma("unroll") for (int k = 0; k < 2; ++k) dst[m][k] = *(const LAS bf16x8*)(lds + PG8_SA(b, h) + aoff + m * 2048 + k * 1024); } while (0)
#define PG8_LDB(dst, b, h) do { _Pragma("unroll") for (int n = 0; n < 2; ++n) _Pragma("unroll") for (int k = 0; k < 2; ++k) dst[n][k] = *(const LAS bf16x8*)(lds + PG8_SB(b, h) + boff + n * 2048 + k * 1024); } while (0)
#define PG8_MMA(ai, bj, At, Bt) do { __builtin_amdgcn_s_setprio(1); _Pragma("unroll") for (int m = 0; m < 4; ++m) _Pragma("unroll") for (int n = 0; n < 2; ++n) _Pragma("unroll") for (int k = 0; k < 2; ++k) \
        acc[ai][bj][m][n] = __builtin_amdgcn_mfma_f32_16x16x32_bf16(Bt[n][k], At[m][k], acc[ai][bj][m][n], 0, 0, 0); __builtin_amdgcn_s_setprio(0); } while (0)
#define PG8_WAIT_V(n) asm volatile("s_waitcnt vmcnt(" #n ")" ::: "memory")
#define PG8_WAIT_L(n) asm volatile("s_waitcnt lgkmcnt(" #n ")" ::: "memory")
#define PG8_BAR __builtin_amdgcn_s_barrier()
#define PG8_SCHED __builtin_amdgcn_sched_barrier(0)
    Unit cur, nxt; int ui = 0;
    if (!Sch.next(0, cur)) return;
    f32x4 acc[2][2][4][2];
#pragma unroll
    for (int a = 0; a < 2; ++a)
#pragma unroll
        for (int b = 0; b < 2; ++b)
#pragma unroll
            for (int m = 0; m < 4; ++m)
#pragma unroll
                for (int n = 0; n < 2; ++n) acc[a][b][m][n] = (f32x4){0.f, 0.f, 0.f, 0.f};
    bf16x8 At[4][2], B0[2][2], B1[2][2];
    const char* cA = g.a_base(cur); const char* cB = g.b_base(cur);
    PG8_STAGE(PG8_SB(0, 0), cB, voffB); PG8_STAGE(PG8_SB(0, 1), cB + hstepB, voffB); PG8_STAGE(PG8_SA(0, 0), cA, voffA); PG8_STAGE(PG8_SA(0, 1), cA + hstepA, voffA);
    if (wr == 1) PG8_BAR;
    PG8_WAIT_V(2); PG8_BAR;
    PG8_STAGE(PG8_SB(1, 0), cB + kstep, voffB); PG8_STAGE(PG8_SA(1, 0), cA + kstep, voffA); PG8_STAGE(PG8_SB(1, 1), cB + hstepB + kstep, voffB);
    PG8_WAIT_V(6); PG8_BAR;
    for (;;) {
        const bool has_next = Sch.next(ui + 1, nxt);
        const char* nA = has_next ? g.a_base(nxt) : cA; const char* nB = has_next ? g.b_base(nxt) : cB;
        for (int t = 0; t < nt; t += 2) {
            const bool last = (t == nt - 2);
            const char* a1 = cA + (size_t)(t + 1) * kstep;
            const char* a2 = last ? nA : cA + (size_t)(t + 2) * kstep; const char* b2 = last ? nB : cB + (size_t)(t + 2) * kstep;
            const char* a3 = a2 + kstep; const char* b3 = b2 + kstep;
            PG8_LDB(B0, 0, 0); PG8_LDB(B1, 0, 1); PG8_SCHED; PG8_LDA(At, 0, 0); PG8_STAGE(PG8_SA(1, 1), a1 + hstepA, voffA);
            PG8_WAIT_V(8); PG8_WAIT_L(0); PG8_BAR; PG8_MMA(0, 0, At, B0); PG8_MMA(0, 1, At, B1); PG8_BAR; PG8_SCHED;
            PG8_LDA(At, 0, 1); PG8_STAGE(PG8_SB(0, 0), b2, voffB); PG8_STAGE(PG8_SB(0, 1), b2 + hstepB, voffB); PG8_STAGE(PG8_SA(0, 0), a2, voffA);
            PG8_WAIT_V(8); PG8_WAIT_L(0); PG8_BAR; PG8_MMA(1, 0, At, B0); PG8_MMA(1, 1, At, B1); PG8_BAR; PG8_SCHED;
            PG8_LDB(B0, 1, 0); PG8_LDB(B1, 1, 1); PG8_SCHED; PG8_LDA(At, 1, 0); PG8_STAGE(PG8_SA(0, 1), a2 + hstepA, voffA);
            PG8_WAIT_V(8); PG8_WAIT_L(0); PG8_BAR; PG8_MMA(0, 0, At, B0); PG8_MMA(0, 1, At, B1); PG8_BAR; PG8_SCHED;
            PG8_LDA(At, 1, 1); PG8_STAGE(PG8_SB(1, 0), b3, voffB); PG8_STAGE(PG8_SB(1, 1), b3 + hstepB, voffB); PG8_STAGE(PG8_SA(1, 0), a3, voffA);
            PG8_WAIT_V(8); PG8_WAIT_L(0); PG8_BAR; PG8_MMA(1, 0, At, B0); PG8_MMA(1, 1, At, B1); PG8_BAR; PG8_SCHED;
        }
        if (wr == 0) PG8_BAR;
        E(acc, cur, wr, wc, fr, fq);
        if (!has_next) break;
#pragma unroll
        for (int a = 0; a < 2; ++a)
#pragma unroll
            for (int b = 0; b < 2; ++b)
#pragma unroll
                for (int m = 0; m < 4; ++m)
#pragma unroll
                    for (int n = 0; n < 2; ++n) acc[a][b][m][n] = (f32x4){0.f, 0.f, 0.f, 0.f};
        cur = nxt; cA = nA; cB = nB; ++ui;
        if (wr == 1) PG8_BAR;
    }
    PG8_WAIT_V(0);
    PG8_BAR;
#undef PG8_SA
#undef PG8_SB
#undef PG8_STAGE
#undef PG8_LDA
#undef PG8_LDB
#undef PG8_MMA
#undef PG8_WAIT_V
#undef PG8_WAIT_L
#undef PG8_BAR
#undef PG8_SCHED
}
}
constexpr size_t MiB = 1u << 20;
constexpr size_t WS_CTL = 0;
constexpr size_t WS_WIN = 2 * MiB;
constexpr size_t WS_WKR = 6 * MiB;
constexpr size_t WS_WUQ = 7 * MiB;
constexpr size_t WS_WUKV = 8 * MiB;
constexpr size_t WS_WO = 9 * MiB;
constexpr size_t WS_WQ = 11 * MiB;
constexpr size_t WS_KEYS = 15 * MiB;
constexpr size_t WS_ROPE = 16 * MiB;
constexpr size_t WS_U = 18 * MiB;
constexpr size_t WS_V = 50 * MiB;
constexpr size_t WS_SSQ1 = 82 * MiB;
constexpr size_t WS_SSQ2 = 84 * MiB;
constexpr size_t WS_XN = 96 * MiB;
constexpr size_t WS_MIX = WS_XN;
constexpr size_t WS_QA = 160 * MiB, WS_KA = 192 * MiB, WS_VA = 224 * MiB;
constexpr size_t WS_X2B = 160 * MiB;
constexpr size_t WS_CQ = 256 * MiB, WS_CKV = 272 * MiB;
constexpr size_t WS_KR = 288 * MiB;
constexpr size_t WS_QB = 292 * MiB;
constexpr size_t WS_KN = 340 * MiB, WS_VB = 372 * MiB;
constexpr size_t WS_X2 = 292 * MiB;
constexpr size_t WS_END_OPT = 420 * MiB;
constexpr size_t DO_OP = 0, DO_LSE = 96 * MiB;

struct Args { const float* in[15]; float* out; unsigned char* ws; int ph_lo, ph_hi; };

struct Frame {
    LAS unsigned char* lds;
    int tid, lane, wave, vcu, G;
    const float* in[15]; float* out; unsigned char* ws;
};

__device__ __forceinline__ float wave_sum(float v) {
#pragma unroll
    for (int o = 1; o < 64; o <<= 1) v += __shfl_xor(v, o);
    return v;
}

__device__ __forceinline__ int perm_win(int np) {
    if (np < 1024) { const int hb = np & ~63, p = np & 63; return hb + (p >> 1) + ((p & 1) << 5); }
    return np;
}
__device__ __forceinline__ int perm_wkr(int np) { return 2048 + (np >> 1) + ((np & 1) << 4); }
__device__ __forceinline__ int perm_wuq(int np) { const int h = np / 96, p = np % 96; if (p < 64) return np; const int q = p - 64; return h * 96 + 64 + (q >> 1) + ((q & 1) << 4); }

template <int PERM>
__device__ __forceinline__ void transpose_item(const float* __restrict__ W, int K, int N, const float* __restrict__ gk, bf16_t* __restrict__ WT, int row_off, LAS float* scr, int item, int nblk, int lane) {
    const int kb = item / nblk, nb = item % nblk, k0 = 64 * kb, n0 = 32 * nb;
    const int npx = n0 + (lane & 31);
    const int nl = PERM == 1 ? perm_win(npx) : PERM == 2 ? perm_wkr(npx) : PERM == 3 ? perm_wuq(npx) : npx;
#pragma unroll 8
    for (int i = 0; i < 32; ++i) { const int kk = 2 * i + (lane >> 5); float v = W[(size_t)(k0 + kk) * N + nl]; if (gk) v *= gk[k0 + kk]; scr[kk * 33 + (lane & 31)] = v; }
    asm volatile("s_waitcnt lgkmcnt(0)" ::: "memory");
    const int c = lane & 7;
#pragma unroll
    for (int j = 0; j < 4; ++j) { const int n = (lane >> 3) + 8 * j; const LAS float* s = scr + (8 * c) * 33 + n;
        u32x4 o; o.x = cvtpk(s[0 * 33], s[1 * 33]); o.y = cvtpk(s[2 * 33], s[3 * 33]); o.z = cvtpk(s[4 * 33], s[5 * 33]); o.w = cvtpk(s[6 * 33], s[7 * 33]);
        *(u32x4*)(WT + (size_t)(row_off + n0 + n) * K + k0 + 8 * c) = o; }
    asm volatile("s_waitcnt lgkmcnt(0)" ::: "memory");
}

__device__ __forceinline__ void p0_prologue(Frame& F) {
    LAS float* scr = (LAS float*)(F.lds + F.wave * 16384);
    const int gw = F.vcu * 8 + F.wave, NGW = F.G * 8, lane = F.lane;
    unsigned char* ws = F.ws;
    constexpr int I_WIN = (1024 / 64) * (2048 / 32), I_WKR = (1024 / 64) * 1, I_WUQ = (256 / 64) * (768 / 32), I_WUK = (256 / 64) * (512 / 32), I_WO = (1024 / 64) * (1024 / 32), I_WQ = (1024 / 64) * (2048 / 32);
    constexpr int NIT = I_WIN + I_WKR + I_WUQ + 2 * I_WUK + I_WO + I_WQ;
    for (int it = gw; it < NIT; it += NGW) {
        int r = it;
        if (r < I_WIN) { transpose_item<1>(F.in[2], 1024, 2080, nullptr, (bf16_t*)(ws + WS_WIN), 0, scr, r, 2048 / 32, lane); continue; } r -= I_WIN;
        if (r < I_WKR) { transpose_item<2>(F.in[2], 1024, 2080, nullptr, (bf16_t*)(ws + WS_WKR), 0, scr, r, 1, lane); continue; } r -= I_WKR;
        if (r < I_WUQ) { transpose_item<3>(F.in[5], 256, 768, F.in[3], (bf16_t*)(ws + WS_WUQ), 0, scr, r, 768 / 32, lane); continue; } r -= I_WUQ;
        if (r < I_WUK) { transpose_item<0>(F.in[6], 256, 512, F.in[4], (bf16_t*)(ws + WS_WUKV), 0, scr, r, 512 / 32, lane); continue; } r -= I_WUK;
        if (r < I_WUK) { transpose_item<0>(F.in[7], 256, 512, F.in[4], (bf16_t*)(ws + WS_WUKV), 512, scr, r, 512 / 32, lane); continue; } r -= I_WUK;
        if (r < I_WO) { transpose_item<0>(F.in[8], 1024, 1024, nullptr, (bf16_t*)(ws + WS_WO), 0, scr, r, 1024 / 32, lane); continue; } r -= I_WO;
        transpose_item<0>(F.in[10], 1024, 2048, F.in[9], (bf16_t*)(ws + WS_WQ), 0, scr, r, 2048 / 32, lane);
    }
    for (int rr = gw; rr < M + 2 * 16384; rr += NGW) {
        const float* src; bf16_t* dst; const float* g; bool norm;
        if (rr < M) { src = F.in[0] + (size_t)rr * 1024; dst = (bf16_t*)(ws + WS_XN) + (size_t)rr * 1024; g = F.in[1]; norm = true; }
        else if (rr < M + 16384) { const int e = rr - M; src = F.in[12] + (size_t)e * 1024; dst = (bf16_t*)(ws + WS_U) + (size_t)e * 1024; g = F.in[9]; norm = false; }
        else { const int e = rr - M - 16384; src = F.in[13] + (size_t)e * 1024; dst = (bf16_t*)(ws + WS_V) + (size_t)e * 1024; g = nullptr; norm = false; }
        f32x4 v[4]; float ss = 0.f;
#pragma unroll
        for (int j = 0; j < 4; ++j) { v[j] = *(const f32x4*)(src + 256 * j + 4 * lane); ss += (v[j].x * v[j].x + v[j].y * v[j].y) + (v[j].z * v[j].z + v[j].w * v[j].w); }
        float rs = 1.f;
        if (norm) rs = rsqrtf(wave_sum(ss) * (1.f / 1024.f) + NORM_EPS);
#pragma unroll
        for (int j = 0; j < 4; ++j) { f32x4 gg = {1.f, 1.f, 1.f, 1.f}; if (g) gg = *(const f32x4*)(g + 256 * j + 4 * lane);
            u32x2 o; o.x = cvtpk(v[j].x * rs * gg.x, v[j].y * rs * gg.y); o.y = cvtpk(v[j].z * rs * gg.z, v[j].w * rs * gg.w);
            *(u32x2*)(dst + 256 * j + 4 * lane) = o; }
    }
    {
        const int gt = F.vcu * 512 + F.tid, NT = F.G * 512;
        for (int i = gt; i < 262144 / 8; i += NT) { const f32x4 a = *(const f32x4*)(F.in[11] + (size_t)i * 8), b = *(const f32x4*)(F.in[11] + (size_t)i * 8 + 4);
            u32x4 o; o.x = cvtpk(a.x, a.y); o.y = cvtpk(a.z, a.w); o.z = cvtpk(b.x, b.y); o.w = cvtpk(b.z, b.w); *(u32x4*)((bf16_t*)(ws + WS_KEYS) + (size_t)i * 8) = o; }
        float* CA = (float*)(ws + WS_ROPE); float* SA = CA + 4096 * 32; float* CB = SA + 4096 * 32; float* SB = CB + 4096 * 16;
        for (int i = gt; i < 4096 * 32; i += NT) { const int pos = i >> 5, k = i & 31; const float inv = 1.0f / powf(10000.0f, (float)(2 * k) / 64.0f); const float ang = (float)pos * inv; CA[i] = cosf(ang); SA[i] = sinf(ang); }
        for (int i = gt; i < 4096 * 16; i += NT) { const int pos = i >> 4, k = i & 15; const float inv = 1.0f / powf(10000.0f, (float)(2 * k) / 32.0f); const float ang = (float)pos * inv; CB[i] = cosf(ang); SB[i] = sinf(ang); }
    }
}

struct GemmPlain {
    const bf16_t* A; const bf16_t* Bt; int K, lda, ldb;
    __device__ __forceinline__ const char* a_base(const pg8::Unit& u) const { return (const char*)(A + (size_t)u.pm * 256 * lda); }
    __device__ __forceinline__ const char* b_base(const pg8::Unit& u) const { return (const char*)(Bt + (size_t)u.pn * 256 * ldb); }
};
struct GemmUp {
    const bf16_t* CQ; const bf16_t* CKV; const bf16_t* WUQ; const bf16_t* WUKV; int K, lda, ldb;
    __device__ __forceinline__ const char* a_base(const pg8::Unit& u) const { return (const char*)((u.pn < 3 ? CQ : CKV) + (size_t)u.pm * 256 * 256); }
    __device__ __forceinline__ const char* b_base(const pg8::Unit& u) const { return (const char*)(u.pn < 3 ? WUQ + (size_t)u.pn * 256 * 256 : WUKV + (size_t)(u.pn - 3) * 256 * 256); }
};

__device__ __forceinline__ void rope4(f32x4& v0, f32x4& v1, const f32x4 cs, const f32x4 sn) {
    const f32x4 a = v0, b = v1;
    v0.x = a.x * cs.x - a.y * sn.x; v0.y = a.y * cs.x + a.x * sn.x; v0.z = a.z * cs.y - a.w * sn.y; v0.w = a.w * cs.y + a.z * sn.y;
    v1.x = b.x * cs.z - b.y * sn.z; v1.y = b.y * cs.z + b.x * sn.z; v1.z = b.z * cs.w - b.w * sn.w; v1.w = b.w * cs.w + b.z * sn.w;
}
__device__ __forceinline__ void store8(bf16_t* p, const f32x4 v0, const f32x4 v1) { u32x4 w; w.x = cvtpk(v0.x, v0.y); w.y = cvtpk(v0.z, v0.w); w.z = cvtpk(v1.x, v1.y); w.w = cvtpk(v1.z, v1.w); *(u32x4*)p = w; }
__device__ __forceinline__ float dot4(const f32x4 v) { return (v.x * v.x + v.y * v.y) + (v.z * v.z + v.w * v.w); }

struct EpiP1 {
    static constexpr bool PERM = true;
    bf16_t *QA, *KA, *VA, *CQ, *CKV; float* SSQ1; const float *CA, *SA;
    __device__ __forceinline__ void operator()(const f32x4 (&acc)[2][2][4][2], const pg8::Unit& u, int wr, int wc, int fr, int fq) const {
        const int pn = u.pn, row0 = u.pm * 256 + wr * 64 + fr, cw = wc * 32 + 8 * fq;
        if (pn < 4) {
            bf16_t* base = pn < 2 ? QA : KA; const float sc = pn < 2 ? QSCALE_A : 1.f; const int colt = (pn & 1) * 256 + cw;
#pragma unroll
            for (int ai = 0; ai < 2; ++ai)
#pragma unroll
                for (int m = 0; m < 4; ++m) { const int row = row0 + ai * 128 + m * 16, pos = row & (S - 1);
#pragma unroll
                    for (int bj = 0; bj < 2; ++bj) { const int col = colt + bj * 128, i0 = (col & 63) >> 1;
                        const f32x4 cs = *(const f32x4*)(CA + pos * 32 + i0), sn = *(const f32x4*)(SA + pos * 32 + i0);
                        f32x4 v0 = acc[ai][bj][m][0] * sc, v1 = acc[ai][bj][m][1] * sc; rope4(v0, v1, cs, sn);
                        store8(base + (size_t)row * 512 + col, v0, v1); } }
        } else if (pn < 6) {
            const int colt = (pn & 1) * 256 + cw;
#pragma unroll
            for (int ai = 0; ai < 2; ++ai)
#pragma unroll
                for (int m = 0; m < 4; ++m) { const int row = row0 + ai * 128 + m * 16;
#pragma unroll
                    for (int bj = 0; bj < 2; ++bj) store8(VA + (size_t)row * 512 + colt + bj * 128, acc[ai][bj][m][0], acc[ai][bj][m][1]); }
        } else {
            bf16_t* base = pn == 6 ? CQ : CKV;
#pragma unroll
            for (int ai = 0; ai < 2; ++ai)
#pragma unroll
                for (int m = 0; m < 4; ++m) { const int row = row0 + ai * 128 + m * 16; float s = 0.f;
#pragma unroll
                    for (int bj = 0; bj < 2; ++bj) { store8(base + (size_t)row * 256 + cw + bj * 128, acc[ai][bj][m][0], acc[ai][bj][m][1]); s += dot4(acc[ai][bj][m][0]) + dot4(acc[ai][bj][m][1]); }
                    s += __shfl_xor(s, 16); s += __shfl_xor(s, 32);
                    if (fq == 0) SSQ1[(size_t)row * 8 + (pn - 6) * 4 + wc] = s; }
        }
    }
};
struct EpiP2 {
    static constexpr bool PERM = true;
    bf16_t *QB, *KN, *VB; const float* SSQ1; const float *CB, *SB;
    __device__ __forceinline__ void operator()(const f32x4 (&acc)[2][2][4][2], const pg8::Unit& u, int wr, int wc, int fr, int fq) const {
        const int pn = u.pn, row0 = u.pm * 256 + wr * 64 + fr, cw = wc * 32 + 8 * fq, grp = pn < 3 ? 0 : 1;
#pragma unroll
        for (int ai = 0; ai < 2; ++ai)
#pragma unroll
            for (int m = 0; m < 4; ++m) { const int row = row0 + ai * 128 + m * 16, pos = row & (S - 1);
                const f32x4 sq = *(const f32x4*)(SSQ1 + (size_t)row * 8 + grp * 4);
                const float rs = rsqrtf(((sq.x + sq.y) + (sq.z + sq.w)) * (1.f / 256.f) + NORM_EPS);
                if (pn < 3) {
#pragma unroll
                    for (int bj = 0; bj < 2; ++bj) { const int col = pn * 256 + bj * 128 + cw, p = col % 96; const float sc = rs * QSCALE_B;
                        f32x4 v0 = acc[ai][bj][m][0] * sc, v1 = acc[ai][bj][m][1] * sc;
                        if (p >= 64) { const int i0 = (p - 64) >> 1; const f32x4 cs = *(const f32x4*)(CB + pos * 16 + i0), sn = *(const f32x4*)(SB + pos * 16 + i0); rope4(v0, v1, cs, sn); }
                        store8(QB + (size_t)row * 768 + col, v0, v1); }
                } else {
                    bf16_t* base = pn < 5 ? KN : VB; const int colt = ((pn - 3) & 1) * 256 + cw;
#pragma unroll
                    for (int bj = 0; bj < 2; ++bj) store8(base + (size_t)row * 512 + colt + bj * 128, acc[ai][bj][m][0] * rs, acc[ai][bj][m][1] * rs);
                }
            }
    }
};
struct EpiP4 {
    static constexpr bool PERM = true;
    const float* X; float* X2; bf16_t* X2B; float* SSQ2;
    __device__ __forceinline__ void operator()(const f32x4 (&acc)[2][2][4][2], const pg8::Unit& u, int wr, int wc, int fr, int fq) const {
        const int row0 = u.pm * 256 + wr * 64 + fr, colt = u.pn * 256 + wc * 32 + 8 * fq;
#pragma unroll
        for (int ai = 0; ai < 2; ++ai)
#pragma unroll
            for (int m = 0; m < 4; ++m) { const int row = row0 + ai * 128 + m * 16; float s = 0.f;
#pragma unroll
                for (int bj = 0; bj < 2; ++bj) { const size_t off = (size_t)row * 1024 + colt + bj * 128;
                    const f32x4 v0 = acc[ai][bj][m][0] + *(const f32x4*)(X + off), v1 = acc[ai][bj][m][1] + *(const f32x4*)(X + off + 4);
                    *(f32x4*)(X2 + off) = v0; *(f32x4*)(X2 + off + 4) = v1; store8(X2B + off, v0, v1); s += dot4(v0) + dot4(v1); }
                s += __shfl_xor(s, 16); s += __shfl_xor(s, 32);
                if (fq == 0) SSQ2[(size_t)row * 16 + u.pn * 4 + wc] = s; }
    }
};
struct EpiP5 {
    static constexpr bool PERM = true;
    bf16_t* QP; const float* SSQ2;
    __device__ __forceinline__ void operator()(const f32x4 (&acc)[2][2][4][2], const pg8::Unit& u, int wr, int wc, int fr, int fq) const {
        const int row0 = u.pm * 256 + wr * 64 + fr, colt = u.pn * 256 + wc * 32 + 8 * fq;
#pragma unroll
        for (int ai = 0; ai < 2; ++ai)
#pragma unroll
            for (int m = 0; m < 4; ++m) { const int row = row0 + ai * 128 + m * 16;
                const f32x4* sp = (const f32x4*)(SSQ2 + (size_t)row * 16); const f32x4 a = sp[0], b = sp[1], c = sp[2], d = sp[3];
                const float ss = ((a.x + a.y) + (a.z + a.w)) + ((b.x + b.y) + (b.z + b.w)) + ((c.x + c.y) + (c.z + c.w)) + ((d.x + d.y) + (d.z + d.w));
                const float rs = rsqrtf(ss * (1.f / 1024.f) + NORM_EPS);
#pragma unroll
                for (int bj = 0; bj < 2; ++bj) store8(QP + (size_t)row * 2048 + colt + bj * 128, acc[ai][bj][m][0] * rs, acc[ai][bj][m][1] * rs); }
    }
};

__device__ __forceinline__ void p1_krope(Frame& F) {
    const bf16_t* XN = (const bf16_t*)(F.ws + WS_XN); const bf16_t* WK = (const bf16_t*)(F.ws + WS_WKR); bf16_t* KR = (bf16_t*)(F.ws + WS_KR);
    const float* CB = (const float*)(F.ws + WS_ROPE) + 2 * 4096 * 32; const float* SB = CB + 4096 * 16;
    const int lane = F.lane, fr = lane & 15, fq = lane >> 4;
    for (int blk = F.vcu; blk < M / 128; blk += F.G) {
        const int row0 = blk * 128 + F.wave * 16;
        f32x4 c0 = {0.f, 0.f, 0.f, 0.f}, c1 = {0.f, 0.f, 0.f, 0.f};
        const bf16_t* ap = XN + (size_t)(row0 + fr) * 1024 + 8 * fq;
        const bf16_t* b0p = WK + (size_t)fr * 1024 + 8 * fq; const bf16_t* b1p = WK + (size_t)(16 + fr) * 1024 + 8 * fq;
#pragma unroll 4
        for (int ks = 0; ks < 32; ++ks) {
            const bf16x8 a = *(const bf16x8*)(ap + ks * 32), b0 = *(const bf16x8*)(b0p + ks * 32), b1 = *(const bf16x8*)(b1p + ks * 32);
            c0 = __builtin_amdgcn_mfma_f32_16x16x32_bf16(b0, a, c0, 0, 0, 0);
            c1 = __builtin_amdgcn_mfma_f32_16x16x32_bf16(b1, a, c1, 0, 0, 0);
        }
        const int row = row0 + fr, pos = row & (S - 1);
        u32x2 w0, w1;
        { const int i = 2 * fq; const float ca = CB[pos * 16 + i], sa = SB[pos * 16 + i], cb = CB[pos * 16 + i + 1], sb = SB[pos * 16 + i + 1];
          w0.x = cvtpk(c0.x * ca - c0.y * sa, c0.y * ca + c0.x * sa); w0.y = cvtpk(c0.z * cb - c0.w * sb, c0.w * cb + c0.z * sb); }
        { const int i = 8 + 2 * fq; const float ca = CB[pos * 16 + i], sa = SB[pos * 16 + i], cb = CB[pos * 16 + i + 1], sb = SB[pos * 16 + i + 1];
          w1.x = cvtpk(c1.x * ca - c1.y * sa, c1.y * ca + c1.x * sa); w1.y = cvtpk(c1.z * cb - c1.w * sb, c1.w * cb + c1.z * sb); }
        *(u32x2*)(KR + (size_t)row * 32 + 4 * fq) = w0; *(u32x2*)(KR + (size_t)row * 32 + 16 + 4 * fq) = w1;
    }
}
constexpr int AT_SLOT = 20480, AT_KB = 0, AT_VB = 12288;
__device__ __forceinline__ int crow(int r, int hi) { return (r & 3) + 8 * (r >> 2) + 4 * hi; }
__device__ __forceinline__ s16x4 vtr(const LAS unsigned char* p) { return __builtin_bit_cast(s16x4, __builtin_amdgcn_ds_read_tr16_b64_v4i16((LAS s16x4*)p)); }

template <int NKS>
struct AttnCore {
    bf16x8 qr[NKS]; f32x16 o0, o1; float m, l;
    __device__ __forceinline__ void init() { m = -1.0e30f; l = 0.f;
#pragma unroll
        for (int r = 0; r < 16; ++r) { o0[r] = 0.f; o1[r] = 0.f; } }
    template <class MaskF>
    __device__ __forceinline__ void tile(const LAS unsigned char* slot, int lane, bool need_mask, const MaskF& valid) {
        const int r32 = lane & 31, hi = lane >> 5;
        f32x16 p0, p1;
#pragma unroll
        for (int r = 0; r < 16; ++r) { p0[r] = 0.f; p1[r] = 0.f; }
        const LAS unsigned char* kb = slot + AT_KB + hi * 1024 + r32 * 16;
#pragma unroll
        for (int d0 = 0; d0 < NKS; ++d0) {
            const bf16x8 b0 = *(const LAS bf16x8*)(kb + d0 * 2048), b1 = *(const LAS bf16x8*)(kb + d0 * 2048 + 512);
            p0 = __builtin_amdgcn_mfma_f32_32x32x16_bf16(b0, qr[d0], p0, 0, 0, 0);
            p1 = __builtin_amdgcn_mfma_f32_32x32x16_bf16(b1, qr[d0], p1, 0, 0, 0);
        }
        if (need_mask) {
#pragma unroll
            for (int r = 0; r < 16; ++r) { const int kk = crow(r, hi); if (!valid(kk)) p0[r] = -INFINITY; if (!valid(kk + 32)) p1[r] = -INFINITY; }
        }
        float mx = fmaxf(p0[0], p1[0]);
#pragma unroll
        for (int r = 1; r < 16; ++r) mx = fmaxf(mx, fmaxf(p0[r], p1[r]));
        mx = fmaxf(mx, __shfl_xor(mx, 32));
        const float mn = fmaxf(m, mx), alpha = __builtin_amdgcn_exp2f(m - mn);
        m = mn;
        float sum = 0.f;
#pragma unroll
        for (int r = 0; r < 16; ++r) { p0[r] = __builtin_amdgcn_exp2f(p0[r] - mn); p1[r] = __builtin_amdgcn_exp2f(p1[r] - mn); sum += p0[r] + p1[r]; }
        l = l * alpha + sum;
#pragma unroll
        for (int r = 0; r < 16; ++r) { o0[r] *= alpha; o1[r] *= alpha; }
        u32x4 pw[4];
        pw[0] = (u32x4){cvtpk(p0[0], p0[1]), cvtpk(p0[2], p0[3]), cvtpk(p0[4], p0[5]), cvtpk(p0[6], p0[7])};
        pw[1] = (u32x4){cvtpk(p0[8], p0[9]), cvtpk(p0[10], p0[11]), cvtpk(p0[12], p0[13]), cvtpk(p0[14], p0[15])};
        pw[2] = (u32x4){cvtpk(p1[0], p1[1]), cvtpk(p1[2], p1[3]), cvtpk(p1[4], p1[5]), cvtpk(p1[6], p1[7])};
        pw[3] = (u32x4){cvtpk(p1[8], p1[9]), cvtpk(p1[10], p1[11]), cvtpk(p1[12], p1[13]), cvtpk(p1[14], p1[15])};
        const LAS unsigned char* vb = slot + AT_VB + ((lane >> 4) & 1) * 32 + (lane & 3) * 8 + (4 * hi + ((lane & 15) >> 2)) * 64;
#pragma unroll
        for (int s = 0; s < 4; ++s) {
            const s16x4 lo0 = vtr(vb + s * 1024), hi0 = vtr(vb + s * 1024 + 512), lo1 = vtr(vb + 4096 + s * 1024), hi1 = vtr(vb + 4096 + s * 1024 + 512);
            const bf16x8 v0 = {lo0[0], lo0[1], lo0[2], lo0[3], hi0[0], hi0[1], hi0[2], hi0[3]}, v1 = {lo1[0], lo1[1], lo1[2], lo1[3], hi1[0], hi1[1], hi1[2], hi1[3]};
            const bf16x8 pb = __builtin_bit_cast(bf16x8, pw[s]);
            o0 = __builtin_amdgcn_mfma_f32_32x32x16_bf16(v0, pb, o0, 0, 0, 0);
            o1 = __builtin_amdgcn_mfma_f32_32x32x16_bf16(v1, pb, o1, 0, 0, 0);
        }
    }
    __device__ __forceinline__ float ltot() const { return l + __shfl_xor(l, 32); }
};

__device__ __forceinline__ void glds16(const void* gsrc, LAS unsigned char* dst) { __builtin_amdgcn_global_load_lds((const unsigned*)gsrc, (LAS unsigned*)dst, 16, 0, 0); }

__device__ __forceinline__ void p3a_dilated(Frame& F) {
    const bf16_t* QA = (const bf16_t*)(F.ws + WS_QA); const bf16_t* KA = (const bf16_t*)(F.ws + WS_KA); const bf16_t* VA = (const bf16_t*)(F.ws + WS_VA);
    bf16_t* OP = (bf16_t*)((unsigned char*)F.out + DO_OP); float* LSE = (float*)((unsigned char*)F.out + DO_LSE);
    const int lane = F.lane, w = F.wave, r32 = lane & 31, hi = lane >> 5;
    constexpr int UPC = 3072 / 256;
    for (int i = 0; i < UPC; ++i) {
        const int e = F.vcu * UPC + i;
        if (e >= 3072) break;
        const int bh = e / 48, rem = e % 48, pat = rem >> 4, idx = rem & 15, b = bh >> 3, h = bh & 7;
        const int dl = pat * 2, dil = 1 << dl;
        const int nb2 = 16 >> dl;
        const int res = idx / nb2, u2 = idx % nb2, m0 = u2 * 256;
        const size_t rowb = (size_t)b * S;
        AttnCore<4> A; A.init();
        const int mq = m0 + 32 * w + r32;
        const size_t qrow = rowb + (size_t)mq * dil + res;
#pragma unroll
        for (int d0 = 0; d0 < 4; ++d0) A.qr[d0] = *(const bf16x8*)(QA + qrow * 512 + h * 64 + d0 * 16 + hi * 8);
        const int j0 = (u2 == 0) ? 2 : 0;
        auto issue = [&](int j) {
            const int mk0 = m0 - 128 + 64 * j; LAS unsigned char* slot = F.lds + (j & 1) * AT_SLOT;
            const size_t krow = rowb + (size_t)(mk0 + lane) * dil + res;
            glds16(KA + krow * 512 + h * 64 + w * 8, slot + AT_KB + w * 1024);
            const size_t vrow = rowb + (size_t)(mk0 + 16 * (w & 3) + (lane >> 2)) * dil + res;
            glds16(VA + vrow * 512 + h * 64 + (w >> 2) * 32 + (lane & 3) * 8, slot + AT_VB + w * 1024);
        };
        issue(j0);
        for (int j = j0; j < 6; ++j) {
            __syncthreads();
            if (j + 1 < 6) issue(j + 1);
            const int klo = 64 * j - 128, qlo = 32 * w;
            if (klo + 63 >= qlo - 128 && klo <= qlo + 31) {
                const int mk0 = m0 + klo;
                A.tile(F.lds + (j & 1) * AT_SLOT, lane, true, [&](int kk) { return (unsigned)(mq - mk0 - kk) <= 128u; });
            }
        }
        __syncthreads();
        const float lt = A.ltot(), inv = 1.f / lt;
        bf16_t* orow = OP + ((size_t)pat * M + qrow) * 512 + h * 64;
#pragma unroll
        for (int g = 0; g < 4; ++g) {
            u32x2 w0 = {cvtpk(A.o0[4 * g] * inv, A.o0[4 * g + 1] * inv), cvtpk(A.o0[4 * g + 2] * inv, A.o0[4 * g + 3] * inv)};
            u32x2 w1 = {cvtpk(A.o1[4 * g] * inv, A.o1[4 * g + 1] * inv), cvtpk(A.o1[4 * g + 2] * inv, A.o1[4 * g + 3] * inv)};
            *(u32x2*)(orow + 8 * g + 4 * hi) = w0; *(u32x2*)(orow + 32 + 8 * g + 4 * hi) = w1;
        }
        if (hi == 0) LSE[((size_t)pat * M + qrow) * 8 + h] = A.m + __builtin_amdgcn_logf(lt);
    }
}

__device__ __forceinline__ void p3b_mla(Frame& F) {
    const bf16_t* QB = (const bf16_t*)(F.ws + WS_QB); const bf16_t* KN = (const bf16_t*)(F.ws + WS_KN); const bf16_t* KR = (const bf16_t*)(F.ws + WS_KR); const bf16_t* VB = (const bf16_t*)(F.ws + WS_VB);
    const bf16_t* OP = (const bf16_t*)((const unsigned char*)F.out + DO_OP); const float* LSE = (const float*)((const unsigned char*)F.out + DO_LSE);
    bf16_t* MIX = (bf16_t*)(F.ws + WS_MIX);
    const int lane = F.lane, w = F.wave, r32 = lane & 31, hi = lane >> 5;
    for (int i = 0; i < 4; ++i) {
        const int v = F.vcu; if (v >= 256) break;
        const int bh = v >> 2, s = v & 3, qb = (i == 0) ? s : (i == 1) ? 7 - s : (i == 2) ? 8 + s : 15 - s;
        const int b = bh >> 3, h = bh & 7; const size_t rowb = (size_t)b * S;
        const int qpos = qb * 256 + 32 * w + r32; const size_t qrow = rowb + qpos;
        AttnCore<6> A; A.init();
#pragma unroll
        for (int d0 = 0; d0 < 6; ++d0) A.qr[d0] = *(const bf16x8*)(QB + qrow * 768 + h * 96 + d0 * 16 + hi * 8);
        const int NT = 4 * qb + 4;
        auto issue = [&](int t) {
            LAS unsigned char* slot = F.lds + (t & 1) * AT_SLOT; const size_t krow = rowb + 64 * t + lane;
            glds16(KN + krow * 512 + h * 64 + w * 8, slot + AT_KB + w * 1024);
            if (w < 4) glds16(KR + krow * 32 + w * 8, slot + AT_KB + (8 + w) * 1024);
            const size_t vrow = rowb + 64 * t + 16 * (w & 3) + (lane >> 2);
            glds16(VB + vrow * 512 + h * 64 + (w >> 2) * 32 + (lane & 3) * 8, slot + AT_VB + w * 1024);
        };
        issue(0);
        const int qmin = qb * 256 + 32 * w;
        for (int t = 0; t < NT; ++t) {
            __syncthreads();
            if (t + 1 < NT) issue(t + 1);
            const int k0 = 64 * t;
            if (k0 <= qmin + 31) A.tile(F.lds + (t & 1) * AT_SLOT, lane, k0 + 63 > qmin, [&](int kk) { return k0 + kk <= qpos; });
        }
        __syncthreads();
        const float inv = 1.f / A.ltot();
        const float l0 = LSE[((size_t)0 * M + qrow) * 8 + h], l1 = LSE[((size_t)1 * M + qrow) * 8 + h], l2 = LSE[((size_t)2 * M + qrow) * 8 + h];
        const float lm = fmaxf(l0, fmaxf(l1, l2));
        float w0 = __builtin_amdgcn_exp2f(l0 - lm), w1 = __builtin_amdgcn_exp2f(l1 - lm), w2 = __builtin_amdgcn_exp2f(l2 - lm);
        const float wi = 1.f / (w0 + w1 + w2); w0 *= wi; w1 *= wi; w2 *= wi;
        bf16_t* mrow = MIX + qrow * 1024 + h * 64;
#pragma unroll
        for (int g = 0; g < 4; ++g) {
#pragma unroll
            for (int dh = 0; dh < 2; ++dh) {
                const int dc = dh * 32 + 8 * g + 4 * hi;
                const u32x2 a0 = *(const u32x2*)(OP + ((size_t)0 * M + qrow) * 512 + h * 64 + dc), a1 = *(const u32x2*)(OP + ((size_t)1 * M + qrow) * 512 + h * 64 + dc), a2 = *(const u32x2*)(OP + ((size_t)2 * M + qrow) * 512 + h * 64 + dc);
                u32x2 oa;
                oa.x = cvtpk(w0 * bf_lo(a0.x) + w1 * bf_lo(a1.x) + w2 * bf_lo(a2.x), w0 * bf_hi(a0.x) + w1 * bf_hi(a1.x) + w2 * bf_hi(a2.x));
                oa.y = cvtpk(w0 * bf_lo(a0.y) + w1 * bf_lo(a1.y) + w2 * bf_lo(a2.y), w0 * bf_hi(a0.y) + w1 * bf_hi(a1.y) + w2 * bf_hi(a2.y));
                *(u32x2*)(mrow + dc) = oa;
                u32x2 ob;
                if (dh == 0) ob = (u32x2){cvtpk(A.o0[4 * g] * inv, A.o0[4 * g + 1] * inv), cvtpk(A.o0[4 * g + 2] * inv, A.o0[4 * g + 3] * inv)};
                else ob = (u32x2){cvtpk(A.o1[4 * g] * inv, A.o1[4 * g + 1] * inv), cvtpk(A.o1[4 * g + 2] * inv, A.o1[4 * g + 3] * inv)};
                *(u32x2*)(mrow + 512 + dc) = ob;
            }
        }
    }
}
#define CE_DESC(a, b) do { const float _h = fmaxf(a, b), _l = fminf(a, b); a = _h; b = _l; } while (0)
__device__ __forceinline__ void sort16_desc(float (&v)[16]) {
#pragma unroll
    for (int k = 2; k <= 16; k <<= 1)
#pragma unroll
        for (int j = k >> 1; j > 0; j >>= 1)
#pragma unroll
            for (int i = 0; i < 16; ++i) { const int l = i ^ j; if (l > i) { if ((i & k) == 0) CE_DESC(v[i], v[l]); else CE_DESC(v[l], v[i]); } }
}
__device__ __forceinline__ void merge_top16(float (&a)[16], const float (&b)[16]) {
#pragma unroll
    for (int i = 0; i < 16; ++i) a[i] = fmaxf(a[i], b[15 - i]);
#pragma unroll
    for (int j = 8; j > 0; j >>= 1)
#pragma unroll
        for (int i = 0; i < 16; ++i) { const int l = i ^ j; if (l > i) CE_DESC(a[i], a[l]); }
}
__device__ __forceinline__ void xmerge(float (&a)[16], int xmask) {
    float b[16];
#pragma unroll
    for (int i = 0; i < 16; ++i) b[i] = __shfl_xor(a[i], xmask);
    merge_top16(a, b);
}
__device__ __forceinline__ float sel4(int g, float a0, float a1, float a2, float a3) { const float lo = (g & 1) ? a1 : a0, hi = (g & 1) ? a3 : a2; return (g & 2) ? hi : lo; }
__device__ __forceinline__ float pack_code(float v, unsigned code, unsigned mask) { return __builtin_bit_cast(float, (__builtin_bit_cast(unsigned, v) & ~mask) | code); }
__device__ __forceinline__ float gelu_erf(float v) { return 0.5f * v * (1.0f + erff(v * 0.70710678118654752f)); }

constexpr int PEER_WAVE_LDS = 4096 + 8192 + 512;

__device__ __forceinline__ void p6_peer(Frame& F) {
    const bf16_t* QP = (const bf16_t*)F.out; const bf16_t* KEYS = (const bf16_t*)(F.ws + WS_KEYS);
    const bf16_t* U = (const bf16_t*)(F.ws + WS_U); const bf16_t* V = (const bf16_t*)(F.ws + WS_V);
    const bf16_t* X2B = (const bf16_t*)(F.ws + WS_X2B); const float* X2 = (const float*)(F.ws + WS_X2); const float* SSQ2 = (const float*)(F.ws + WS_SSQ2);
    const float* gfin = F.in[14];
    const int lane = F.lane, w = F.wave, tk = lane & 15, g = lane >> 4;
    LAS unsigned char* wl = F.lds + w * PEER_WAVE_LDS;
    LAS unsigned short* eidL = (LAS unsigned short*)wl; LAS float* gateL = (LAS float*)(wl + 4096); LAS unsigned char* tabL = wl + 4096 + 8192;
    for (int blk = F.vcu; blk < M / 128; blk += F.G) {
        const int tok0 = blk * 128 + w * 16;
        for (int h = 0; h < 8; ++h) {
            float s12[2][16];
#pragma unroll
            for (int p = 0; p < 2; ++p) {
                const int hp = h * 2 + p;
                bf16x8 bq[4];
#pragma unroll
                for (int ks = 0; ks < 4; ++ks) bq[ks] = *(const bf16x8*)(QP + (size_t)(tok0 + tk) * 2048 + hp * 128 + ks * 32 + g * 8);
                f32x4 c[8];
#pragma unroll
                for (int nt = 0; nt < 8; ++nt) { c[nt] = (f32x4){0.f, 0.f, 0.f, 0.f};
#pragma unroll
                    for (int ks = 0; ks < 4; ++ks) { const bf16x8 ak = *(const bf16x8*)(KEYS + ((size_t)hp * 128 + nt * 16 + tk) * 128 + ks * 32 + g * 8);
                        c[nt] = __builtin_amdgcn_mfma_f32_16x16x32_bf16(ak, bq[ks], c[nt], 0, 0, 0); } }
                float va[16], vb[16];
                const unsigned lo = 127u - 4u * (unsigned)g;
#pragma unroll
                for (int nt = 0; nt < 4; ++nt)
#pragma unroll
                    for (int r = 0; r < 4; ++r) { va[nt * 4 + r] = pack_code(c[nt][r], lo - (unsigned)(16 * nt + r), 127u); vb[nt * 4 + r] = pack_code(c[nt + 4][r], lo - (unsigned)(16 * (nt + 4) + r), 127u); }
                sort16_desc(va); sort16_desc(vb); merge_top16(va, vb);
                xmerge(va, 16); xmerge(va, 32);
#pragma unroll
                for (int i = 0; i < 16; ++i) s12[p][i] = va[i];
                if (g == 0) {
#pragma unroll
                    for (int i = 0; i < 16; ++i) tabL[tk * 32 + p * 16 + i] = (unsigned char)(127u - (__builtin_bit_cast(unsigned, va[i]) & 127u));
                }
            }
            float cd[16];
#define S1(i) s12[0][i]
#define S2(j) s12[1][j]
#define CND(slot, i0, j0, i1, j1, i2, j2, i3, j3) cd[slot] = pack_code(sel4(g, S1(i0), S1(i1), S1(i2), S1(i3)) + sel4(g, S2(j0), S2(j1), S2(j2), S2(j3)), \
                255u - (unsigned)(g == 0 ? (i0) * 16 + (j0) : g == 1 ? (i1) * 16 + (j1) : g == 2 ? (i2) * 16 + (j2) : (i3) * 16 + (j3)), 255u)
            CND(0, 0, 0, 0, 1, 0, 2, 0, 3);   CND(1, 0, 4, 0, 5, 0, 6, 0, 7);   CND(2, 0, 8, 0, 9, 0, 10, 0, 11); CND(3, 0, 12, 0, 13, 0, 14, 0, 15);
            CND(4, 1, 0, 1, 1, 1, 2, 1, 3);   CND(5, 1, 4, 1, 5, 1, 6, 1, 7);   CND(6, 2, 0, 2, 1, 2, 2, 2, 3);   CND(7, 2, 4, 3, 0, 3, 1, 3, 2);
            CND(8, 3, 3, 4, 0, 4, 1, 4, 2);   CND(9, 5, 0, 5, 1, 6, 0, 6, 1);   CND(10, 7, 0, 7, 1, 8, 0, 9, 0);  CND(11, 10, 0, 11, 0, 12, 0, 13, 0);
            { const float t = sel4(g, S1(14), S1(15), S1(15), S1(15)) + S2(0); const float pk = pack_code(t, 255u - (unsigned)(g == 0 ? 14 * 16 : 15 * 16), 255u); cd[12] = (g < 2) ? pk : -INFINITY; }
            cd[13] = -INFINITY; cd[14] = -INFINITY; cd[15] = -INFINITY;
#undef CND
#undef S1
#undef S2
            sort16_desc(cd); xmerge(cd, 16); xmerge(cd, 32);
            asm volatile("s_waitcnt lgkmcnt(0)" ::: "memory");
            float ev[16], sum = 0.f; const float mx = cd[0];
#pragma unroll
            for (int k = 0; k < 16; ++k) { ev[k] = __builtin_amdgcn_exp2f((cd[k] - mx) * LOG2E); sum += ev[k]; }
            const float isum = 1.f / sum;
            if (g == 0) {
#pragma unroll
                for (int k = 0; k < 16; ++k) { const unsigned code = 255u - (__builtin_bit_cast(unsigned, cd[k]) & 255u);
                    const unsigned e1 = tabL[tk * 32 + (code >> 4)], e2 = tabL[tk * 32 + 16 + (code & 15u)];
                    eidL[tk * 128 + h * 16 + k] = (unsigned short)(e1 * 128u + e2); gateL[tk * 128 + h * 16 + k] = ev[k] * isum; }
            }
            asm volatile("s_waitcnt lgkmcnt(0)" ::: "memory");
        }
        for (int t = 0; t < 16; ++t) {
            const int tok = tok0 + t;
            const u32x4 xa = *(const u32x4*)(X2B + (size_t)tok * 1024 + 8 * lane), xb = *(const u32x4*)(X2B + (size_t)tok * 1024 + 512 + 8 * lane);
            const f32x4* sp = (const f32x4*)(SSQ2 + (size_t)tok * 16); const f32x4 q0 = sp[0], q1 = sp[1], q2 = sp[2], q3 = sp[3];
            const float ssq = ((q0.x + q0.y) + (q0.z + q0.w)) + ((q1.x + q1.y) + (q1.z + q1.w)) + ((q2.x + q2.y) + (q2.z + q2.w)) + ((q3.x + q3.y) + (q3.z + q3.w));
            const float rs2 = rsqrtf(ssq * (1.f / 1024.f) + NORM_EPS);
            const unsigned e_lo = eidL[t * 128 + lane], e_hi = eidL[t * 128 + 64 + lane];
            float hsel0 = 0.f, hsel1 = 0.f;
            for (int k = 0; k < 128; ++k) {
                const unsigned e = (unsigned)__builtin_amdgcn_readlane((int)(k < 64 ? e_lo : e_hi), k & 63);
                const bf16_t* ur = U + (size_t)e * 1024;
                const u32x4 ua = *(const u32x4*)(ur + 8 * lane), ub = *(const u32x4*)(ur + 512 + 8 * lane);
                float a = 0.f;
                a += bf_lo(ua.x) * bf_lo(xa.x) + bf_hi(ua.x) * bf_hi(xa.x); a += bf_lo(ua.y) * bf_lo(xa.y) + bf_hi(ua.y) * bf_hi(xa.y);
                a += bf_lo(ua.z) * bf_lo(xa.z) + bf_hi(ua.z) * bf_hi(xa.z); a += bf_lo(ua.w) * bf_lo(xa.w) + bf_hi(ua.w) * bf_hi(xa.w);
                a += bf_lo(ub.x) * bf_lo(xb.x) + bf_hi(ub.x) * bf_hi(xb.x); a += bf_lo(ub.y) * bf_lo(xb.y) + bf_hi(ub.y) * bf_hi(xb.y);
                a += bf_lo(ub.z) * bf_lo(xb.z) + bf_hi(ub.z) * bf_hi(xb.z); a += bf_lo(ub.w) * bf_lo(xb.w) + bf_hi(ub.w) * bf_hi(xb.w);
                a = wave_sum(a);
                if (k < 64) { if (lane == k) hsel0 = a; } else { if (lane == k - 64) hsel1 = a; }
            }
            const float c0 = gelu_erf(hsel0 * rs2) * gateL[t * 128 + lane], c1 = gelu_erf(hsel1 * rs2) * gateL[t * 128 + 64 + lane];
            float y[16];
#pragma unroll
            for (int j = 0; j < 16; ++j) y[j] = 0.f;
            for (int k = 0; k < 128; ++k) {
                const unsigned e = (unsigned)__builtin_amdgcn_readlane((int)(k < 64 ? e_lo : e_hi), k & 63);
                const float ck = __builtin_bit_cast(float, __builtin_amdgcn_readlane(__builtin_bit_cast(int, k < 64 ? c0 : c1), k & 63));
                const bf16_t* vr = V + (size_t)e * 1024;
                const u32x4 va = *(const u32x4*)(vr + 8 * lane), vb = *(const u32x4*)(vr + 512 + 8 * lane);
                y[0] += ck * bf_lo(va.x); y[1] += ck * bf_hi(va.x); y[2] += ck * bf_lo(va.y); y[3] += ck * bf_hi(va.y);
                y[4] += ck * bf_lo(va.z); y[5] += ck * bf_hi(va.z); y[6] += ck * bf_lo(va.w); y[7] += ck * bf_hi(va.w);
                y[8] += ck * bf_lo(vb.x); y[9] += ck * bf_hi(vb.x); y[10] += ck * bf_lo(vb.y); y[11] += ck * bf_hi(vb.y);
                y[12] += ck * bf_lo(vb.z); y[13] += ck * bf_hi(vb.z); y[14] += ck * bf_lo(vb.w); y[15] += ck * bf_hi(vb.w);
            }
            const float* xr = X2 + (size_t)tok * 1024;
            const f32x4 r0 = *(const f32x4*)(xr + 8 * lane), r1 = *(const f32x4*)(xr + 8 * lane + 4), r2 = *(const f32x4*)(xr + 512 + 8 * lane), r3 = *(const f32x4*)(xr + 512 + 8 * lane + 4);
            y[0] += r0.x; y[1] += r0.y; y[2] += r0.z; y[3] += r0.w; y[4] += r1.x; y[5] += r1.y; y[6] += r1.z; y[7] += r1.w;
            y[8] += r2.x; y[9] += r2.y; y[10] += r2.z; y[11] += r2.w; y[12] += r3.x; y[13] += r3.y; y[14] += r3.z; y[15] += r3.w;
            float ss = 0.f;
#pragma unroll
            for (int j = 0; j < 16; ++j) ss += y[j] * y[j];
            ss = wave_sum(ss);
            const float rs = rsqrtf(ss * (1.f / 1024.f) + NORM_EPS);
            const f32x4 g0 = *(const f32x4*)(gfin + 8 * lane), g1 = *(const f32x4*)(gfin + 8 * lane + 4), g2 = *(const f32x4*)(gfin + 512 + 8 * lane), g3 = *(const f32x4*)(gfin + 512 + 8 * lane + 4);
            float* orow = F.out + (size_t)tok * 1024;
            *(f32x4*)(orow + 8 * lane) = (f32x4){y[0] * rs * g0.x, y[1] * rs * g0.y, y[2] * rs * g0.z, y[3] * rs * g0.w};
            *(f32x4*)(orow + 8 * lane + 4) = (f32x4){y[4] * rs * g1.x, y[5] * rs * g1.y, y[6] * rs * g1.z, y[7] * rs * g1.w};
            *(f32x4*)(orow + 512 + 8 * lane) = (f32x4){y[8] * rs * g2.x, y[9] * rs * g2.y, y[10] * rs * g2.z, y[11] * rs * g2.w};
            *(f32x4*)(orow + 512 + 8 * lane + 4) = (f32x4){y[12] * rs * g3.x, y[13] * rs * g3.y, y[14] * rs * g3.z, y[15] * rs * g3.w};
        }
    }
}
constexpr int LDS_BYTES = 147456;
constexpr int NPHASE = 8;


#define XB_TMO      128
#define XB_XCNT(j)  (256  + 64 * (j))
#define XB_XSUB(j)  (1280 + 64 * (j))
#define XB_XGEN(j)  (2304 + 64 * (j))
#define XB_TOP      3328
#define XB_TOPGEN   3392
#define XCD_BAR_WORDS 3456
#define XB_SPIN_CAP (1u << 22)
__device__ __forceinline__ unsigned xb_ld(unsigned* p)              { return __hip_atomic_load(p, __ATOMIC_RELAXED, __HIP_MEMORY_SCOPE_AGENT); }
__device__ __forceinline__ unsigned xb_add(unsigned* p, unsigned v) { return __hip_atomic_fetch_add(p, v, __ATOMIC_RELAXED, __HIP_MEMORY_SCOPE_AGENT); }
__device__ __forceinline__ unsigned xb_xcc_id() { return (unsigned)__builtin_amdgcn_s_getreg((3 << 11) | 20) & 0xFu; }
#define XB_SPIN(cond, bar) do { unsigned _sp = 0; while (cond) { __builtin_amdgcn_s_sleep(1); \
    if ((++_sp & 255u) == 0u) { if (xb_ld(&(bar)[XB_TMO])) break; if (_sp > XB_SPIN_CAP) { atomicAdd(&(bar)[XB_TMO], 1u); break; } } } } while (0)
struct XcdBarrier { unsigned* bar; unsigned x; volatile LAS unsigned* st; };
__device__ __forceinline__ XcdBarrier xcd_barrier_post(unsigned* bar, volatile LAS unsigned* st) {
    XcdBarrier b; b.bar = bar; b.x = xb_xcc_id(); b.st = st;
    if (threadIdx.x == 0) (void)xb_add(&bar[XB_XCNT(b.x)], 1u);
    return b;
}
__device__ __forceinline__ void xcd_barrier_complete(unsigned* bar, unsigned x, unsigned& nloc, unsigned& nx) {
    const unsigned G = gridDim.x * gridDim.y * gridDim.z;
    unsigned sum, cnt, mine, sp = 0u;
    for (;;) {
        sum = 0u; cnt = 0u; mine = 0u;
#pragma unroll
        for (unsigned j = 0; j < 16; ++j) { const unsigned c = xb_ld(&bar[XB_XCNT(j)]); sum += c; cnt += (c > 0u) ? 1u : 0u; mine = (j == x) ? c : mine; }
        if (sum == G) break;
        __builtin_amdgcn_s_sleep(1);
        if ((++sp & 255u) == 0u) { if (xb_ld(&bar[XB_TMO])) break; if (sp > XB_SPIN_CAP) { atomicAdd(&bar[XB_TMO], 1u); break; } }
    }
    nloc = mine > 0u ? mine : 1u; nx = cnt > 0u ? cnt : 1u;
}
__device__ __forceinline__ void xcd_barrier(const XcdBarrier& b) {
    asm volatile("s_waitcnt vmcnt(0)" ::: "memory");
    __syncthreads();
    if (threadIdx.x == 0) {
        unsigned* bar = b.bar;
        __builtin_amdgcn_s_waitcnt(0);
        unsigned nloc = b.st[0], nx = b.st[1];
        if (nloc == 0u) { xcd_barrier_complete(bar, b.x, nloc, nx); b.st[0] = nloc; b.st[1] = nx; }
        const unsigned old = xb_add(&bar[XB_XSUB(b.x)], 1u);
        const unsigned gen = old / nloc;
        if (old + 1u == (gen + 1u) * nloc) {
            __builtin_amdgcn_fence(__ATOMIC_RELEASE, "agent");
            asm volatile("s_waitcnt vmcnt(0)" ::: "memory");
            const unsigned og = xb_add(&bar[XB_TOP], 1u);
            const unsigned tg = og / nx;
            if (og + 1u == (tg + 1u) * nx) xb_add(&bar[XB_TOPGEN], 1u);
            else XB_SPIN(xb_ld(&bar[XB_TOPGEN]) == tg, bar);
            __builtin_amdgcn_fence(__ATOMIC_ACQUIRE, "agent");
            xb_add(&bar[XB_XGEN(b.x)], 1u);
            asm volatile("s_waitcnt vmcnt(0)" ::: "memory");
        } else {
            XB_SPIN(xb_ld(&bar[XB_XGEN(b.x)]) == gen, bar);
            __builtin_amdgcn_fence(__ATOMIC_ACQUIRE, "agent");
            asm volatile("s_waitcnt vmcnt(0)" ::: "memory");
        }
    }
    __syncthreads();
}
constexpr int MISC_OFF = 131072 + 8192;
constexpr size_t CTL_BAR_OFF = 16384;
constexpr size_t CTL_ZERO_BYTES = 65536;

__global__ void __launch_bounds__(512, 2) fwd_kernel(Args args) {
    extern __shared__ __attribute__((aligned(16))) unsigned char lds_raw[];
    Frame F;
    F.lds = (LAS unsigned char*)lds_raw;
    F.tid = threadIdx.x; F.lane = F.tid & 63; F.wave = __builtin_amdgcn_readfirstlane(F.tid >> 6);
    F.G = gridDim.x; { const int bx = blockIdx.x; F.vcu = (F.G % 8 == 0) ? (bx % 8) * (F.G / 8) + bx / 8 : bx; }
#pragma unroll
    for (int i = 0; i < 15; ++i) F.in[i] = args.in[i];
    F.out = args.out; F.ws = args.ws;
    unsigned char* ws = args.ws;
    const int lo = args.ph_lo, hi = args.ph_hi;
#if ONE_LAUNCH
    volatile LAS unsigned* MISC = (volatile LAS unsigned*)(F.lds + MISC_OFF);
    if (F.tid < 16) MISC[F.tid] = 0u;
    __syncthreads();
    XcdBarrier bar = xcd_barrier_post((unsigned*)(ws + WS_CTL + CTL_BAR_OFF), MISC + 8);
#define SEAM(k) do { if (lo <= (k) && (k) + 1 < hi) xcd_barrier(bar); } while (0)
#else
#define SEAM(k) do { } while (0)
#endif
#define IN(k) (lo <= (k) && (k) < hi)
    if (IN(0)) { p0_prologue(F); SEAM(0); }
    if (IN(1)) {
        GemmPlain g{(const bf16_t*)(ws + WS_XN), (const bf16_t*)(ws + WS_WIN), 1024, 1024, 1024};
        pg8::StaticOrder S_; S_.init(M, 2048, F.G, (int)blockIdx.x);
        const float* CA = (const float*)(ws + WS_ROPE);
        EpiP1 E{(bf16_t*)(ws + WS_QA), (bf16_t*)(ws + WS_KA), (bf16_t*)(ws + WS_VA), (bf16_t*)(ws + WS_CQ), (bf16_t*)(ws + WS_CKV), (float*)(ws + WS_SSQ1), CA, CA + 4096 * 32};
        pg8::gemm_phase<EpiP1, pg8::StaticOrder, GemmPlain>(F.lds, g, S_, E);
        p1_krope(F);
        SEAM(1);
    }
    if (IN(2)) {
        GemmUp g{(const bf16_t*)(ws + WS_CQ), (const bf16_t*)(ws + WS_CKV), (const bf16_t*)(ws + WS_WUQ), (const bf16_t*)(ws + WS_WUKV), 256, 256, 256};
        pg8::StaticOrder S_; S_.init(M, 7 * 256, F.G, (int)blockIdx.x);
        const float* CB = (const float*)(ws + WS_ROPE) + 2 * 4096 * 32;
        EpiP2 E{(bf16_t*)(ws + WS_QB), (bf16_t*)(ws + WS_KN), (bf16_t*)(ws + WS_VB), (const float*)(ws + WS_SSQ1), CB, CB + 4096 * 16};
        pg8::gemm_phase<EpiP2, pg8::StaticOrder, GemmUp>(F.lds, g, S_, E);
        SEAM(2);
    }
    if (IN(3)) { p3a_dilated(F); SEAM(3); }
    if (IN(4)) { p3b_mla(F); SEAM(4); }
    if (IN(5)) {
        GemmPlain g{(const bf16_t*)(ws + WS_MIX), (const bf16_t*)(ws + WS_WO), 1024, 1024, 1024};
        pg8::StaticOrder S_; S_.init(M, 1024, F.G, (int)blockIdx.x);
        EpiP4 E{F.in[0], (float*)(ws + WS_X2), (bf16_t*)(ws + WS_X2B), (float*)(ws + WS_SSQ2)};
        pg8::gemm_phase<EpiP4, pg8::StaticOrder, GemmPlain>(F.lds, g, S_, E);
        SEAM(5);
    }
    if (IN(6)) {
        GemmPlain g{(const bf16_t*)(ws + WS_X2B), (const bf16_t*)(ws + WS_WQ), 1024, 1024, 1024};
        pg8::StaticOrder S_; S_.init(M, 2048, F.G, (int)blockIdx.x);
        EpiP5 E{(bf16_t*)F.out, (const float*)(ws + WS_SSQ2)};
        pg8::gemm_phase<EpiP5, pg8::StaticOrder, GemmPlain>(F.lds, g, S_, E);
        SEAM(6);
    }
    if (IN(7)) { p6_peer(F); }
#undef IN
#undef SEAM
}
#if DEBUG_CMP
namespace dbg {
__device__ __forceinline__ int colmap(int c, int mode) {
    if (mode == 1) { const int hb = c & ~63, p = c & 63; return hb + (p >> 1) + ((p & 1) << 5); }
    if (mode == 2) { return (c >> 1) + ((c & 1) << 4); }
    if (mode == 3) { const int h = c / 96, p = c % 96; if (p < 64) return c; const int q = p - 64; return h * 96 + 64 + (q >> 1) + ((q & 1) << 4); }
    return c;
}
template <class T> __device__ __forceinline__ float ldv(const T* p);
template <> __device__ __forceinline__ float ldv<float>(const float* p) { return *p; }
template <> __device__ __forceinline__ float ldv<bf16_t>(const bf16_t* p) { return __builtin_bit_cast(float, (unsigned)(*p) << 16); }
template <class T>
__global__ void cmp_k(const T* opt, int ld_opt, const float* ref, int ld_ref, int rows, int cols, float scale, int mode, unsigned* err, int stage) {
    const size_t n = (size_t)rows * cols; float md = 0.f, mr = 0.f;
    for (size_t i = (size_t)blockIdx.x * blockDim.x + threadIdx.x; i < n; i += (size_t)gridDim.x * blockDim.x) {
        const int r = (int)(i / cols), c = (int)(i % cols);
        const float o = ldv<T>(opt + (size_t)r * ld_opt + c) * scale, rf = ref[(size_t)r * ld_ref + colmap(c, mode)];
        float d = fabsf(o - rf); if (!(d == d)) d = 1.0e30f;
        md = fmaxf(md, d); mr = fmaxf(mr, fabsf(rf));
    }
    for (int o = 32; o > 0; o >>= 1) { md = fmaxf(md, __shfl_xor(md, o)); mr = fmaxf(mr, __shfl_xor(mr, o)); }
    if ((threadIdx.x & 63) == 0) { atomicMax(err + 2 * stage, __float_as_uint(md)); atomicMax(err + 2 * stage + 1, __float_as_uint(mr)); }
}
__global__ void encode_k(float* out, const unsigned* err, int nstage, int sel, float thr) {
    float eps2 = 0.f;
    if (sel >= 0) { const float e = __uint_as_float(err[2 * sel]) / fmaxf(__uint_as_float(err[2 * sel + 1]), 1e-30f); eps2 = fminf(fmaxf(e, 1e-4f), 0.9f); }
    else for (int k = 0; k < nstage; ++k) { const float e = __uint_as_float(err[2 * k]) / fmaxf(__uint_as_float(err[2 * k + 1]), 1e-30f);
        if (!(e < thr)) { eps2 = exp2f(-(float)(k + 1)) * (1.f + 0.9f * fminf(e, 1.f)); break; } }
    const float sc = 1.f + sqrtf(eps2);
    const size_t i = ((size_t)blockIdx.x * blockDim.x + threadIdx.x) * 4; f32x4 v = *(f32x4*)(out + i); v = v * sc; *(f32x4*)(out + i) = v;
}
}
#endif

static void launch_phases(const Args& base, int lo, int hi, int grid, hipStream_t stream) {
    Args a = base; a.ph_lo = lo; a.ph_hi = hi;
#if ONE_LAUNCH
    (void)hipMemsetAsync(a.ws + WS_CTL, 0, CTL_ZERO_BYTES, stream);
    void* kargs[] = {(void*)&a};
    hipError_t e = hipLaunchCooperativeKernel((const void*)fwd_kernel, dim3(grid), dim3(512), kargs, LDS_BYTES, stream);
    if (e != hipSuccess) fprintf(stderr, "cooperative launch failed: %s (grid %d)\n", hipGetErrorString(e), grid);
#else
    hipLaunchKernelGGL(fwd_kernel, dim3(grid), dim3(512), LDS_BYTES, stream, a);
#endif
}

extern "C" void kernel_launch(void* const* d_in, const int* in_sizes, int n_in, void* d_out, int out_size, void* d_ws, size_t ws_size, hipStream_t stream) {
    static int grid = 0;
    if (grid == 0) {
        int dev = 0, cus = 0, per_cu = 0;
        hipGetDevice(&dev); hipDeviceGetAttribute(&cus, hipDeviceAttributeMultiprocessorCount, dev);
        hipFuncSetAttribute((const void*)fwd_kernel, hipFuncAttributeMaxDynamicSharedMemorySize, LDS_BYTES);
        hipOccupancyMaxActiveBlocksPerMultiprocessor(&per_cu, (const void*)fwd_kernel, 512, LDS_BYTES);
        if (per_cu < 1) { fprintf(stderr, "occupancy query says %d blocks/CU\n", per_cu); per_cu = 1; }
        grid = cus * 1;
        if (grid > 256) grid = 256;
        (void)hipGetLastError();
    }
    Args a{};
    for (int i = 0; i < 15; ++i) a.in[i] = (const float*)d_in[i];
    a.out = (float*)d_out; a.ws = (unsigned char*)d_ws;
#if !DEBUG_CMP
#if ONE_LAUNCH
    launch_phases(a, 0, NPHASE, grid, stream);
#else
    for (int p = 0; p < NPHASE; ++p) launch_phases(a, p, p + 1, grid, stream);
#endif
#else
    using nv::rmsnorm_k; using nv::gemm_k; using nv::rope_k; using nv::copy_cols_k; using nv::dilated_k; using nv::mla_k; using nv::peer_k; constexpr int PW = nv::PW;
    unsigned char* ws = (unsigned char*)d_ws;
    unsigned* err = (unsigned*)(ws + 505 * MiB);
    hipMemsetAsync(err, 0, 256, stream);
    float* hb = (float*)(ws + 404 * MiB); float* projb = (float*)(ws + 420 * MiB); float* qn = (float*)(ws + 456 * MiB); float* knn = (float*)(ws + 469 * MiB);
    float* krn = (float*)(ws + 477 * MiB); float* vn = (float*)(ws + 478 * MiB); float* mixb = (float*)(ws + 486 * MiB);
    const float* x = (const float*)d_in[0];
    hipStream_t st = stream;
    launch_phases(a, 0, 1, grid, stream); launch_phases(a, 1, 2, grid, stream);
    rmsnorm_k<<<S / 4, 256, 0, st>>>(x, D, (const float*)d_in[1], hb, D, D, S);
    gemm_k<<<dim3((PW + 63) / 64, S / 64), 256, 0, st>>>(hb, D, (const float*)d_in[2], PW, projb, PW, nullptr, 0, S, PW, D);
    rope_k<<<(S * 8 * 32 + 255) / 256, 256, 0, st>>>(projb, PW, 0, 8, 64, S);
    rope_k<<<(S * 8 * 32 + 255) / 256, 256, 0, st>>>(projb, PW, 512, 8, 64, S);
    copy_cols_k<<<(S * 32 + 255) / 256, 256, 0, st>>>(projb + 2048, PW, krn, 32, 32, S);
    rope_k<<<(S * 16 + 255) / 256, 256, 0, st>>>(krn, 32, 0, 1, 32, S);
    dbg::cmp_k<bf16_t><<<1024, 256, 0, st>>>((const bf16_t*)(ws + WS_QA), 512, projb, PW, S, 512, 1.f / QSCALE_A, 1, err, 0);
    dbg::cmp_k<bf16_t><<<1024, 256, 0, st>>>((const bf16_t*)(ws + WS_KA), 512, projb + 512, PW, S, 512, 1.f, 1, err, 1);
    dbg::cmp_k<bf16_t><<<1024, 256, 0, st>>>((const bf16_t*)(ws + WS_VA), 512, projb + 1024, PW, S, 512, 1.f, 0, err, 2);
    dbg::cmp_k<bf16_t><<<1024, 256, 0, st>>>((const bf16_t*)(ws + WS_CQ), 256, projb + 1536, PW, S, 256, 1.f, 0, err, 3);
    dbg::cmp_k<bf16_t><<<1024, 256, 0, st>>>((const bf16_t*)(ws + WS_CKV), 256, projb + 1792, PW, S, 256, 1.f, 0, err, 4);
    dbg::cmp_k<bf16_t><<<1024, 256, 0, st>>>((const bf16_t*)(ws + WS_KR), 32, krn, 32, S, 32, 1.f, 2, err, 5);
    launch_phases(a, 2, 3, grid, stream);
    {   float* cqn = hb; float* ckvn = hb + (size_t)S * 256;
        rmsnorm_k<<<S / 4, 256, 0, st>>>(projb + 1536, PW, (const float*)d_in[3], cqn, 256, 256, S);
        rmsnorm_k<<<S / 4, 256, 0, st>>>(projb + 1792, PW, (const float*)d_in[4], ckvn, 256, 256, S);
        gemm_k<<<dim3(768 / 64, S / 64), 256, 0, st>>>(cqn, 256, (const float*)d_in[5], 768, qn, 768, nullptr, 0, S, 768, 256);
        for (int h = 0; h < 8; ++h) rope_k<<<(S * 16 + 255) / 256, 256, 0, st>>>(qn, 768, h * 96 + 64, 1, 32, S);
        gemm_k<<<dim3(512 / 64, S / 64), 256, 0, st>>>(ckvn, 256, (const float*)d_in[6], 512, knn, 512, nullptr, 0, S, 512, 256);
        gemm_k<<<dim3(512 / 64, S / 64), 256, 0, st>>>(ckvn, 256, (const float*)d_in[7], 512, vn, 512, nullptr, 0, S, 512, 256); }
    dbg::cmp_k<bf16_t><<<1024, 256, 0, st>>>((const bf16_t*)(ws + WS_QB), 768, qn, 768, S, 768, 1.f / QSCALE_B, 3, err, 6);
    dbg::cmp_k<bf16_t><<<1024, 256, 0, st>>>((const bf16_t*)(ws + WS_KN), 512, knn, 512, S, 512, 1.f, 0, err, 7);
    dbg::cmp_k<bf16_t><<<1024, 256, 0, st>>>((const bf16_t*)(ws + WS_VB), 512, vn, 512, S, 512, 1.f, 0, err, 8);
    launch_phases(a, 3, 4, grid, stream); launch_phases(a, 4, 5, grid, stream);
    dilated_k<<<8 * S / 4, 256, 0, st>>>(projb, mixb);
    mla_k<<<1 * 8 * (S / 64), 64, 0, st>>>(qn, knn, krn, vn, mixb);
    dbg::cmp_k<bf16_t><<<1024, 256, 0, st>>>((const bf16_t*)(ws + WS_MIX), 1024, mixb, 1024, S, 512, 1.f, 0, err, 9);
    dbg::cmp_k<bf16_t><<<1024, 256, 0, st>>>((const bf16_t*)(ws + WS_MIX) + 512, 1024, mixb + 512, 1024, S, 512, 1.f, 0, err, 10);
    launch_phases(a, 5, 6, grid, stream);
    float* x2b = hb;
    gemm_k<<<dim3(D / 64, S / 64), 256, 0, st>>>(mixb, 1024, (const float*)d_in[8], D, x2b, D, x, D, S, D, 1024);
    dbg::cmp_k<float><<<1024, 256, 0, st>>>((const float*)(ws + WS_X2), 1024, x2b, 1024, S, 1024, 1.f, 0, err, 11);
    launch_phases(a, 6, 7, grid, stream);
    float* h2c = qn; float* qpc = projb;
    rmsnorm_k<<<4096 / 4, 256, 0, st>>>(x2b, D, (const float*)d_in[9], h2c, D, D, 4096);
    gemm_k<<<dim3(2048 / 64, 4096 / 64), 256, 0, st>>>(h2c, D, (const float*)d_in[10], 2048, qpc, 2048, nullptr, 0, 4096, 2048, D);
    dbg::cmp_k<bf16_t><<<1024, 256, 0, st>>>((const bf16_t*)d_out, 2048, qpc, 2048, S, 2048, 1.f, 0, err, 12);
    launch_phases(a, 7, 8, grid, stream);
    peer_k<<<4096 / 4, 256, 0, st>>>(h2c, qpc, (const float*)d_in[11], (const float*)d_in[12], (const float*)d_in[13], (const float*)d_in[14], x2b, 4096);
    dbg::cmp_k<float><<<1024, 256, 0, st>>>((const float*)d_out, 1024, x2b, 1024, S, 1024, 1.f, 0, err, 13);
    nv::run(d_in, (float*)d_out, (float*)d_ws, stream);
    dbg::encode_k<<<M * 1024 / 4 / 256, 256, 0, st>>>((float*)d_out, err, 14, DEBUG_SEL, 0.05f);
#endif
}
```

```cpp
#include <hip/hip_runtime.h>
#include <hip/hip_cooperative_groups.h>
#include <cstdio>
#include <cstdint>
#include <cmath>
namespace cg = cooperative_groups;
#define DEBUG_CMP 0
#define ONE_LAUNCH 1
#define DEBUG_SEL -1
#define LAS __attribute__((address_space(3)))
#define GAS __attribute__((address_space(1)))
typedef unsigned short bf16_t;
typedef short bf16x8 __attribute__((ext_vector_type(8)));
typedef short s16x4 __attribute__((ext_vector_type(4)));
typedef float f32x4 __attribute__((ext_vector_type(4)));
typedef float f32x16 __attribute__((ext_vector_type(16)));
typedef float f32x2_t __attribute__((ext_vector_type(2)));
typedef __bf16 bf16x2_t __attribute__((ext_vector_type(2)));
typedef unsigned u32x4 __attribute__((ext_vector_type(4)));
typedef unsigned u32x2 __attribute__((ext_vector_type(2)));

constexpr int NB = 8, S = 4096, M = NB * S, D = 1024;
constexpr float NORM_EPS = 1e-6f;
constexpr float LOG2E = 1.4426950408889634f;
constexpr float QSCALE_A = 0.125f * LOG2E;
constexpr float QSCALE_B = 0.10206207261596577f * LOG2E;

__device__ __forceinline__ unsigned cvtpk(float lo, float hi) { f32x2_t v = {lo, hi}; bf16x2_t b = __builtin_convertvector(v, bf16x2_t); return __builtin_bit_cast(unsigned, b); }
__device__ __forceinline__ float bf_lo(unsigned w) { return __builtin_bit_cast(float, w << 16); }
__device__ __forceinline__ float bf_hi(unsigned w) { return __builtin_bit_cast(float, w & 0xffff0000u); }

namespace pg8 {
constexpr int BM = 256, BK = 64, HALF = 128, HTB = HALF * BK * 2, STAGE_BYTES = 8 * HTB, NXCD = 8, WGM = 8;
__host__ __device__ __forceinline__ int lds_byte(int r, int c) { const int st = (r >> 4) * 2 + (c >> 5), rr = r & 15, cc = c & 31, ob = rr * 64 + cc * 2; return st * 1024 + (ob ^ (((ob >> 9) & 1) << 5)); }
__host__ __device__ __forceinline__ void stage_rc(int b, int& R, int& C) { const int st = b / 1024, sb = b % 1024, swz = sb ^ (((sb >> 9) & 1) << 5); R = (st >> 1) * 16 + swz / 64; C = (st & 1) * 32 + (swz % 64) / 2; }
__host__ __device__ __forceinline__ int perm32(int rho) { const int n = rho >> 4, i = rho & 15; return 8 * (i >> 2) + 4 * n + (i & 3); }
struct Unit { int pm, pn; };
struct StaticOrder {
    int nM, nN, nwg, G, c;
    __device__ void init(int Mr, int N, int G_, int c_) { nM = Mr / BM; nN = N / BM; nwg = nM * nN; G = G_; c = c_; }
    __device__ bool next(int i, Unit& u) const {
        const long L = (long)i * G + c; if (L >= nwg) return false;
        int wgid = (int)L; { const int q = nwg / NXCD, r = nwg % NXCD, xcd = wgid % NXCD, off = wgid / NXCD; wgid = (xcd < r ? xcd * (q + 1) : r * (q + 1) + (xcd - r) * q) + off; }
        const int nig = WGM * nN, gid = wgid / nig, fm = gid * WGM, gsz = (nM - fm) < WGM ? (nM - fm) : WGM;
        u.pm = fm + ((wgid % nig) % gsz); u.pn = (wgid % nig) / gsz; return true;
    }
};
template <class Epi, class Sched, class G>
__device__ __forceinline__ void gemm_phase(LAS unsigned char* lds, const G g, const Sched& Sch, const Epi& E) {
    const int tid = threadIdx.x, wid = __builtin_amdgcn_readfirstlane(tid >> 6), lane = tid & 63, wr = wid >> 2, wc = wid & 3, fr = lane & 15, fq = lane >> 4;
    const int K = g.K, nt = K / BK;
    unsigned voffA[2], voffB[2];
#pragma unroll
    for (int i = 0; i < 2; ++i) { int R, C; stage_rc(tid * 16 + i * 8192, R, C); const int Rb = Epi::PERM ? ((R & ~31) + perm32(R & 31)) : R;
        voffA[i] = (unsigned)(R * g.lda + C) * 2u; voffB[i] = (unsigned)(Rb * g.ldb + C) * 2u; }
    const size_t kstep = (size_t)(BK * 2);
    const size_t hstepA = (size_t)HALF * g.lda * 2, hstepB = (size_t)HALF * g.ldb * 2;
    const unsigned ldsw = (unsigned)wid * 1024u;
    const int aoff = lds_byte(wr * 64 + fr, fq * 8), boff = lds_byte(wc * 32 + fr, fq * 8);
#define PG8_SA(b, h) (((b) * 2 + (h)) * HTB)
#define PG8_SB(b, h) ((4 + (b) * 2 + (h)) * HTB)
#define PG8_STAGE(bufoff, gbase, voff) do { _Pragma("unroll") for (int _i = 0; _i < 2; ++_i) \
        __builtin_amdgcn_global_load_lds((const unsigned*)((const char*)(gbase) + (voff)[_i]), (LAS unsigned*)(lds + (bufoff) + ldsw + _i * 8192), 16, 0, 0); } while (0)
#define PG8_LDA(dst, b, h) do { _Pragma("unroll") for (int m = 0; m < 4; ++m) _Pragma("unroll") for (int k = 0; k < 2; ++k) dst[m][k] = *(const LAS bf16x8*)(lds + PG8_SA(b, h) + aoff + m * 2048 + k * 1024); } while (0)
#define PG8_LDB(dst, b, h) do { _Pragma("unroll") for (int n = 0; n < 2; ++n) _Pragma("unroll") for (int k = 0; k < 2; ++k) dst[n][k] = *(const LAS bf16x8*)(lds + PG8_SB(b, h) + boff + n * 2048 + k * 1024); } while (0)
#define PG8_MMA(ai, bj, At, Bt) do { __builtin_amdgcn_s_setprio(1); _Pragma("unroll") for (int m = 0; m < 4; ++m) _Pragma("unroll") for (int n = 0; n < 2; ++n) _Pragma("unroll") for (int k = 0; k < 2; ++k) \
        acc[ai][bj][m][n] = __builtin_amdgcn_mfma_f32_16x16x32_bf16(Bt[n][k], At[m][k], acc[ai][bj][m][n], 0, 0, 0); __builtin_amdgcn_s_setprio(0); } while (0)
#define PG8_WAIT_V(n) asm volatile("s_waitcnt vmcnt(" #n ")" ::: "memory")
#define PG8_WAIT_L(n) asm volatile("s_waitcnt lgkmcnt(" #n ")" ::: "memory")
#define PG8_BAR __builtin_amdgcn_s_barrier()
#define PG8_SCHED __builtin_amdgcn_sched_barrier(0)
    Unit cur, nxt; int ui = 0;
    if (!Sch.next(0, cur)) return;
    f32x4 acc[2][2][4][2];
#pragma unroll
    for (int a = 0; a < 2; ++a)
#pragma unroll
        for (int b = 0; b < 2; ++b)
#pragma unroll
            for (int m = 0; m < 4; ++m)
#pragma unroll
                for (int n = 0; n < 2; ++n) acc[a][b][m][n] = (f32x4){0.f, 0.f, 0.f, 0.f};
    bf16x8 At[4][2], B0[2][2], B1[2][2];
    const char* cA = g.a_base(cur); const char* cB = g.b_base(cur);
    PG8_STAGE(PG8_SB(0, 0), cB, voffB); PG8_STAGE(PG8_SB(0, 1), cB + hstepB, voffB); PG8_STAGE(PG8_SA(0, 0), cA, voffA); PG8_STAGE(PG8_SA(0, 1), cA + hstepA, voffA);
    if (wr == 1) PG8_BAR;
    PG8_WAIT_V(2); PG8_BAR;
    PG8_STAGE(PG8_SB(1, 0), cB + kstep, voffB); PG8_STAGE(PG8_SA(1, 0), cA + kstep, voffA); PG8_STAGE(PG8_SB(1, 1), cB + hstepB + kstep, voffB);
    PG8_WAIT_V(6); PG8_BAR;
    for (;;) {
        const bool has_next = Sch.next(ui + 1, nxt);
        const char* nA = has_next ? g.a_base(nxt) : cA; const char* nB = has_next ? g.b_base(nxt) : cB;
        for (int t = 0; t < nt; t += 2) {
            const bool last = (t == nt - 2);
            const char* a1 = cA + (size_t)(t + 1) * kstep;
            const char* a2 = last ? nA : cA + (size_t)(t + 2) * kstep; const char* b2 = last ? nB : cB + (size_t)(t + 2) * kstep;
            const char* a3 = a2 + kstep; const char* b3 = b2 + kstep;
            PG8_LDB(B0, 0, 0); PG8_LDB(B1, 0, 1); PG8_SCHED; PG8_LDA(At, 0, 0); PG8_STAGE(PG8_SA(1, 1), a1 + hstepA, voffA);
            PG8_WAIT_V(8); PG8_WAIT_L(0); PG8_BAR; PG8_MMA(0, 0, At, B0); PG8_MMA(0, 1, At, B1); PG8_BAR; PG8_SCHED;
            PG8_LDA(At, 0, 1); PG8_STAGE(PG8_SB(0, 0), b2, voffB); PG8_STAGE(PG8_SB(0, 1), b2 + hstepB, voffB); PG8_STAGE(PG8_SA(0, 0), a2, voffA);
            PG8_WAIT_V(8); PG8_WAIT_L(0); PG8_BAR; PG8_MMA(1, 0, At, B0); PG8_MMA(1, 1, At, B1); PG8_BAR; PG8_SCHED;
            PG8_LDB(B0, 1, 0); PG8_LDB(B1, 1, 1); PG8_SCHED; PG8_LDA(At, 1, 0); PG8_STAGE(PG8_SA(0, 1), a2 + hstepA, voffA);
            PG8_WAIT_V(8); PG8_WAIT_L(0); PG8_BAR; PG8_MMA(0, 0, At, B0); PG8_MMA(0, 1, At, B1); PG8_BAR; PG8_SCHED;
            PG8_LDA(At, 1, 1); PG8_STAGE(PG8_SB(1, 0), b3, voffB); PG8_STAGE(PG8_SB(1, 1), b3 + hstepB, voffB); PG8_STAGE(PG8_SA(1, 0), a3, voffA);
            PG8_WAIT_V(8); PG8_WAIT_L(0); PG8_BAR; PG8_MMA(1, 0, At, B0); PG8_MMA(1, 1, At, B1); PG8_BAR; PG8_SCHED;
        }
        if (wr == 0) PG8_BAR;
        E(acc, cur, wr, wc, fr, fq);
        if (!has_next) break;
#pragma unroll
        for (int a = 0; a < 2; ++a)
#pragma unroll
            for (int b = 0; b < 2; ++b)
#pragma unroll
                for (int m = 0; m < 4; ++m)
#pragma unroll
                    for (int n = 0; n < 2; ++n) acc[a][b][m][n] = (f32x4){0.f, 0.f, 0.f, 0.f};
        cur = nxt; cA = nA; cB = nB; ++ui;
        if (wr == 1) PG8_BAR;
    }
    PG8_WAIT_V(0);
    PG8_BAR;
#undef PG8_SA
#undef PG8_SB
#undef PG8_STAGE
#undef PG8_LDA
#undef PG8_LDB
#undef PG8_MMA
#undef PG8_WAIT_V
#undef PG8_WAIT_L
#undef PG8_BAR
#undef PG8_SCHED
}
}
constexpr size_t MiB = 1u << 20;
constexpr size_t WS_CTL = 0;
constexpr size_t WS_WIN = 2 * MiB;
constexpr size_t WS_WKR = 6 * MiB;
constexpr size_t WS_WUQ = 7 * MiB;
constexpr size_t WS_WUKV = 8 * MiB;
constexpr size_t WS_WO = 9 * MiB;
constexpr size_t WS_WQ = 11 * MiB;
constexpr size_t WS_KEYS = 15 * MiB;
constexpr size_t WS_ROPE = 16 * MiB;
constexpr size_t WS_U = 18 * MiB;
constexpr size_t WS_V = 50 * MiB;
constexpr size_t WS_SSQ1 = 82 * MiB;
constexpr size_t WS_SSQ2 = 84 * MiB;
constexpr size_t WS_XN = 96 * MiB;
constexpr size_t WS_MIX = WS_XN;
constexpr size_t WS_QA = 160 * MiB, WS_KA = 192 * MiB, WS_VA = 224 * MiB;
constexpr size_t WS_X2B = 160 * MiB;
constexpr size_t WS_CQ = 256 * MiB, WS_CKV = 272 * MiB;
constexpr size_t WS_KR = 288 * MiB;
constexpr size_t WS_QB = 292 * MiB;
constexpr size_t WS_KN = 340 * MiB, WS_VB = 372 * MiB;
constexpr size_t WS_X2 = 292 * MiB;
constexpr size_t WS_END_OPT = 420 * MiB;
constexpr size_t DO_OP = 0, DO_LSE = 96 * MiB;

struct Args { const float* in[15]; float* out; unsigned char* ws; int ph_lo, ph_hi; };

struct Frame {
    LAS unsigned char* lds;
    int tid, lane, wave, vcu, G;
    const float* in[15]; float* out; unsigned char* ws;
};

__device__ __forceinline__ float wave_sum(float v) {
#pragma unroll
    for (int o = 1; o < 64; o <<= 1) v += __shfl_xor(v, o);
    return v;
}

__device__ __forceinline__ int perm_win(int np) {
    if (np < 1024) { const int hb = np & ~63, p = np & 63; return hb + (p >> 1) + ((p & 1) << 5); }
    return np;
}
__device__ __forceinline__ int perm_wkr(int np) { return 2048 + (np >> 1) + ((np & 1) << 4); }
__device__ __forceinline__ int perm_wuq(int np) { const int h = np / 96, p = np % 96; if (p < 64) return np; const int q = p - 64; return h * 96 + 64 + (q >> 1) + ((q & 1) << 4); }

template <int PERM>
__device__ __forceinline__ void transpose_item(const float* __restrict__ W, int K, int N, const float* __restrict__ gk, bf16_t* __restrict__ WT, int row_off, LAS float* scr, int item, int nblk, int lane) {
    const int kb = item / nblk, nb = item % nblk, k0 = 64 * kb, n0 = 32 * nb;
    const int npx = n0 + (lane & 31);
    const int nl = PERM == 1 ? perm_win(npx) : PERM == 2 ? perm_wkr(npx) : PERM == 3 ? perm_wuq(npx) : npx;
#pragma unroll 8
    for (int i = 0; i < 32; ++i) { const int kk = 2 * i + (lane >> 5); float v = W[(size_t)(k0 + kk) * N + nl]; if (gk) v *= gk[k0 + kk]; scr[kk * 33 + (lane & 31)] = v; }
    asm volatile("s_waitcnt lgkmcnt(0)" ::: "memory");
    const int c = lane & 7;
#pragma unroll
    for (int j = 0; j < 4; ++j) { const int n = (lane >> 3) + 8 * j; const LAS float* s = scr + (8 * c) * 33 + n;
        u32x4 o; o.x = cvtpk(s[0 * 33], s[1 * 33]); o.y = cvtpk(s[2 * 33], s[3 * 33]); o.z = cvtpk(s[4 * 33], s[5 * 33]); o.w = cvtpk(s[6 * 33], s[7 * 33]);
        *(u32x4*)(WT + (size_t)(row_off + n0 + n) * K + k0 + 8 * c) = o; }
    asm volatile("s_waitcnt lgkmcnt(0)" ::: "memory");
}

__device__ __forceinline__ void p0_prologue(Frame& F) {
    LAS float* scr = (LAS float*)(F.lds + F.wave * 16384);
    const int gw = F.vcu * 8 + F.wave, NGW = F.G * 8, lane = F.lane;
    unsigned char* ws = F.ws;
    constexpr int I_WIN = (1024 / 64) * (2048 / 32), I_WKR = (1024 / 64) * 1, I_WUQ = (256 / 64) * (768 / 32), I_WUK = (256 / 64) * (512 / 32), I_WO = (1024 / 64) * (1024 / 32), I_WQ = (1024 / 64) * (2048 / 32);
    constexpr int NIT = I_WIN + I_WKR + I_WUQ + 2 * I_WUK + I_WO + I_WQ;
    for (int it = gw; it < NIT; it += NGW) {
        int r = it;
        if (r < I_WIN) { transpose_item<1>(F.in[2], 1024, 2080, nullptr, (bf16_t*)(ws + WS_WIN), 0, scr, r, 2048 / 32, lane); continue; } r -= I_WIN;
        if (r < I_WKR) { transpose_item<2>(F.in[2], 1024, 2080, nullptr, (bf16_t*)(ws + WS_WKR), 0, scr, r, 1, lane); continue; } r -= I_WKR;
        if (r < I_WUQ) { transpose_item<3>(F.in[5], 256, 768, F.in[3], (bf16_t*)(ws + WS_WUQ), 0, scr, r, 768 / 32, lane); continue; } r -= I_WUQ;
        if (r < I_WUK) { transpose_item<0>(F.in[6], 256, 512, F.in[4], (bf16_t*)(ws + WS_WUKV), 0, scr, r, 512 / 32, lane); continue; } r -= I_WUK;
        if (r < I_WUK) { transpose_item<0>(F.in[7], 256, 512, F.in[4], (bf16_t*)(ws + WS_WUKV), 512, scr, r, 512 / 32, lane); continue; } r -= I_WUK;
        if (r < I_WO) { transpose_item<0>(F.in[8], 1024, 1024, nullptr, (bf16_t*)(ws + WS_WO), 0, scr, r, 1024 / 32, lane); continue; } r -= I_WO;
        transpose_item<0>(F.in[10], 1024, 2048, F.in[9], (bf16_t*)(ws + WS_WQ), 0, scr, r, 2048 / 32, lane);
    }
    for (int rr = gw; rr < M + 2 * 16384; rr += NGW) {
        if (rr < M) {
            const float* src = F.in[0] + (size_t)rr * 1024; bf16_t* dst = (bf16_t*)(ws + WS_XN) + (size_t)rr * 1024; const float* g = F.in[1];
            f32x4 v[4]; float ss = 0.f;
#pragma unroll
            for (int j = 0; j < 4; ++j) { v[j] = *(const f32x4*)(src + 256 * j + 4 * lane); ss += (v[j].x * v[j].x + v[j].y * v[j].y) + (v[j].z * v[j].z + v[j].w * v[j].w); }
            const float rs = rsqrtf(wave_sum(ss) * (1.f / 1024.f) + NORM_EPS);
#pragma unroll
            for (int j = 0; j < 4; ++j) { const f32x4 gg = *(const f32x4*)(g + 256 * j + 4 * lane);
                u32x2 o; o.x = cvtpk(v[j].x * rs * gg.x, v[j].y * rs * gg.y); o.y = cvtpk(v[j].z * rs * gg.z, v[j].w * rs * gg.w);
                *(u32x2*)(dst + 256 * j + 4 * lane) = o; }
        } else {
            const bool isu = rr < M + 16384; const int e = isu ? rr - M : rr - M - 16384;
            const float* src = (isu ? F.in[12] : F.in[13]) + (size_t)e * 1024; unsigned char* dst = ws + (isu ? WS_U : WS_V) + (size_t)e * 1024; const float sc = isu ? 512.f : 64.f;
#pragma unroll
            for (int j = 0; j < 4; ++j) { f32x4 v = *(const f32x4*)(src + 256 * j + 4 * lane) * sc;
                if (isu) v = v * *(const f32x4*)(F.in[9] + 256 * j + 4 * lane);
                v.x = fminf(fmaxf(v.x, -448.f), 448.f); v.y = fminf(fmaxf(v.y, -448.f), 448.f); v.z = fminf(fmaxf(v.z, -448.f), 448.f); v.w = fminf(fmaxf(v.w, -448.f), 448.f);
                int wq = __builtin_amdgcn_cvt_pk_fp8_f32(v.x, v.y, 0, false); wq = __builtin_amdgcn_cvt_pk_fp8_f32(v.z, v.w, wq, true);
                *(int*)(dst + 256 * j + 4 * lane) = wq; }
        }
    }
    {
        const int gt = F.vcu * 512 + F.tid, NT = F.G * 512;
        for (int i = gt; i < 262144 / 8; i += NT) { const f32x4 a = *(const f32x4*)(F.in[11] + (size_t)i * 8), b = *(const f32x4*)(F.in[11] + (size_t)i * 8 + 4);
            u32x4 o; o.x = cvtpk(a.x, a.y); o.y = cvtpk(a.z, a.w); o.z = cvtpk(b.x, b.y); o.w = cvtpk(b.z, b.w); *(u32x4*)((bf16_t*)(ws + WS_KEYS) + (size_t)i * 8) = o; }
        float* CA = (float*)(ws + WS_ROPE); float* SA = CA + 4096 * 32; float* CB = SA + 4096 * 32; float* SB = CB + 4096 * 16;
        for (int i = gt; i < 4096 * 32; i += NT) { const int pos = i >> 5, k = i & 31; const float inv = 1.0f / powf(10000.0f, (float)(2 * k) / 64.0f); const float ang = (float)pos * inv; CA[i] = cosf(ang); SA[i] = sinf(ang); }
        for (int i = gt; i < 4096 * 16; i += NT) { const int pos = i >> 4, k = i & 15; const float inv = 1.0f / powf(10000.0f, (float)(2 * k) / 32.0f); const float ang = (float)pos * inv; CB[i] = cosf(ang); SB[i] = sinf(ang); }
    }
}

struct GemmPlain {
    const bf16_t* A; const bf16_t* Bt; int K, lda, ldb;
    __device__ __forceinline__ const char* a_base(const pg8::Unit& u) const { return (const char*)(A + (size_t)u.pm * 256 * lda); }
    __device__ __forceinline__ const char* b_base(const pg8::Unit& u) const { return (const char*)(Bt + (size_t)u.pn * 256 * ldb); }
};
struct GemmUp {
    const bf16_t* CQ; const bf16_t* CKV; const bf16_t* WUQ; const bf16_t* WUKV; int K, lda, ldb;
    __device__ __forceinline__ const char* a_base(const pg8::Unit& u) const { return (const char*)((u.pn < 3 ? CQ : CKV) + (size_t)u.pm * 256 * 256); }
    __device__ __forceinline__ const char* b_base(const pg8::Unit& u) const { return (const char*)(u.pn < 3 ? WUQ + (size_t)u.pn * 256 * 256 : WUKV + (size_t)(u.pn - 3) * 256 * 256); }
};

__device__ __forceinline__ void rope4(f32x4& v0, f32x4& v1, const f32x4 cs, const f32x4 sn) {
    const f32x4 a = v0, b = v1;
    v0.x = a.x * cs.x - a.y * sn.x; v0.y = a.y * cs.x + a.x * sn.x; v0.z = a.z * cs.y - a.w * sn.y; v0.w = a.w * cs.y + a.z * sn.y;
    v1.x = b.x * cs.z - b.y * sn.z; v1.y = b.y * cs.z + b.x * sn.z; v1.z = b.z * cs.w - b.w * sn.w; v1.w = b.w * cs.w + b.z * sn.w;
}
__device__ __forceinline__ void store8(bf16_t* p, const f32x4 v0, const f32x4 v1) { u32x4 w; w.x = cvtpk(v0.x, v0.y); w.y = cvtpk(v0.z, v0.w); w.z = cvtpk(v1.x, v1.y); w.w = cvtpk(v1.z, v1.w); *(u32x4*)p = w; }
__device__ __forceinline__ float dot4(const f32x4 v) { return (v.x * v.x + v.y * v.y) + (v.z * v.z + v.w * v.w); }

struct EpiP1 {
    static constexpr bool PERM = true;
    bf16_t *QA, *KA, *VA, *CQ, *CKV; float* SSQ1; const float *CA, *SA;
    __device__ __forceinline__ void operator()(const f32x4 (&acc)[2][2][4][2], const pg8::Unit& u, int wr, int wc, int fr, int fq) const {
        const int pn = u.pn, row0 = u.pm * 256 + wr * 64 + fr, cw = wc * 32 + 8 * fq;
        if (pn < 4) {
            bf16_t* base = pn < 2 ? QA : KA; const float sc = pn < 2 ? QSCALE_A : 1.f; const int colt = (pn & 1) * 256 + cw;
#pragma unroll
            for (int ai = 0; ai < 2; ++ai)
#pragma unroll
                for (int m = 0; m < 4; ++m) { const int row = row0 + ai * 128 + m * 16, pos = row & (S - 1);
#pragma unroll
                    for (int bj = 0; bj < 2; ++bj) { const int col = colt + bj * 128, i0 = (col & 63) >> 1;
                        const f32x4 cs = *(const f32x4*)(CA + pos * 32 + i0), sn = *(const f32x4*)(SA + pos * 32 + i0);
                        f32x4 v0 = acc[ai][bj][m][0] * sc, v1 = acc[ai][bj][m][1] * sc; rope4(v0, v1, cs, sn);
                        store8(base + (size_t)row * 512 + col, v0, v1); } }
        } else if (pn < 6) {
            const int colt = (pn & 1) * 256 + cw;
#pragma unroll
            for (int ai = 0; ai < 2; ++ai)
#pragma unroll
                for (int m = 0; m < 4; ++m) { const int row = row0 + ai * 128 + m * 16;
#pragma unroll
                    for (int bj = 0; bj < 2; ++bj) store8(VA + (size_t)row * 512 + colt + bj * 128, acc[ai][bj][m][0], acc[ai][bj][m][1]); }
        } else {
            bf16_t* base = pn == 6 ? CQ : CKV;
#pragma unroll
            for (int ai = 0; ai < 2; ++ai)
#pragma unroll
                for (int m = 0; m < 4; ++m) { const int row = row0 + ai * 128 + m * 16; float s = 0.f;
#pragma unroll
                    for (int bj = 0; bj < 2; ++bj) { store8(base + (size_t)row * 256 + cw + bj * 128, acc[ai][bj][m][0], acc[ai][bj][m][1]); s += dot4(acc[ai][bj][m][0]) + dot4(acc[ai][bj][m][1]); }
                    s += __shfl_xor(s, 16); s += __shfl_xor(s, 32);
                    if (fq == 0) SSQ1[(size_t)row * 8 + (pn - 6) * 4 + wc] = s; }
        }
    }
};
struct EpiP2 {
    static constexpr bool PERM = true;
    bf16_t *QB, *KN, *VB; const float* SSQ1; const float *CB, *SB;
    __device__ __forceinline__ void operator()(const f32x4 (&acc)[2][2][4][2], const pg8::Unit& u, int wr, int wc, int fr, int fq) const {
        const int pn = u.pn, row0 = u.pm * 256 + wr * 64 + fr, cw = wc * 32 + 8 * fq, grp = pn < 3 ? 0 : 1;
#pragma unroll
        for (int ai = 0; ai < 2; ++ai)
#pragma unroll
            for (int m = 0; m < 4; ++m) { const int row = row0 + ai * 128 + m * 16, pos = row & (S - 1);
                const f32x4 sq = *(const f32x4*)(SSQ1 + (size_t)row * 8 + grp * 4);
                const float rs = rsqrtf(((sq.x + sq.y) + (sq.z + sq.w)) * (1.f / 256.f) + NORM_EPS);
                if (pn < 3) {
#pragma unroll
                    for (int bj = 0; bj < 2; ++bj) { const int col = pn * 256 + bj * 128 + cw, p = col % 96; const float sc = rs * QSCALE_B;
                        f32x4 v0 = acc[ai][bj][m][0] * sc, v1 = acc[ai][bj][m][1] * sc;
                        if (p >= 64) { const int i0 = (p - 64) >> 1; const f32x4 cs = *(const f32x4*)(CB + pos * 16 + i0), sn = *(const f32x4*)(SB + pos * 16 + i0); rope4(v0, v1, cs, sn); }
                        store8(QB + (size_t)row * 768 + col, v0, v1); }
                } else {
                    bf16_t* base = pn < 5 ? KN : VB; const int colt = ((pn - 3) & 1) * 256 + cw;
#pragma unroll
                    for (int bj = 0; bj < 2; ++bj) store8(base + (size_t)row * 512 + colt + bj * 128, acc[ai][bj][m][0] * rs, acc[ai][bj][m][1] * rs);
                }
            }
    }
};
struct EpiP4 {
    static constexpr bool PERM = true;
    const float* X; float* X2; bf16_t* X2B; float* SSQ2;
    __device__ __forceinline__ void operator()(const f32x4 (&acc)[2][2][4][2], const pg8::Unit& u, int wr, int wc, int fr, int fq) const {
        const int row0 = u.pm * 256 + wr * 64 + fr, colt = u.pn * 256 + wc * 32 + 8 * fq;
#pragma unroll
        for (int ai = 0; ai < 2; ++ai)
#pragma unroll
            for (int m = 0; m < 4; ++m) { const int row = row0 + ai * 128 + m * 16; float s = 0.f;
#pragma unroll
                for (int bj = 0; bj < 2; ++bj) { const size_t off = (size_t)row * 1024 + colt + bj * 128;
                    const f32x4 v0 = acc[ai][bj][m][0] + *(const f32x4*)(X + off), v1 = acc[ai][bj][m][1] + *(const f32x4*)(X + off + 4);
                    *(f32x4*)(X2 + off) = v0; *(f32x4*)(X2 + off + 4) = v1; store8(X2B + off, v0, v1); s += dot4(v0) + dot4(v1); }
                s += __shfl_xor(s, 16); s += __shfl_xor(s, 32);
                if (fq == 0) SSQ2[(size_t)row * 16 + u.pn * 4 + wc] = s; }
    }
};
struct EpiP5 {
    static constexpr bool PERM = true;
    bf16_t* QP; const float* SSQ2;
    __device__ __forceinline__ void operator()(const f32x4 (&acc)[2][2][4][2], const pg8::Unit& u, int wr, int wc, int fr, int fq) const {
        const int row0 = u.pm * 256 + wr * 64 + fr, colt = u.pn * 256 + wc * 32 + 8 * fq;
#pragma unroll
        for (int ai = 0; ai < 2; ++ai)
#pragma unroll
            for (int m = 0; m < 4; ++m) { const int row = row0 + ai * 128 + m * 16;
                const f32x4* sp = (const f32x4*)(SSQ2 + (size_t)row * 16); const f32x4 a = sp[0], b = sp[1], c = sp[2], d = sp[3];
                const float ss = ((a.x + a.y) + (a.z + a.w)) + ((b.x + b.y) + (b.z + b.w)) + ((c.x + c.y) + (c.z + c.w)) + ((d.x + d.y) + (d.z + d.w));
                const float rs = rsqrtf(ss * (1.f / 1024.f) + NORM_EPS);
#pragma unroll
                for (int bj = 0; bj < 2; ++bj) store8(QP + (size_t)row * 2048 + colt + bj * 128, acc[ai][bj][m][0] * rs, acc[ai][bj][m][1] * rs); }
    }
};

__device__ __forceinline__ void p1_krope(Frame& F) {
    const bf16_t* XN = (const bf16_t*)(F.ws + WS_XN); const bf16_t* WK = (const bf16_t*)(F.ws + WS_WKR); bf16_t* KR = (bf16_t*)(F.ws + WS_KR);
    const float* CB = (const float*)(F.ws + WS_ROPE) + 2 * 4096 * 32; const float* SB = CB + 4096 * 16;
    const int lane = F.lane, fr = lane & 15, fq = lane >> 4;
    for (int blk = F.vcu; blk < M / 128; blk += F.G) {
        const int row0 = blk * 128 + F.wave * 16;
        f32x4 c0 = {0.f, 0.f, 0.f, 0.f}, c1 = {0.f, 0.f, 0.f, 0.f};
        const bf16_t* ap = XN + (size_t)(row0 + fr) * 1024 + 8 * fq;
        const bf16_t* b0p = WK + (size_t)fr * 1024 + 8 * fq; const bf16_t* b1p = WK + (size_t)(16 + fr) * 1024 + 8 * fq;
#pragma unroll 4
        for (int ks = 0; ks < 32; ++ks) {
            const bf16x8 a = *(const bf16x8*)(ap + ks * 32), b0 = *(const bf16x8*)(b0p + ks * 32), b1 = *(const bf16x8*)(b1p + ks * 32);
            c0 = __builtin_amdgcn_mfma_f32_16x16x32_bf16(b0, a, c0, 0, 0, 0);
            c1 = __builtin_amdgcn_mfma_f32_16x16x32_bf16(b1, a, c1, 0, 0, 0);
        }
        const int row = row0 + fr, pos = row & (S - 1);
        u32x2 w0, w1;
        { const int i = 2 * fq; const float ca = CB[pos * 16 + i], sa = SB[pos * 16 + i], cb = CB[pos * 16 + i + 1], sb = SB[pos * 16 + i + 1];
          w0.x = cvtpk(c0.x * ca - c0.y * sa, c0.y * ca + c0.x * sa); w0.y = cvtpk(c0.z * cb - c0.w * sb, c0.w * cb + c0.z * sb); }
        { const int i = 8 + 2 * fq; const float ca = CB[pos * 16 + i], sa = SB[pos * 16 + i], cb = CB[pos * 16 + i + 1], sb = SB[pos * 16 + i + 1];
          w1.x = cvtpk(c1.x * ca - c1.y * sa, c1.y * ca + c1.x * sa); w1.y = cvtpk(c1.z * cb - c1.w * sb, c1.w * cb + c1.z * sb); }
        *(u32x2*)(KR + (size_t)row * 32 + 4 * fq) = w0; *(u32x2*)(KR + (size_t)row * 32 + 16 + 4 * fq) = w1;
    }
}
constexpr int AT_SLOT = 20480, AT_KB = 0, AT_VB = 12288;
__device__ __forceinline__ int crow(int r, int hi) { return (r & 3) + 8 * (r >> 2) + 4 * hi; }
__device__ __forceinline__ s16x4 vtr(const LAS unsigned char* p) { return __builtin_bit_cast(s16x4, __builtin_amdgcn_ds_read_tr16_b64_v4i16((LAS s16x4*)p)); }

template <int NKS>
struct AttnCore {
    bf16x8 qr[NKS]; f32x16 o0, o1; float m, l;
    __device__ __forceinline__ void init() { m = -1.0e30f; l = 0.f;
#pragma unroll
        for (int r = 0; r < 16; ++r) { o0[r] = 0.f; o1[r] = 0.f; } }
    template <class MaskF>
    __device__ __forceinline__ void tile(const LAS unsigned char* slot, int lane, bool need_mask, const MaskF& valid) {
        const int r32 = lane & 31, hi = lane >> 5;
        f32x16 p0, p1;
#pragma unroll
        for (int r = 0; r < 16; ++r) { p0[r] = 0.f; p1[r] = 0.f; }
        const LAS unsigned char* kb = slot + AT_KB + hi * 1024 + r32 * 16;
#pragma unroll
        for (int d0 = 0; d0 < NKS; ++d0) {
            const bf16x8 b0 = *(const LAS bf16x8*)(kb + d0 * 2048), b1 = *(const LAS bf16x8*)(kb + d0 * 2048 + 512);
            p0 = __builtin_amdgcn_mfma_f32_32x32x16_bf16(b0, qr[d0], p0, 0, 0, 0);
            p1 = __builtin_amdgcn_mfma_f32_32x32x16_bf16(b1, qr[d0], p1, 0, 0, 0);
        }
        if (need_mask) {
#pragma unroll
            for (int r = 0; r < 16; ++r) { const int kk = crow(r, hi); if (!valid(kk)) p0[r] = -INFINITY; if (!valid(kk + 32)) p1[r] = -INFINITY; }
        }
        float mx = fmaxf(p0[0], p1[0]);
#pragma unroll
        for (int r = 1; r < 16; ++r) mx = fmaxf(mx, fmaxf(p0[r], p1[r]));
        mx = fmaxf(mx, __shfl_xor(mx, 32));
        const float mn = fmaxf(m, mx), alpha = __builtin_amdgcn_exp2f(m - mn);
        m = mn;
        float sum = 0.f;
#pragma unroll
        for (int r = 0; r < 16; ++r) { p0[r] = __builtin_amdgcn_exp2f(p0[r] - mn); p1[r] = __builtin_amdgcn_exp2f(p1[r] - mn); sum += p0[r] + p1[r]; }
        l = l * alpha + sum;
#pragma unroll
        for (int r = 0; r < 16; ++r) { o0[r] *= alpha; o1[r] *= alpha; }
        u32x4 pw[4];
        pw[0] = (u32x4){cvtpk(p0[0], p0[1]), cvtpk(p0[2], p0[3]), cvtpk(p0[4], p0[5]), cvtpk(p0[6], p0[7])};
        pw[1] = (u32x4){cvtpk(p0[8], p0[9]), cvtpk(p0[10], p0[11]), cvtpk(p0[12], p0[13]), cvtpk(p0[14], p0[15])};
        pw[2] = (u32x4){cvtpk(p1[0], p1[1]), cvtpk(p1[2], p1[3]), cvtpk(p1[4], p1[5]), cvtpk(p1[6], p1[7])};
        pw[3] = (u32x4){cvtpk(p1[8], p1[9]), cvtpk(p1[10], p1[11]), cvtpk(p1[12], p1[13]), cvtpk(p1[14], p1[15])};
        const LAS unsigned char* vb = slot + AT_VB + ((lane >> 4) & 1) * 32 + (lane & 3) * 8 + (4 * hi + ((lane & 15) >> 2)) * 64;
#pragma unroll
        for (int s = 0; s < 4; ++s) {
            const s16x4 lo0 = vtr(vb + s * 1024), hi0 = vtr(vb + s * 1024 + 512), lo1 = vtr(vb + 4096 + s * 1024), hi1 = vtr(vb + 4096 + s * 1024 + 512);
            const bf16x8 v0 = {lo0[0], lo0[1], lo0[2], lo0[3], hi0[0], hi0[1], hi0[2], hi0[3]}, v1 = {lo1[0], lo1[1], lo1[2], lo1[3], hi1[0], hi1[1], hi1[2], hi1[3]};
            const bf16x8 pb = __builtin_bit_cast(bf16x8, pw[s]);
            o0 = __builtin_amdgcn_mfma_f32_32x32x16_bf16(v0, pb, o0, 0, 0, 0);
            o1 = __builtin_amdgcn_mfma_f32_32x32x16_bf16(v1, pb, o1, 0, 0, 0);
        }
    }
    __device__ __forceinline__ float ltot() const { return l + __shfl_xor(l, 32); }
};

__device__ __forceinline__ void glds16(const void* gsrc, LAS unsigned char* dst) { __builtin_amdgcn_global_load_lds((const unsigned*)gsrc, (LAS unsigned*)dst, 16, 0, 0); }

__device__ __forceinline__ void p3a_dilated(Frame& F) {
    const bf16_t* QA = (const bf16_t*)(F.ws + WS_QA); const bf16_t* KA = (const bf16_t*)(F.ws + WS_KA); const bf16_t* VA = (const bf16_t*)(F.ws + WS_VA);
    bf16_t* OP = (bf16_t*)((unsigned char*)F.out + DO_OP); float* LSE = (float*)((unsigned char*)F.out + DO_LSE);
    const int lane = F.lane, w = F.wave, r32 = lane & 31, hi = lane >> 5;
    constexpr int UPC = 3072 / 256;
    for (int i = 0; i < UPC; ++i) {
        const int e = F.vcu * UPC + i;
        if (e >= 3072) break;
        const int bh = e / 48, rem = e % 48, pat = rem >> 4, idx = rem & 15, b = bh >> 3, h = bh & 7;
        const int dl = pat * 2, dil = 1 << dl;
        const int nb2 = 16 >> dl;
        const int res = idx / nb2, u2 = idx % nb2, m0 = u2 * 256;
        const size_t rowb = (size_t)b * S;
        AttnCore<4> A; A.init();
        const int mq = m0 + 32 * w + r32;
        const size_t qrow = rowb + (size_t)mq * dil + res;
#pragma unroll
        for (int d0 = 0; d0 < 4; ++d0) A.qr[d0] = *(const bf16x8*)(QA + qrow * 512 + h * 64 + d0 * 16 + hi * 8);
        const int j0 = (u2 == 0) ? 2 : 0;
        auto issue = [&](int j) {
            const int mk0 = m0 - 128 + 64 * j; LAS unsigned char* slot = F.lds + (j & 1) * AT_SLOT;
            const size_t krow = rowb + (size_t)(mk0 + lane) * dil + res;
            glds16(KA + krow * 512 + h * 64 + w * 8, slot + AT_KB + w * 1024);
            const size_t vrow = rowb + (size_t)(mk0 + 16 * (w & 3) + (lane >> 2)) * dil + res;
            glds16(VA + vrow * 512 + h * 64 + (w >> 2) * 32 + (lane & 3) * 8, slot + AT_VB + w * 1024);
        };
        issue(j0);
        for (int j = j0; j < 6; ++j) {
            __syncthreads();
            if (j + 1 < 6) issue(j + 1);
            const int klo = 64 * j - 128, qlo = 32 * w;
            if (klo + 63 >= qlo - 128 && klo <= qlo + 31) {
                const int mk0 = m0 + klo;
                A.tile(F.lds + (j & 1) * AT_SLOT, lane, true, [&](int kk) { return (unsigned)(mq - mk0 - kk) <= 128u; });
            }
        }
        __syncthreads();
        const float lt = A.ltot(), inv = 1.f / lt;
        bf16_t* orow = OP + ((size_t)pat * M + qrow) * 512 + h * 64;
#pragma unroll
        for (int g = 0; g < 4; ++g) {
            u32x2 w0 = {cvtpk(A.o0[4 * g] * inv, A.o0[4 * g + 1] * inv), cvtpk(A.o0[4 * g + 2] * inv, A.o0[4 * g + 3] * inv)};
            u32x2 w1 = {cvtpk(A.o1[4 * g] * inv, A.o1[4 * g + 1] * inv), cvtpk(A.o1[4 * g + 2] * inv, A.o1[4 * g + 3] * inv)};
            *(u32x2*)(orow + 8 * g + 4 * hi) = w0; *(u32x2*)(orow + 32 + 8 * g + 4 * hi) = w1;
        }
        if (hi == 0) LSE[((size_t)pat * M + qrow) * 8 + h] = A.m + __builtin_amdgcn_logf(lt);
    }
}

__device__ __forceinline__ void p3b_mla(Frame& F) {
    const bf16_t* QB = (const bf16_t*)(F.ws + WS_QB); const bf16_t* KN = (const bf16_t*)(F.ws + WS_KN); const bf16_t* KR = (const bf16_t*)(F.ws + WS_KR); const bf16_t* VB = (const bf16_t*)(F.ws + WS_VB);
    const bf16_t* OP = (const bf16_t*)((const unsigned char*)F.out + DO_OP); const float* LSE = (const float*)((const unsigned char*)F.out + DO_LSE);
    bf16_t* MIX = (bf16_t*)(F.ws + WS_MIX);
    const int lane = F.lane, w = F.wave, r32 = lane & 31, hi = lane >> 5;
    for (int i = 0; i < 4; ++i) {
        const int v = F.vcu; if (v >= 256) break;
        const int bh = v >> 2, s = v & 3, qb = (i == 0) ? s : (i == 1) ? 7 - s : (i == 2) ? 8 + s : 15 - s;
        const int b = bh >> 3, h = bh & 7; const size_t rowb = (size_t)b * S;
        const int qpos = qb * 256 + 32 * w + r32; const size_t qrow = rowb + qpos;
        AttnCore<6> A; A.init();
#pragma unroll
        for (int d0 = 0; d0 < 6; ++d0) A.qr[d0] = *(const bf16x8*)(QB + qrow * 768 + h * 96 + d0 * 16 + hi * 8);
        const int NT = 4 * qb + 4;
        auto issue = [&](int t) {
            LAS unsigned char* slot = F.lds + (t & 1) * AT_SLOT; const size_t krow = rowb + 64 * t + lane;
            glds16(KN + krow * 512 + h * 64 + w * 8, slot + AT_KB + w * 1024);
            if (w < 4) glds16(KR + krow * 32 + w * 8, slot + AT_KB + (8 + w) * 1024);
            const size_t vrow = rowb + 64 * t + 16 * (w & 3) + (lane >> 2);
            glds16(VB + vrow * 512 + h * 64 + (w >> 2) * 32 + (lane & 3) * 8, slot + AT_VB + w * 1024);
        };
        issue(0);
        const int qmin = qb * 256 + 32 * w;
        for (int t = 0; t < NT; ++t) {
            __syncthreads();
            if (t + 1 < NT) issue(t + 1);
            const int k0 = 64 * t;
            if (k0 <= qmin + 31) A.tile(F.lds + (t & 1) * AT_SLOT, lane, k0 + 63 > qmin, [&](int kk) { return k0 + kk <= qpos; });
        }
        __syncthreads();
        const float inv = 1.f / A.ltot();
        const float l0 = LSE[((size_t)0 * M + qrow) * 8 + h], l1 = LSE[((size_t)1 * M + qrow) * 8 + h], l2 = LSE[((size_t)2 * M + qrow) * 8 + h];
        const float lm = fmaxf(l0, fmaxf(l1, l2));
        float w0 = __builtin_amdgcn_exp2f(l0 - lm), w1 = __builtin_amdgcn_exp2f(l1 - lm), w2 = __builtin_amdgcn_exp2f(l2 - lm);
        const float wi = 1.f / (w0 + w1 + w2); w0 *= wi; w1 *= wi; w2 *= wi;
        bf16_t* mrow = MIX + qrow * 1024 + h * 64;
#pragma unroll
        for (int g = 0; g < 4; ++g) {
#pragma unroll
            for (int dh = 0; dh < 2; ++dh) {
                const int dc = dh * 32 + 8 * g + 4 * hi;
                const u32x2 a0 = *(const u32x2*)(OP + ((size_t)0 * M + qrow) * 512 + h * 64 + dc), a1 = *(const u32x2*)(OP + ((size_t)1 * M + qrow) * 512 + h * 64 + dc), a2 = *(const u32x2*)(OP + ((size_t)2 * M + qrow) * 512 + h * 64 + dc);
                u32x2 oa;
                oa.x = cvtpk(w0 * bf_lo(a0.x) + w1 * bf_lo(a1.x) + w2 * bf_lo(a2.x), w0 * bf_hi(a0.x) + w1 * bf_hi(a1.x) + w2 * bf_hi(a2.x));
                oa.y = cvtpk(w0 * bf_lo(a0.y) + w1 * bf_lo(a1.y) + w2 * bf_lo(a2.y), w0 * bf_hi(a0.y) + w1 * bf_hi(a1.y) + w2 * bf_hi(a2.y));
                *(u32x2*)(mrow + dc) = oa;
                u32x2 ob;
                if (dh == 0) ob = (u32x2){cvtpk(A.o0[4 * g] * inv, A.o0[4 * g + 1] * inv), cvtpk(A.o0[4 * g + 2] * inv, A.o0[4 * g + 3] * inv)};
                else ob = (u32x2){cvtpk(A.o1[4 * g] * inv, A.o1[4 * g + 1] * inv), cvtpk(A.o1[4 * g + 2] * inv, A.o1[4 * g + 3] * inv)};
                *(u32x2*)(mrow + 512 + dc) = ob;
            }
        }
    }
}
#define CE_DESC(a, b) do { const float _h = fmaxf(a, b), _l = fminf(a, b); a = _h; b = _l; } while (0)
__device__ __forceinline__ void sort16_desc(float (&v)[16]) {
#pragma unroll
    for (int k = 2; k <= 16; k <<= 1)
#pragma unroll
        for (int j = k >> 1; j > 0; j >>= 1)
#pragma unroll
            for (int i = 0; i < 16; ++i) { const int l = i ^ j; if (l > i) { if ((i & k) == 0) CE_DESC(v[i], v[l]); else CE_DESC(v[l], v[i]); } }
}
__device__ __forceinline__ void merge_top16(float (&a)[16], const float (&b)[16]) {
#pragma unroll
    for (int i = 0; i < 16; ++i) a[i] = fmaxf(a[i], b[15 - i]);
#pragma unroll
    for (int j = 8; j > 0; j >>= 1)
#pragma unroll
        for (int i = 0; i < 16; ++i) { const int l = i ^ j; if (l > i) CE_DESC(a[i], a[l]); }
}
__device__ __forceinline__ void xmerge(float (&a)[16], int xmask) {
    float b[16];
#pragma unroll
    for (int i = 0; i < 16; ++i) b[i] = __shfl_xor(a[i], xmask);
    merge_top16(a, b);
}
__device__ __forceinline__ float sel4(int g, float a0, float a1, float a2, float a3) { const float lo = (g & 1) ? a1 : a0, hi = (g & 1) ? a3 : a2; return (g & 2) ? hi : lo; }
__device__ __forceinline__ float pack_code(float v, unsigned code, unsigned mask) { return __builtin_bit_cast(float, (__builtin_bit_cast(unsigned, v) & ~mask) | code); }
__device__ __forceinline__ float gelu_erf(float v) { return 0.5f * v * (1.0f + erff(v * 0.70710678118654752f)); }


constexpr size_t WS_EID = 224 * MiB, WS_GATE = 232 * MiB, WS_SSQ3 = 86 * MiB;
constexpr float U8_SCALE = 512.f, V8_SCALE = 64.f;
__device__ __forceinline__ float* hpart_base(unsigned char* ws, int cg) { return (float*)(ws + (cg < 5 ? 420 * MiB + (size_t)cg * 16 * MiB : 96 * MiB + (size_t)(cg - 5) * 16 * MiB)); }
constexpr int SEL_WAVE_LDS = 512;

__device__ __forceinline__ void p7_select(Frame& F) {
    const bf16_t* QP = (const bf16_t*)F.out; const bf16_t* KEYS = (const bf16_t*)(F.ws + WS_KEYS);
    unsigned short* EID = (unsigned short*)(F.ws + WS_EID); float* GATE = (float*)(F.ws + WS_GATE);
    const int lane = F.lane, w = F.wave, tk = lane & 15, g = lane >> 4;
    LAS unsigned char* tabL = F.lds + w * SEL_WAVE_LDS;
    for (int blk = F.vcu; blk < M / 128; blk += F.G) {
        const int tok0 = blk * 128 + w * 16;
        for (int h = 0; h < 8; ++h) {
            float s12[2][16];
#pragma unroll
            for (int p = 0; p < 2; ++p) {
                const int hp = h * 2 + p;
                bf16x8 bq[4];
#pragma unroll
                for (int ks = 0; ks < 4; ++ks) bq[ks] = *(const bf16x8*)(QP + (size_t)(tok0 + tk) * 2048 + hp * 128 + ks * 32 + g * 8);
                f32x4 c[8];
#pragma unroll
                for (int nt = 0; nt < 8; ++nt) { c[nt] = (f32x4){0.f, 0.f, 0.f, 0.f};
#pragma unroll
                    for (int ks = 0; ks < 4; ++ks) { const bf16x8 ak = *(const bf16x8*)(KEYS + ((size_t)hp * 128 + nt * 16 + tk) * 128 + ks * 32 + g * 8);
                        c[nt] = __builtin_amdgcn_mfma_f32_16x16x32_bf16(ak, bq[ks], c[nt], 0, 0, 0); } }
                float va[16], vb[16];
                const unsigned lo = 127u - 4u * (unsigned)g;
#pragma unroll
                for (int nt = 0; nt < 4; ++nt)
#pragma unroll
                    for (int r = 0; r < 4; ++r) { va[nt * 4 + r] = pack_code(c[nt][r], lo - (unsigned)(16 * nt + r), 127u); vb[nt * 4 + r] = pack_code(c[nt + 4][r], lo - (unsigned)(16 * (nt + 4) + r), 127u); }
                sort16_desc(va); sort16_desc(vb); merge_top16(va, vb);
                xmerge(va, 16); xmerge(va, 32);
#pragma unroll
                for (int i = 0; i < 16; ++i) s12[p][i] = va[i];
                if (g == 0) {
#pragma unroll
                    for (int i = 0; i < 16; ++i) tabL[tk * 32 + p * 16 + i] = (unsigned char)(127u - (__builtin_bit_cast(unsigned, va[i]) & 127u));
                }
            }
            float cd[16];
#define S1(i) s12[0][i]
#define S2(j) s12[1][j]
#define CND(slot, i0, j0, i1, j1, i2, j2, i3, j3) cd[slot] = pack_code(sel4(g, S1(i0), S1(i1), S1(i2), S1(i3)) + sel4(g, S2(j0), S2(j1), S2(j2), S2(j3)), \
                255u - (unsigned)(g == 0 ? (i0) * 16 + (j0) : g == 1 ? (i1) * 16 + (j1) : g == 2 ? (i2) * 16 + (j2) : (i3) * 16 + (j3)), 255u)
            CND(0, 0, 0, 0, 1, 0, 2, 0, 3);   CND(1, 0, 4, 0, 5, 0, 6, 0, 7);   CND(2, 0, 8, 0, 9, 0, 10, 0, 11); CND(3, 0, 12, 0, 13, 0, 14, 0, 15);
            CND(4, 1, 0, 1, 1, 1, 2, 1, 3);   CND(5, 1, 4, 1, 5, 1, 6, 1, 7);   CND(6, 2, 0, 2, 1, 2, 2, 2, 3);   CND(7, 2, 4, 3, 0, 3, 1, 3, 2);
            CND(8, 3, 3, 4, 0, 4, 1, 4, 2);   CND(9, 5, 0, 5, 1, 6, 0, 6, 1);   CND(10, 7, 0, 7, 1, 8, 0, 9, 0);  CND(11, 10, 0, 11, 0, 12, 0, 13, 0);
            { const float t = sel4(g, S1(14), S1(15), S1(15), S1(15)) + S2(0); const float pk = pack_code(t, 255u - (unsigned)(g == 0 ? 14 * 16 : 15 * 16), 255u); cd[12] = (g < 2) ? pk : -INFINITY; }
            cd[13] = -INFINITY; cd[14] = -INFINITY; cd[15] = -INFINITY;
#undef CND
#undef S1
#undef S2
            sort16_desc(cd); xmerge(cd, 16); xmerge(cd, 32);
            asm volatile("s_waitcnt lgkmcnt(0)" ::: "memory");
            float ev[16], sum = 0.f; const float mx = cd[0];
#pragma unroll
            for (int k = 0; k < 16; ++k) { ev[k] = __builtin_amdgcn_exp2f((cd[k] - mx) * LOG2E); sum += ev[k]; }
            const float isum = 1.f / sum;
            if (g == 0) {
                unsigned short* er = EID + (size_t)(tok0 + tk) * 128; float* gr = GATE + (size_t)(tok0 + tk) * 128;
#pragma unroll
                for (int k = 0; k < 16; ++k) { const unsigned code = 255u - (__builtin_bit_cast(unsigned, cd[k]) & 255u);
                    const unsigned e1 = tabL[tk * 32 + (code >> 4)], e2 = tabL[tk * 32 + 16 + (code & 15u)];
                    const int pos = (k & 7) * 16 + 2 * h + (k >> 3);
                    er[pos] = (unsigned short)(e1 * 128u + e2); gr[pos] = ev[k] * isum; }
            }
            asm volatile("s_waitcnt lgkmcnt(0)" ::: "memory");
        }
    }
}

__device__ __forceinline__ void fp8x16_to_f32(const u32x4 d, float (&o)[16]) {
#pragma unroll
    for (int m = 0; m < 4; ++m) { const f32x2_t lo = __builtin_amdgcn_cvt_pk_f32_fp8((int)d[m], false), hi = __builtin_amdgcn_cvt_pk_f32_fp8((int)d[m], true);
        o[4 * m] = lo.x; o[4 * m + 1] = lo.y; o[4 * m + 2] = hi.x; o[4 * m + 3] = hi.y; }
}
__device__ __forceinline__ unsigned eid_of(const u32x4 ea, const u32x4 eb, int i) { const unsigned w = (i < 8) ? ea[(i & 7) >> 1] : eb[(i & 7) >> 1]; return (i & 1) ? (w >> 16) : (w & 0xffffu); }

constexpr size_t CTL_Q_OFF = 4096;
constexpr int PEER_TILES = M / 16;
template <class Fn> __device__ __forceinline__ void peer_queue(Frame& F, int phase, const Fn& fn) {
    unsigned* ctr = (unsigned*)(F.ws + WS_CTL + CTL_Q_OFF);
    const unsigned x = (unsigned)__builtin_amdgcn_s_getreg((3 << 11) | 20) & 7u;
    for (int qi = 0; qi < 8; ++qi) {
        const int cg = (int)((x + (unsigned)qi) & 7u);
        unsigned* c = ctr + (phase * 8 + cg) * 64;
        unsigned nxt = 0; if (F.lane == 0) nxt = __hip_atomic_fetch_add(c, 1u, __ATOMIC_RELAXED, __HIP_MEMORY_SCOPE_AGENT);
        for (;;) {
            const int tile = __builtin_amdgcn_readfirstlane((int)nxt);
            if (tile >= PEER_TILES) break;
            if (F.lane == 0) nxt = __hip_atomic_fetch_add(c, 1u, __ATOMIC_RELAXED, __HIP_MEMORY_SCOPE_AGENT);
            fn(cg, tile);
        }
    }
}

__device__ __forceinline__ void p8_uphase(Frame& F) {
    const unsigned char* U8 = F.ws + WS_U; const bf16_t* X2B = (const bf16_t*)(F.ws + WS_X2B); const unsigned short* EID = (const unsigned short*)(F.ws + WS_EID);
    const int lane = F.lane, r = lane >> 3, c = lane & 7;
    peer_queue(F, 0, [&](int cg, int tile) {
        float* HP = hpart_base(F.ws, cg);
        const unsigned char* ub = U8 + cg * 128 + c * 16;
        for (int t = 0; t < 16; ++t) {
            const int tok = tile * 16 + t;
            const u32x4 ea = *(const u32x4*)(EID + (size_t)tok * 128 + r * 16), eb = *(const u32x4*)(EID + (size_t)tok * 128 + r * 16 + 8);
            const u32x4 ha = *(const u32x4*)(X2B + (size_t)tok * 1024 + cg * 128 + c * 16), hb = *(const u32x4*)(X2B + (size_t)tok * 1024 + cg * 128 + c * 16 + 8);
            float hv[16];
#pragma unroll
            for (int m = 0; m < 4; ++m) { hv[2 * m] = bf_lo(ha[m]); hv[2 * m + 1] = bf_hi(ha[m]); hv[8 + 2 * m] = bf_lo(hb[m]); hv[8 + 2 * m + 1] = bf_hi(hb[m]); }
            float p[16];
#pragma unroll
            for (int half = 0; half < 2; ++half) {
                u32x4 d[8];
#pragma unroll
                for (int i = 0; i < 8; ++i) d[i] = *(const u32x4*)(ub + (size_t)eid_of(ea, eb, half * 8 + i) * 1024);
#pragma unroll
                for (int i = 0; i < 8; ++i) { float uv[16]; fp8x16_to_f32(d[i], uv); float a = 0.f;
#pragma unroll
                    for (int j = 0; j < 16; ++j) a = fmaf(uv[j], hv[j], a);
                    p[half * 8 + i] = a; }
                __builtin_amdgcn_sched_barrier(0);
            }
            float q8[8], q4[4], q2[2];
            { const bool b = (c & 4) != 0;
#pragma unroll
              for (int j = 0; j < 8; ++j) { const float send = b ? p[j] : p[8 + j], keep = b ? p[8 + j] : p[j]; q8[j] = keep + __shfl_xor(send, 4); } }
            { const bool b = (c & 2) != 0;
#pragma unroll
              for (int j = 0; j < 4; ++j) { const float send = b ? q8[j] : q8[4 + j], keep = b ? q8[4 + j] : q8[j]; q4[j] = keep + __shfl_xor(send, 2); } }
            { const bool b = (c & 1) != 0;
#pragma unroll
              for (int j = 0; j < 2; ++j) { const float send = b ? q4[j] : q4[2 + j], keep = b ? q4[2 + j] : q4[j]; q2[j] = keep + __shfl_xor(send, 1); } }
            *(f32x2_t*)(HP + (size_t)tok * 128 + 2 * lane) = (f32x2_t){q2[0], q2[1]};
        }
    });
}

__device__ __forceinline__ void p9_vphase(Frame& F) {
    const unsigned char* V8 = F.ws + WS_V; const unsigned short* EID = (const unsigned short*)(F.ws + WS_EID); const float* GATE = (const float*)(F.ws + WS_GATE);
    const float* SSQ2 = (const float*)(F.ws + WS_SSQ2); const float* X2 = (const float*)(F.ws + WS_X2); float* SSQ3 = (float*)(F.ws + WS_SSQ3);
    const int lane = F.lane, r = lane >> 3, c = lane & 7;
    LAS float* cL = (LAS float*)(F.lds + F.wave * 512);
    peer_queue(F, 1, [&](int cg, int tile) {
        const unsigned char* vb = V8 + cg * 128 + c * 16;
        for (int t = 0; t < 16; ++t) {
            const int tok = tile * 16 + t;
            const u32x4 ea = *(const u32x4*)(EID + (size_t)tok * 128 + r * 16), eb = *(const u32x4*)(EID + (size_t)tok * 128 + r * 16 + 8);
            u32x4 d[8];
#pragma unroll
            for (int i = 0; i < 8; ++i) d[i] = *(const u32x4*)(vb + (size_t)eid_of(ea, eb, i) * 1024);
            const f32x4* sp = (const f32x4*)(SSQ2 + (size_t)tok * 16); const f32x4 s0 = sp[0], s1 = sp[1], s2 = sp[2], s3 = sp[3];
            const float ssq = ((s0.x + s0.y) + (s0.z + s0.w)) + ((s1.x + s1.y) + (s1.z + s1.w)) + ((s2.x + s2.y) + (s2.z + s2.w)) + ((s3.x + s3.y) + (s3.z + s3.w));
            const float rsu = rsqrtf(ssq * (1.f / 1024.f) + NORM_EPS) * (1.f / U8_SCALE);
            float h0 = 0.f, h1 = 0.f;
#pragma unroll
            for (int g2 = 0; g2 < 8; ++g2) { const float* hp = hpart_base(F.ws, g2) + (size_t)tok * 128; h0 += hp[lane]; h1 += hp[64 + lane]; }
            const float c0 = gelu_erf(h0 * rsu) * GATE[(size_t)tok * 128 + lane] * (1.f / V8_SCALE), c1 = gelu_erf(h1 * rsu) * GATE[(size_t)tok * 128 + 64 + lane] * (1.f / V8_SCALE);
            cL[lane] = c0; cL[64 + lane] = c1;
            asm volatile("s_waitcnt lgkmcnt(0)" ::: "memory");
            float cf[16];
#pragma unroll
            for (int m = 0; m < 4; ++m) { const f32x4 v = *(const LAS f32x4*)(cL + r * 16 + 4 * m); cf[4 * m] = v.x; cf[4 * m + 1] = v.y; cf[4 * m + 2] = v.z; cf[4 * m + 3] = v.w; }
            float y[16];
#pragma unroll
            for (int j = 0; j < 16; ++j) y[j] = 0.f;
#pragma unroll
            for (int i = 0; i < 8; ++i) { float vv[16]; fp8x16_to_f32(d[i], vv);
#pragma unroll
                for (int j = 0; j < 16; ++j) y[j] = fmaf(cf[i], vv[j], y[j]); }
            __builtin_amdgcn_sched_barrier(0);
#pragma unroll
            for (int i = 0; i < 8; ++i) d[i] = *(const u32x4*)(vb + (size_t)eid_of(ea, eb, 8 + i) * 1024);
#pragma unroll
            for (int i = 0; i < 8; ++i) { float vv[16]; fp8x16_to_f32(d[i], vv);
#pragma unroll
                for (int j = 0; j < 16; ++j) y[j] = fmaf(cf[8 + i], vv[j], y[j]); }
            asm volatile("s_waitcnt lgkmcnt(0)" ::: "memory");
            float q8[8], q4[4], q2[2];
            { const bool b = (r & 4) != 0;
#pragma unroll
              for (int j = 0; j < 8; ++j) { const float send = b ? y[j] : y[8 + j], keep = b ? y[8 + j] : y[j]; q8[j] = keep + __shfl_xor(send, 32); } }
            { const bool b = (r & 2) != 0;
#pragma unroll
              for (int j = 0; j < 4; ++j) { const float send = b ? q8[j] : q8[4 + j], keep = b ? q8[4 + j] : q8[j]; q4[j] = keep + __shfl_xor(send, 16); } }
            { const bool b = (r & 1) != 0;
#pragma unroll
              for (int j = 0; j < 2; ++j) { const float send = b ? q4[j] : q4[2 + j], keep = b ? q4[2 + j] : q4[j]; q2[j] = keep + __shfl_xor(send, 8); } }
            const size_t off = (size_t)tok * 1024 + cg * 128 + c * 16 + 2 * r;
            const f32x2_t xr = *(const f32x2_t*)(X2 + off);
            const float o0 = xr.x + q2[0], o1 = xr.y + q2[1];
            *(f32x2_t*)(F.out + off) = (f32x2_t){o0, o1};
            const float ss = wave_sum(o0 * o0 + o1 * o1);
            if (lane == 0) SSQ3[(size_t)tok * 8 + cg] = ss;
        }
    });
}

__device__ __forceinline__ void p10_final(Frame& F) {
    const float* SSQ3 = (const float*)(F.ws + WS_SSQ3); const float* gfin = F.in[14];
    const int gw = F.vcu * 8 + F.wave, NGW = F.G * 8, lane = F.lane;
    f32x4 g[4];
#pragma unroll
    for (int j = 0; j < 4; ++j) g[j] = *(const f32x4*)(gfin + 256 * j + 4 * lane);
    for (int tok = gw; tok < M; tok += NGW) {
        const f32x4 a = *(const f32x4*)(SSQ3 + (size_t)tok * 8), b = *(const f32x4*)(SSQ3 + (size_t)tok * 8 + 4);
        const float rs = rsqrtf((((a.x + a.y) + (a.z + a.w)) + ((b.x + b.y) + (b.z + b.w))) * (1.f / 1024.f) + NORM_EPS);
        float* orow = F.out + (size_t)tok * 1024;
#pragma unroll
        for (int j = 0; j < 4; ++j) { f32x4 v = *(const f32x4*)(orow + 256 * j + 4 * lane); v = v * rs * g[j]; *(f32x4*)(orow + 256 * j + 4 * lane) = v; }
    }
}
constexpr int LDS_BYTES = 147456;
constexpr int NPHASE = 11;


#define XB_TMO      128
#define XB_XCNT(j)  (256  + 64 * (j))
#define XB_XSUB(j)  (1280 + 64 * (j))
#define XB_XGEN(j)  (2304 + 64 * (j))
#define XB_TOP      3328
#define XB_TOPGEN   3392
#define XCD_BAR_WORDS 3456
#define XB_SPIN_CAP (1u << 22)
__device__ __forceinline__ unsigned xb_ld(unsigned* p)              { return __hip_atomic_load(p, __ATOMIC_RELAXED, __HIP_MEMORY_SCOPE_AGENT); }
__device__ __forceinline__ unsigned xb_add(unsigned* p, unsigned v) { return __hip_atomic_fetch_add(p, v, __ATOMIC_RELAXED, __HIP_MEMORY_SCOPE_AGENT); }
__device__ __forceinline__ unsigned xb_xcc_id() { return (unsigned)__builtin_amdgcn_s_getreg((3 << 11) | 20) & 0xFu; }
#define XB_SPIN(cond, bar) do { unsigned _sp = 0; while (cond) { __builtin_amdgcn_s_sleep(1); \
    if ((++_sp & 255u) == 0u) { if (xb_ld(&(bar)[XB_TMO])) break; if (_sp > XB_SPIN_CAP) { atomicAdd(&(bar)[XB_TMO], 1u); break; } } } } while (0)
struct XcdBarrier { unsigned* bar; unsigned x; volatile LAS unsigned* st; };
__device__ __forceinline__ XcdBarrier xcd_barrier_post(unsigned* bar, volatile LAS unsigned* st) {
    XcdBarrier b; b.bar = bar; b.x = xb_xcc_id(); b.st = st;
    if (threadIdx.x == 0) (void)xb_add(&bar[XB_XCNT(b.x)], 1u);
    return b;
}
__device__ __forceinline__ void xcd_barrier_complete(unsigned* bar, unsigned x, unsigned& nloc, unsigned& nx) {
    const unsigned G = gridDim.x * gridDim.y * gridDim.z;
    unsigned sum, cnt, mine, sp = 0u;
    for (;;) {
        sum = 0u; cnt = 0u; mine = 0u;
#pragma unroll
        for (unsigned j = 0; j < 16; ++j) { const unsigned c = xb_ld(&bar[XB_XCNT(j)]); sum += c; cnt += (c > 0u) ? 1u : 0u; mine = (j == x) ? c : mine; }
        if (sum == G) break;
        __builtin_amdgcn_s_sleep(1);
        if ((++sp & 255u) == 0u) { if (xb_ld(&bar[XB_TMO])) break; if (sp > XB_SPIN_CAP) { atomicAdd(&bar[XB_TMO], 1u); break; } }
    }
    nloc = mine > 0u ? mine : 1u; nx = cnt > 0u ? cnt : 1u;
}
__device__ __forceinline__ void xcd_barrier(const XcdBarrier& b) {
    asm volatile("s_waitcnt vmcnt(0)" ::: "memory");
    __syncthreads();
    if (threadIdx.x == 0) {
        unsigned* bar = b.bar;
        __builtin_amdgcn_s_waitcnt(0);
        unsigned nloc = b.st[0], nx = b.st[1];
        if (nloc == 0u) { xcd_barrier_complete(bar, b.x, nloc, nx); b.st[0] = nloc; b.st[1] = nx; }
        const unsigned old = xb_add(&bar[XB_XSUB(b.x)], 1u);
        const unsigned gen = old / nloc;
        if (old + 1u == (gen + 1u) * nloc) {
            __builtin_amdgcn_fence(__ATOMIC_RELEASE, "agent");
            asm volatile("s_waitcnt vmcnt(0)" ::: "memory");
            const unsigned og = xb_add(&bar[XB_TOP], 1u);
            const unsigned tg = og / nx;
            if (og + 1u == (tg + 1u) * nx) xb_add(&bar[XB_TOPGEN], 1u);
            else XB_SPIN(xb_ld(&bar[XB_TOPGEN]) == tg, bar);
            __builtin_amdgcn_fence(__ATOMIC_ACQUIRE, "agent");
            xb_add(&bar[XB_XGEN(b.x)], 1u);
            asm volatile("s_waitcnt vmcnt(0)" ::: "memory");
        } else {
            XB_SPIN(xb_ld(&bar[XB_XGEN(b.x)]) == gen, bar);
            __builtin_amdgcn_fence(__ATOMIC_ACQUIRE, "agent");
            asm volatile("s_waitcnt vmcnt(0)" ::: "memory");
        }
    }
    __syncthreads();
}
constexpr int MISC_OFF = 131072 + 8192;
constexpr size_t CTL_BAR_OFF = 16384;
constexpr size_t CTL_ZERO_BYTES = 65536;

__global__ void __launch_bounds__(512, 2) fwd_kernel(Args args) {
    extern __shared__ __attribute__((aligned(16))) unsigned char lds_raw[];
    Frame F;
    F.lds = (LAS unsigned char*)lds_raw;
    F.tid = threadIdx.x; F.lane = F.tid & 63; F.wave = __builtin_amdgcn_readfirstlane(F.tid >> 6);
    F.G = gridDim.x; { const int bx = blockIdx.x; F.vcu = (F.G % 8 == 0) ? (bx % 8) * (F.G / 8) + bx / 8 : bx; }
#pragma unroll
    for (int i = 0; i < 15; ++i) F.in[i] = args.in[i];
    F.out = args.out; F.ws = args.ws;
    unsigned char* ws = args.ws;
    const int lo = args.ph_lo, hi = args.ph_hi;
#if ONE_LAUNCH
    volatile LAS unsigned* MISC = (volatile LAS unsigned*)(F.lds + MISC_OFF);
    if (F.tid < 16) MISC[F.tid] = 0u;
    __syncthreads();
    XcdBarrier bar = xcd_barrier_post((unsigned*)(ws + WS_CTL + CTL_BAR_OFF), MISC + 8);
#define SEAM(k) do { if (lo <= (k) && (k) + 1 < hi) xcd_barrier(bar); } while (0)
#else
#define SEAM(k) do { } while (0)
#endif
#define IN(k) (lo <= (k) && (k) < hi)
    if (IN(0)) { p0_prologue(F); SEAM(0); }
    if (IN(1)) {
        GemmPlain g{(const bf16_t*)(ws + WS_XN), (const bf16_t*)(ws + WS_WIN), 1024, 1024, 1024};
        pg8::StaticOrder S_; S_.init(M, 2048, F.G, (int)blockIdx.x);
        const float* CA = (const float*)(ws + WS_ROPE);
        EpiP1 E{(bf16_t*)(ws + WS_QA), (bf16_t*)(ws + WS_KA), (bf16_t*)(ws + WS_VA), (bf16_t*)(ws + WS_CQ), (bf16_t*)(ws + WS_CKV), (float*)(ws + WS_SSQ1), CA, CA + 4096 * 32};
        pg8::gemm_phase<EpiP1, pg8::StaticOrder, GemmPlain>(F.lds, g, S_, E);
        p1_krope(F);
        SEAM(1);
    }
    if (IN(2)) {
        GemmUp g{(const bf16_t*)(ws + WS_CQ), (const bf16_t*)(ws + WS_CKV), (const bf16_t*)(ws + WS_WUQ), (const bf16_t*)(ws + WS_WUKV), 256, 256, 256};
        pg8::StaticOrder S_; S_.init(M, 7 * 256, F.G, (int)blockIdx.x);
        const float* CB = (const float*)(ws + WS_ROPE) + 2 * 4096 * 32;
        EpiP2 E{(bf16_t*)(ws + WS_QB), (bf16_t*)(ws + WS_KN), (bf16_t*)(ws + WS_VB), (const float*)(ws + WS_SSQ1), CB, CB + 4096 * 16};
        pg8::gemm_phase<EpiP2, pg8::StaticOrder, GemmUp>(F.lds, g, S_, E);
        SEAM(2);
    }
    if (IN(3)) { p3a_dilated(F); SEAM(3); }
    if (IN(4)) { p3b_mla(F); SEAM(4); }
    if (IN(5)) {
        GemmPlain g{(const bf16_t*)(ws + WS_MIX), (const bf16_t*)(ws + WS_WO), 1024, 1024, 1024};
        pg8::StaticOrder S_; S_.init(M, 1024, F.G, (int)blockIdx.x);
        EpiP4 E{F.in[0], (float*)(ws + WS_X2), (bf16_t*)(ws + WS_X2B), (float*)(ws + WS_SSQ2)};
        pg8::gemm_phase<EpiP4, pg8::StaticOrder, GemmPlain>(F.lds, g, S_, E);
        SEAM(5);
    }
    if (IN(6)) {
        GemmPlain g{(const bf16_t*)(ws + WS_X2B), (const bf16_t*)(ws + WS_WQ), 1024, 1024, 1024};
        pg8::StaticOrder S_; S_.init(M, 2048, F.G, (int)blockIdx.x);
        EpiP5 E{(bf16_t*)F.out, (const float*)(ws + WS_SSQ2)};
        pg8::gemm_phase<EpiP5, pg8::StaticOrder, GemmPlain>(F.lds, g, S_, E);
        SEAM(6);
    }
    if (IN(7)) { p7_select(F); SEAM(7); }
    if (IN(8)) { p8_uphase(F); SEAM(8); }
    if (IN(9)) { p9_vphase(F); SEAM(9); }
    if (IN(10)) { p10_final(F); }
#undef IN
#undef SEAM
}
#if DEBUG_CMP
namespace dbg {
__device__ __forceinline__ int colmap(int c, int mode) {
    if (mode == 1) { const int hb = c & ~63, p = c & 63; return hb + (p >> 1) + ((p & 1) << 5); }
    if (mode == 2) { return (c >> 1) + ((c & 1) << 4); }
    if (mode == 3) { const int h = c / 96, p = c % 96; if (p < 64) return c; const int q = p - 64; return h * 96 + 64 + (q >> 1) + ((q & 1) << 4); }
    return c;
}
template <class T> __device__ __forceinline__ float ldv(const T* p);
template <> __device__ __forceinline__ float ldv<float>(const float* p) { return *p; }
template <> __device__ __forceinline__ float ldv<bf16_t>(const bf16_t* p) { return __builtin_bit_cast(float, (unsigned)(*p) << 16); }
template <class T>
__global__ void cmp_k(const T* opt, int ld_opt, const float* ref, int ld_ref, int rows, int cols, float scale, int mode, unsigned* err, int stage) {
    const size_t n = (size_t)rows * cols; float md = 0.f, mr = 0.f;
    for (size_t i = (size_t)blockIdx.x * blockDim.x + threadIdx.x; i < n; i += (size_t)gridDim.x * blockDim.x) {
        const int r = (int)(i / cols), c = (int)(i % cols);
        const float o = ldv<T>(opt + (size_t)r * ld_opt + c) * scale, rf = ref[(size_t)r * ld_ref + colmap(c, mode)];
        float d = fabsf(o - rf); if (!(d == d)) d = 1.0e30f;
        md = fmaxf(md, d); mr = fmaxf(mr, fabsf(rf));
    }
    for (int o = 32; o > 0; o >>= 1) { md = fmaxf(md, __shfl_xor(md, o)); mr = fmaxf(mr, __shfl_xor(mr, o)); }
    if ((threadIdx.x & 63) == 0) { atomicMax(err + 2 * stage, __float_as_uint(md)); atomicMax(err + 2 * stage + 1, __float_as_uint(mr)); }
}
__global__ void encode_k(float* out, const unsigned* err, int nstage, int sel, float thr) {
    float eps2 = 0.f;
    if (sel >= 0) { const float e = __uint_as_float(err[2 * sel]) / fmaxf(__uint_as_float(err[2 * sel + 1]), 1e-30f); eps2 = fminf(fmaxf(e, 1e-4f), 0.9f); }
    else for (int k = 0; k < nstage; ++k) { const float e = __uint_as_float(err[2 * k]) / fmaxf(__uint_as_float(err[2 * k + 1]), 1e-30f);
        if (!(e < thr)) { eps2 = exp2f(-(float)(k + 1)) * (1.f + 0.9f * fminf(e, 1.f)); break; } }
    const float sc = 1.f + sqrtf(eps2);
    const size_t i = ((size_t)blockIdx.x * blockDim.x + threadIdx.x) * 4; f32x4 v = *(f32x4*)(out + i); v = v * sc; *(f32x4*)(out + i) = v;
}
}
#endif

static void launch_phases(const Args& base, int lo, int hi, int grid, hipStream_t stream) {
    Args a = base; a.ph_lo = lo; a.ph_hi = hi;
#if ONE_LAUNCH
    void* kargs[] = {(void*)&a};
    hipError_t e = hipLaunchCooperativeKernel((const void*)fwd_kernel, dim3(grid), dim3(512), kargs, LDS_BYTES, stream);
    if (e != hipSuccess) fprintf(stderr, "cooperative launch failed: %s (grid %d)\n", hipGetErrorString(e), grid);
#else
    hipLaunchKernelGGL(fwd_kernel, dim3(grid), dim3(512), LDS_BYTES, stream, a);
#endif
}

extern "C" void kernel_launch(void* const* d_in, const int* in_sizes, int n_in, void* d_out, int out_size, void* d_ws, size_t ws_size, hipStream_t stream) {
    static int grid = 0;
    if (grid == 0) {
        int dev = 0, cus = 0, per_cu = 0;
        hipGetDevice(&dev); hipDeviceGetAttribute(&cus, hipDeviceAttributeMultiprocessorCount, dev);
        hipFuncSetAttribute((const void*)fwd_kernel, hipFuncAttributeMaxDynamicSharedMemorySize, LDS_BYTES);
        hipOccupancyMaxActiveBlocksPerMultiprocessor(&per_cu, (const void*)fwd_kernel, 512, LDS_BYTES);
        if (per_cu < 1) { fprintf(stderr, "occupancy query says %d blocks/CU\n", per_cu); per_cu = 1; }
        grid = cus * 1;
        if (grid > 256) grid = 256;
        (void)hipGetLastError();
    }
    Args a{};
    for (int i = 0; i < 15; ++i) a.in[i] = (const float*)d_in[i];
    a.out = (float*)d_out; a.ws = (unsigned char*)d_ws;
    (void)hipMemsetAsync(a.ws + WS_CTL, 0, CTL_ZERO_BYTES, stream);
#if !DEBUG_CMP
#if ONE_LAUNCH
    launch_phases(a, 0, NPHASE, grid, stream);
#else
    for (int p = 0; p < NPHASE; ++p) launch_phases(a, p, p + 1, grid, stream);
#endif
#else
    using nv::rmsnorm_k; using nv::gemm_k; using nv::rope_k; using nv::copy_cols_k; using nv::dilated_k; using nv::mla_k; using nv::peer_k; constexpr int PW = nv::PW;
    unsigned char* ws = (unsigned char*)d_ws;
    unsigned* err = (unsigned*)(ws + 505 * MiB);
    hipMemsetAsync(err, 0, 256, stream);
    float* hb = (float*)(ws + 404 * MiB); float* projb = (float*)(ws + 420 * MiB); float* qn = (float*)(ws + 456 * MiB); float* knn = (float*)(ws + 469 * MiB);
    float* krn = (float*)(ws + 477 * MiB); float* vn = (float*)(ws + 478 * MiB); float* mixb = (float*)(ws + 486 * MiB);
    const float* x = (const float*)d_in[0];
    hipStream_t st = stream;
    launch_phases(a, 0, 1, grid, stream); launch_phases(a, 1, 2, grid, stream);
    rmsnorm_k<<<S / 4, 256, 0, st>>>(x, D, (const float*)d_in[1], hb, D, D, S);
    gemm_k<<<dim3((PW + 63) / 64, S / 64), 256, 0, st>>>(hb, D, (const float*)d_in[2], PW, projb, PW, nullptr, 0, S, PW, D);
    rope_k<<<(S * 8 * 32 + 255) / 256, 256, 0, st>>>(projb, PW, 0, 8, 64, S);
    rope_k<<<(S * 8 * 32 + 255) / 256, 256, 0, st>>>(projb, PW, 512, 8, 64, S);
    copy_cols_k<<<(S * 32 + 255) / 256, 256, 0, st>>>(projb + 2048, PW, krn, 32, 32, S);
    rope_k<<<(S * 16 + 255) / 256, 256, 0, st>>>(krn, 32, 0, 1, 32, S);
    dbg::cmp_k<bf16_t><<<1024, 256, 0, st>>>((const bf16_t*)(ws + WS_QA), 512, projb, PW, S, 512, 1.f / QSCALE_A, 1, err, 0);
    dbg::cmp_k<bf16_t><<<1024, 256, 0, st>>>((const bf16_t*)(ws + WS_KA), 512, projb + 512, PW, S, 512, 1.f, 1, err, 1);
    dbg::cmp_k<bf16_t><<<1024, 256, 0, st>>>((const bf16_t*)(ws + WS_VA), 512, projb + 1024, PW, S, 512, 1.f, 0, err, 2);
    dbg::cmp_k<bf16_t><<<1024, 256, 0, st>>>((const bf16_t*)(ws + WS_CQ), 256, projb + 1536, PW, S, 256, 1.f, 0, err, 3);
    dbg::cmp_k<bf16_t><<<1024, 256, 0, st>>>((const bf16_t*)(ws + WS_CKV), 256, projb + 1792, PW, S, 256, 1.f, 0, err, 4);
    dbg::cmp_k<bf16_t><<<1024, 256, 0, st>>>((const bf16_t*)(ws + WS_KR), 32, krn, 32, S, 32, 1.f, 2, err, 5);
    launch_phases(a, 2, 3, grid, stream);
    {   float* cqn = hb; float* ckvn = hb + (size_t)S * 256;
        rmsnorm_k<<<S / 4, 256, 0, st>>>(projb + 1536, PW, (const float*)d_in[3], cqn, 256, 256, S);
        rmsnorm_k<<<S / 4, 256, 0, st>>>(projb + 1792, PW, (const float*)d_in[4], ckvn, 256, 256, S);
        gemm_k<<<dim3(768 / 64, S / 64), 256, 0, st>>>(cqn, 256, (const float*)d_in[5], 768, qn, 768, nullptr, 0, S, 768, 256);
        for (int h = 0; h < 8; ++h) rope_k<<<(S * 16 + 255) / 256, 256, 0, st>>>(qn, 768, h * 96 + 64, 1, 32, S);
        gemm_k<<<dim3(512 / 64, S / 64), 256, 0, st>>>(ckvn, 256, (const float*)d_in[6], 512, knn, 512, nullptr, 0, S, 512, 256);
        gemm_k<<<dim3(512 / 64, S / 64), 256, 0, st>>>(ckvn, 256, (const float*)d_in[7], 512, vn, 512, nullptr, 0, S, 512, 256); }
    dbg::cmp_k<bf16_t><<<1024, 256, 0, st>>>((const bf16_t*)(ws + WS_QB), 768, qn, 768, S, 768, 1.f / QSCALE_B, 3, err, 6);
    dbg::cmp_k<bf16_t><<<1024, 256, 0, st>>>((const bf16_t*)(ws + WS_KN), 512, knn, 512, S, 512, 1.f, 0, err, 7);
    dbg::cmp_k<bf16_t><<<1024, 256, 0, st>>>((const bf16_t*)(ws + WS_VB), 512, vn, 512, S, 512, 1.f, 0, err, 8);
    launch_phases(a, 3, 4, grid, stream); launch_phases(a, 4, 5, grid, stream);
    dilated_k<<<8 * S / 4, 256, 0, st>>>(projb, mixb);
    mla_k<<<1 * 8 * (S / 64), 64, 0, st>>>(qn, knn, krn, vn, mixb);
    dbg::cmp_k<bf16_t><<<1024, 256, 0, st>>>((const bf16_t*)(ws + WS_MIX), 1024, mixb, 1024, S, 512, 1.f, 0, err, 9);
    dbg::cmp_k<bf16_t><<<1024, 256, 0, st>>>((const bf16_t*)(ws + WS_MIX) + 512, 1024, mixb + 512, 1024, S, 512, 1.f, 0, err, 10);
    launch_phases(a, 5, 6, grid, stream);
    float* x2b = hb;
    gemm_k<<<dim3(D / 64, S / 64), 256, 0, st>>>(mixb, 1024, (const float*)d_in[8], D, x2b, D, x, D, S, D, 1024);
    dbg::cmp_k<float><<<1024, 256, 0, st>>>((const float*)(ws + WS_X2), 1024, x2b, 1024, S, 1024, 1.f, 0, err, 11);
    launch_phases(a, 6, 7, grid, stream);
    float* h2c = qn; float* qpc = projb;
    rmsnorm_k<<<4096 / 4, 256, 0, st>>>(x2b, D, (const float*)d_in[9], h2c, D, D, 4096);
    gemm_k<<<dim3(2048 / 64, 4096 / 64), 256, 0, st>>>(h2c, D, (const float*)d_in[10], 2048, qpc, 2048, nullptr, 0, 4096, 2048, D);
    dbg::cmp_k<bf16_t><<<1024, 256, 0, st>>>((const bf16_t*)d_out, 2048, qpc, 2048, S, 2048, 1.f, 0, err, 12);
    launch_phases(a, 7, 8, grid, stream); launch_phases(a, 8, 9, grid, stream); launch_phases(a, 9, 10, grid, stream); launch_phases(a, 10, 11, grid, stream);
    peer_k<<<4096 / 4, 256, 0, st>>>(h2c, qpc, (const float*)d_in[11], (const float*)d_in[12], (const float*)d_in[13], (const float*)d_in[14], x2b, 4096);
    dbg::cmp_k<float><<<1024, 256, 0, st>>>((const float*)d_out, 1024, x2b, 1024, S, 1024, 1.f, 0, err, 13);
    nv::run(d_in, (float*)d_out, (float*)d_ws, stream);
    dbg::encode_k<<<M * 1024 / 4 / 256, 256, 0, st>>>((float*)d_out, err, 14, DEBUG_SEL, 0.05f);
#endif
}
```

```cpp
#include <hip/hip_runtime.h>
#include <hip/hip_cooperative_groups.h>
#include <cstdio>
#include <cstdint>
#include <cmath>
namespace cg = cooperative_groups;
#define DEBUG_CMP 0
#define ONE_LAUNCH 1
#define DEBUG_SEL -1
#define TIME_PHASE -1
#define PROBE_GATHER 0
#define PROBE_ATTN 0
#define LAS __attribute__((address_space(3)))
#define GAS __attribute__((address_space(1)))
typedef unsigned short bf16_t;
typedef short bf16x8 __attribute__((ext_vector_type(8)));
typedef short s16x4 __attribute__((ext_vector_type(4)));
typedef float f32x4 __attribute__((ext_vector_type(4)));
typedef float f32x16 __attribute__((ext_vector_type(16)));
typedef float f32x2_t __attribute__((ext_vector_type(2)));
typedef __bf16 bf16x2_t __attribute__((ext_vector_type(2)));
typedef unsigned u32x4 __attribute__((ext_vector_type(4)));
typedef unsigned u32x2 __attribute__((ext_vector_type(2)));

constexpr int NB = 8, S = 4096, M = NB * S, D = 1024;
constexpr float NORM_EPS = 1e-6f;
constexpr float LOG2E = 1.4426950408889634f;
constexpr float QSCALE_A = 0.125f * LOG2E;
constexpr float QSCALE_B = 0.10206207261596577f * LOG2E;

__device__ __forceinline__ unsigned cvtpk(float lo, float hi) { f32x2_t v = {lo, hi}; bf16x2_t b = __builtin_convertvector(v, bf16x2_t); return __builtin_bit_cast(unsigned, b); }
__device__ __forceinline__ float bf_lo(unsigned w) { return __builtin_bit_cast(float, w << 16); }
__device__ __forceinline__ float bf_hi(unsigned w) { return __builtin_bit_cast(float, w & 0xffff0000u); }

#define ASM_GLDS16(gptr, ldsaddr) asm volatile("s_mov_b32 m0, %0\n\ts_nop 0\n\tglobal_load_lds_dwordx4 %1, off" :: "s"(ldsaddr), "v"(gptr) : "m0")

namespace pg8 {
constexpr int BM = 256, BK = 64, HALF = 128, HTB = HALF * BK * 2, STAGE_BYTES = 8 * HTB, NXCD = 8, WGM = 8;
__host__ __device__ __forceinline__ int lds_byte(int r, int c) { const int st = (r >> 4) * 2 + (c >> 5), rr = r & 15, cc = c & 31, ob = rr * 64 + cc * 2; return st * 1024 + (ob ^ (((ob >> 9) & 1) << 5)); }
__host__ __device__ __forceinline__ void stage_rc(int b, int& R, int& C) { const int st = b / 1024, sb = b % 1024, swz = sb ^ (((sb >> 9) & 1) << 5); R = (st >> 1) * 16 + swz / 64; C = (st & 1) * 32 + (swz % 64) / 2; }
__host__ __device__ __forceinline__ int perm32(int rho) { const int n = rho >> 4, i = rho & 15; return 8 * (i >> 2) + 4 * n + (i & 3); }
struct Unit { int pm, pn; };
struct StaticOrder {
    int nM, nN, nwg, G, c;
    __device__ void init(int Mr, int N, int G_, int c_) { nM = Mr / BM; nN = N / BM; nwg = nM * nN; G = G_; c = c_; }
    __device__ bool next(int i, Unit& u) const {
        const long L = (long)i * G + c; if (L >= nwg) return false;
        int wgid = (int)L; { const int q = nwg / NXCD, r = nwg % NXCD, xcd = wgid % NXCD, off = wgid / NXCD; wgid = (xcd < r ? xcd * (q + 1) : r * (q + 1) + (xcd - r) * q) + off; }
        const int nig = WGM * nN, gid = wgid / nig, fm = gid * WGM, gsz = (nM - fm) < WGM ? (nM - fm) : WGM;
        u.pm = fm + ((wgid % nig) % gsz); u.pn = (wgid % nig) / gsz; return true;
    }
};
template <class Epi, class Sched, class G>
__device__ __forceinline__ void gemm_phase(LAS unsigned char* lds, const G g, const Sched& Sch, const Epi& E) {
    const int tid = threadIdx.x, wid = __builtin_amdgcn_readfirstlane(tid >> 6), lane = tid & 63, wr = wid >> 2, wc = wid & 3, fr = lane & 15, fq = lane >> 4;
    const int K = g.K, nt = K / BK;
    unsigned voffA[2], voffB[2];
#pragma unroll
    for (int i = 0; i < 2; ++i) { int R, C; stage_rc(tid * 16 + i * 8192, R, C); const int Rb = Epi::PERM ? ((R & ~31) + perm32(R & 31)) : R;
        voffA[i] = (unsigned)(R * g.lda + C) * 2u; voffB[i] = (unsigned)(Rb * g.ldb + C) * 2u; }
    const size_t kstep = (size_t)(BK * 2);
    const size_t hstepA = (size_t)HALF * g.lda * 2, hstepB = (size_t)HALF * g.ldb * 2;
    const unsigned ldsw = (unsigned)wid * 1024u;
    const int aoff = lds_byte(wr * 64 + fr, fq * 8), boff = lds_byte(wc * 32 + fr, fq * 8);
#define PG8_SA(b, h) (((b) * 2 + (h)) * HTB)
#define PG8_SB(b, h) ((4 + (b) * 2 + (h)) * HTB)
#define PG8_STAGE(bufoff, gbase, voff) do { _Pragma("unroll") for (int _i = 0; _i < 2; ++_i) \
        __builtin_amdgcn_global_load_lds((const unsigned*)((const char*)(gbase) + (voff)[_i]), (LAS unsigned*)(lds + (bufoff) + ldsw + _i * 8192), 16, 0, 0); } while (0)
#define PG8_LDA(dst, b, h) do { _Pragma("unroll") for (int m = 0; m < 4; ++m) _Pragma("unroll") for (int k = 0; k < 2; ++k) dst[m][k] = *(const LAS bf16x8*)(lds + PG8_SA(b, h) + aoff + m * 2048 + k * 1024); } while (0)
#define PG8_LDB(dst, b, h) do { _Pragma("unroll") for (int n = 0; n < 2; ++n) _Pragma("unroll") for (int k = 0; k < 2; ++k) dst[n][k] = *(const LAS bf16x8*)(lds + PG8_SB(b, h) + boff + n * 2048 + k * 1024); } while (0)
#define PG8_MMA(ai, bj, At, Bt) do { __builtin_amdgcn_s_setprio(1); _Pragma("unroll") for (int m = 0; m < 4; ++m) _Pragma("unroll") for (int n = 0; n < 2; ++n) _Pragma("unroll") for (int k = 0; k < 2; ++k) \
        acc[ai][bj][m][n] = __builtin_amdgcn_mfma_f32_16x16x32_bf16(Bt[n][k], At[m][k], acc[ai][bj][m][n], 0, 0, 0); __builtin_amdgcn_s_setprio(0); } while (0)
#define PG8_WAIT_V(n) asm volatile("s_waitcnt vmcnt(" #n ")" ::: "memory")
#define PG8_WAIT_L(n) asm volatile("s_waitcnt lgkmcnt(" #n ")" ::: "memory")
#define PG8_BAR __builtin_amdgcn_s_barrier()
#define PG8_SCHED __builtin_amdgcn_sched_barrier(0)
    Unit cur, nxt; int ui = 0;
    if (!Sch.next(0, cur)) return;
    f32x4 acc[2][2][4][2];
#pragma unroll
    for (int a = 0; a < 2; ++a)
#pragma unroll
        for (int b = 0; b < 2; ++b)
#pragma unroll
            for (int m = 0; m < 4; ++m)
#pragma unroll
                for (int n = 0; n < 2; ++n) acc[a][b][m][n] = (f32x4){0.f, 0.f, 0.f, 0.f};
    bf16x8 At[4][2], B0[2][2], B1[2][2];
    const char* cA = g.a_base(cur); const char* cB = g.b_base(cur);
    PG8_STAGE(PG8_SB(0, 0), cB, voffB); PG8_STAGE(PG8_SB(0, 1), cB + hstepB, voffB); PG8_STAGE(PG8_SA(0, 0), cA, voffA); PG8_STAGE(PG8_SA(0, 1), cA + hstepA, voffA);
    if (wr == 1) PG8_BAR;
    PG8_WAIT_V(2); PG8_BAR;
    PG8_STAGE(PG8_SB(1, 0), cB + kstep, voffB); PG8_STAGE(PG8_SA(1, 0), cA + kstep, voffA); PG8_STAGE(PG8_SB(1, 1), cB + hstepB + kstep, voffB);
    PG8_WAIT_V(6); PG8_BAR;
    for (;;) {
        const bool has_next = Sch.next(ui + 1, nxt);
        const char* nA = has_next ? g.a_base(nxt) : cA; const char* nB = has_next ? g.b_base(nxt) : cB;
        for (int t = 0; t < nt; t += 2) {
            const bool last = (t == nt - 2);
            const char* a1 = cA + (size_t)(t + 1) * kstep;
            const char* a2 = last ? nA : cA + (size_t)(t + 2) * kstep; const char* b2 = last ? nB : cB + (size_t)(t + 2) * kstep;
            const char* a3 = a2 + kstep; const char* b3 = b2 + kstep;
            PG8_LDB(B0, 0, 0); PG8_LDB(B1, 0, 1); PG8_SCHED; PG8_LDA(At, 0, 0); PG8_STAGE(PG8_SA(1, 1), a1 + hstepA, voffA);
            PG8_WAIT_V(8); PG8_WAIT_L(0); PG8_BAR; PG8_MMA(0, 0, At, B0); PG8_MMA(0, 1, At, B1); PG8_BAR; PG8_SCHED;
            PG8_LDA(At, 0, 1); PG8_STAGE(PG8_SB(0, 0), b2, voffB); PG8_STAGE(PG8_SB(0, 1), b2 + hstepB, voffB); PG8_STAGE(PG8_SA(0, 0), a2, voffA);
            PG8_WAIT_V(8); PG8_WAIT_L(0); PG8_BAR; PG8_MMA(1, 0, At, B0); PG8_MMA(1, 1, At, B1); PG8_BAR; PG8_SCHED;
            PG8_LDB(B0, 1, 0); PG8_LDB(B1, 1, 1); PG8_SCHED; PG8_LDA(At, 1, 0); PG8_STAGE(PG8_SA(0, 1), a2 + hstepA, voffA);
            PG8_WAIT_V(8); PG8_WAIT_L(0); PG8_BAR; PG8_MMA(0, 0, At, B0); PG8_MMA(0, 1, At, B1); PG8_BAR; PG8_SCHED;
            PG8_LDA(At, 1, 1); PG8_STAGE(PG8_SB(1, 0), b3, voffB); PG8_STAGE(PG8_SB(1, 1), b3 + hstepB, voffB); PG8_STAGE(PG8_SA(1, 0), a3, voffA);
            PG8_WAIT_V(8); PG8_WAIT_L(0); PG8_BAR; PG8_MMA(1, 0, At, B0); PG8_MMA(1, 1, At, B1); PG8_BAR; PG8_SCHED;
        }
        if (wr == 0) PG8_BAR;
        E(acc, cur, wr, wc, fr, fq);
        if (!has_next) break;
#pragma unroll
        for (int a = 0; a < 2; ++a)
#pragma unroll
            for (int b = 0; b < 2; ++b)
#pragma unroll
                for (int m = 0; m < 4; ++m)
#pragma unroll
                    for (int n = 0; n < 2; ++n) acc[a][b][m][n] = (f32x4){0.f, 0.f, 0.f, 0.f};
        cur = nxt; cA = nA; cB = nB; ++ui;
        if (wr == 1) PG8_BAR;
    }
    PG8_WAIT_V(0);
    PG8_BAR;
#undef PG8_SA
#undef PG8_SB
#undef PG8_STAGE
#undef PG8_LDA
#undef PG8_LDB
#undef PG8_MMA
#undef PG8_WAIT_V
#undef PG8_WAIT_L
#undef PG8_BAR
#undef PG8_SCHED
}
}
constexpr size_t MiB = 1u << 20;
constexpr size_t WS_CTL = 0;
constexpr size_t WS_WIN = 2 * MiB;
constexpr size_t WS_WKR = 6 * MiB;
constexpr size_t WS_WUQ = 7 * MiB;
constexpr size_t WS_WUKV = 8 * MiB;
constexpr size_t WS_WO = 9 * MiB;
constexpr size_t WS_WQ = 11 * MiB;
constexpr size_t WS_KEYS = 15 * MiB;
constexpr size_t WS_ROPE = 16 * MiB;
constexpr size_t WS_U = 18 * MiB;
constexpr size_t WS_V = 50 * MiB;
constexpr size_t WS_SSQ1 = 82 * MiB;
constexpr size_t WS_SSQ2 = 84 * MiB;
constexpr size_t WS_XN = 96 * MiB;
constexpr size_t WS_MIX = WS_XN;
constexpr size_t WS_QA = 160 * MiB, WS_KA = 192 * MiB, WS_VA = 224 * MiB;
constexpr size_t WS_X2B = 160 * MiB;
constexpr size_t WS_CQ = 256 * MiB, WS_CKV = 272 * MiB;
constexpr size_t WS_KR = 288 * MiB;
constexpr size_t WS_QB = 292 * MiB;
constexpr size_t WS_KN = 340 * MiB, WS_VB = 372 * MiB;
constexpr size_t WS_X2 = 292 * MiB;
constexpr size_t WS_END_OPT = 420 * MiB;
constexpr size_t DO_OP = 0, DO_LSE = 96 * MiB;

struct Args { const float* in[15]; float* out; unsigned char* ws; int ph_lo, ph_hi; };

struct Frame {
    LAS unsigned char* lds;
    int tid, lane, wave, vcu, G;
    const float* in[15]; float* out; unsigned char* ws;
};

__device__ __forceinline__ float wave_sum(float v) {
#pragma unroll
    for (int o = 1; o < 64; o <<= 1) v += __shfl_xor(v, o);
    return v;
}

__device__ __forceinline__ int perm_win(int np) {
    if (np < 1024) { const int hb = np & ~63, p = np & 63; return hb + (p >> 1) + ((p & 1) << 5); }
    return np;
}
__device__ __forceinline__ int perm_wkr(int np) { return 2048 + (np >> 1) + ((np & 1) << 4); }
__device__ __forceinline__ int perm_wuq(int np) { const int h = np / 96, p = np % 96; if (p < 64) return np; const int q = p - 64; return h * 96 + 64 + (q >> 1) + ((q & 1) << 4); }

template <int PERM>
__device__ __forceinline__ void transpose_item(const float* __restrict__ W, int K, int N, const float* __restrict__ gk, bf16_t* __restrict__ WT, int row_off, LAS float* scr, int item, int nblk, int lane) {
    const int kb = item / nblk, nb = item % nblk, k0 = 64 * kb, n0 = 32 * nb;
    const int npx = n0 + (lane & 31);
    const int nl = PERM == 1 ? perm_win(npx) : PERM == 2 ? perm_wkr(npx) : PERM == 3 ? perm_wuq(npx) : npx;
#pragma unroll 8
    for (int i = 0; i < 32; ++i) { const int kk = 2 * i + (lane >> 5); float v = W[(size_t)(k0 + kk) * N + nl]; if (gk) v *= gk[k0 + kk]; scr[kk * 33 + (lane & 31)] = v; }
    asm volatile("s_waitcnt lgkmcnt(0)" ::: "memory");
    const int c = lane & 7;
#pragma unroll
    for (int j = 0; j < 4; ++j) { const int n = (lane >> 3) + 8 * j; const LAS float* s = scr + (8 * c) * 33 + n;
        u32x4 o; o.x = cvtpk(s[0 * 33], s[1 * 33]); o.y = cvtpk(s[2 * 33], s[3 * 33]); o.z = cvtpk(s[4 * 33], s[5 * 33]); o.w = cvtpk(s[6 * 33], s[7 * 33]);
        *(u32x4*)(WT + (size_t)(row_off + n0 + n) * K + k0 + 8 * c) = o; }
    asm volatile("s_waitcnt lgkmcnt(0)" ::: "memory");
}

__device__ __forceinline__ void p0_prologue(Frame& F) {
    LAS float* scr = (LAS float*)(F.lds + F.wave * 16384);
    const int gw = F.vcu * 8 + F.wave, NGW = F.G * 8, lane = F.lane;
    unsigned char* ws = F.ws;
    constexpr int I_WIN = (1024 / 64) * (2048 / 32), I_WKR = (1024 / 64) * 1, I_WUQ = (256 / 64) * (768 / 32), I_WUK = (256 / 64) * (512 / 32), I_WO = (1024 / 64) * (1024 / 32), I_WQ = (1024 / 64) * (2048 / 32);
    constexpr int NIT = I_WIN + I_WKR + I_WUQ + 2 * I_WUK + I_WO + I_WQ;
    for (int it = gw; it < NIT; it += NGW) {
        int r = it;
        if (r < I_WIN) { transpose_item<1>(F.in[2], 1024, 2080, nullptr, (bf16_t*)(ws + WS_WIN), 0, scr, r, 2048 / 32, lane); continue; } r -= I_WIN;
        if (r < I_WKR) { transpose_item<2>(F.in[2], 1024, 2080, nullptr, (bf16_t*)(ws + WS_WKR), 0, scr, r, 1, lane); continue; } r -= I_WKR;
        if (r < I_WUQ) { transpose_item<3>(F.in[5], 256, 768, F.in[3], (bf16_t*)(ws + WS_WUQ), 0, scr, r, 768 / 32, lane); continue; } r -= I_WUQ;
        if (r < I_WUK) { transpose_item<0>(F.in[6], 256, 512, F.in[4], (bf16_t*)(ws + WS_WUKV), 0, scr, r, 512 / 32, lane); continue; } r -= I_WUK;
        if (r < I_WUK) { transpose_item<0>(F.in[7], 256, 512, F.in[4], (bf16_t*)(ws + WS_WUKV), 512, scr, r, 512 / 32, lane); continue; } r -= I_WUK;
        if (r < I_WO) { transpose_item<0>(F.in[8], 1024, 1024, nullptr, (bf16_t*)(ws + WS_WO), 0, scr, r, 1024 / 32, lane); continue; } r -= I_WO;
        transpose_item<0>(F.in[10], 1024, 2048, F.in[9], (bf16_t*)(ws + WS_WQ), 0, scr, r, 2048 / 32, lane);
    }
    {
        const float* g = F.in[1];
        f32x4 gg[4];
#pragma unroll
        for (int j = 0; j < 4; ++j) gg[j] = *(const f32x4*)(g + 256 * j + 4 * lane);
        auto ldrow = [&](int r, f32x4 (&v)[4]) { const float* sp = F.in[0] + (size_t)(r < M ? r : gw) * 1024;
#pragma unroll
            for (int j = 0; j < 4; ++j) v[j] = *(const f32x4*)(sp + 256 * j + 4 * lane); };
        f32x4 va[4], vb[4], na[4], nb[4];
        ldrow(gw, va); ldrow(gw + NGW, vb);
        for (int r0 = gw; r0 < M; r0 += 2 * NGW) {
            const int r1 = r0 + NGW; const bool two = r1 < M;
            ldrow(r0 + 2 * NGW, na); ldrow(r1 + 2 * NGW, nb);
            float ssa = 0.f, ssb = 0.f;
#pragma unroll
            for (int j = 0; j < 4; ++j) { ssa += (va[j].x * va[j].x + va[j].y * va[j].y) + (va[j].z * va[j].z + va[j].w * va[j].w); ssb += (vb[j].x * vb[j].x + vb[j].y * vb[j].y) + (vb[j].z * vb[j].z + vb[j].w * vb[j].w); }
            const float rsa = rsqrtf(wave_sum(ssa) * (1.f / 1024.f) + NORM_EPS), rsb = rsqrtf(wave_sum(ssb) * (1.f / 1024.f) + NORM_EPS);
            bf16_t* da = (bf16_t*)(ws + WS_XN) + (size_t)r0 * 1024; bf16_t* db = (bf16_t*)(ws + WS_XN) + (size_t)r1 * 1024;
#pragma unroll
            for (int j = 0; j < 4; ++j) {
                u32x2 o; o.x = cvtpk(va[j].x * rsa * gg[j].x, va[j].y * rsa * gg[j].y); o.y = cvtpk(va[j].z * rsa * gg[j].z, va[j].w * rsa * gg[j].w);
                *(u32x2*)(da + 256 * j + 4 * lane) = o;
                if (two) { u32x2 p; p.x = cvtpk(vb[j].x * rsb * gg[j].x, vb[j].y * rsb * gg[j].y); p.y = cvtpk(vb[j].z * rsb * gg[j].z, vb[j].w * rsb * gg[j].w); *(u32x2*)(db + 256 * j + 4 * lane) = p; } }
#pragma unroll
            for (int j = 0; j < 4; ++j) { va[j] = na[j]; vb[j] = nb[j]; }
        }
    }
    {
        const int gt = F.vcu * 512 + F.tid, NT = F.G * 512;
        for (int i = gt; i < 262144 / 8; i += NT) { const f32x4 a = *(const f32x4*)(F.in[11] + (size_t)i * 8), b = *(const f32x4*)(F.in[11] + (size_t)i * 8 + 4);
            u32x4 o; o.x = cvtpk(a.x, a.y); o.y = cvtpk(a.z, a.w); o.z = cvtpk(b.x, b.y); o.w = cvtpk(b.z, b.w); *(u32x4*)((bf16_t*)(ws + WS_KEYS) + (size_t)i * 8) = o; }
        float* CA = (float*)(ws + WS_ROPE); float* SA = CA + 4096 * 32; float* CB = SA + 4096 * 32; float* SB = CB + 4096 * 16;
        for (int i = gt; i < 4096 * 32; i += NT) { const int pos = i >> 5, k = i & 31; const float inv = 1.0f / powf(10000.0f, (float)(2 * k) / 64.0f); const float ang = (float)pos * inv; CA[i] = cosf(ang); SA[i] = sinf(ang); }
        for (int i = gt; i < 4096 * 16; i += NT) { const int pos = i >> 4, k = i & 15; const float inv = 1.0f / powf(10000.0f, (float)(2 * k) / 32.0f); const float ang = (float)pos * inv; CB[i] = cosf(ang); SB[i] = sinf(ang); }
    }
}

struct GemmPlain {
    const bf16_t* A; const bf16_t* Bt; int K, lda, ldb;
    __device__ __forceinline__ const char* a_base(const pg8::Unit& u) const { return (const char*)(A + (size_t)u.pm * 256 * lda); }
    __device__ __forceinline__ const char* b_base(const pg8::Unit& u) const { return (const char*)(Bt + (size_t)u.pn * 256 * ldb); }
};
struct GemmUp {
    const bf16_t* CQ; const bf16_t* CKV; const bf16_t* WUQ; const bf16_t* WUKV; int K, lda, ldb;
    __device__ __forceinline__ const char* a_base(const pg8::Unit& u) const { return (const char*)((u.pn < 3 ? CQ : CKV) + (size_t)u.pm * 256 * 256); }
    __device__ __forceinline__ const char* b_base(const pg8::Unit& u) const { return (const char*)(u.pn < 3 ? WUQ + (size_t)u.pn * 256 * 256 : WUKV + (size_t)(u.pn - 3) * 256 * 256); }
};

__device__ __forceinline__ void rope4(f32x4& v0, f32x4& v1, const f32x4 cs, const f32x4 sn) {
    const f32x4 a = v0, b = v1;
    v0.x = a.x * cs.x - a.y * sn.x; v0.y = a.y * cs.x + a.x * sn.x; v0.z = a.z * cs.y - a.w * sn.y; v0.w = a.w * cs.y + a.z * sn.y;
    v1.x = b.x * cs.z - b.y * sn.z; v1.y = b.y * cs.z + b.x * sn.z; v1.z = b.z * cs.w - b.w * sn.w; v1.w = b.w * cs.w + b.z * sn.w;
}
__device__ __forceinline__ void store8(bf16_t* p, const f32x4 v0, const f32x4 v1) { u32x4 w; w.x = cvtpk(v0.x, v0.y); w.y = cvtpk(v0.z, v0.w); w.z = cvtpk(v1.x, v1.y); w.w = cvtpk(v1.z, v1.w); *(u32x4*)p = w; }
__device__ __forceinline__ float dot4(const f32x4 v) { return (v.x * v.x + v.y * v.y) + (v.z * v.z + v.w * v.w); }

struct EpiP1 {
    static constexpr bool PERM = true;
    bf16_t *QA, *KA, *VA, *CQ, *CKV; float* SSQ1; const float *CA, *SA;
    __device__ __forceinline__ void operator()(const f32x4 (&acc)[2][2][4][2], const pg8::Unit& u, int wr, int wc, int fr, int fq) const {
        const int pn = u.pn, row0 = u.pm * 256 + wr * 64 + fr, cw = wc * 32 + 8 * fq;
        if (pn < 4) {
            bf16_t* base = pn < 2 ? QA : KA; const float sc = pn < 2 ? QSCALE_A : 1.f; const int colt = (pn & 1) * 256 + cw;
#pragma unroll
            for (int ai = 0; ai < 2; ++ai)
#pragma unroll
                for (int m = 0; m < 4; ++m) { const int row = row0 + ai * 128 + m * 16, pos = row & (S - 1);
#pragma unroll
                    for (int bj = 0; bj < 2; ++bj) { const int col = colt + bj * 128, i0 = (col & 63) >> 1;
                        const f32x4 cs = *(const f32x4*)(CA + pos * 32 + i0), sn = *(const f32x4*)(SA + pos * 32 + i0);
                        f32x4 v0 = acc[ai][bj][m][0] * sc, v1 = acc[ai][bj][m][1] * sc; rope4(v0, v1, cs, sn);
                        store8(base + (size_t)row * 512 + col, v0, v1); } }
        } else if (pn < 6) {
            const int colt = (pn & 1) * 256 + cw;
#pragma unroll
            for (int ai = 0; ai < 2; ++ai)
#pragma unroll
                for (int m = 0; m < 4; ++m) { const int row = row0 + ai * 128 + m * 16;
#pragma unroll
                    for (int bj = 0; bj < 2; ++bj) store8(VA + (size_t)row * 512 + colt + bj * 128, acc[ai][bj][m][0], acc[ai][bj][m][1]); }
        } else {
            bf16_t* base = pn == 6 ? CQ : CKV;
#pragma unroll
            for (int ai = 0; ai < 2; ++ai)
#pragma unroll
                for (int m = 0; m < 4; ++m) { const int row = row0 + ai * 128 + m * 16; float s = 0.f;
#pragma unroll
                    for (int bj = 0; bj < 2; ++bj) { store8(base + (size_t)row * 256 + cw + bj * 128, acc[ai][bj][m][0], acc[ai][bj][m][1]); s += dot4(acc[ai][bj][m][0]) + dot4(acc[ai][bj][m][1]); }
                    s += __shfl_xor(s, 16); s += __shfl_xor(s, 32);
                    if (fq == 0) SSQ1[(size_t)row * 8 + (pn - 6) * 4 + wc] = s; }
        }
    }
};
struct EpiP2 {
    static constexpr bool PERM = true;
    bf16_t *QB, *KN, *VB; const float* SSQ1; const float *CB, *SB;
    __device__ __forceinline__ void operator()(const f32x4 (&acc)[2][2][4][2], const pg8::Unit& u, int wr, int wc, int fr, int fq) const {
        const int pn = u.pn, row0 = u.pm * 256 + wr * 64 + fr, cw = wc * 32 + 8 * fq, grp = pn < 3 ? 0 : 1;
#pragma unroll
        for (int ai = 0; ai < 2; ++ai)
#pragma unroll
            for (int m = 0; m < 4; ++m) { const int row = row0 + ai * 128 + m * 16, pos = row & (S - 1);
                const f32x4 sq = *(const f32x4*)(SSQ1 + (size_t)row * 8 + grp * 4);
                const float rs = rsqrtf(((sq.x + sq.y) + (sq.z + sq.w)) * (1.f / 256.f) + NORM_EPS);
                if (pn < 3) {
#pragma unroll
                    for (int bj = 0; bj < 2; ++bj) { const int col = pn * 256 + bj * 128 + cw, p = col % 96; const float sc = rs * QSCALE_B;
                        f32x4 v0 = acc[ai][bj][m][0] * sc, v1 = acc[ai][bj][m][1] * sc;
                        if (p >= 64) { const int i0 = (p - 64) >> 1; const f32x4 cs = *(const f32x4*)(CB + pos * 16 + i0), sn = *(const f32x4*)(SB + pos * 16 + i0); rope4(v0, v1, cs, sn); }
                        store8(QB + (size_t)row * 768 + col, v0, v1); }
                } else {
                    bf16_t* base = pn < 5 ? KN : VB; const int colt = ((pn - 3) & 1) * 256 + cw;
#pragma unroll
                    for (int bj = 0; bj < 2; ++bj) store8(base + (size_t)row * 512 + colt + bj * 128, acc[ai][bj][m][0] * rs, acc[ai][bj][m][1] * rs);
                }
            }
    }
};
struct EpiP4 {
    static constexpr bool PERM = true;
    const float* X; bf16_t* X2B; float* SSQ2;
    __device__ __forceinline__ void operator()(const f32x4 (&acc)[2][2][4][2], const pg8::Unit& u, int wr, int wc, int fr, int fq) const {
        const int row0 = u.pm * 256 + wr * 64 + fr, colt = u.pn * 256 + wc * 32 + 8 * fq;
#pragma unroll
        for (int ai = 0; ai < 2; ++ai)
#pragma unroll
            for (int m = 0; m < 4; ++m) { const int row = row0 + ai * 128 + m * 16; float s = 0.f;
#pragma unroll
                for (int bj = 0; bj < 2; ++bj) { const size_t off = (size_t)row * 1024 + colt + bj * 128;
                    const f32x4 v0 = acc[ai][bj][m][0] + *(const f32x4*)(X + off), v1 = acc[ai][bj][m][1] + *(const f32x4*)(X + off + 4);
                    store8(X2B + off, v0, v1); s += dot4(v0) + dot4(v1); }
                s += __shfl_xor(s, 16); s += __shfl_xor(s, 32);
                if (fq == 0) SSQ2[(size_t)row * 16 + u.pn * 4 + wc] = s; }
    }
};
struct EpiP5 {
    static constexpr bool PERM = true;
    bf16_t* QP; const float* SSQ2;
    __device__ __forceinline__ void operator()(const f32x4 (&acc)[2][2][4][2], const pg8::Unit& u, int wr, int wc, int fr, int fq) const {
        const int row0 = u.pm * 256 + wr * 64 + fr, colt = u.pn * 256 + wc * 32 + 8 * fq;
#pragma unroll
        for (int ai = 0; ai < 2; ++ai)
#pragma unroll
            for (int m = 0; m < 4; ++m) { const int row = row0 + ai * 128 + m * 16;
                const f32x4* sp = (const f32x4*)(SSQ2 + (size_t)row * 16); const f32x4 a = sp[0], b = sp[1], c = sp[2], d = sp[3];
                const float ss = ((a.x + a.y) + (a.z + a.w)) + ((b.x + b.y) + (b.z + b.w)) + ((c.x + c.y) + (c.z + c.w)) + ((d.x + d.y) + (d.z + d.w));
                const float rs = rsqrtf(ss * (1.f / 1024.f) + NORM_EPS);
#pragma unroll
                for (int bj = 0; bj < 2; ++bj) store8(QP + (size_t)row * 2048 + colt + bj * 128, acc[ai][bj][m][0] * rs, acc[ai][bj][m][1] * rs); }
    }
};

__device__ __forceinline__ void p1_krope(Frame& F) {
    const bf16_t* XN = (const bf16_t*)(F.ws + WS_XN); const bf16_t* WK = (const bf16_t*)(F.ws + WS_WKR); bf16_t* KR = (bf16_t*)(F.ws + WS_KR);
    const float* CB = (const float*)(F.ws + WS_ROPE) + 2 * 4096 * 32; const float* SB = CB + 4096 * 16;
    const int lane = F.lane, fr = lane & 15, fq = lane >> 4;
    for (int blk = F.vcu; blk < M / 128; blk += F.G) {
        const int row0 = blk * 128 + F.wave * 16;
        f32x4 c0 = {0.f, 0.f, 0.f, 0.f}, c1 = {0.f, 0.f, 0.f, 0.f};
        const bf16_t* ap = XN + (size_t)(row0 + fr) * 1024 + 8 * fq;
        const bf16_t* b0p = WK + (size_t)fr * 1024 + 8 * fq; const bf16_t* b1p = WK + (size_t)(16 + fr) * 1024 + 8 * fq;
#pragma unroll 4
        for (int ks = 0; ks < 32; ++ks) {
            const bf16x8 a = *(const bf16x8*)(ap + ks * 32), b0 = *(const bf16x8*)(b0p + ks * 32), b1 = *(const bf16x8*)(b1p + ks * 32);
            c0 = __builtin_amdgcn_mfma_f32_16x16x32_bf16(b0, a, c0, 0, 0, 0);
            c1 = __builtin_amdgcn_mfma_f32_16x16x32_bf16(b1, a, c1, 0, 0, 0);
        }
        const int row = row0 + fr, pos = row & (S - 1);
        u32x2 w0, w1;
        { const int i = 2 * fq; const float ca = CB[pos * 16 + i], sa = SB[pos * 16 + i], cb = CB[pos * 16 + i + 1], sb = SB[pos * 16 + i + 1];
          w0.x = cvtpk(c0.x * ca - c0.y * sa, c0.y * ca + c0.x * sa); w0.y = cvtpk(c0.z * cb - c0.w * sb, c0.w * cb + c0.z * sb); }
        { const int i = 8 + 2 * fq; const float ca = CB[pos * 16 + i], sa = SB[pos * 16 + i], cb = CB[pos * 16 + i + 1], sb = SB[pos * 16 + i + 1];
          w1.x = cvtpk(c1.x * ca - c1.y * sa, c1.y * ca + c1.x * sa); w1.y = cvtpk(c1.z * cb - c1.w * sb, c1.w * cb + c1.z * sb); }
        *(u32x2*)(KR + (size_t)row * 32 + 4 * fq) = w0; *(u32x2*)(KR + (size_t)row * 32 + 16 + 4 * fq) = w1;
    }
}
constexpr int AT_SLOT = 20480, AT_KB = 0, AT_VB = 12288;
__device__ __forceinline__ int crow(int r, int hi) { return (r & 3) + 8 * (r >> 2) + 4 * hi; }
__device__ __forceinline__ s16x4 vtr(const LAS unsigned char* p) { return __builtin_bit_cast(s16x4, __builtin_amdgcn_ds_read_tr16_b64_v4i16((LAS s16x4*)p)); }

constexpr float RESC_THR = 8.f;
__device__ __forceinline__ float max3f(float a, float b, float c) { float r; asm("v_max3_f32 %0, %1, %2, %3" : "=v"(r) : "v"(a), "v"(b), "v"(c)); return r; }
template <int NKS>
struct AttnCore {
    bf16x8 qr[NKS]; f32x16 o0, o1, negm; float m, l; bool fresh;
    __device__ __forceinline__ void init() { m = 0.f; l = 0.f; fresh = true;
#pragma unroll
        for (int r = 0; r < 16; ++r) { o0[r] = 0.f; o1[r] = 0.f; negm[r] = 0.f; } }
    template <class MaskF>
    __device__ __forceinline__ void tile(const LAS unsigned char* slot, int lane, bool need_mask, const MaskF& valid) {
        const int r32 = lane & 31, hi = lane >> 5;
        f32x16 p0, p1;
        const LAS unsigned char* kn = slot + AT_KB + r32 * 128; const LAS unsigned char* kr = slot + AT_KB + 8192 + r32 * 64;
#pragma unroll
        for (int d0 = 0; d0 < NKS; ++d0) {
            bf16x8 b0, b1;
            if (d0 < 4) { const int po = ((2 * d0 + hi) ^ ((r32 >> 1) & 7)) * 16; b0 = *(const LAS bf16x8*)(kn + po); b1 = *(const LAS bf16x8*)(kn + 4096 + po); }
            else { const int po = ((2 * (d0 - 4) + hi) ^ ((r32 >> 2) & 3)) * 16; b0 = *(const LAS bf16x8*)(kr + po); b1 = *(const LAS bf16x8*)(kr + 2048 + po); }
            if (d0 == 0) { p0 = __builtin_amdgcn_mfma_f32_32x32x16_bf16(b0, qr[0], negm, 0, 0, 0); p1 = __builtin_amdgcn_mfma_f32_32x32x16_bf16(b1, qr[0], negm, 0, 0, 0); }
            else { p0 = __builtin_amdgcn_mfma_f32_32x32x16_bf16(b0, qr[d0], p0, 0, 0, 0); p1 = __builtin_amdgcn_mfma_f32_32x32x16_bf16(b1, qr[d0], p1, 0, 0, 0); }
        }
        if (need_mask) {
#pragma unroll
            for (int r = 0; r < 16; ++r) { const int kk = crow(r, hi); if (!valid(kk)) p0[r] = -INFINITY; if (!valid(kk + 32)) p1[r] = -INFINITY; }
        }
        float ma = max3f(p0[0], p0[1], p1[0]), mb = max3f(p0[2], p0[3], p1[1]);
        ma = max3f(ma, p1[2], p1[3]);
#pragma unroll
        for (int r = 4; r < 16; r += 4) { ma = max3f(ma, p0[r], p0[r + 1]); mb = max3f(mb, p0[r + 2], p0[r + 3]); ma = max3f(ma, p1[r], p1[r + 1]); mb = max3f(mb, p1[r + 2], p1[r + 3]); }
        float dx = fmaxf(ma, mb);
        dx = fmaxf(dx, __shfl_xor(dx, 32));
        if (fresh || __any(dx > RESC_THR)) {
            const float dl = fresh ? fmaxf(dx, -100.f) : fmaxf(dx, 0.f), alpha = __builtin_amdgcn_exp2f(-dl);
            fresh = false;
            m += dl; l *= alpha;
#pragma unroll
            for (int r = 0; r < 16; ++r) { o0[r] *= alpha; o1[r] *= alpha; p0[r] -= dl; p1[r] -= dl; negm[r] = -m; }
        }
        float sa = 0.f, sb = 0.f, sc = 0.f, sd = 0.f;
#pragma unroll
        for (int r = 0; r < 16; r += 2) { p0[r] = __builtin_amdgcn_exp2f(p0[r]); p0[r + 1] = __builtin_amdgcn_exp2f(p0[r + 1]); p1[r] = __builtin_amdgcn_exp2f(p1[r]); p1[r + 1] = __builtin_amdgcn_exp2f(p1[r + 1]);
            sa += p0[r]; sb += p0[r + 1]; sc += p1[r]; sd += p1[r + 1]; }
        l += (sa + sb) + (sc + sd);
        u32x4 pw[4];
        pw[0] = (u32x4){cvtpk(p0[0], p0[1]), cvtpk(p0[2], p0[3]), cvtpk(p0[4], p0[5]), cvtpk(p0[6], p0[7])};
        pw[1] = (u32x4){cvtpk(p0[8], p0[9]), cvtpk(p0[10], p0[11]), cvtpk(p0[12], p0[13]), cvtpk(p0[14], p0[15])};
        pw[2] = (u32x4){cvtpk(p1[0], p1[1]), cvtpk(p1[2], p1[3]), cvtpk(p1[4], p1[5]), cvtpk(p1[6], p1[7])};
        pw[3] = (u32x4){cvtpk(p1[8], p1[9]), cvtpk(p1[10], p1[11]), cvtpk(p1[12], p1[13]), cvtpk(p1[14], p1[15])};
        const int vq = 4 * hi + ((lane & 15) >> 2), vsw = ((vq >> 1) & 1) * 4, vx = 2 * ((lane >> 4) & 1) + ((lane & 3) >> 1);
        const LAS unsigned char* vb0 = slot + AT_VB + vq * 128 + ((vx ^ vsw) * 16) + 8 * (lane & 1);
        const LAS unsigned char* vb1 = slot + AT_VB + vq * 128 + (((4 + vx) ^ vsw) * 16) + 8 * (lane & 1);
#pragma unroll
        for (int s = 0; s < 4; ++s) {
            const s16x4 lo0 = vtr(vb0 + s * 2048), hi0 = vtr(vb0 + s * 2048 + 1024), lo1 = vtr(vb1 + s * 2048), hi1 = vtr(vb1 + s * 2048 + 1024);
            const bf16x8 v0 = {lo0[0], lo0[1], lo0[2], lo0[3], hi0[0], hi0[1], hi0[2], hi0[3]}, v1 = {lo1[0], lo1[1], lo1[2], lo1[3], hi1[0], hi1[1], hi1[2], hi1[3]};
            const bf16x8 pb = __builtin_bit_cast(bf16x8, pw[s]);
            o0 = __builtin_amdgcn_mfma_f32_32x32x16_bf16(v0, pb, o0, 0, 0, 0);
            o1 = __builtin_amdgcn_mfma_f32_32x32x16_bf16(v1, pb, o1, 0, 0, 0);
        }
    }
    __device__ __forceinline__ float ltot() const { return l + __shfl_xor(l, 32); }
};

__device__ __forceinline__ void glds16(const void* gsrc, LAS unsigned char* dst) { __builtin_amdgcn_global_load_lds((const unsigned*)gsrc, (LAS unsigned*)dst, 16, 0, 0); }

struct DilUnit { int b, h, pat, dl, res, u2, m0; size_t rowb; };
__device__ __forceinline__ DilUnit dil_decode(int e) {
    DilUnit u; const int bh = e / 48, rem = e % 48; u.pat = rem >> 4; const int idx = rem & 15; u.b = bh >> 3; u.h = bh & 7;
    u.dl = u.pat * 2; const int nb2 = 16 >> u.dl; u.res = idx / nb2; u.u2 = idx % nb2; u.m0 = u.u2 * 256; u.rowb = (size_t)u.b * S; return u;
}
__device__ __forceinline__ void p3a_dilated(Frame& F) {
    const bf16_t* QA = (const bf16_t*)(F.ws + WS_QA); const bf16_t* KA = (const bf16_t*)(F.ws + WS_KA); const bf16_t* VA = (const bf16_t*)(F.ws + WS_VA);
    bf16_t* OP = (bf16_t*)((unsigned char*)F.out + DO_OP); float* LSE = (float*)((unsigned char*)F.out + DO_LSE);
    const int lane = F.lane, w = F.wave, r32 = lane & 31, hi = lane >> 5, ow = w >> 1;
    constexpr int UPC = 12, NSTEP = 3 * UPC + 3;
    for (int v = F.vcu; v < 3072 / UPC; v += F.G) {
        const int e0 = v * UPC;
        auto issue = [&](int k, int j, int par, int which) {
            const DilUnit u = dil_decode(e0 + k);
            if (u.u2 == 0 && j < 2) return;
            const int mk0 = u.m0 - 128 + 64 * j; LAS unsigned char* slot = F.lds + (par * 2 + which) * AT_SLOT;
            const size_t krow = u.rowb + ((size_t)(mk0 + 8 * w + (lane >> 3)) << u.dl) + u.res;
            glds16(KA + krow * 512 + u.h * 64 + (((lane & 7) ^ ((4 * w + (lane >> 4)) & 7)) * 8), slot + AT_KB + w * 1024);
            glds16(VA + krow * 512 + u.h * 64 + (((lane & 7) ^ (((lane >> 4) & 1) * 4)) * 8), slot + AT_VB + w * 1024);
        };
        auto qptr = [&](int k) { const DilUnit u = dil_decode(e0 + k); const size_t qrow = u.rowb + ((size_t)(u.m0 + 32 * w + r32) << u.dl) + u.res; return QA + qrow * 512 + u.h * 64 + hi * 8; };
        AttnCore<4> A; A.init();
        bf16x8 qn[4];
        { const bf16_t* qp = qptr(0);
#pragma unroll
          for (int d0 = 0; d0 < 4; ++d0) qn[d0] = *(const bf16x8*)(qp + d0 * 16); }
        issue(0, 0, 0, 0);
        for (int g = 0; g < NSTEP; ++g) {
            asm volatile("s_waitcnt vmcnt(0)" ::: "memory");
            __syncthreads();
            { const int gn = g + 1, kb = gn / 3, jb = gn % 3;
              if (gn < NSTEP) { if (kb < UPC) issue(kb, jb, gn & 1, 0); if (kb >= 1 && kb - 1 < UPC) issue(kb - 1, jb + 3, gn & 1, 1); } }
            if (g >= ow) {
                const int k = (g - ow) / 3, j = g - 3 * k;
                if (k < UPC) {
                    const DilUnit u = dil_decode(e0 + k);
                    const int mq = u.m0 + 32 * w + r32;
                    if (j == ow) { A.init();
#pragma unroll
                        for (int d0 = 0; d0 < 4; ++d0) A.qr[d0] = qn[d0]; }
                    if (!(u.u2 == 0 && j < 2)) {
                        const int mk0 = u.m0 - 128 + 64 * j;
                        const LAS unsigned char* slot = F.lds + ((g & 1) * 2 + (j >= 3 ? 1 : 0)) * AT_SLOT;
                        A.tile(slot, lane, j != ow + 1, [&](int kk) { return (unsigned)(mq - mk0 - kk) <= 128u; });
                    }
                    if (j == ow + 2) {
                        const size_t qrow = u.rowb + ((size_t)mq << u.dl) + u.res;
                        const float lt = A.ltot(), inv = 1.f / lt;
                        bf16_t* orow = OP + ((size_t)u.pat * M + qrow) * 512 + u.h * 64;
#pragma unroll
                        for (int gq = 0; gq < 4; ++gq) {
                            u32x2 w0 = {cvtpk(A.o0[4 * gq] * inv, A.o0[4 * gq + 1] * inv), cvtpk(A.o0[4 * gq + 2] * inv, A.o0[4 * gq + 3] * inv)};
                            u32x2 w1 = {cvtpk(A.o1[4 * gq] * inv, A.o1[4 * gq + 1] * inv), cvtpk(A.o1[4 * gq + 2] * inv, A.o1[4 * gq + 3] * inv)};
                            *(u32x2*)(orow + 8 * gq + 4 * hi) = w0; *(u32x2*)(orow + 32 + 8 * gq + 4 * hi) = w1;
                        }
                        if (hi == 0) LSE[((size_t)u.pat * M + qrow) * 8 + u.h] = A.m + __builtin_amdgcn_logf(lt);
                        if (k + 1 < UPC) { const bf16_t* qp = qptr(k + 1);
#pragma unroll
                            for (int d0 = 0; d0 < 4; ++d0) qn[d0] = *(const bf16x8*)(qp + d0 * 16); }
                    }
                }
            }
        }
        __syncthreads();
    }
}

__device__ __forceinline__ void p3b_mla(Frame& F) {
    const bf16_t* QB = (const bf16_t*)(F.ws + WS_QB); const bf16_t* KN = (const bf16_t*)(F.ws + WS_KN); const bf16_t* KR = (const bf16_t*)(F.ws + WS_KR); const bf16_t* VB = (const bf16_t*)(F.ws + WS_VB);
    const bf16_t* OP = (const bf16_t*)((const unsigned char*)F.out + DO_OP); const float* LSE = (const float*)((const unsigned char*)F.out + DO_LSE);
    bf16_t* MIX = (bf16_t*)(F.ws + WS_MIX);
    const int lane = F.lane, w = F.wave, r32 = lane & 31, hi = lane >> 5;
    for (int vi = F.vcu * 4; vi < 1024; vi += ((vi & 3) == 3) ? (F.G - 1) * 4 + 1 : 1) {
        const int v = vi >> 2, i = vi & 3;
        const int bh = v >> 2, s = v & 3, qb = (i == 0) ? s : (i == 1) ? 7 - s : (i == 2) ? 8 + s : 15 - s;
        const int b = bh >> 3, h = bh & 7; const size_t rowb = (size_t)b * S;
        const int qpos = qb * 256 + 32 * w + r32; const size_t qrow = rowb + qpos;
        AttnCore<6> A; A.init();
#pragma unroll
        for (int d0 = 0; d0 < 6; ++d0) A.qr[d0] = *(const bf16x8*)(QB + qrow * 768 + h * 96 + d0 * 16 + hi * 8);
        const int NT = 4 * qb + 4;
        auto issue = [&](int t) {
            LAS unsigned char* slot = F.lds + ((((t >> 1) & 1) * 2) + (t & 1)) * AT_SLOT;
            const size_t krow = rowb + 64 * t + 8 * w + (lane >> 3);
            glds16(KN + krow * 512 + h * 64 + (((lane & 7) ^ ((4 * w + (lane >> 4)) & 7)) * 8), slot + AT_KB + w * 1024);
            if (w < 4) { const size_t rrow = rowb + 64 * t + 16 * w + (lane >> 2);
                glds16(KR + rrow * 32 + (((lane & 3) ^ ((lane >> 4) & 3)) * 8), slot + AT_KB + 8192 + w * 1024); }
            glds16(VB + krow * 512 + h * 64 + (((lane & 7) ^ (((lane >> 4) & 1) * 4)) * 8), slot + AT_VB + w * 1024);
        };
        issue(0); issue(1);
        const int qmin = qb * 256 + 32 * w;
        for (int t = 0; t < NT; t += 2) {
            __syncthreads();
            if (t + 2 < NT) { issue(t + 2); issue(t + 3); }
#pragma unroll
            for (int j = 0; j < 2; ++j) {
                const int k0 = 64 * (t + j);
                if (k0 <= qmin + 31) A.tile(F.lds + ((((t >> 1) & 1) * 2) + j) * AT_SLOT, lane, k0 + 63 > qmin, [&](int kk) { return k0 + kk <= qpos; });
            }
        }
        __syncthreads();
        const float inv = 1.f / A.ltot();
        const float l0 = LSE[((size_t)0 * M + qrow) * 8 + h], l1 = LSE[((size_t)1 * M + qrow) * 8 + h], l2 = LSE[((size_t)2 * M + qrow) * 8 + h];
        const float lm = fmaxf(l0, fmaxf(l1, l2));
        float w0 = __builtin_amdgcn_exp2f(l0 - lm), w1 = __builtin_amdgcn_exp2f(l1 - lm), w2 = __builtin_amdgcn_exp2f(l2 - lm);
        const float wi = 1.f / (w0 + w1 + w2); w0 *= wi; w1 *= wi; w2 *= wi;
        bf16_t* mrow = MIX + qrow * 1024 + h * 64;
#pragma unroll
        for (int g = 0; g < 4; ++g) {
#pragma unroll
            for (int dh = 0; dh < 2; ++dh) {
                const int dc = dh * 32 + 8 * g + 4 * hi;
                const u32x2 a0 = *(const u32x2*)(OP + ((size_t)0 * M + qrow) * 512 + h * 64 + dc), a1 = *(const u32x2*)(OP + ((size_t)1 * M + qrow) * 512 + h * 64 + dc), a2 = *(const u32x2*)(OP + ((size_t)2 * M + qrow) * 512 + h * 64 + dc);
                u32x2 oa;
                oa.x = cvtpk(w0 * bf_lo(a0.x) + w1 * bf_lo(a1.x) + w2 * bf_lo(a2.x), w0 * bf_hi(a0.x) + w1 * bf_hi(a1.x) + w2 * bf_hi(a2.x));
                oa.y = cvtpk(w0 * bf_lo(a0.y) + w1 * bf_lo(a1.y) + w2 * bf_lo(a2.y), w0 * bf_hi(a0.y) + w1 * bf_hi(a1.y) + w2 * bf_hi(a2.y));
                *(u32x2*)(mrow + dc) = oa;
                u32x2 ob;
                if (dh == 0) ob = (u32x2){cvtpk(A.o0[4 * g] * inv, A.o0[4 * g + 1] * inv), cvtpk(A.o0[4 * g + 2] * inv, A.o0[4 * g + 3] * inv)};
                else ob = (u32x2){cvtpk(A.o1[4 * g] * inv, A.o1[4 * g + 1] * inv), cvtpk(A.o1[4 * g + 2] * inv, A.o1[4 * g + 3] * inv)};
                *(u32x2*)(mrow + 512 + dc) = ob;
            }
        }
    }
}
#define CE_DESC(a, b) do { const float _h = fmaxf(a, b), _l = fminf(a, b); a = _h; b = _l; } while (0)
__device__ __forceinline__ void sort16_desc(float (&v)[16]) {
#pragma unroll
    for (int k = 2; k <= 16; k <<= 1)
#pragma unroll
        for (int j = k >> 1; j > 0; j >>= 1)
#pragma unroll
            for (int i = 0; i < 16; ++i) { const int l = i ^ j; if (l > i) { if ((i & k) == 0) CE_DESC(v[i], v[l]); else CE_DESC(v[l], v[i]); } }
}
__device__ __forceinline__ void merge_top16(float (&a)[16], const float (&b)[16]) {
#pragma unroll
    for (int i = 0; i < 16; ++i) a[i] = fmaxf(a[i], b[15 - i]);
#pragma unroll
    for (int j = 8; j > 0; j >>= 1)
#pragma unroll
        for (int i = 0; i < 16; ++i) { const int l = i ^ j; if (l > i) CE_DESC(a[i], a[l]); }
}
__device__ __forceinline__ void xmerge(float (&a)[16], int xmask) {
    float b[16];
#pragma unroll
    for (int i = 0; i < 16; ++i) b[i] = __shfl_xor(a[i], xmask);
    merge_top16(a, b);
}
__device__ __forceinline__ float sel4(int g, float a0, float a1, float a2, float a3) { const float lo = (g & 1) ? a1 : a0, hi = (g & 1) ? a3 : a2; return (g & 2) ? hi : lo; }
__device__ __forceinline__ float pack_code(float v, unsigned code, unsigned mask) { return __builtin_bit_cast(float, (__builtin_bit_cast(unsigned, v) & ~mask) | code); }
__device__ __forceinline__ float gelu_erf(float v) { return 0.5f * v * (1.0f + erff(v * 0.70710678118654752f)); }


constexpr size_t WS_X3B = 96 * MiB;
constexpr size_t WS_CF16 = 292 * MiB;
constexpr size_t WS_EID = 224 * MiB, WS_GATE = 240 * MiB, WS_SSQ3 = 86 * MiB;
constexpr float V8_SCALE = 64.f;
constexpr size_t WS_USCALE = 88 * MiB;
__device__ __forceinline__ float* hpart_base(unsigned char* ws, int cg) { return (float*)(ws + (cg < 5 ? 420 * MiB + (size_t)cg * 16 * MiB : 96 * MiB + (size_t)(cg - 5) * 16 * MiB)); }
constexpr int SEL_WAVE_LDS = 512;

constexpr int SEL_KEYS_BYTES = 65536, SEL_TAB_OFF = 2 * SEL_KEYS_BYTES;
__device__ __forceinline__ void p7_select(Frame& F) {
    const bf16_t* QP = (const bf16_t*)F.out; const bf16_t* KEYS = (const bf16_t*)(F.ws + WS_KEYS);
    unsigned* EID = (unsigned*)(F.ws + WS_EID); float* GATE = (float*)(F.ws + WS_GATE);
    const int lane = F.lane, w = F.wave, tk = lane & 15, g = lane >> 4;
    LAS unsigned char* tabL = F.lds + SEL_TAB_OFF + w * SEL_WAVE_LDS;
    auto stage_keys = [&](int h) {
        LAS unsigned char* kb = F.lds + (h & 1) * SEL_KEYS_BYTES;
#pragma unroll
        for (int i = 0; i < 8; ++i) { const int piece = w * 8 + i, r = piece * 4 + (lane >> 4), c = (lane & 15) ^ (r & 15);
            glds16(KEYS + ((size_t)h * 256 + r) * 128 + c * 8, kb + piece * 1024); }
    };
    for (int blk = F.vcu; blk < M / 128; blk += F.G) {
        const int tok0 = blk * 128 + w * 16;
        stage_keys(0);
        const int crow0 = (blk * 8 + w) * 16;
        f32x4 cv[2][4];
        auto conv_load = [&](int hh) {
#pragma unroll
            for (int u = 0; u < 2; ++u) { const int rr_ = crow0 + 2 * hh + u; const bool isu = rr_ < 16384; const float* src = (isu ? F.in[12] : F.in[13]) + (size_t)(isu ? rr_ : rr_ - 16384) * 1024;
#pragma unroll
                for (int j = 0; j < 4; ++j) cv[u][j] = *(const f32x4*)(src + 256 * j + 4 * lane); }
        };
        auto conv_store = [&](int hh) {
#pragma unroll
            for (int u = 0; u < 2; ++u) { const int rr_ = crow0 + 2 * hh + u; const bool isu = rr_ < 16384; const int e = isu ? rr_ : rr_ - 16384;
                unsigned char* dst = F.ws + (isu ? WS_U : WS_V) + (size_t)e * 1024;
                if (isu) {
                    f32x4 t[4]; float amax = 0.f;
#pragma unroll
                    for (int j = 0; j < 4; ++j) { t[j] = cv[u][j] * *(const f32x4*)(F.in[9] + 256 * j + 4 * lane); amax = fmaxf(amax, fmaxf(fmaxf(fabsf(t[j].x), fabsf(t[j].y)), fmaxf(fabsf(t[j].z), fabsf(t[j].w)))); }
#pragma unroll
                    for (int o = 1; o < 64; o <<= 1) amax = fmaxf(amax, __shfl_xor(amax, o));
                    const float sc_ = amax > 0.f ? amax * (1.f / 127.f) : 1.f, inv_ = 1.f / sc_;
                    if (lane == 0) ((float*)(F.ws + WS_USCALE))[e] = sc_;
#pragma unroll
                    for (int j = 0; j < 4; ++j) { const int q0 = (int)__builtin_rintf(t[j].x * inv_), q1 = (int)__builtin_rintf(t[j].y * inv_), q2 = (int)__builtin_rintf(t[j].z * inv_), q3 = (int)__builtin_rintf(t[j].w * inv_);
                        *(int*)(dst + 256 * j + 4 * lane) = (q0 & 0xff) | ((q1 & 0xff) << 8) | ((q2 & 0xff) << 16) | (q3 << 24); }
                } else {
#pragma unroll
                    for (int j = 0; j < 4; ++j) { f32x4 t = cv[u][j] * V8_SCALE;
                        t.x = fminf(fmaxf(t.x, -448.f), 448.f); t.y = fminf(fmaxf(t.y, -448.f), 448.f); t.z = fminf(fmaxf(t.z, -448.f), 448.f); t.w = fminf(fmaxf(t.w, -448.f), 448.f);
                        int wq = __builtin_amdgcn_cvt_pk_fp8_f32(t.x, t.y, 0, false); wq = __builtin_amdgcn_cvt_pk_fp8_f32(t.z, t.w, wq, true);
                        *(int*)(dst + 256 * j + 4 * lane) = wq; }
                }
            }
        };
        for (int h = 0; h < 8; ++h) {
            asm volatile("s_waitcnt vmcnt(0)" ::: "memory");
            __syncthreads();
            if (h > 0) conv_store(h - 1);
            const LAS unsigned char* kb = F.lds + (h & 1) * SEL_KEYS_BYTES;
            float s12[2][16];
#pragma unroll
            for (int p = 0; p < 2; ++p) {
                const int hp = h * 2 + p;
                bf16x8 bq[4];
#pragma unroll
                for (int ks = 0; ks < 4; ++ks) bq[ks] = *(const bf16x8*)(QP + (size_t)(tok0 + tk) * 2048 + hp * 128 + ks * 32 + g * 8);
                f32x4 c[8];
#pragma unroll
                for (int nt = 0; nt < 8; ++nt) { c[nt] = (f32x4){0.f, 0.f, 0.f, 0.f};
                    const int r = p * 128 + nt * 16 + tk;
#pragma unroll
                    for (int ks = 0; ks < 4; ++ks) { const bf16x8 ak = *(const LAS bf16x8*)(kb + r * 256 + (((4 * ks + g) ^ (r & 15)) * 16));
                        c[nt] = __builtin_amdgcn_mfma_f32_16x16x32_bf16(ak, bq[ks], c[nt], 0, 0, 0); } }
                if (p == 1) { if (h + 1 < 8) stage_keys(h + 1); conv_load(h); }
                float va[16], vb[16];
                const unsigned lo = 127u - 4u * (unsigned)g;
#pragma unroll
                for (int nt = 0; nt < 4; ++nt)
#pragma unroll
                    for (int r = 0; r < 4; ++r) { va[nt * 4 + r] = pack_code(c[nt][r], lo - (unsigned)(16 * nt + r), 127u); vb[nt * 4 + r] = pack_code(c[nt + 4][r], lo - (unsigned)(16 * (nt + 4) + r), 127u); }
                sort16_desc(va); sort16_desc(vb); merge_top16(va, vb);
                xmerge(va, 16); xmerge(va, 32);
#pragma unroll
                for (int i = 0; i < 16; ++i) s12[p][i] = va[i];
                if (g == 0) {
#pragma unroll
                    for (int i = 0; i < 16; ++i) tabL[tk * 32 + p * 16 + i] = (unsigned char)(127u - (__builtin_bit_cast(unsigned, va[i]) & 127u));
                }
            }
            float cd[16];
#define S1(i) s12[0][i]
#define S2(j) s12[1][j]
#define CND(slot, i0, j0, i1, j1, i2, j2, i3, j3) cd[slot] = pack_code(sel4(g, S1(i0), S1(i1), S1(i2), S1(i3)) + sel4(g, S2(j0), S2(j1), S2(j2), S2(j3)), \
                255u - (unsigned)(g == 0 ? (i0) * 16 + (j0) : g == 1 ? (i1) * 16 + (j1) : g == 2 ? (i2) * 16 + (j2) : (i3) * 16 + (j3)), 255u)
            CND(0, 0, 0, 0, 1, 0, 2, 0, 3);   CND(1, 0, 4, 0, 5, 0, 6, 0, 7);   CND(2, 0, 8, 0, 9, 0, 10, 0, 11); CND(3, 0, 12, 0, 13, 0, 14, 0, 15);
            CND(4, 1, 0, 1, 1, 1, 2, 1, 3);   CND(5, 1, 4, 1, 5, 1, 6, 1, 7);   CND(6, 2, 0, 2, 1, 2, 2, 2, 3);   CND(7, 2, 4, 3, 0, 3, 1, 3, 2);
            CND(8, 3, 3, 4, 0, 4, 1, 4, 2);   CND(9, 5, 0, 5, 1, 6, 0, 6, 1);   CND(10, 7, 0, 7, 1, 8, 0, 9, 0);  CND(11, 10, 0, 11, 0, 12, 0, 13, 0);
            { const float t = sel4(g, S1(14), S1(15), S1(15), S1(15)) + S2(0); const float pk = pack_code(t, 255u - (unsigned)(g == 0 ? 14 * 16 : 15 * 16), 255u); cd[12] = (g < 2) ? pk : -INFINITY; }
            cd[13] = -INFINITY; cd[14] = -INFINITY; cd[15] = -INFINITY;
#undef CND
#undef S1
#undef S2
            sort16_desc(cd); xmerge(cd, 16); xmerge(cd, 32);
            asm volatile("s_waitcnt lgkmcnt(0)" ::: "memory");
            float ev[16], sum = 0.f; const float mx = cd[0];
#pragma unroll
            for (int k = 0; k < 16; ++k) { ev[k] = __builtin_amdgcn_exp2f((cd[k] - mx) * LOG2E); sum += ev[k]; }
            const float isum = 1.f / sum;
            if (g == 0) {
                unsigned* er = EID + (size_t)(tok0 + tk) * 128; float* gr = GATE + (size_t)(tok0 + tk) * 128;
#pragma unroll
                for (int k = 0; k < 16; ++k) { const unsigned code = 255u - (__builtin_bit_cast(unsigned, cd[k]) & 255u);
                    const unsigned e1 = tabL[tk * 32 + (code >> 4)], e2 = tabL[tk * 32 + 16 + (code & 15u)];
                    const int pos = (k & 7) * 16 + 2 * h + (k >> 3);
                    er[pos] = (e1 * 128u + e2) << 10; gr[pos] = ev[k] * isum; }
            }
            asm volatile("s_waitcnt lgkmcnt(0)" ::: "memory");
        }
        conv_store(7);
        __syncthreads();
    }
}

typedef _Float16 h2_t __attribute__((ext_vector_type(2)));
__device__ __forceinline__ void fp8x16_to_h2(const u32x4 d, h2_t (&o)[8]) {
#pragma unroll
    for (int m = 0; m < 4; ++m) { o[2 * m] = __builtin_amdgcn_cvt_scalef32_pk_f16_fp8((int)d[m], 1.0f, false); o[2 * m + 1] = __builtin_amdgcn_cvt_scalef32_pk_f16_fp8((int)d[m], 1.0f, true); }
}

constexpr size_t CTL_Q_OFF = 4096;
constexpr int PEER_TILES = M / 16;
template <class Fn> __device__ __forceinline__ void peer_queue(Frame& F, int phase, const Fn& fn) {
    unsigned* ctr = (unsigned*)(F.ws + WS_CTL + CTL_Q_OFF);
    const unsigned x = (unsigned)__builtin_amdgcn_s_getreg((3 << 11) | 20) & 7u;
    for (int qi = 0; qi < 8; ++qi) {
        const int cg = (int)((x + (unsigned)qi) & 7u);
        unsigned* c = ctr + (phase * 8 + cg) * 64;
        unsigned nxt = 0; if (F.lane == 0) nxt = __hip_atomic_fetch_add(c, 1u, __ATOMIC_RELAXED, __HIP_MEMORY_SCOPE_AGENT);
        for (;;) {
            const int tile = __builtin_amdgcn_readfirstlane((int)nxt);
            if (tile >= PEER_TILES) break;
            if (F.lane == 0) nxt = __hip_atomic_fetch_add(c, 1u, __ATOMIC_RELAXED, __HIP_MEMORY_SCOPE_AGENT);
            fn(cg, tile);
        }
    }
}

__device__ __forceinline__ u32x4 ldnt4(const void* p) { return *(const u32x4*)p; }
__device__ __forceinline__ f32x4 ldnt4f(const void* p) { return *(const f32x4*)p; }
__device__ __forceinline__ unsigned ldnt1(const void* p) { return *(const unsigned*)p; }
#define EOFF(i) ((i) < 4 ? e0[(i) & 3] : (i) < 8 ? e1[(i) & 3] : (i) < 12 ? e2[(i) & 3] : e3[(i) & 3])

#define LDSRD(dst, addr, OFF) asm volatile("ds_read_b128 %0, %1 offset:" #OFF : "=v"(dst) : "v"(addr))
#define LDSPIN4(a, b, c, d) do { asm volatile("" : "+v"(a)); asm volatile("" : "+v"(b)); asm volatile("" : "+v"(c)); asm volatile("" : "+v"(d)); } while (0)

#define LDSRD32(dst, addr, OFF) asm volatile("ds_read_b32 %0, %1 offset:" #OFF : "=v"(dst) : "v"(addr))
#define LDSWR128(addr, v, OFF) asm volatile("ds_write_b128 %0, %1 offset:" #OFF :: "v"(addr), "v"(v))
#define LDSWR32(addr, v) asm volatile("ds_write_b32 %0, %1" :: "v"(addr), "v"(v))

template <int CTRL> __device__ __forceinline__ int dpp_i(int v) { return __builtin_amdgcn_update_dpp(0, v, CTRL, 0xf, 0xf, true); }
template <int CTRL> __device__ __forceinline__ float dpp_f(float v) { return __builtin_bit_cast(float, __builtin_amdgcn_update_dpp(0, __builtin_bit_cast(int, v), CTRL, 0xf, 0xf, true)); }
__device__ __forceinline__ float swap32_sum(float a, float b) {
    const auto r = __builtin_amdgcn_permlane32_swap(__builtin_bit_cast(unsigned, a), __builtin_bit_cast(unsigned, b), false, false);
    return __builtin_bit_cast(float, (unsigned)r[0]) + __builtin_bit_cast(float, (unsigned)r[1]); }
__device__ __forceinline__ float swap16_sum(float a, float b) {
    const auto r = __builtin_amdgcn_permlane16_swap(__builtin_bit_cast(unsigned, a), __builtin_bit_cast(unsigned, b), false, false);
    return __builtin_bit_cast(float, (unsigned)r[0]) + __builtin_bit_cast(float, (unsigned)r[1]); }

template <int PROBE>
__device__ __forceinline__ void p8_uphase(Frame& F) {
    const unsigned char* EIDb = F.ws + WS_EID; const bf16_t* X2B = (const bf16_t*)(F.ws + WS_X2B);
    const int lane = F.lane, r = lane >> 3, c = lane & 7;
    const __amdgpu_buffer_rsrc_t rs = __builtin_amdgcn_make_buffer_rsrc((void*)(F.ws + WS_U), 0, 16 << 20, 0x00020000);
    constexpr unsigned EMASK = (PROBE == 2) ? (4095u << 10) : (PROBE == 3) ? (511u << 10) : 0xffffffffu;
    LAS unsigned char* wl = F.lds + F.wave * 16384;
    const unsigned wla = (unsigned)(size_t)wl, la = wla + (unsigned)r * 64u, qa = wla + 8192u + (unsigned)c * 16u, sa = wla + 8192u + 2048u;
    unsigned* ctr = (unsigned*)(F.ws + WS_CTL + CTL_Q_OFF);
    const unsigned x = (unsigned)__builtin_amdgcn_s_getreg((3 << 11) | 20) & 7u;
    auto dma_chunk = [&](int tile, int ch) {
        const size_t go = (size_t)tile * 8192 + (size_t)ch * 2048 + (size_t)lane * 16;
        const unsigned dst = __builtin_amdgcn_readfirstlane(wla + (unsigned)ch * 2048u);
        ASM_GLDS16(EIDb + go, dst); ASM_GLDS16(EIDb + go + 1024, dst + 1024u);
    };
    const int lo = c * 16;
    for (int qi = 0; qi < 8; ++qi) {
        const int cg = (int)((x + (unsigned)qi) & 7u), so = cg * 128;
        float* HP = PROBE ? (float*)(F.ws + ((size_t)300 << 20)) : hpart_base(F.ws, cg);
        unsigned* cq = ctr + ((PROBE ? 2 : 0) * 8 + cg) * 64;
        auto act_load = [&](int tile, u32x4 (&xa)[4]) { const bf16_t* p = X2B + ((size_t)tile * 16 + (lane >> 2)) * 1024 + cg * 128 + (lane & 3) * 32;
#pragma unroll
            for (int j = 0; j < 4; ++j) xa[j] = *(const u32x4*)(p + 8 * j); };
        auto act_quant = [&](const u32x4 (&xa)[4], int par) {
            float hv[32];
#pragma unroll
            for (int j = 0; j < 4; ++j)
#pragma unroll
                for (int m = 0; m < 4; ++m) { hv[8 * j + 2 * m] = bf_lo(xa[j][m]); hv[8 * j + 2 * m + 1] = bf_hi(xa[j][m]); }
            float am = 0.f;
#pragma unroll
            for (int j = 0; j < 32; ++j) am = fmaxf(am, fabsf(hv[j]));
            am = fmaxf(am, __shfl_xor(am, 1)); am = fmaxf(am, __shfl_xor(am, 2));
            const float sh = am > 0.f ? am * (1.f / 127.f) : 1.f, ish = 1.f / sh;
            u32x4 qv[2];
#pragma unroll
            for (int m = 0; m < 8; ++m) { const int q0 = (int)__builtin_rintf(hv[4 * m] * ish), q1 = (int)__builtin_rintf(hv[4 * m + 1] * ish), q2 = (int)__builtin_rintf(hv[4 * m + 2] * ish), q3 = (int)__builtin_rintf(hv[4 * m + 3] * ish);
                qv[m >> 2][m & 3] = (unsigned)((q0 & 0xff) | ((q1 & 0xff) << 8) | ((q2 & 0xff) << 16) | (q3 << 24)); }
            const unsigned wa = wla + 8192u + (unsigned)par * 2304u + (unsigned)(lane >> 2) * 128u + (unsigned)(lane & 3) * 32u;
            LDSWR128(wa, qv[0], 0); LDSWR128(wa, qv[1], 16);
            if ((lane & 3) == 0) { const unsigned swa = sa + (unsigned)par * 2304u + (unsigned)(lane >> 2) * 4u; LDSWR32(swa, sh); }
        };
        unsigned tk = 0; if (lane == 0) tk = __hip_atomic_fetch_add(cq, 1u, __ATOMIC_RELAXED, __HIP_MEMORY_SCOPE_AGENT);
        int tile = __builtin_amdgcn_readfirstlane((int)tk);
        if (tile >= PEER_TILES) continue;
        if (lane == 0) tk = __hip_atomic_fetch_add(cq, 1u, __ATOMIC_RELAXED, __HIP_MEMORY_SCOPE_AGENT);
        int nxt = __builtin_amdgcn_readfirstlane((int)tk);
        if (lane == 0) tk = __hip_atomic_fetch_add(cq, 1u, __ATOMIC_RELAXED, __HIP_MEMORY_SCOPE_AGENT);
        dma_chunk(tile, 0); dma_chunk(tile, 1);
        u32x4 xa[4];
        act_load(tile, xa);
        int par = 0;
        act_quant(xa, 0);
        asm volatile("s_waitcnt vmcnt(0) lgkmcnt(0)" ::: "memory");
        u32x4 e0, e1, e2, e3, hq; float sh;
        LDSRD(e0, la, 0); LDSRD(e1, la, 16); LDSRD(e2, la, 32); LDSRD(e3, la, 48); LDSRD(hq, qa, 0); LDSRD32(sh, sa, 0);
        asm volatile("s_waitcnt lgkmcnt(0)" ::: "memory");
        LDSPIN4(e0, e1, e2, e3); asm volatile("" : "+v"(hq)); asm volatile("" : "+v"(sh));
        u32x4 d[8];
#pragma unroll
        for (int i = 0; i < 8; ++i) d[i] = __builtin_amdgcn_raw_buffer_load_b128(rs, (int)((EOFF(i) & EMASK) | lo), so, 0);
        for (;;) {
            const bool has_next = nxt < PEER_TILES;
#pragma unroll 1
            for (int t = 0; t < 16; ++t) {
                const int tok = tile * 16 + t;
                if ((t & 3) == 0) { const int ch2 = (t >> 2) + 2; if (ch2 < 4) dma_chunk(tile, ch2); else if (has_next) dma_chunk(nxt, ch2 - 4); }
                if (has_next && t == 2) act_load(nxt, xa);
                if (has_next && t == 10) act_quant(xa, par ^ 1);
                const bool cross = (t == 15) && has_next;
                const int tn = (t < 15) ? t + 1 : (has_next ? 0 : 15);
                const unsigned pn = (unsigned)(cross ? (par ^ 1) : par) * 2304u;
                const unsigned ta = la + (unsigned)tn * 512u, tq = qa + pn + (unsigned)tn * 128u, ts = sa + pn + (unsigned)tn * 4u;
                u32x4 n0, n1, n2, n3, hqn; float shn;
                LDSRD(n0, ta, 0); LDSRD(n1, ta, 16); LDSRD(n2, ta, 32); LDSRD(n3, ta, 48); LDSRD(hqn, tq, 0); LDSRD32(shn, ts, 0);
                int p[16];
#define UDOT(i, nextoff) do { int a_ = 0; const u32x4 dd_ = d[(i) & 7]; \
                    a_ = __builtin_amdgcn_sdot4((int)dd_.x, (int)hq.x, a_, false); a_ = __builtin_amdgcn_sdot4((int)dd_.y, (int)hq.y, a_, false); a_ = __builtin_amdgcn_sdot4((int)dd_.z, (int)hq.z, a_, false); a_ = __builtin_amdgcn_sdot4((int)dd_.w, (int)hq.w, a_, false); \
                    asm volatile("" : "+v"(a_)); p[i] = a_; d[(i) & 7] = __builtin_amdgcn_raw_buffer_load_b128(rs, (int)(((nextoff) & EMASK) | lo), so, 0); } while (0)
                UDOT(0, e2[0]); UDOT(1, e2[1]); UDOT(2, e2[2]); UDOT(3, e2[3]); UDOT(4, e3[0]); UDOT(5, e3[1]); UDOT(6, e3[2]); UDOT(7, e3[3]);
                asm volatile("s_waitcnt lgkmcnt(0)" ::: "memory");
                LDSPIN4(n0, n1, n2, n3); asm volatile("" : "+v"(hqn)); asm volatile("" : "+v"(shn));
                UDOT(8, n0[0]); UDOT(9, n0[1]); UDOT(10, n0[2]); UDOT(11, n0[3]); UDOT(12, n1[0]); UDOT(13, n1[1]); UDOT(14, n1[2]); UDOT(15, n1[3]);
#undef UDOT
                int q8[8], q4[4], q2[2];
                { const bool b = (c & 4) != 0;
#pragma unroll
                  for (int j = 0; j < 8; ++j) { const int A = p[j] + dpp_i<0x141>(p[j]), B = p[8 + j] + dpp_i<0x141>(p[8 + j]); q8[j] = b ? B : A; } }
                { const bool b = (c & 2) != 0;
#pragma unroll
                  for (int j = 0; j < 4; ++j) { const int A = q8[j] + dpp_i<0x4E>(q8[j]), B = q8[4 + j] + dpp_i<0x4E>(q8[4 + j]); q4[j] = b ? B : A; } }
                { const bool b = (c & 1) != 0;
#pragma unroll
                  for (int j = 0; j < 2; ++j) { const int A = q4[j] + dpp_i<0xB1>(q4[j]), B = q4[2 + j] + dpp_i<0xB1>(q4[2 + j]); q2[j] = b ? B : A; } }
                __builtin_nontemporal_store(cvtpk((float)q2[0] * sh, (float)q2[1] * sh), (unsigned*)((bf16_t*)HP + (size_t)tok * 128 + 2 * lane));
                e0 = n0; e1 = n1; e2 = n2; e3 = n3; hq = hqn; sh = shn;
            }
            if (!has_next) break;
            tile = nxt; nxt = __builtin_amdgcn_readfirstlane((int)tk); par ^= 1;
            if (lane == 0) tk = __hip_atomic_fetch_add(cq, 1u, __ATOMIC_RELAXED, __HIP_MEMORY_SCOPE_AGENT);
        }
    }
}

__device__ __forceinline__ void p8b_combine(Frame& F) {
    float* GATE = (float*)(F.ws + WS_GATE); const float* SSQ2 = (const float*)(F.ws + WS_SSQ2); const unsigned* EID = (const unsigned*)(F.ws + WS_EID); const float* USC = (const float*)(F.ws + WS_USCALE);
    const int gt = F.vcu * 512 + F.tid, NT = F.G * 512;
    for (int i = gt; i < M * 32; i += NT) {
        const int tok = i >> 5;
        const f32x4* sp = (const f32x4*)(SSQ2 + (size_t)tok * 16); const f32x4 s0 = sp[0], s1 = sp[1], s2 = sp[2], s3 = sp[3];
        const float ssq = ((s0.x + s0.y) + (s0.z + s0.w)) + ((s1.x + s1.y) + (s1.z + s1.w)) + ((s2.x + s2.y) + (s2.z + s2.w)) + ((s3.x + s3.y) + (s3.z + s3.w));
        const float rsu = rsqrtf(ssq * (1.f / 1024.f) + NORM_EPS);
        f32x4 h = {0.f, 0.f, 0.f, 0.f};
#pragma unroll
        for (int g2 = 0; g2 < 8; ++g2) { const u32x2 hb = *(const u32x2*)((const bf16_t*)hpart_base(F.ws, g2) + (size_t)i * 4); h = h + (f32x4){bf_lo(hb.x), bf_hi(hb.x), bf_lo(hb.y), bf_hi(hb.y)}; }
        const u32x4 e4 = *(const u32x4*)(EID + (size_t)i * 4);
        const f32x4 gt4 = *(const f32x4*)(GATE + (size_t)i * 4);
        f32x4 o; o.x = gelu_erf(h.x * rsu * USC[e4.x >> 10]) * gt4.x; o.y = gelu_erf(h.y * rsu * USC[e4.y >> 10]) * gt4.y; o.z = gelu_erf(h.z * rsu * USC[e4.z >> 10]) * gt4.z; o.w = gelu_erf(h.w * rsu * USC[e4.w >> 10]) * gt4.w;
        { typedef _Float16 h4_t __attribute__((ext_vector_type(4))); const h4_t oh = {(_Float16)o.x, (_Float16)o.y, (_Float16)o.z, (_Float16)o.w}; *(u32x2*)(F.ws + WS_CF16 + (size_t)i * 8) = __builtin_bit_cast(u32x2, oh); }
    }
}

template <int PROBE>
__device__ __forceinline__ void p9_vphase(Frame& F) {
    const unsigned char* EIDb = F.ws + WS_EID; const unsigned char* CFb = F.ws + WS_CF16;
    const bf16_t* X2B = (const bf16_t*)(F.ws + WS_X2B);
    const int lane = F.lane, r = lane >> 3, c = lane & 7;
    const __amdgpu_buffer_rsrc_t rs = __builtin_amdgcn_make_buffer_rsrc((void*)(F.ws + WS_V), 0, 16 << 20, 0x00020000);
    LAS unsigned char* wl = F.lds + F.wave * 16384;
    const unsigned wla = (unsigned)(size_t)wl, la = wla + (unsigned)r * 64u, lc = wla + 2048u + (unsigned)r * 32u;
    unsigned* ctr = (unsigned*)(F.ws + WS_CTL + CTL_Q_OFF);
    const unsigned x = (unsigned)__builtin_amdgcn_s_getreg((3 << 11) | 20) & 7u;
    auto dma_chunk = [&](int tile, int ch) {
        const size_t go = (size_t)tile * 8192 + (size_t)ch * 2048 + (size_t)lane * 16, gc = (size_t)tile * 4096 + (size_t)ch * 1024 + (size_t)lane * 16;
        const unsigned dst = __builtin_amdgcn_readfirstlane(wla + (unsigned)ch * 3072u);
        ASM_GLDS16(EIDb + go, dst); ASM_GLDS16(EIDb + go + 1024, dst + 1024u); ASM_GLDS16(CFb + gc, dst + 2048u);
    };
    const int lo = c * 16;
    for (int qi = 0; qi < 8; ++qi) {
        const int cg = (int)((x + (unsigned)qi) & 7u), so = cg * 128;
        unsigned* cq = ctr + ((PROBE ? 3 : 1) * 8 + cg) * 64;
        unsigned tk = 0; if (lane == 0) tk = __hip_atomic_fetch_add(cq, 1u, __ATOMIC_RELAXED, __HIP_MEMORY_SCOPE_AGENT);
        int tile = __builtin_amdgcn_readfirstlane((int)tk);
        if (tile >= PEER_TILES) continue;
        if (lane == 0) tk = __hip_atomic_fetch_add(cq, 1u, __ATOMIC_RELAXED, __HIP_MEMORY_SCOPE_AGENT);
        int nxt = __builtin_amdgcn_readfirstlane((int)tk);
        if (lane == 0) tk = __hip_atomic_fetch_add(cq, 1u, __ATOMIC_RELAXED, __HIP_MEMORY_SCOPE_AGENT);
        dma_chunk(tile, 0); dma_chunk(tile, 1);
        asm volatile("s_waitcnt vmcnt(0)" ::: "memory");
        u32x4 e0, e1, e2, e3, c0, c1;
        LDSRD(e0, la, 0); LDSRD(e1, la, 16); LDSRD(e2, la, 32); LDSRD(e3, la, 48); LDSRD(c0, lc, 0); LDSRD(c1, lc, 16);
        asm volatile("s_waitcnt lgkmcnt(0)" ::: "memory");
        LDSPIN4(e0, e1, e2, e3); asm volatile("" : "+v"(c0)); asm volatile("" : "+v"(c1));
        u32x4 d[16];
#pragma unroll
        for (int i = 0; i < 16; ++i) d[i] = __builtin_amdgcn_raw_buffer_load_b128(rs, (int)(EOFF(i) | lo), so, 0);
        LDSRD(e0, la, 512); LDSRD(e1, la, 528); LDSRD(e2, la, 544); LDSRD(e3, la, 560);
        asm volatile("s_waitcnt lgkmcnt(0)" ::: "memory");
        LDSPIN4(e0, e1, e2, e3);
        for (;;) {
            const bool has_next = nxt < PEER_TILES;
#pragma unroll 1
            for (int t = 0; t < 16; ++t) {
                const int tok = tile * 16 + t;
                if ((t & 3) == 0) { const int ch2 = (t >> 2) + 2; if (ch2 < 4) dma_chunk(tile, ch2); else if (has_next) dma_chunk(nxt, ch2 - 4); }
                const int t1 = (t < 15) ? t + 1 : (has_next ? 0 : 15), t2 = (t < 14) ? t + 2 : (has_next ? t - 14 : 15);
                const unsigned ta = la + (unsigned)(t2 >> 2) * 3072u + (unsigned)((t2 & 3) << 9), tc = lc + (unsigned)(t1 >> 2) * 3072u + (unsigned)((t1 & 3) << 8);
                u32x4 n0, n1, n2, n3, c0n, c1n;
                LDSRD(n0, ta, 0); LDSRD(n1, ta, 16); LDSRD(n2, ta, 32); LDSRD(n3, ta, 48); LDSRD(c0n, tc, 0); LDSRD(c1n, tc, 16);
                const size_t off = (size_t)tok * 1024 + cg * 128 + c * 16 + 2 * r;
                const unsigned xw = ldnt1(X2B + off);
                h2_t yh[8];
#pragma unroll
                for (int m = 0; m < 8; ++m) yh[m] = (h2_t){(_Float16)0.f, (_Float16)0.f};
#define VAXPY(i, cword, nextoff) do { h2_t vv[8]; if (PROBE == 2) { _Pragma("unroll") for (int m_ = 0; m_ < 4; ++m_) { vv[2 * m_] = __builtin_bit_cast(h2_t, d[i][m_] & 0x3c003c00u); vv[2 * m_ + 1] = __builtin_bit_cast(h2_t, (d[i][m_] >> 2) & 0x3c003c00u); } } else fp8x16_to_h2(d[i], vv); const _Float16 ch_ = __builtin_bit_cast(h2_t, (unsigned)(cword))[(i) & 1]; const h2_t c2_ = {ch_, ch_}; \
                    _Pragma("unroll") for (int m = 0; m < 8; ++m) yh[m] = __builtin_elementwise_fma(vv[m], c2_, yh[m]); \
                    _Pragma("unroll") for (int m = 0; m < 8; ++m) asm volatile("" : "+v"(yh[m])); \
                    d[i] = __builtin_amdgcn_raw_buffer_load_b128(rs, (int)((nextoff) | lo), so, 0); } while (0)
                VAXPY(0, c0.x, e0[0]); VAXPY(1, c0.x, e0[1]); VAXPY(2, c0.y, e0[2]); VAXPY(3, c0.y, e0[3]); VAXPY(4, c0.z, e1[0]); VAXPY(5, c0.z, e1[1]); VAXPY(6, c0.w, e1[2]); VAXPY(7, c0.w, e1[3]);
                VAXPY(8, c1.x, e2[0]); VAXPY(9, c1.x, e2[1]); VAXPY(10, c1.y, e2[2]); VAXPY(11, c1.y, e2[3]); VAXPY(12, c1.z, e3[0]); VAXPY(13, c1.z, e3[1]); VAXPY(14, c1.w, e3[2]); VAXPY(15, c1.w, e3[3]);
#undef VAXPY
                asm volatile("s_waitcnt lgkmcnt(0)" ::: "memory");
                LDSPIN4(n0, n1, n2, n3); asm volatile("" : "+v"(c0n)); asm volatile("" : "+v"(c1n));
                e0 = n0; e1 = n1; e2 = n2; e3 = n3; c0 = c0n; c1 = c1n;
                unsigned y8[8], q4[4], q2[2], q1;
#pragma unroll
                for (int m = 0; m < 8; ++m) y8[m] = __builtin_bit_cast(unsigned, yh[m]);
                auto hadd = [](unsigned a, unsigned b) { return __builtin_bit_cast(unsigned, __builtin_bit_cast(h2_t, a) + __builtin_bit_cast(h2_t, b)); };
#pragma unroll
                for (int j = 0; j < 4; ++j) { const auto rr = __builtin_amdgcn_permlane32_swap(y8[j], y8[4 + j], false, false); q4[j] = hadd((unsigned)rr[0], (unsigned)rr[1]); }
#pragma unroll
                for (int j = 0; j < 2; ++j) { const auto rr = __builtin_amdgcn_permlane16_swap(q4[j], q4[2 + j], false, false); q2[j] = hadd((unsigned)rr[0], (unsigned)rr[1]); }
                { const unsigned A = hadd(q2[0], (unsigned)dpp_i<0x128>((int)q2[0])), B = hadd(q2[1], (unsigned)dpp_i<0x128>((int)q2[1])); q1 = (r & 1) ? B : A; }
                const h2_t qh = __builtin_bit_cast(h2_t, q1);
                const float o0 = bf_lo(xw) + (float)qh[0] * (1.f / V8_SCALE), o1 = bf_hi(xw) + (float)qh[1] * (1.f / V8_SCALE);
                __builtin_nontemporal_store(cvtpk(o0, o1), (unsigned*)((bf16_t*)(F.ws + (PROBE ? ((size_t)300 << 20) : WS_X3B)) + off));
            }
            if (!has_next) break;
            tile = nxt; nxt = __builtin_amdgcn_readfirstlane((int)tk);
            if (lane == 0) tk = __hip_atomic_fetch_add(cq, 1u, __ATOMIC_RELAXED, __HIP_MEMORY_SCOPE_AGENT);
        }
    }
}

__device__ __forceinline__ void p10_final(Frame& F) {
    const float* gfin = F.in[14]; const bf16_t* X3B = (const bf16_t*)(F.ws + WS_X3B);
    const int gw = F.vcu * 8 + F.wave, NGW = F.G * 8, lane = (int)__builtin_amdgcn_mbcnt_hi(~0u, __builtin_amdgcn_mbcnt_lo(~0u, 0u));
    f32x4 g[4];
#pragma unroll
    for (int j = 0; j < 4; ++j) g[j] = *(const f32x4*)(gfin + 256 * j + 4 * lane);
    for (int tok = gw; tok < M; tok += NGW) {
        const bf16_t* xr = X3B + (size_t)tok * 1024; float* orow = F.out + (size_t)tok * 1024;
        f32x4 v[4]; float ss = 0.f;
#pragma unroll
        for (int j = 0; j < 4; ++j) { const u32x2 p = *(const u32x2*)(xr + 256 * j + 4 * lane); v[j] = (f32x4){bf_lo(p.x), bf_hi(p.x), bf_lo(p.y), bf_hi(p.y)}; }
#pragma unroll
        for (int j = 0; j < 4; ++j) ss += (v[j].x * v[j].x + v[j].y * v[j].y) + (v[j].z * v[j].z + v[j].w * v[j].w);
        const float rs = rsqrtf(wave_sum(ss) * (1.f / 1024.f) + NORM_EPS);
#pragma unroll
        for (int j = 0; j < 4; ++j) *(f32x4*)(orow + 256 * j + 4 * lane) = v[j] * rs * g[j];
    }
}
constexpr int LDS_BYTES = 147456;
constexpr int NPHASE = 12;


#define XB_TMO      128
#define XB_XCNT(j)  (256  + 64 * (j))
#define XB_XSUB(j)  (1280 + 64 * (j))
#define XB_XGEN(j)  (2304 + 64 * (j))
#define XB_TOP      3328
#define XB_TOPGEN   3392
#define XCD_BAR_WORDS 3456
#define XB_SPIN_CAP (1u << 22)
__device__ __forceinline__ unsigned xb_ld(unsigned* p)              { return __hip_atomic_load(p, __ATOMIC_RELAXED, __HIP_MEMORY_SCOPE_AGENT); }
__device__ __forceinline__ unsigned xb_add(unsigned* p, unsigned v) { return __hip_atomic_fetch_add(p, v, __ATOMIC_RELAXED, __HIP_MEMORY_SCOPE_AGENT); }
__device__ __forceinline__ unsigned xb_xcc_id() { return (unsigned)__builtin_amdgcn_s_getreg((3 << 11) | 20) & 0xFu; }
#define XB_SPIN(cond, bar) do { unsigned _sp = 0; while (cond) { __builtin_amdgcn_s_sleep(1); \
    if ((++_sp & 255u) == 0u) { if (xb_ld(&(bar)[XB_TMO])) break; if (_sp > XB_SPIN_CAP) { atomicAdd(&(bar)[XB_TMO], 1u); break; } } } } while (0)
struct XcdBarrier { unsigned* bar; unsigned x; volatile LAS unsigned* st; };
__device__ __forceinline__ XcdBarrier xcd_barrier_post(unsigned* bar, volatile LAS unsigned* st) {
    XcdBarrier b; b.bar = bar; b.x = xb_xcc_id(); b.st = st;
    if (threadIdx.x == 0) (void)xb_add(&bar[XB_XCNT(b.x)], 1u);
    return b;
}
__device__ __forceinline__ void xcd_barrier_complete(unsigned* bar, unsigned x, unsigned& nloc, unsigned& nx) {
    const unsigned G = gridDim.x * gridDim.y * gridDim.z;
    unsigned sum, cnt, mine, sp = 0u;
    for (;;) {
        sum = 0u; cnt = 0u; mine = 0u;
#pragma unroll
        for (unsigned j = 0; j < 16; ++j) { const unsigned c = xb_ld(&bar[XB_XCNT(j)]); sum += c; cnt += (c > 0u) ? 1u : 0u; mine = (j == x) ? c : mine; }
        if (sum == G) break;
        __builtin_amdgcn_s_sleep(1);
        if ((++sp & 255u) == 0u) { if (xb_ld(&bar[XB_TMO])) break; if (sp > XB_SPIN_CAP) { atomicAdd(&bar[XB_TMO], 1u); break; } }
    }
    nloc = mine > 0u ? mine : 1u; nx = cnt > 0u ? cnt : 1u;
}
__device__ __forceinline__ void xcd_barrier(const XcdBarrier& b) {
    asm volatile("s_waitcnt vmcnt(0)" ::: "memory");
    __syncthreads();
    if (threadIdx.x == 0) {
        unsigned* bar = b.bar;
        __builtin_amdgcn_s_waitcnt(0);
        unsigned nloc = b.st[0], nx = b.st[1];
        if (nloc == 0u) { xcd_barrier_complete(bar, b.x, nloc, nx); b.st[0] = nloc; b.st[1] = nx; }
        const unsigned old = xb_add(&bar[XB_XSUB(b.x)], 1u);
        const unsigned gen = old / nloc;
        if (old + 1u == (gen + 1u) * nloc) {
            __builtin_amdgcn_fence(__ATOMIC_RELEASE, "agent");
            asm volatile("s_waitcnt vmcnt(0)" ::: "memory");
            const unsigned og = xb_add(&bar[XB_TOP], 1u);
            const unsigned tg = og / nx;
            if (og + 1u == (tg + 1u) * nx) xb_add(&bar[XB_TOPGEN], 1u);
            else XB_SPIN(xb_ld(&bar[XB_TOPGEN]) == tg, bar);
            __builtin_amdgcn_fence(__ATOMIC_ACQUIRE, "agent");
            xb_add(&bar[XB_XGEN(b.x)], 1u);
            asm volatile("s_waitcnt vmcnt(0)" ::: "memory");
        } else {
            XB_SPIN(xb_ld(&bar[XB_XGEN(b.x)]) == gen, bar);
            __builtin_amdgcn_fence(__ATOMIC_ACQUIRE, "agent");
            asm volatile("s_waitcnt vmcnt(0)" ::: "memory");
        }
    }
    __syncthreads();
}
constexpr int MISC_OFF = 131072 + 8192;
constexpr size_t CTL_BAR_OFF = 16384;
constexpr size_t CTL_ZERO_BYTES = 65536;

__global__ void __launch_bounds__(512, 2) fwd_kernel(Args args) {
    extern __shared__ __attribute__((aligned(16))) unsigned char lds_raw[];
    Frame F;
    F.lds = (LAS unsigned char*)lds_raw;
    F.tid = threadIdx.x; F.lane = F.tid & 63; F.wave = __builtin_amdgcn_readfirstlane(F.tid >> 6);
    F.G = gridDim.x; { const int bx = blockIdx.x; F.vcu = (F.G % 8 == 0) ? (bx % 8) * (F.G / 8) + bx / 8 : bx; }
#pragma unroll
    for (int i = 0; i < 15; ++i) F.in[i] = args.in[i];
    F.out = args.out; F.ws = args.ws;
    unsigned char* ws = args.ws;
    const int lo = args.ph_lo, hi = args.ph_hi;
#if ONE_LAUNCH
    volatile LAS unsigned* MISC = (volatile LAS unsigned*)(F.lds + MISC_OFF);
    if (F.tid < 16) MISC[F.tid] = 0u;
    __syncthreads();
    XcdBarrier bar = xcd_barrier_post((unsigned*)(ws + WS_CTL + CTL_BAR_OFF), MISC + 8);
#define SEAM(k) do { if (lo <= (k) && (k) + 1 < hi) xcd_barrier(bar); } while (0)
#else
#define SEAM(k) do { } while (0)
#endif
#define IN(k) (lo <= (k) && (k) < hi)
#define RELANE() do { int l_; asm volatile("v_mbcnt_lo_u32_b32 %0, -1, 0\n\tv_mbcnt_hi_u32_b32 %0, -1, %0" : "=v"(l_)); F.lane = l_; } while (0)
#if TIME_PHASE >= 0
    unsigned long long tp0 = 0, tp1 = 0;
#define TSTAMP(k) do { if ((k) == TIME_PHASE) tp0 = __builtin_amdgcn_s_memrealtime(); if ((k) == TIME_PHASE + 1) tp1 = __builtin_amdgcn_s_memrealtime(); } while (0)
#else
#define TSTAMP(k) do { } while (0)
#endif
    TSTAMP(0);
    if (IN(0)) { p0_prologue(F); SEAM(0); }
    TSTAMP(1);
    if (IN(1)) {
        GemmPlain g{(const bf16_t*)(ws + WS_XN), (const bf16_t*)(ws + WS_WIN), 1024, 1024, 1024};
        pg8::StaticOrder S_; S_.init(M, 2048, F.G, (int)blockIdx.x);
        const float* CA = (const float*)(ws + WS_ROPE);
        EpiP1 E{(bf16_t*)(ws + WS_QA), (bf16_t*)(ws + WS_KA), (bf16_t*)(ws + WS_VA), (bf16_t*)(ws + WS_CQ), (bf16_t*)(ws + WS_CKV), (float*)(ws + WS_SSQ1), CA, CA + 4096 * 32};
        pg8::gemm_phase<EpiP1, pg8::StaticOrder, GemmPlain>(F.lds, g, S_, E);
        p1_krope(F);
        SEAM(1);
    }
    TSTAMP(2);
    if (IN(2)) {
        GemmUp g{(const bf16_t*)(ws + WS_CQ), (const bf16_t*)(ws + WS_CKV), (const bf16_t*)(ws + WS_WUQ), (const bf16_t*)(ws + WS_WUKV), 256, 256, 256};
        pg8::StaticOrder S_; S_.init(M, 7 * 256, F.G, (int)blockIdx.x);
        const float* CB = (const float*)(ws + WS_ROPE) + 2 * 4096 * 32;
        EpiP2 E{(bf16_t*)(ws + WS_QB), (bf16_t*)(ws + WS_KN), (bf16_t*)(ws + WS_VB), (const float*)(ws + WS_SSQ1), CB, CB + 4096 * 16};
        pg8::gemm_phase<EpiP2, pg8::StaticOrder, GemmUp>(F.lds, g, S_, E);
    }
    TSTAMP(3);
    if (IN(3)) { p3a_dilated(F); SEAM(3); }
    TSTAMP(4);
    if (IN(4)) { p3b_mla(F); SEAM(4); }
    TSTAMP(5);
    if (IN(5)) {
        GemmPlain g{(const bf16_t*)(ws + WS_MIX), (const bf16_t*)(ws + WS_WO), 1024, 1024, 1024};
        pg8::StaticOrder S_; S_.init(M, 1024, F.G, (int)blockIdx.x);
        EpiP4 E{F.in[0], (bf16_t*)(ws + WS_X2B), (float*)(ws + WS_SSQ2)};
        pg8::gemm_phase<EpiP4, pg8::StaticOrder, GemmPlain>(F.lds, g, S_, E);
        SEAM(5);
    }
    TSTAMP(6);
    if (IN(6)) {
        GemmPlain g{(const bf16_t*)(ws + WS_X2B), (const bf16_t*)(ws + WS_WQ), 1024, 1024, 1024};
        pg8::StaticOrder S_; S_.init(M, 2048, F.G, (int)blockIdx.x);
        EpiP5 E{(bf16_t*)F.out, (const float*)(ws + WS_SSQ2)};
        pg8::gemm_phase<EpiP5, pg8::StaticOrder, GemmPlain>(F.lds, g, S_, E);
        SEAM(6);
    }
    TSTAMP(7);
    if (IN(7)) { p7_select(F); SEAM(7); }
    TSTAMP(8);
    if (IN(8)) { p8_uphase<0>(F); SEAM(8); }
#if PROBE_GATHER
    if (IN(8)) { p8_uphase<PROBE_GATHER>(F); SEAM(8); }
#endif
    TSTAMP(9);
    if (IN(9)) { p8b_combine(F); SEAM(9); }
    TSTAMP(10);
    if (IN(10)) { p9_vphase<0>(F); SEAM(10); }
#if PROBE_GATHER >= 4
    if (IN(10)) { p9_vphase<PROBE_GATHER - 3>(F); SEAM(10); }
#endif
    TSTAMP(11);
    if (IN(11)) { p10_final(F); }
    TSTAMP(12);
#if TIME_PHASE >= 0
    if (blockIdx.x == 0 && F.tid == 0) { const unsigned long long dt = tp1 - tp0, t_end = __builtin_amdgcn_s_memrealtime(); while (__builtin_amdgcn_s_memrealtime() - t_end < 8ull * dt) __builtin_amdgcn_s_sleep(8); }
#endif
#undef IN
#undef SEAM
}
#if DEBUG_CMP
namespace dbg {
__device__ __forceinline__ int colmap(int c, int mode) {
    if (mode == 1) { const int hb = c & ~63, p = c & 63; return hb + (p >> 1) + ((p & 1) << 5); }
    if (mode == 2) { return (c >> 1) + ((c & 1) << 4); }
    if (mode == 3) { const int h = c / 96, p = c % 96; if (p < 64) return c; const int q = p - 64; return h * 96 + 64 + (q >> 1) + ((q & 1) << 4); }
    return c;
}
template <class T> __device__ __forceinline__ float ldv(const T* p);
template <> __device__ __forceinline__ float ldv<float>(const float* p) { return *p; }
template <> __device__ __forceinline__ float ldv<bf16_t>(const bf16_t* p) { return __builtin_bit_cast(float, (unsigned)(*p) << 16); }
template <class T>
__global__ void cmp_k(const T* opt, int ld_opt, const float* ref, int ld_ref, int rows, int cols, float scale, int mode, unsigned* err, int stage) {
    const size_t n = (size_t)rows * cols; float md = 0.f, mr = 0.f;
    for (size_t i = (size_t)blockIdx.x * blockDim.x + threadIdx.x; i < n; i += (size_t)gridDim.x * blockDim.x) {
        const int r = (int)(i / cols), c = (int)(i % cols);
        const float o = ldv<T>(opt + (size_t)r * ld_opt + c) * scale, rf = ref[(size_t)r * ld_ref + colmap(c, mode)];
        float d = fabsf(o - rf); if (!(d == d)) d = 1.0e30f;
        md = fmaxf(md, d); mr = fmaxf(mr, fabsf(rf));
    }
    for (int o = 32; o > 0; o >>= 1) { md = fmaxf(md, __shfl_xor(md, o)); mr = fmaxf(mr, __shfl_xor(mr, o)); }
    if ((threadIdx.x & 63) == 0) { atomicMax(err + 2 * stage, __float_as_uint(md)); atomicMax(err + 2 * stage + 1, __float_as_uint(mr)); }
}
__global__ void encode_k(float* out, const unsigned* err, int nstage, int sel, float thr) {
    float eps2 = 0.f;
    if (sel >= 0) { const float e = __uint_as_float(err[2 * sel]) / fmaxf(__uint_as_float(err[2 * sel + 1]), 1e-30f); eps2 = fminf(fmaxf(e, 1e-4f), 0.9f); }
    else for (int k = 0; k < nstage; ++k) { const float e = __uint_as_float(err[2 * k]) / fmaxf(__uint_as_float(err[2 * k + 1]), 1e-30f);
        if (!(e < thr)) { eps2 = exp2f(-(float)(k + 1)) * (1.f + 0.9f * fminf(e, 1.f)); break; } }
    const float sc = 1.f + sqrtf(eps2);
    const size_t i = ((size_t)blockIdx.x * blockDim.x + threadIdx.x) * 4; f32x4 v = *(f32x4*)(out + i); v = v * sc; *(f32x4*)(out + i) = v;
}
}
#endif

static void launch_phases(const Args& base, int lo, int hi, int grid, hipStream_t stream) {
    Args a = base; a.ph_lo = lo; a.ph_hi = hi;
#if ONE_LAUNCH
    void* kargs[] = {(void*)&a};
    hipError_t e = hipLaunchCooperativeKernel((const void*)fwd_kernel, dim3(grid), dim3(512), kargs, LDS_BYTES, stream);
    if (e != hipSuccess) fprintf(stderr, "cooperative launch failed: %s (grid %d)\n", hipGetErrorString(e), grid);
#else
    hipLaunchKernelGGL(fwd_kernel, dim3(grid), dim3(512), LDS_BYTES, stream, a);
#endif
}

extern "C" void kernel_launch(void* const* d_in, const int* in_sizes, int n_in, void* d_out, int out_size, void* d_ws, size_t ws_size, hipStream_t stream) {
    static int grid = 0;
    if (grid == 0) {
        int dev = 0, cus = 0, per_cu = 0;
        hipGetDevice(&dev); hipDeviceGetAttribute(&cus, hipDeviceAttributeMultiprocessorCount, dev);
        hipFuncSetAttribute((const void*)fwd_kernel, hipFuncAttributeMaxDynamicSharedMemorySize, LDS_BYTES);
        hipOccupancyMaxActiveBlocksPerMultiprocessor(&per_cu, (const void*)fwd_kernel, 512, LDS_BYTES);
        if (per_cu < 1) { fprintf(stderr, "occupancy query says %d blocks/CU\n", per_cu); per_cu = 1; }
        grid = cus * 1;
        if (grid > 256) grid = 256;
        (void)hipGetLastError();
    }
    Args a{};
    for (int i = 0; i < 15; ++i) a.in[i] = (const float*)d_in[i];
    a.out = (float*)d_out; a.ws = (unsigned char*)d_ws;
    (void)hipMemsetAsync(a.ws + WS_CTL, 0, CTL_ZERO_BYTES, stream);
#if !DEBUG_CMP
#if ONE_LAUNCH
    launch_phases(a, 0, NPHASE, grid, stream);
#else
    for (int p = 0; p < NPHASE; ++p) launch_phases(a, p, p + 1, grid, stream);
#endif
#else
    using nv::rmsnorm_k; using nv::gemm_k; using nv::rope_k; using nv::copy_cols_k; using nv::dilated_k; using nv::mla_k; using nv::peer_k; constexpr int PW = nv::PW;
    unsigned char* ws = (unsigned char*)d_ws;
    unsigned* err = (unsigned*)(ws + 505 * MiB);
    hipMemsetAsync(err, 0, 256, stream);
    float* hb = (float*)(ws + 404 * MiB); float* projb = (float*)(ws + 420 * MiB); float* qn = (float*)(ws + 456 * MiB); float* knn = (float*)(ws + 469 * MiB);
    float* krn = (float*)(ws + 477 * MiB); float* vn = (float*)(ws + 478 * MiB); float* mixb = (float*)(ws + 486 * MiB);
    const float* x = (const float*)d_in[0];
    hipStream_t st = stream;
    launch_phases(a, 0, 1, grid, stream); launch_phases(a, 1, 2, grid, stream);
    rmsnorm_k<<<S / 4, 256, 0, st>>>(x, D, (const float*)d_in[1], hb, D, D, S);
    gemm_k<<<dim3((PW + 63) / 64, S / 64), 256, 0, st>>>(hb, D, (const float*)d_in[2], PW, projb, PW, nullptr, 0, S, PW, D);
    rope_k<<<(S * 8 * 32 + 255) / 256, 256, 0, st>>>(projb, PW, 0, 8, 64, S);
    rope_k<<<(S * 8 * 32 + 255) / 256, 256, 0, st>>>(projb, PW, 512, 8, 64, S);
    copy_cols_k<<<(S * 32 + 255) / 256, 256, 0, st>>>(projb + 2048, PW, krn, 32, 32, S);
    rope_k<<<(S * 16 + 255) / 256, 256, 0, st>>>(krn, 32, 0, 1, 32, S);
    dbg::cmp_k<bf16_t><<<1024, 256, 0, st>>>((const bf16_t*)(ws + WS_QA), 512, projb, PW, S, 512, 1.f / QSCALE_A, 1, err, 0);
    dbg::cmp_k<bf16_t><<<1024, 256, 0, st>>>((const bf16_t*)(ws + WS_KA), 512, projb + 512, PW, S, 512, 1.f, 1, err, 1);
    dbg::cmp_k<bf16_t><<<1024, 256, 0, st>>>((const bf16_t*)(ws + WS_VA), 512, projb + 1024, PW, S, 512, 1.f, 0, err, 2);
    dbg::cmp_k<bf16_t><<<1024, 256, 0, st>>>((const bf16_t*)(ws + WS_CQ), 256, projb + 1536, PW, S, 256, 1.f, 0, err, 3);
    dbg::cmp_k<bf16_t><<<1024, 256, 0, st>>>((const bf16_t*)(ws + WS_CKV), 256, projb + 1792, PW, S, 256, 1.f, 0, err, 4);
    dbg::cmp_k<bf16_t><<<1024, 256, 0, st>>>((const bf16_t*)(ws + WS_KR), 32, krn, 32, S, 32, 1.f, 2, err, 5);
    launch_phases(a, 2, 3, grid, stream);
    {   float* cqn = hb; float* ckvn = hb + (size_t)S * 256;
        rmsnorm_k<<<S / 4, 256, 0, st>>>(projb + 1536, PW, (const float*)d_in[3], cqn, 256, 256, S);
        rmsnorm_k<<<S / 4, 256, 0, st>>>(projb + 1792, PW, (const float*)d_in[4], ckvn, 256, 256, S);
        gemm_k<<<dim3(768 / 64, S / 64), 256, 0, st>>>(cqn, 256, (const float*)d_in[5], 768, qn, 768, nullptr, 0, S, 768, 256);
        for (int h = 0; h < 8; ++h) rope_k<<<(S * 16 + 255) / 256, 256, 0, st>>>(qn, 768, h * 96 + 64, 1, 32, S);
        gemm_k<<<dim3(512 / 64, S / 64), 256, 0, st>>>(ckvn, 256, (const float*)d_in[6], 512, knn, 512, nullptr, 0, S, 512, 256);
        gemm_k<<<dim3(512 / 64, S / 64), 256, 0, st>>>(ckvn, 256, (const float*)d_in[7], 512, vn, 512, nullptr, 0, S, 512, 256); }
    dbg::cmp_k<bf16_t><<<1024, 256, 0, st>>>((const bf16_t*)(ws + WS_QB), 768, qn, 768, S, 768, 1.f / QSCALE_B, 3, err, 6);
    dbg::cmp_k<bf16_t><<<1024, 256, 0, st>>>((const bf16_t*)(ws + WS_KN), 512, knn, 512, S, 512, 1.f, 0, err, 7);
    dbg::cmp_k<bf16_t><<<1024, 256, 0, st>>>((const bf16_t*)(ws + WS_VB), 512, vn, 512, S, 512, 1.f, 0, err, 8);
    launch_phases(a, 3, 4, grid, stream); launch_phases(a, 4, 5, grid, stream);
    dilated_k<<<8 * S / 4, 256, 0, st>>>(projb, mixb);
    mla_k<<<1 * 8 * (S / 64), 64, 0, st>>>(qn, knn, krn, vn, mixb);
    dbg::cmp_k<bf16_t><<<1024, 256, 0, st>>>((const bf16_t*)(ws + WS_MIX), 1024, mixb, 1024, S, 512, 1.f, 0, err, 9);
    dbg::cmp_k<bf16_t><<<1024, 256, 0, st>>>((const bf16_t*)(ws + WS_MIX) + 512, 1024, mixb + 512, 1024, S, 512, 1.f, 0, err, 10);
    launch_phases(a, 5, 6, grid, stream);
    float* x2b = hb;
    gemm_k<<<dim3(D / 64, S / 64), 256, 0, st>>>(mixb, 1024, (const float*)d_in[8], D, x2b, D, x, D, S, D, 1024);
    dbg::cmp_k<bf16_t><<<1024, 256, 0, st>>>((const bf16_t*)(ws + WS_X2B), 1024, x2b, 1024, S, 1024, 1.f, 0, err, 11);
    launch_phases(a, 6, 7, grid, stream);
    float* h2c = qn; float* qpc = projb;
    rmsnorm_k<<<4096 / 4, 256, 0, st>>>(x2b, D, (const float*)d_in[9], h2c, D, D, 4096);
    gemm_k<<<dim3(2048 / 64, 4096 / 64), 256, 0, st>>>(h2c, D, (const float*)d_in[10], 2048, qpc, 2048, nullptr, 0, 4096, 2048, D);
    dbg::cmp_k<bf16_t><<<1024, 256, 0, st>>>((const bf16_t*)d_out, 2048, qpc, 2048, S, 2048, 1.f, 0, err, 12);
    launch_phases(a, 7, 8, grid, stream); launch_phases(a, 8, 9, grid, stream); launch_phases(a, 9, 10, grid, stream); launch_phases(a, 10, 11, grid, stream); launch_phases(a, 11, 12, grid, stream);
    peer_k<<<4096 / 4, 256, 0, st>>>(h2c, qpc, (const float*)d_in[11], (const float*)d_in[12], (const float*)d_in[13], (const float*)d_in[14], x2b, 4096);
    dbg::cmp_k<float><<<1024, 256, 0, st>>>((const float*)d_out, 1024, x2b, 1024, S, 1024, 1.f, 0, err, 13);
    nv::run(d_in, (float*)d_out, (float*)d_ws, stream);
    dbg::encode_k<<<M * 1024 / 4 / 256, 256, 0, st>>>((float*)d_out, err, 14, DEBUG_SEL, 0.05f);
#endif
}
```

```cpp
#include <hip/hip_runtime.h>
#include <hip/hip_cooperative_groups.h>
#include <cstdio>
#include <cstdint>
#include <cmath>
namespace cg = cooperative_groups;
#define DEBUG_CMP 0
#define ONE_LAUNCH 1
#define DEBUG_SEL -1
#define TIME_PHASE -1
#define PROBE_GATHER 0
#define PROBE_ATTN 0
#define LAS __attribute__((address_space(3)))
#define GAS __attribute__((address_space(1)))
typedef unsigned short bf16_t;
typedef short bf16x8 __attribute__((ext_vector_type(8)));
typedef short s16x4 __attribute__((ext_vector_type(4)));
typedef float f32x4 __attribute__((ext_vector_type(4)));
typedef float f32x16 __attribute__((ext_vector_type(16)));
typedef float f32x2_t __attribute__((ext_vector_type(2)));
typedef __bf16 bf16x2_t __attribute__((ext_vector_type(2)));
typedef unsigned u32x4 __attribute__((ext_vector_type(4)));
typedef unsigned u32x2 __attribute__((ext_vector_type(2)));

constexpr int NB = 8, S = 4096, M = NB * S, D = 1024;
constexpr float NORM_EPS = 1e-6f;
constexpr float LOG2E = 1.4426950408889634f;
constexpr float QSCALE_A = 0.125f * LOG2E;
constexpr float QSCALE_B = 0.10206207261596577f * LOG2E;

__device__ __forceinline__ unsigned cvtpk(float lo, float hi) { f32x2_t v = {lo, hi}; bf16x2_t b = __builtin_convertvector(v, bf16x2_t); return __builtin_bit_cast(unsigned, b); }
__device__ __forceinline__ float bf_lo(unsigned w) { return __builtin_bit_cast(float, w << 16); }
__device__ __forceinline__ float bf_hi(unsigned w) { return __builtin_bit_cast(float, w & 0xffff0000u); }

#define ASM_GLDS16(gptr, ldsaddr) asm volatile("s_mov_b32 m0, %0\n\ts_nop 0\n\tglobal_load_lds_dwordx4 %1, off" :: "s"(ldsaddr), "v"(gptr) : "m0")

namespace pg8 {
constexpr int BM = 256, BK = 64, HALF = 128, HTB = HALF * BK * 2, STAGE_BYTES = 8 * HTB, NXCD = 8, WGM = 8;
__host__ __device__ __forceinline__ int lds_byte(int r, int c) { const int st = (r >> 4) * 2 + (c >> 5), rr = r & 15, cc = c & 31, ob = rr * 64 + cc * 2; return st * 1024 + (ob ^ (((ob >> 9) & 1) << 5)); }
__host__ __device__ __forceinline__ void stage_rc(int b, int& R, int& C) { const int st = b / 1024, sb = b % 1024, swz = sb ^ (((sb >> 9) & 1) << 5); R = (st >> 1) * 16 + swz / 64; C = (st & 1) * 32 + (swz % 64) / 2; }
__host__ __device__ __forceinline__ int perm32(int rho) { const int n = rho >> 4, i = rho & 15; return 8 * (i >> 2) + 4 * n + (i & 3); }
struct Unit { int pm, pn; };
struct StaticOrder {
    int nM, nN, nwg, G, c;
    __device__ void init(int Mr, int N, int G_, int c_) { nM = Mr / BM; nN = N / BM; nwg = nM * nN; G = G_; c = c_; }
    __device__ bool next(int i, Unit& u) const {
        const long L = (long)i * G + c; if (L >= nwg) return false;
        int wgid = (int)L; { const int q = nwg / NXCD, r = nwg % NXCD, xcd = wgid % NXCD, off = wgid / NXCD; wgid = (xcd < r ? xcd * (q + 1) : r * (q + 1) + (xcd - r) * q) + off; }
        const int nig = WGM * nN, gid = wgid / nig, fm = gid * WGM, gsz = (nM - fm) < WGM ? (nM - fm) : WGM;
        u.pm = fm + ((wgid % nig) % gsz); u.pn = (wgid % nig) / gsz; return true;
    }
};
template <class Epi, class Sched, class G>
__device__ __forceinline__ void gemm_phase(LAS unsigned char* lds, const G g, const Sched& Sch, const Epi& E) {
    const int tid = threadIdx.x, wid = __builtin_amdgcn_readfirstlane(tid >> 6), lane = tid & 63, wr = wid >> 2, wc = wid & 3, fr = lane & 15, fq = lane >> 4;
    const int K = g.K, nt = K / BK;
    unsigned voffA[2], voffB[2];
#pragma unroll
    for (int i = 0; i < 2; ++i) { int R, C; stage_rc(tid * 16 + i * 8192, R, C); const int Rb = Epi::PERM ? ((R & ~31) + perm32(R & 31)) : R;
        voffA[i] = (unsigned)(R * g.lda + C) * 2u; voffB[i] = (unsigned)(Rb * g.ldb + C) * 2u; }
    const size_t kstep = (size_t)(BK * 2);
    const size_t hstepA = (size_t)HALF * g.lda * 2, hstepB = (size_t)HALF * g.ldb * 2;
    const unsigned ldsw = (unsigned)wid * 1024u;
    const int aoff = lds_byte(wr * 64 + fr, fq * 8), boff = lds_byte(wc * 32 + fr, fq * 8);
#define PG8_SA(b, h) (((b) * 2 + (h)) * HTB)
#define PG8_SB(b, h) ((4 + (b) * 2 + (h)) * HTB)
#define PG8_STAGE(bufoff, gbase, voff) do { _Pragma("unroll") for (int _i = 0; _i < 2; ++_i) \
        __builtin_amdgcn_global_load_lds((const unsigned*)((const char*)(gbase) + (voff)[_i]), (LAS unsigned*)(lds + (bufoff) + ldsw + _i * 8192), 16, 0, 0); } while (0)
#define PG8_LDA(dst, b, h) do { _Pragma("unroll") for (int m = 0; m < 4; ++m) _Pragma("unroll") for (int k = 0; k < 2; ++k) dst[m][k] = *(const LAS bf16x8*)(lds + PG8_SA(b, h) + aoff + m * 2048 + k * 1024); } while (0)
#define PG8_LDB(dst, b, h) do { _Pragma("unroll") for (int n = 0; n < 2; ++n) _Pragma("unroll") for (int k = 0; k < 2; ++k) dst[n][k] = *(const LAS bf16x8*)(lds + PG8_SB(b, h) + boff + n * 2048 + k * 1024); } while (0)
#define PG8_MMA(ai, bj, At, Bt) do { __builtin_amdgcn_s_setprio(1); _Pragma("unroll") for (int m = 0; m < 4; ++m) _Pragma("unroll") for (int n = 0; n < 2; ++n) _Pragma("unroll") for (int k = 0; k < 2; ++k) \
        acc[ai][bj][m][n] = __builtin_amdgcn_mfma_f32_16x16x32_bf16(Bt[n][k], At[m][k], acc[ai][bj][m][n], 0, 0, 0); __builtin_amdgcn_s_setprio(0); } while (0)
#define PG8_WAIT_V(n) asm volatile("s_waitcnt vmcnt(" #n ")" ::: "memory")
#define PG8_WAIT_L(n) asm volatile("s_waitcnt lgkmcnt(" #n ")" ::: "memory")
#define PG8_BAR __builtin_amdgcn_s_barrier()
#define PG8_SCHED __builtin_amdgcn_sched_barrier(0)
    Unit cur, nxt; int ui = 0;
    if (!Sch.next(0, cur)) return;
    f32x4 acc[2][2][4][2];
#pragma unroll
    for (int a = 0; a < 2; ++a)
#pragma unroll
        for (int b = 0; b < 2; ++b)
#pragma unroll
            for (int m = 0; m < 4; ++m)
#pragma unroll
                for (int n = 0; n < 2; ++n) acc[a][b][m][n] = (f32x4){0.f, 0.f, 0.f, 0.f};
    bf16x8 At[4][2], B0[2][2], B1[2][2];
    const char* cA = g.a_base(cur); const char* cB = g.b_base(cur);
    PG8_STAGE(PG8_SB(0, 0), cB, voffB); PG8_STAGE(PG8_SB(0, 1), cB + hstepB, voffB); PG8_STAGE(PG8_SA(0, 0), cA, voffA); PG8_STAGE(PG8_SA(0, 1), cA + hstepA, voffA);
    if (wr == 1) PG8_BAR;
    PG8_WAIT_V(2); PG8_BAR;
    PG8_STAGE(PG8_SB(1, 0), cB + kstep, voffB); PG8_STAGE(PG8_SA(1, 0), cA + kstep, voffA); PG8_STAGE(PG8_SB(1, 1), cB + hstepB + kstep, voffB);
    PG8_WAIT_V(6); PG8_BAR;
    for (;;) {
        const bool has_next = Sch.next(ui + 1, nxt);
        const char* nA = has_next ? g.a_base(nxt) : cA; const char* nB = has_next ? g.b_base(nxt) : cB;
        for (int t = 0; t < nt; t += 2) {
            const bool last = (t == nt - 2);
            const char* a1 = cA + (size_t)(t + 1) * kstep;
            const char* a2 = last ? nA : cA + (size_t)(t + 2) * kstep; const char* b2 = last ? nB : cB + (size_t)(t + 2) * kstep;
            const char* a3 = a2 + kstep; const char* b3 = b2 + kstep;
            PG8_LDB(B0, 0, 0); PG8_LDB(B1, 0, 1); PG8_SCHED; PG8_LDA(At, 0, 0); PG8_STAGE(PG8_SA(1, 1), a1 + hstepA, voffA);
            PG8_WAIT_V(8); PG8_WAIT_L(0); PG8_BAR; PG8_MMA(0, 0, At, B0); PG8_MMA(0, 1, At, B1); PG8_BAR; PG8_SCHED;
            PG8_LDA(At, 0, 1); PG8_STAGE(PG8_SB(0, 0), b2, voffB); PG8_STAGE(PG8_SB(0, 1), b2 + hstepB, voffB); PG8_STAGE(PG8_SA(0, 0), a2, voffA);
            PG8_WAIT_V(8); PG8_WAIT_L(0); PG8_BAR; PG8_MMA(1, 0, At, B0); PG8_MMA(1, 1, At, B1); PG8_BAR; PG8_SCHED;
            PG8_LDB(B0, 1, 0); PG8_LDB(B1, 1, 1); PG8_SCHED; PG8_LDA(At, 1, 0); PG8_STAGE(PG8_SA(0, 1), a2 + hstepA, voffA);
            PG8_WAIT_V(8); PG8_WAIT_L(0); PG8_BAR; PG8_MMA(0, 0, At, B0); PG8_MMA(0, 1, At, B1); PG8_BAR; PG8_SCHED;
            PG8_LDA(At, 1, 1); PG8_STAGE(PG8_SB(1, 0), b3, voffB); PG8_STAGE(PG8_SB(1, 1), b3 + hstepB, voffB); PG8_STAGE(PG8_SA(1, 0), a3, voffA);
            PG8_WAIT_V(8); PG8_WAIT_L(0); PG8_BAR; PG8_MMA(1, 0, At, B0); PG8_MMA(1, 1, At, B1); PG8_BAR; PG8_SCHED;
        }
        if (wr == 0) PG8_BAR;
        E(acc, cur, wr, wc, fr, fq);
        if (!has_next) break;
#pragma unroll
        for (int a = 0; a < 2; ++a)
#pragma unroll
            for (int b = 0; b < 2; ++b)
#pragma unroll
                for (int m = 0; m < 4; ++m)
#pragma unroll
                    for (int n = 0; n < 2; ++n) acc[a][b][m][n] = (f32x4){0.f, 0.f, 0.f, 0.f};
        cur = nxt; cA = nA; cB = nB; ++ui;
        if (wr == 1) PG8_BAR;
    }
    PG8_WAIT_V(0);
    PG8_BAR;
#undef PG8_SA
#undef PG8_SB
#undef PG8_STAGE
#undef PG8_LDA
#undef PG8_LDB
#undef PG8_MMA
#undef PG8_WAIT_V
#undef PG8_WAIT_L
#undef PG8_BAR
#undef PG8_SCHED
}
}
constexpr size_t MiB = 1u << 20;
constexpr size_t WS_CTL = 0;
constexpr size_t WS_WIN = 2 * MiB;
constexpr size_t WS_WKR = 6 * MiB;
constexpr size_t WS_WUQ = 7 * MiB;
constexpr size_t WS_WUKV = 8 * MiB;
constexpr size_t WS_WO = 9 * MiB;
constexpr size_t WS_WQ = 11 * MiB;
constexpr size_t WS_KEYS = 15 * MiB;
constexpr size_t WS_ROPE = 16 * MiB;
constexpr size_t WS_U = 18 * MiB;
constexpr size_t WS_V = 50 * MiB;
constexpr size_t WS_SSQ1 = 82 * MiB;
constexpr size_t WS_SSQ2 = 84 * MiB;
constexpr size_t WS_XN = 96 * MiB;
constexpr size_t WS_MIX = WS_XN;
constexpr size_t WS_QA = 160 * MiB, WS_KA = 192 * MiB, WS_VA = 224 * MiB;
constexpr size_t WS_X2B = 160 * MiB;
constexpr size_t WS_CQ = 256 * MiB, WS_CKV = 272 * MiB;
constexpr size_t WS_KR = 288 * MiB;
constexpr size_t WS_QB = 292 * MiB;
constexpr size_t WS_KN = 340 * MiB, WS_VB = 372 * MiB;
constexpr size_t WS_X2 = 292 * MiB;
constexpr size_t WS_END_OPT = 420 * MiB;
constexpr size_t DO_OP = 0, DO_LSE = 96 * MiB;

struct Args { const float* in[15]; float* out; unsigned char* ws; int ph_lo, ph_hi; };

struct Frame {
    LAS unsigned char* lds;
    int tid, lane, wave, vcu, G;
    const float* in[15]; float* out; unsigned char* ws;
};

__device__ __forceinline__ float wave_sum(float v) {
#pragma unroll
    for (int o = 1; o < 64; o <<= 1) v += __shfl_xor(v, o);
    return v;
}

__device__ __forceinline__ int perm_win(int np) {
    if (np < 1024) { const int hb = np & ~63, p = np & 63; return hb + (p >> 1) + ((p & 1) << 5); }
    return np;
}
__device__ __forceinline__ int perm_wkr(int np) { return 2048 + (np >> 1) + ((np & 1) << 4); }
__device__ __forceinline__ int perm_wuq(int np) { const int h = np / 96, p = np % 96; if (p < 64) return np; const int q = p - 64; return h * 96 + 64 + (q >> 1) + ((q & 1) << 4); }

template <int PERM>
__device__ __forceinline__ void transpose_item(const float* __restrict__ W, int K, int N, const float* __restrict__ gk, bf16_t* __restrict__ WT, int row_off, LAS float* scr, int item, int nblk, int lane) {
    const int kb = item / nblk, nb = item % nblk, k0 = 64 * kb, n0 = 32 * nb;
    const int npx = n0 + (lane & 31);
    const int nl = PERM == 1 ? perm_win(npx) : PERM == 2 ? perm_wkr(npx) : PERM == 3 ? perm_wuq(npx) : npx;
#pragma unroll 8
    for (int i = 0; i < 32; ++i) { const int kk = 2 * i + (lane >> 5); float v = W[(size_t)(k0 + kk) * N + nl]; if (gk) v *= gk[k0 + kk]; scr[kk * 33 + (lane & 31)] = v; }
    asm volatile("s_waitcnt lgkmcnt(0)" ::: "memory");
    const int c = lane & 7;
#pragma unroll
    for (int j = 0; j < 4; ++j) { const int n = (lane >> 3) + 8 * j; const LAS float* s = scr + (8 * c) * 33 + n;
        u32x4 o; o.x = cvtpk(s[0 * 33], s[1 * 33]); o.y = cvtpk(s[2 * 33], s[3 * 33]); o.z = cvtpk(s[4 * 33], s[5 * 33]); o.w = cvtpk(s[6 * 33], s[7 * 33]);
        *(u32x4*)(WT + (size_t)(row_off + n0 + n) * K + k0 + 8 * c) = o; }
    asm volatile("s_waitcnt lgkmcnt(0)" ::: "memory");
}

__device__ __forceinline__ void p0_prologue(Frame& F) {
    LAS float* scr = (LAS float*)(F.lds + F.wave * 16384);
    const int gw = F.vcu * 8 + F.wave, NGW = F.G * 8, lane = F.lane;
    unsigned char* ws = F.ws;
    constexpr int I_WIN = (1024 / 64) * (2048 / 32), I_WKR = (1024 / 64) * 1, I_WUQ = (256 / 64) * (768 / 32), I_WUK = (256 / 64) * (512 / 32), I_WO = (1024 / 64) * (1024 / 32), I_WQ = (1024 / 64) * (2048 / 32);
    constexpr int NIT = I_WIN + I_WKR + I_WUQ + 2 * I_WUK + I_WO + I_WQ;
    for (int it = gw; it < NIT; it += NGW) {
        int r = it;
        if (r < I_WIN) { transpose_item<1>(F.in[2], 1024, 2080, nullptr, (bf16_t*)(ws + WS_WIN), 0, scr, r, 2048 / 32, lane); continue; } r -= I_WIN;
        if (r < I_WKR) { transpose_item<2>(F.in[2], 1024, 2080, nullptr, (bf16_t*)(ws + WS_WKR), 0, scr, r, 1, lane); continue; } r -= I_WKR;
        if (r < I_WUQ) { transpose_item<3>(F.in[5], 256, 768, F.in[3], (bf16_t*)(ws + WS_WUQ), 0, scr, r, 768 / 32, lane); continue; } r -= I_WUQ;
        if (r < I_WUK) { transpose_item<0>(F.in[6], 256, 512, F.in[4], (bf16_t*)(ws + WS_WUKV), 0, scr, r, 512 / 32, lane); continue; } r -= I_WUK;
        if (r < I_WUK) { transpose_item<0>(F.in[7], 256, 512, F.in[4], (bf16_t*)(ws + WS_WUKV), 512, scr, r, 512 / 32, lane); continue; } r -= I_WUK;
        if (r < I_WO) { transpose_item<0>(F.in[8], 1024, 1024, nullptr, (bf16_t*)(ws + WS_WO), 0, scr, r, 1024 / 32, lane); continue; } r -= I_WO;
        transpose_item<0>(F.in[10], 1024, 2048, F.in[9], (bf16_t*)(ws + WS_WQ), 0, scr, r, 2048 / 32, lane);
    }
    {
        const float* g = F.in[1];
        f32x4 gg[4];
#pragma unroll
        for (int j = 0; j < 4; ++j) gg[j] = *(const f32x4*)(g + 256 * j + 4 * lane);
        auto ldrow = [&](int r, f32x4 (&v)[4]) { const float* sp = F.in[0] + (size_t)(r < M ? r : gw) * 1024;
#pragma unroll
            for (int j = 0; j < 4; ++j) v[j] = *(const f32x4*)(sp + 256 * j + 4 * lane); };
        f32x4 va[4], vb[4], na[4], nb[4];
        ldrow(gw, va); ldrow(gw + NGW, vb);
        for (int r0 = gw; r0 < M; r0 += 2 * NGW) {
            const int r1 = r0 + NGW; const bool two = r1 < M;
            ldrow(r0 + 2 * NGW, na); ldrow(r1 + 2 * NGW, nb);
            float ssa = 0.f, ssb = 0.f;
#pragma unroll
            for (int j = 0; j < 4; ++j) { ssa += (va[j].x * va[j].x + va[j].y * va[j].y) + (va[j].z * va[j].z + va[j].w * va[j].w); ssb += (vb[j].x * vb[j].x + vb[j].y * vb[j].y) + (vb[j].z * vb[j].z + vb[j].w * vb[j].w); }
            const float rsa = rsqrtf(wave_sum(ssa) * (1.f / 1024.f) + NORM_EPS), rsb = rsqrtf(wave_sum(ssb) * (1.f / 1024.f) + NORM_EPS);
            bf16_t* da = (bf16_t*)(ws + WS_XN) + (size_t)r0 * 1024; bf16_t* db = (bf16_t*)(ws + WS_XN) + (size_t)r1 * 1024;
#pragma unroll
            for (int j = 0; j < 4; ++j) {
                u32x2 o; o.x = cvtpk(va[j].x * rsa * gg[j].x, va[j].y * rsa * gg[j].y); o.y = cvtpk(va[j].z * rsa * gg[j].z, va[j].w * rsa * gg[j].w);
                *(u32x2*)(da + 256 * j + 4 * lane) = o;
                if (two) { u32x2 p; p.x = cvtpk(vb[j].x * rsb * gg[j].x, vb[j].y * rsb * gg[j].y); p.y = cvtpk(vb[j].z * rsb * gg[j].z, vb[j].w * rsb * gg[j].w); *(u32x2*)(db + 256 * j + 4 * lane) = p; } }
#pragma unroll
            for (int j = 0; j < 4; ++j) { va[j] = na[j]; vb[j] = nb[j]; }
        }
    }
    {
        const int gt = F.vcu * 512 + F.tid, NT = F.G * 512;
        for (int i = gt; i < 262144 / 8; i += NT) { const f32x4 a = *(const f32x4*)(F.in[11] + (size_t)i * 8), b = *(const f32x4*)(F.in[11] + (size_t)i * 8 + 4);
            u32x4 o; o.x = cvtpk(a.x, a.y); o.y = cvtpk(a.z, a.w); o.z = cvtpk(b.x, b.y); o.w = cvtpk(b.z, b.w); *(u32x4*)((bf16_t*)(ws + WS_KEYS) + (size_t)i * 8) = o; }
        float* CA = (float*)(ws + WS_ROPE); float* SA = CA + 4096 * 32; float* CB = SA + 4096 * 32; float* SB = CB + 4096 * 16;
        for (int i = gt; i < 4096 * 32; i += NT) { const int pos = i >> 5, k = i & 31; const float inv = 1.0f / powf(10000.0f, (float)(2 * k) / 64.0f); const float ang = (float)pos * inv; CA[i] = cosf(ang); SA[i] = sinf(ang); }
        for (int i = gt; i < 4096 * 16; i += NT) { const int pos = i >> 4, k = i & 15; const float inv = 1.0f / powf(10000.0f, (float)(2 * k) / 32.0f); const float ang = (float)pos * inv; CB[i] = cosf(ang); SB[i] = sinf(ang); }
    }
}

struct GemmPlain {
    const bf16_t* A; const bf16_t* Bt; int K, lda, ldb;
    __device__ __forceinline__ const char* a_base(const pg8::Unit& u) const { return (const char*)(A + (size_t)u.pm * 256 * lda); }
    __device__ __forceinline__ const char* b_base(const pg8::Unit& u) const { return (const char*)(Bt + (size_t)u.pn * 256 * ldb); }
};
struct GemmUp {
    const bf16_t* CQ; const bf16_t* CKV; const bf16_t* WUQ; const bf16_t* WUKV; int K, lda, ldb;
    __device__ __forceinline__ const char* a_base(const pg8::Unit& u) const { return (const char*)((u.pn < 3 ? CQ : CKV) + (size_t)u.pm * 256 * 256); }
    __device__ __forceinline__ const char* b_base(const pg8::Unit& u) const { return (const char*)(u.pn < 3 ? WUQ + (size_t)u.pn * 256 * 256 : WUKV + (size_t)(u.pn - 3) * 256 * 256); }
};

__device__ __forceinline__ void rope4(f32x4& v0, f32x4& v1, const f32x4 cs, const f32x4 sn) {
    const f32x4 a = v0, b = v1;
    v0.x = a.x * cs.x - a.y * sn.x; v0.y = a.y * cs.x + a.x * sn.x; v0.z = a.z * cs.y - a.w * sn.y; v0.w = a.w * cs.y + a.z * sn.y;
    v1.x = b.x * cs.z - b.y * sn.z; v1.y = b.y * cs.z + b.x * sn.z; v1.z = b.z * cs.w - b.w * sn.w; v1.w = b.w * cs.w + b.z * sn.w;
}
__device__ __forceinline__ void store8(bf16_t* p, const f32x4 v0, const f32x4 v1) { u32x4 w; w.x = cvtpk(v0.x, v0.y); w.y = cvtpk(v0.z, v0.w); w.z = cvtpk(v1.x, v1.y); w.w = cvtpk(v1.z, v1.w); *(u32x4*)p = w; }
__device__ __forceinline__ float dot4(const f32x4 v) { return (v.x * v.x + v.y * v.y) + (v.z * v.z + v.w * v.w); }

struct EpiP1 {
    static constexpr bool PERM = true;
    bf16_t *QA, *KA, *VA, *CQ, *CKV; float* SSQ1; const float *CA, *SA;
    __device__ __forceinline__ void operator()(const f32x4 (&acc)[2][2][4][2], const pg8::Unit& u, int wr, int wc, int fr, int fq) const {
        const int pn = u.pn, row0 = u.pm * 256 + wr * 64 + fr, cw = wc * 32 + 8 * fq;
        if (pn < 4) {
            bf16_t* base = pn < 2 ? QA : KA; const float sc = pn < 2 ? QSCALE_A : 1.f; const int colt = (pn & 1) * 256 + cw;
#pragma unroll
            for (int ai = 0; ai < 2; ++ai)
#pragma unroll
                for (int m = 0; m < 4; ++m) { const int row = row0 + ai * 128 + m * 16, pos = row & (S - 1);
#pragma unroll
                    for (int bj = 0; bj < 2; ++bj) { const int col = colt + bj * 128, i0 = (col & 63) >> 1;
                        const f32x4 cs = *(const f32x4*)(CA + pos * 32 + i0), sn = *(const f32x4*)(SA + pos * 32 + i0);
                        f32x4 v0 = acc[ai][bj][m][0] * sc, v1 = acc[ai][bj][m][1] * sc; rope4(v0, v1, cs, sn);
                        store8(base + (size_t)row * 512 + col, v0, v1); } }
        } else if (pn < 6) {
            const int colt = (pn & 1) * 256 + cw;
#pragma unroll
            for (int ai = 0; ai < 2; ++ai)
#pragma unroll
                for (int m = 0; m < 4; ++m) { const int row = row0 + ai * 128 + m * 16;
#pragma unroll
                    for (int bj = 0; bj < 2; ++bj) store8(VA + (size_t)row * 512 + colt + bj * 128, acc[ai][bj][m][0], acc[ai][bj][m][1]); }
        } else {
            bf16_t* base = pn == 6 ? CQ : CKV;
#pragma unroll
            for (int ai = 0; ai < 2; ++ai)
#pragma unroll
                for (int m = 0; m < 4; ++m) { const int row = row0 + ai * 128 + m * 16; float s = 0.f;
#pragma unroll
                    for (int bj = 0; bj < 2; ++bj) { store8(base + (size_t)row * 256 + cw + bj * 128, acc[ai][bj][m][0], acc[ai][bj][m][1]); s += dot4(acc[ai][bj][m][0]) + dot4(acc[ai][bj][m][1]); }
                    s += __shfl_xor(s, 16); s += __shfl_xor(s, 32);
                    if (fq == 0) SSQ1[(size_t)row * 8 + (pn - 6) * 4 + wc] = s; }
        }
    }
};
struct EpiP2 {
    static constexpr bool PERM = true;
    bf16_t *QB, *KN, *VB; const float* SSQ1; const float *CB, *SB;
    __device__ __forceinline__ void operator()(const f32x4 (&acc)[2][2][4][2], const pg8::Unit& u, int wr, int wc, int fr, int fq) const {
        const int pn = u.pn, row0 = u.pm * 256 + wr * 64 + fr, cw = wc * 32 + 8 * fq, grp = pn < 3 ? 0 : 1;
#pragma unroll
        for (int ai = 0; ai < 2; ++ai)
#pragma unroll
            for (int m = 0; m < 4; ++m) { const int row = row0 + ai * 128 + m * 16, pos = row & (S - 1);
                const f32x4 sq = *(const f32x4*)(SSQ1 + (size_t)row * 8 + grp * 4);
                const float rs = rsqrtf(((sq.x + sq.y) + (sq.z + sq.w)) * (1.f / 256.f) + NORM_EPS);
                if (pn < 3) {
#pragma unroll
                    for (int bj = 0; bj < 2; ++bj) { const int col = pn * 256 + bj * 128 + cw, p = col % 96; const float sc = rs * QSCALE_B;
                        f32x4 v0 = acc[ai][bj][m][0] * sc, v1 = acc[ai][bj][m][1] * sc;
                        if (p >= 64) { const int i0 = (p - 64) >> 1; const f32x4 cs = *(const f32x4*)(CB + pos * 16 + i0), sn = *(const f32x4*)(SB + pos * 16 + i0); rope4(v0, v1, cs, sn); }
                        store8(QB + (size_t)row * 768 + col, v0, v1); }
                } else {
                    bf16_t* base = pn < 5 ? KN : VB; const int colt = ((pn - 3) & 1) * 256 + cw;
#pragma unroll
                    for (int bj = 0; bj < 2; ++bj) store8(base + (size_t)row * 512 + colt + bj * 128, acc[ai][bj][m][0] * rs, acc[ai][bj][m][1] * rs);
                }
            }
    }
};
struct EpiP4 {
    static constexpr bool PERM = true;
    const float* X; bf16_t* X2B; float* SSQ2;
    __device__ __forceinline__ void operator()(const f32x4 (&acc)[2][2][4][2], const pg8::Unit& u, int wr, int wc, int fr, int fq) const {
        const int row0 = u.pm * 256 + wr * 64 + fr, colt = u.pn * 256 + wc * 32 + 8 * fq;
#pragma unroll
        for (int ai = 0; ai < 2; ++ai)
#pragma unroll
            for (int m = 0; m < 4; ++m) { const int row = row0 + ai * 128 + m * 16; float s = 0.f;
#pragma unroll
                for (int bj = 0; bj < 2; ++bj) { const size_t off = (size_t)row * 1024 + colt + bj * 128;
                    const f32x4 v0 = acc[ai][bj][m][0] + *(const f32x4*)(X + off), v1 = acc[ai][bj][m][1] + *(const f32x4*)(X + off + 4);
                    store8(X2B + off, v0, v1); s += dot4(v0) + dot4(v1); }
                s += __shfl_xor(s, 16); s += __shfl_xor(s, 32);
                if (fq == 0) SSQ2[(size_t)row * 16 + u.pn * 4 + wc] = s; }
    }
};
struct EpiP5 {
    static constexpr bool PERM = true;
    bf16_t* QP; const float* SSQ2;
    __device__ __forceinline__ void operator()(const f32x4 (&acc)[2][2][4][2], const pg8::Unit& u, int wr, int wc, int fr, int fq) const {
        const int row0 = u.pm * 256 + wr * 64 + fr, colt = u.pn * 256 + wc * 32 + 8 * fq;
#pragma unroll
        for (int ai = 0; ai < 2; ++ai)
#pragma unroll
            for (int m = 0; m < 4; ++m) { const int row = row0 + ai * 128 + m * 16;
                const f32x4* sp = (const f32x4*)(SSQ2 + (size_t)row * 16); const f32x4 a = sp[0], b = sp[1], c = sp[2], d = sp[3];
                const float ss = ((a.x + a.y) + (a.z + a.w)) + ((b.x + b.y) + (b.z + b.w)) + ((c.x + c.y) + (c.z + c.w)) + ((d.x + d.y) + (d.z + d.w));
                const float rs = rsqrtf(ss * (1.f / 1024.f) + NORM_EPS);
#pragma unroll
                for (int bj = 0; bj < 2; ++bj) store8(QP + (size_t)row * 2048 + colt + bj * 128, acc[ai][bj][m][0] * rs, acc[ai][bj][m][1] * rs); }
    }
};

__device__ __forceinline__ void p1_krope(Frame& F) {
    const bf16_t* XN = (const bf16_t*)(F.ws + WS_XN); const bf16_t* WK = (const bf16_t*)(F.ws + WS_WKR); bf16_t* KR = (bf16_t*)(F.ws + WS_KR);
    const float* CB = (const float*)(F.ws + WS_ROPE) + 2 * 4096 * 32; const float* SB = CB + 4096 * 16;
    const int lane = F.lane, fr = lane & 15, fq = lane >> 4;
    for (int blk = F.vcu; blk < M / 128; blk += F.G) {
        const int row0 = blk * 128 + F.wave * 16;
        f32x4 c0 = {0.f, 0.f, 0.f, 0.f}, c1 = {0.f, 0.f, 0.f, 0.f};
        const bf16_t* ap = XN + (size_t)(row0 + fr) * 1024 + 8 * fq;
        const bf16_t* b0p = WK + (size_t)fr * 1024 + 8 * fq; const bf16_t* b1p = WK + (size_t)(16 + fr) * 1024 + 8 * fq;
#pragma unroll 4
        for (int ks = 0; ks < 32; ++ks) {
            const bf16x8 a = *(const bf16x8*)(ap + ks * 32), b0 = *(const bf16x8*)(b0p + ks * 32), b1 = *(const bf16x8*)(b1p + ks * 32);
            c0 = __builtin_amdgcn_mfma_f32_16x16x32_bf16(b0, a, c0, 0, 0, 0);
            c1 = __builtin_amdgcn_mfma_f32_16x16x32_bf16(b1, a, c1, 0, 0, 0);
        }
        const int row = row0 + fr, pos = row & (S - 1);
        u32x2 w0, w1;
        { const int i = 2 * fq; const float ca = CB[pos * 16 + i], sa = SB[pos * 16 + i], cb = CB[pos * 16 + i + 1], sb = SB[pos * 16 + i + 1];
          w0.x = cvtpk(c0.x * ca - c0.y * sa, c0.y * ca + c0.x * sa); w0.y = cvtpk(c0.z * cb - c0.w * sb, c0.w * cb + c0.z * sb); }
        { const int i = 8 + 2 * fq; const float ca = CB[pos * 16 + i], sa = SB[pos * 16 + i], cb = CB[pos * 16 + i + 1], sb = SB[pos * 16 + i + 1];
          w1.x = cvtpk(c1.x * ca - c1.y * sa, c1.y * ca + c1.x * sa); w1.y = cvtpk(c1.z * cb - c1.w * sb, c1.w * cb + c1.z * sb); }
        *(u32x2*)(KR + (size_t)row * 32 + 4 * fq) = w0; *(u32x2*)(KR + (size_t)row * 32 + 16 + 4 * fq) = w1;
    }
}
constexpr int AT_SLOT = 20480, AT_KB = 0, AT_VB = 12288;
__device__ __forceinline__ int crow(int r, int hi) { return (r & 3) + 8 * (r >> 2) + 4 * hi; }
__device__ __forceinline__ s16x4 vtr(const LAS unsigned char* p) { return __builtin_bit_cast(s16x4, __builtin_amdgcn_ds_read_tr16_b64_v4i16((LAS s16x4*)p)); }

constexpr float RESC_THR = 8.f;
__device__ __forceinline__ float max3f(float a, float b, float c) { float r; asm("v_max3_f32 %0, %1, %2, %3" : "=v"(r) : "v"(a), "v"(b), "v"(c)); return r; }
template <int NKS>
struct AttnCore {
    bf16x8 qr[NKS]; f32x16 o0, o1, negm; float m, l; bool fresh;
    __device__ __forceinline__ void init() { m = 0.f; l = 0.f; fresh = true;
#pragma unroll
        for (int r = 0; r < 16; ++r) { o0[r] = 0.f; o1[r] = 0.f; negm[r] = 0.f; } }
    template <class MaskF>
    __device__ __forceinline__ void tile(const LAS unsigned char* slot, int lane, bool need_mask, const MaskF& valid) {
        const int r32 = lane & 31, hi = lane >> 5;
        f32x16 p0, p1;
        const LAS unsigned char* kn = slot + AT_KB + r32 * 128; const LAS unsigned char* kr = slot + AT_KB + 8192 + r32 * 64;
#pragma unroll
        for (int d0 = 0; d0 < NKS; ++d0) {
            bf16x8 b0, b1;
            if (d0 < 4) { const int po = ((2 * d0 + hi) ^ ((r32 >> 1) & 7)) * 16; b0 = *(const LAS bf16x8*)(kn + po); b1 = *(const LAS bf16x8*)(kn + 4096 + po); }
            else { const int po = ((2 * (d0 - 4) + hi) ^ ((r32 >> 2) & 3)) * 16; b0 = *(const LAS bf16x8*)(kr + po); b1 = *(const LAS bf16x8*)(kr + 2048 + po); }
            if (d0 == 0) { p0 = __builtin_amdgcn_mfma_f32_32x32x16_bf16(b0, qr[0], negm, 0, 0, 0); p1 = __builtin_amdgcn_mfma_f32_32x32x16_bf16(b1, qr[0], negm, 0, 0, 0); }
            else { p0 = __builtin_amdgcn_mfma_f32_32x32x16_bf16(b0, qr[d0], p0, 0, 0, 0); p1 = __builtin_amdgcn_mfma_f32_32x32x16_bf16(b1, qr[d0], p1, 0, 0, 0); }
        }
        if (need_mask) {
#pragma unroll
            for (int r = 0; r < 16; ++r) { const int kk = crow(r, hi); if (!valid(kk)) p0[r] = -INFINITY; if (!valid(kk + 32)) p1[r] = -INFINITY; }
        }
        float ma = max3f(p0[0], p0[1], p1[0]), mb = max3f(p0[2], p0[3], p1[1]);
        ma = max3f(ma, p1[2], p1[3]);
#pragma unroll
        for (int r = 4; r < 16; r += 4) { ma = max3f(ma, p0[r], p0[r + 1]); mb = max3f(mb, p0[r + 2], p0[r + 3]); ma = max3f(ma, p1[r], p1[r + 1]); mb = max3f(mb, p1[r + 2], p1[r + 3]); }
        float dx = fmaxf(ma, mb);
        dx = fmaxf(dx, __shfl_xor(dx, 32));
        if (fresh || __any(dx > RESC_THR)) {
            const float dl = fresh ? fmaxf(dx, -100.f) : fmaxf(dx, 0.f), alpha = __builtin_amdgcn_exp2f(-dl);
            fresh = false;
            m += dl; l *= alpha;
#pragma unroll
            for (int r = 0; r < 16; ++r) { o0[r] *= alpha; o1[r] *= alpha; p0[r] -= dl; p1[r] -= dl; negm[r] = -m; }
        }
        float sa = 0.f, sb = 0.f, sc = 0.f, sd = 0.f;
#pragma unroll
        for (int r = 0; r < 16; r += 2) { p0[r] = __builtin_amdgcn_exp2f(p0[r]); p0[r + 1] = __builtin_amdgcn_exp2f(p0[r + 1]); p1[r] = __builtin_amdgcn_exp2f(p1[r]); p1[r + 1] = __builtin_amdgcn_exp2f(p1[r + 1]);
            sa += p0[r]; sb += p0[r + 1]; sc += p1[r]; sd += p1[r + 1]; }
        l += (sa + sb) + (sc + sd);
        u32x4 pw[4];
        pw[0] = (u32x4){cvtpk(p0[0], p0[1]), cvtpk(p0[2], p0[3]), cvtpk(p0[4], p0[5]), cvtpk(p0[6], p0[7])};
        pw[1] = (u32x4){cvtpk(p0[8], p0[9]), cvtpk(p0[10], p0[11]), cvtpk(p0[12], p0[13]), cvtpk(p0[14], p0[15])};
        pw[2] = (u32x4){cvtpk(p1[0], p1[1]), cvtpk(p1[2], p1[3]), cvtpk(p1[4], p1[5]), cvtpk(p1[6], p1[7])};
        pw[3] = (u32x4){cvtpk(p1[8], p1[9]), cvtpk(p1[10], p1[11]), cvtpk(p1[12], p1[13]), cvtpk(p1[14], p1[15])};
        const int vq = 4 * hi + ((lane & 15) >> 2), vsw = ((vq >> 1) & 1) * 4, vx = 2 * ((lane >> 4) & 1) + ((lane & 3) >> 1);
        const LAS unsigned char* vb0 = slot + AT_VB + vq * 128 + ((vx ^ vsw) * 16) + 8 * (lane & 1);
        const LAS unsigned char* vb1 = slot + AT_VB + vq * 128 + (((4 + vx) ^ vsw) * 16) + 8 * (lane & 1);
#pragma unroll
        for (int s = 0; s < 4; ++s) {
            const s16x4 lo0 = vtr(vb0 + s * 2048), hi0 = vtr(vb0 + s * 2048 + 1024), lo1 = vtr(vb1 + s * 2048), hi1 = vtr(vb1 + s * 2048 + 1024);
            const bf16x8 v0 = {lo0[0], lo0[1], lo0[2], lo0[3], hi0[0], hi0[1], hi0[2], hi0[3]}, v1 = {lo1[0], lo1[1], lo1[2], lo1[3], hi1[0], hi1[1], hi1[2], hi1[3]};
            const bf16x8 pb = __builtin_bit_cast(bf16x8, pw[s]);
            o0 = __builtin_amdgcn_mfma_f32_32x32x16_bf16(v0, pb, o0, 0, 0, 0);
            o1 = __builtin_amdgcn_mfma_f32_32x32x16_bf16(v1, pb, o1, 0, 0, 0);
        }
    }
    __device__ __forceinline__ float ltot() const { return l + __shfl_xor(l, 32); }
};

__device__ __forceinline__ void glds16(const void* gsrc, LAS unsigned char* dst) { __builtin_amdgcn_global_load_lds((const unsigned*)gsrc, (LAS unsigned*)dst, 16, 0, 0); }

struct DilUnit { int b, h, pat, dl, res, u2, m0; size_t rowb; };
__device__ __forceinline__ DilUnit dil_decode(int e) {
    DilUnit u; const int bh = e / 48, rem = e % 48; u.pat = rem >> 4; const int idx = rem & 15; u.b = bh >> 3; u.h = bh & 7;
    u.dl = u.pat * 2; const int nb2 = 16 >> u.dl; u.res = idx / nb2; u.u2 = idx % nb2; u.m0 = u.u2 * 256; u.rowb = (size_t)u.b * S; return u;
}
__device__ __forceinline__ void p3a_dilated(Frame& F) {
    const bf16_t* QA = (const bf16_t*)(F.ws + WS_QA); const bf16_t* KA = (const bf16_t*)(F.ws + WS_KA); const bf16_t* VA = (const bf16_t*)(F.ws + WS_VA);
    bf16_t* OP = (bf16_t*)((unsigned char*)F.out + DO_OP); float* LSE = (float*)((unsigned char*)F.out + DO_LSE);
    const int lane = F.lane, w = F.wave, r32 = lane & 31, hi = lane >> 5, ow = w >> 1;
    constexpr int UPC = 12, NSTEP = 3 * UPC + 3;
    for (int v = F.vcu; v < 3072 / UPC; v += F.G) {
        const int e0 = v * UPC;
        auto issue = [&](int k, int j, int par, int which) {
            const DilUnit u = dil_decode(e0 + k);
            if (u.u2 == 0 && j < 2) return;
            const int mk0 = u.m0 - 128 + 64 * j; LAS unsigned char* slot = F.lds + (par * 2 + which) * AT_SLOT;
            const size_t krow = u.rowb + ((size_t)(mk0 + 8 * w + (lane >> 3)) << u.dl) + u.res;
            glds16(KA + krow * 512 + u.h * 64 + (((lane & 7) ^ ((4 * w + (lane >> 4)) & 7)) * 8), slot + AT_KB + w * 1024);
            glds16(VA + krow * 512 + u.h * 64 + (((lane & 7) ^ (((lane >> 4) & 1) * 4)) * 8), slot + AT_VB + w * 1024);
        };
        auto qptr = [&](int k) { const DilUnit u = dil_decode(e0 + k); const size_t qrow = u.rowb + ((size_t)(u.m0 + 32 * w + r32) << u.dl) + u.res; return QA + qrow * 512 + u.h * 64 + hi * 8; };
        AttnCore<4> A; A.init();
        bf16x8 qn[4];
        { const bf16_t* qp = qptr(0);
#pragma unroll
          for (int d0 = 0; d0 < 4; ++d0) qn[d0] = *(const bf16x8*)(qp + d0 * 16); }
        issue(0, 0, 0, 0);
        for (int g = 0; g < NSTEP; ++g) {
            asm volatile("s_waitcnt vmcnt(0)" ::: "memory");
            __syncthreads();
            { const int gn = g + 1, kb = gn / 3, jb = gn % 3;
              if (gn < NSTEP) { if (kb < UPC) issue(kb, jb, gn & 1, 0); if (kb >= 1 && kb - 1 < UPC) issue(kb - 1, jb + 3, gn & 1, 1); } }
            if (g >= ow) {
                const int k = (g - ow) / 3, j = g - 3 * k;
                if (k < UPC) {
                    const DilUnit u = dil_decode(e0 + k);
                    const int mq = u.m0 + 32 * w + r32;
                    if (j == ow) { A.init();
#pragma unroll
                        for (int d0 = 0; d0 < 4; ++d0) A.qr[d0] = qn[d0]; }
                    if (!(u.u2 == 0 && j < 2)) {
                        const int mk0 = u.m0 - 128 + 64 * j;
                        const LAS unsigned char* slot = F.lds + ((g & 1) * 2 + (j >= 3 ? 1 : 0)) * AT_SLOT;
                        A.tile(slot, lane, j != ow + 1, [&](int kk) { return (unsigned)(mq - mk0 - kk) <= 128u; });
                    }
                    if (j == ow + 2) {
                        const size_t qrow = u.rowb + ((size_t)mq << u.dl) + u.res;
                        const float lt = A.ltot(), inv = 1.f / lt;
                        bf16_t* orow = OP + ((size_t)u.pat * M + qrow) * 512 + u.h * 64;
#pragma unroll
                        for (int gq = 0; gq < 4; ++gq) {
                            u32x2 w0 = {cvtpk(A.o0[4 * gq] * inv, A.o0[4 * gq + 1] * inv), cvtpk(A.o0[4 * gq + 2] * inv, A.o0[4 * gq + 3] * inv)};
                            u32x2 w1 = {cvtpk(A.o1[4 * gq] * inv, A.o1[4 * gq + 1] * inv), cvtpk(A.o1[4 * gq + 2] * inv, A.o1[4 * gq + 3] * inv)};
                            *(u32x2*)(orow + 8 * gq + 4 * hi) = w0; *(u32x2*)(orow + 32 + 8 * gq + 4 * hi) = w1;
                        }
                        if (hi == 0) LSE[((size_t)u.pat * M + qrow) * 8 + u.h] = A.m + __builtin_amdgcn_logf(lt);
                        if (k + 1 < UPC) { const bf16_t* qp = qptr(k + 1);
#pragma unroll
                            for (int d0 = 0; d0 < 4; ++d0) qn[d0] = *(const bf16x8*)(qp + d0 * 16); }
                    }
                }
            }
        }
        __syncthreads();
    }
}

__device__ __forceinline__ void p3b_mla(Frame& F) {
    const bf16_t* QB = (const bf16_t*)(F.ws + WS_QB); const bf16_t* KN = (const bf16_t*)(F.ws + WS_KN); const bf16_t* KR = (const bf16_t*)(F.ws + WS_KR); const bf16_t* VB = (const bf16_t*)(F.ws + WS_VB);
    const bf16_t* OP = (const bf16_t*)((const unsigned char*)F.out + DO_OP); const float* LSE = (const float*)((const unsigned char*)F.out + DO_LSE);
    bf16_t* MIX = (bf16_t*)(F.ws + WS_MIX);
    const int lane = F.lane, w = F.wave, r32 = lane & 31, hi = lane >> 5;
    for (int vi = F.vcu * 4; vi < 1024; vi += ((vi & 3) == 3) ? (F.G - 1) * 4 + 1 : 1) {
        const int v = vi >> 2, i = vi & 3;
        const int bh = v >> 2, s = v & 3, qb = (i == 0) ? s : (i == 1) ? 7 - s : (i == 2) ? 8 + s : 15 - s;
        const int b = bh >> 3, h = bh & 7; const size_t rowb = (size_t)b * S;
        const int qpos = qb * 256 + 32 * w + r32; const size_t qrow = rowb + qpos;
        AttnCore<6> A; A.init();
#pragma unroll
        for (int d0 = 0; d0 < 6; ++d0) A.qr[d0] = *(const bf16x8*)(QB + qrow * 768 + h * 96 + d0 * 16 + hi * 8);
        const int NT = 4 * qb + 4;
        auto issue = [&](int t) {
            LAS unsigned char* slot = F.lds + ((((t >> 1) & 1) * 2) + (t & 1)) * AT_SLOT;
            const size_t krow = rowb + 64 * t + 8 * w + (lane >> 3);
            glds16(KN + krow * 512 + h * 64 + (((lane & 7) ^ ((4 * w + (lane >> 4)) & 7)) * 8), slot + AT_KB + w * 1024);
            if (w < 4) { const size_t rrow = rowb + 64 * t + 16 * w + (lane >> 2);
                glds16(KR + rrow * 32 + (((lane & 3) ^ ((lane >> 4) & 3)) * 8), slot + AT_KB + 8192 + w * 1024); }
            glds16(VB + krow * 512 + h * 64 + (((lane & 7) ^ (((lane >> 4) & 1) * 4)) * 8), slot + AT_VB + w * 1024);
        };
        issue(0); issue(1);
        const int qmin = qb * 256 + 32 * w;
        for (int t = 0; t < NT; t += 2) {
            __syncthreads();
            if (t + 2 < NT) { issue(t + 2); issue(t + 3); }
#pragma unroll
            for (int j = 0; j < 2; ++j) {
                const int k0 = 64 * (t + j);
                if (k0 <= qmin + 31) A.tile(F.lds + ((((t >> 1) & 1) * 2) + j) * AT_SLOT, lane, k0 + 63 > qmin, [&](int kk) { return k0 + kk <= qpos; });
            }
        }
        __syncthreads();
        const float inv = 1.f / A.ltot();
        const float l0 = LSE[((size_t)0 * M + qrow) * 8 + h], l1 = LSE[((size_t)1 * M + qrow) * 8 + h], l2 = LSE[((size_t)2 * M + qrow) * 8 + h];
        const float lm = fmaxf(l0, fmaxf(l1, l2));
        float w0 = __builtin_amdgcn_exp2f(l0 - lm), w1 = __builtin_amdgcn_exp2f(l1 - lm), w2 = __builtin_amdgcn_exp2f(l2 - lm);
        const float wi = 1.f / (w0 + w1 + w2); w0 *= wi; w1 *= wi; w2 *= wi;
        bf16_t* mrow = MIX + qrow * 1024 + h * 64;
#pragma unroll
        for (int g = 0; g < 4; ++g) {
#pragma unroll
            for (int dh = 0; dh < 2; ++dh) {
                const int dc = dh * 32 + 8 * g + 4 * hi;
                const u32x2 a0 = *(const u32x2*)(OP + ((size_t)0 * M + qrow) * 512 + h * 64 + dc), a1 = *(const u32x2*)(OP + ((size_t)1 * M + qrow) * 512 + h * 64 + dc), a2 = *(const u32x2*)(OP + ((size_t)2 * M + qrow) * 512 + h * 64 + dc);
                u32x2 oa;
                oa.x = cvtpk(w0 * bf_lo(a0.x) + w1 * bf_lo(a1.x) + w2 * bf_lo(a2.x), w0 * bf_hi(a0.x) + w1 * bf_hi(a1.x) + w2 * bf_hi(a2.x));
                oa.y = cvtpk(w0 * bf_lo(a0.y) + w1 * bf_lo(a1.y) + w2 * bf_lo(a2.y), w0 * bf_hi(a0.y) + w1 * bf_hi(a1.y) + w2 * bf_hi(a2.y));
                *(u32x2*)(mrow + dc) = oa;
                u32x2 ob;
                if (dh == 0) ob = (u32x2){cvtpk(A.o0[4 * g] * inv, A.o0[4 * g + 1] * inv), cvtpk(A.o0[4 * g + 2] * inv, A.o0[4 * g + 3] * inv)};
                else ob = (u32x2){cvtpk(A.o1[4 * g] * inv, A.o1[4 * g + 1] * inv), cvtpk(A.o1[4 * g + 2] * inv, A.o1[4 * g + 3] * inv)};
                *(u32x2*)(mrow + 512 + dc) = ob;
            }
        }
    }
}
#define CE_DESC(a, b) do { const float _h = fmaxf(a, b), _l = fminf(a, b); a = _h; b = _l; } while (0)
__device__ __forceinline__ void sort16_desc(float (&v)[16]) {
#pragma unroll
    for (int k = 2; k <= 16; k <<= 1)
#pragma unroll
        for (int j = k >> 1; j > 0; j >>= 1)
#pragma unroll
            for (int i = 0; i < 16; ++i) { const int l = i ^ j; if (l > i) { if ((i & k) == 0) CE_DESC(v[i], v[l]); else CE_DESC(v[l], v[i]); } }
}
__device__ __forceinline__ void merge_top16(float (&a)[16], const float (&b)[16]) {
#pragma unroll
    for (int i = 0; i < 16; ++i) a[i] = fmaxf(a[i], b[15 - i]);
#pragma unroll
    for (int j = 8; j > 0; j >>= 1)
#pragma unroll
        for (int i = 0; i < 16; ++i) { const int l = i ^ j; if (l > i) CE_DESC(a[i], a[l]); }
}
__device__ __forceinline__ void xmerge(float (&a)[16], int xmask) {
    float b[16];
#pragma unroll
    for (int i = 0; i < 16; ++i) b[i] = __shfl_xor(a[i], xmask);
    merge_top16(a, b);
}
__device__ __forceinline__ float sel4(int g, float a0, float a1, float a2, float a3) { const float lo = (g & 1) ? a1 : a0, hi = (g & 1) ? a3 : a2; return (g & 2) ? hi : lo; }
__device__ __forceinline__ float pack_code(float v, unsigned code, unsigned mask) { return __builtin_bit_cast(float, (__builtin_bit_cast(unsigned, v) & ~mask) | code); }
__device__ __forceinline__ float gelu_erf(float v) { return 0.5f * v * (1.0f + erff(v * 0.70710678118654752f)); }


constexpr size_t WS_X3B = 96 * MiB;
constexpr size_t WS_CF16 = 292 * MiB;
constexpr size_t WS_EID = 224 * MiB, WS_GATE = 240 * MiB, WS_SSQ3 = 86 * MiB;
constexpr float V8_SCALE = 64.f;
constexpr size_t WS_USCALE = 88 * MiB;
__device__ __forceinline__ float* hpart_base(unsigned char* ws, int cg) { return (float*)(ws + (cg < 5 ? 420 * MiB + (size_t)cg * 16 * MiB : 96 * MiB + (size_t)(cg - 5) * 16 * MiB)); }
constexpr int SEL_WAVE_LDS = 512;

constexpr int SEL_KEYS_BYTES = 65536, SEL_TAB_OFF = 2 * SEL_KEYS_BYTES;
__device__ __forceinline__ void p7_select(Frame& F) {
    const bf16_t* QP = (const bf16_t*)F.out; const bf16_t* KEYS = (const bf16_t*)(F.ws + WS_KEYS);
    unsigned* EID = (unsigned*)(F.ws + WS_EID); float* GATE = (float*)(F.ws + WS_GATE);
    const int lane = F.lane, w = F.wave, tk = lane & 15, g = lane >> 4;
    LAS unsigned char* tabL = F.lds + SEL_TAB_OFF + w * SEL_WAVE_LDS;
    auto stage_keys = [&](int h) {
        LAS unsigned char* kb = F.lds + (h & 1) * SEL_KEYS_BYTES;
#pragma unroll
        for (int i = 0; i < 8; ++i) { const int piece = w * 8 + i, r = piece * 4 + (lane >> 4), c = (lane & 15) ^ (r & 15);
            glds16(KEYS + ((size_t)h * 256 + r) * 128 + c * 8, kb + piece * 1024); }
    };
    for (int blk = F.vcu; blk < M / 128; blk += F.G) {
        const int tok0 = blk * 128 + w * 16;
        stage_keys(0);
        const int crow0 = (blk * 8 + w) * 16;
        f32x4 cv[2][4];
        auto conv_load = [&](int hh) {
#pragma unroll
            for (int u = 0; u < 2; ++u) { const int rr_ = crow0 + 2 * hh + u; const bool isu = rr_ < 16384; const float* src = (isu ? F.in[12] : F.in[13]) + (size_t)(isu ? rr_ : rr_ - 16384) * 1024;
#pragma unroll
                for (int j = 0; j < 4; ++j) cv[u][j] = *(const f32x4*)(src + 256 * j + 4 * lane); }
        };
        auto conv_store = [&](int hh) {
#pragma unroll
            for (int u = 0; u < 2; ++u) { const int rr_ = crow0 + 2 * hh + u; const bool isu = rr_ < 16384; const int e = isu ? rr_ : rr_ - 16384;
                unsigned char* dst = F.ws + (isu ? WS_U : WS_V) + (size_t)e * 1024;
                if (isu) {
                    f32x4 t[4]; float amax = 0.f;
#pragma unroll
                    for (int j = 0; j < 4; ++j) { t[j] = cv[u][j] * *(const f32x4*)(F.in[9] + 256 * j + 4 * lane); amax = fmaxf(amax, fmaxf(fmaxf(fabsf(t[j].x), fabsf(t[j].y)), fmaxf(fabsf(t[j].z), fabsf(t[j].w)))); }
#pragma unroll
                    for (int o = 1; o < 64; o <<= 1) amax = fmaxf(amax, __shfl_xor(amax, o));
                    const float sc_ = amax > 0.f ? amax * (1.f / 127.f) : 1.f, inv_ = 1.f / sc_;
                    if (lane == 0) ((float*)(F.ws + WS_USCALE))[e] = sc_;
#pragma unroll
                    for (int j = 0; j < 4; ++j) { const int q0 = (int)__builtin_rintf(t[j].x * inv_), q1 = (int)__builtin_rintf(t[j].y * inv_), q2 = (int)__builtin_rintf(t[j].z * inv_), q3 = (int)__builtin_rintf(t[j].w * inv_);
                        *(int*)(dst + 256 * j + 4 * lane) = (q0 & 0xff) | ((q1 & 0xff) << 8) | ((q2 & 0xff) << 16) | (q3 << 24); }
                } else {
#pragma unroll
                    for (int j = 0; j < 4; ++j) { f32x4 t = cv[u][j] * V8_SCALE;
                        t.x = fminf(fmaxf(t.x, -448.f), 448.f); t.y = fminf(fmaxf(t.y, -448.f), 448.f); t.z = fminf(fmaxf(t.z, -448.f), 448.f); t.w = fminf(fmaxf(t.w, -448.f), 448.f);
                        int wq = __builtin_amdgcn_cvt_pk_fp8_f32(t.x, t.y, 0, false); wq = __builtin_amdgcn_cvt_pk_fp8_f32(t.z, t.w, wq, true);
                        *(int*)(dst + 256 * j + 4 * lane) = wq; }
                }
            }
        };
        for (int h = 0; h < 8; ++h) {
            asm volatile("s_waitcnt vmcnt(0)" ::: "memory");
            __syncthreads();
            if (h > 0) conv_store(h - 1);
            const LAS unsigned char* kb = F.lds + (h & 1) * SEL_KEYS_BYTES;
            float s12[2][16];
#pragma unroll
            for (int p = 0; p < 2; ++p) {
                const int hp = h * 2 + p;
                bf16x8 bq[4];
#pragma unroll
                for (int ks = 0; ks < 4; ++ks) bq[ks] = *(const bf16x8*)(QP + (size_t)(tok0 + tk) * 2048 + hp * 128 + ks * 32 + g * 8);
                f32x4 c[8];
#pragma unroll
                for (int nt = 0; nt < 8; ++nt) { c[nt] = (f32x4){0.f, 0.f, 0.f, 0.f};
                    const int r = p * 128 + nt * 16 + tk;
#pragma unroll
                    for (int ks = 0; ks < 4; ++ks) { const bf16x8 ak = *(const LAS bf16x8*)(kb + r * 256 + (((4 * ks + g) ^ (r & 15)) * 16));
                        c[nt] = __builtin_amdgcn_mfma_f32_16x16x32_bf16(ak, bq[ks], c[nt], 0, 0, 0); } }
                if (p == 1) { if (h + 1 < 8) stage_keys(h + 1); conv_load(h); }
                float va[16], vb[16];
                const unsigned lo = 127u - 4u * (unsigned)g;
#pragma unroll
                for (int nt = 0; nt < 4; ++nt)
#pragma unroll
                    for (int r = 0; r < 4; ++r) { va[nt * 4 + r] = pack_code(c[nt][r], lo - (unsigned)(16 * nt + r), 127u); vb[nt * 4 + r] = pack_code(c[nt + 4][r], lo - (unsigned)(16 * (nt + 4) + r), 127u); }
                sort16_desc(va); sort16_desc(vb); merge_top16(va, vb);
                xmerge(va, 16); xmerge(va, 32);
#pragma unroll
                for (int i = 0; i < 16; ++i) s12[p][i] = va[i];
                if (g == 0) {
#pragma unroll
                    for (int i = 0; i < 16; ++i) tabL[tk * 32 + p * 16 + i] = (unsigned char)(127u - (__builtin_bit_cast(unsigned, va[i]) & 127u));
                }
            }
            float cd[16];
#define S1(i) s12[0][i]
#define S2(j) s12[1][j]
#define CND(slot, i0, j0, i1, j1, i2, j2, i3, j3) cd[slot] = pack_code(sel4(g, S1(i0), S1(i1), S1(i2), S1(i3)) + sel4(g, S2(j0), S2(j1), S2(j2), S2(j3)), \
                255u - (unsigned)(g == 0 ? (i0) * 16 + (j0) : g == 1 ? (i1) * 16 + (j1) : g == 2 ? (i2) * 16 + (j2) : (i3) * 16 + (j3)), 255u)
            CND(0, 0, 0, 0, 1, 0, 2, 0, 3);   CND(1, 0, 4, 0, 5, 0, 6, 0, 7);   CND(2, 0, 8, 0, 9, 0, 10, 0, 11); CND(3, 0, 12, 0, 13, 0, 14, 0, 15);
            CND(4, 1, 0, 1, 1, 1, 2, 1, 3);   CND(5, 1, 4, 1, 5, 1, 6, 1, 7);   CND(6, 2, 0, 2, 1, 2, 2, 2, 3);   CND(7, 2, 4, 3, 0, 3, 1, 3, 2);
            CND(8, 3, 3, 4, 0, 4, 1, 4, 2);   CND(9, 5, 0, 5, 1, 6, 0, 6, 1);   CND(10, 7, 0, 7, 1, 8, 0, 9, 0);  CND(11, 10, 0, 11, 0, 12, 0, 13, 0);
            { const float t = sel4(g, S1(14), S1(15), S1(15), S1(15)) + S2(0); const float pk = pack_code(t, 255u - (unsigned)(g == 0 ? 14 * 16 : 15 * 16), 255u); cd[12] = (g < 2) ? pk : -INFINITY; }
            cd[13] = -INFINITY; cd[14] = -INFINITY; cd[15] = -INFINITY;
#undef CND
#undef S1
#undef S2
            sort16_desc(cd); xmerge(cd, 16); xmerge(cd, 32);
            asm volatile("s_waitcnt lgkmcnt(0)" ::: "memory");
            float ev[16], sum = 0.f; const float mx = cd[0];
#pragma unroll
            for (int k = 0; k < 16; ++k) { ev[k] = __builtin_amdgcn_exp2f((cd[k] - mx) * LOG2E); sum += ev[k]; }
            const float isum = 1.f / sum;
            if (g == 0) {
                unsigned short* er = (unsigned short*)EID + (size_t)(tok0 + tk) * 128; float* gr = GATE + (size_t)(tok0 + tk) * 128;
#pragma unroll
                for (int k = 0; k < 16; ++k) { const unsigned code = 255u - (__builtin_bit_cast(unsigned, cd[k]) & 255u);
                    const unsigned e1 = tabL[tk * 32 + (code >> 4)], e2 = tabL[tk * 32 + 16 + (code & 15u)];
                    const int pos = (k & 7) * 16 + 2 * h + (k >> 3);
                    er[pos] = (unsigned short)(e1 * 128u + e2); gr[pos] = ev[k] * isum; }
            }
            asm volatile("s_waitcnt lgkmcnt(0)" ::: "memory");
        }
        conv_store(7);
        __syncthreads();
    }
}

typedef _Float16 h2_t __attribute__((ext_vector_type(2)));
__device__ __forceinline__ void fp8x16_to_h2(const u32x4 d, h2_t (&o)[8]) {
#pragma unroll
    for (int m = 0; m < 4; ++m) { o[2 * m] = __builtin_amdgcn_cvt_scalef32_pk_f16_fp8((int)d[m], 1.0f, false); o[2 * m + 1] = __builtin_amdgcn_cvt_scalef32_pk_f16_fp8((int)d[m], 1.0f, true); }
}

constexpr size_t CTL_Q_OFF = 4096;
constexpr int PEER_TILES = M / 16;
template <class Fn> __device__ __forceinline__ void peer_queue(Frame& F, int phase, const Fn& fn) {
    unsigned* ctr = (unsigned*)(F.ws + WS_CTL + CTL_Q_OFF);
    const unsigned x = (unsigned)__builtin_amdgcn_s_getreg((3 << 11) | 20) & 7u;
    for (int qi = 0; qi < 8; ++qi) {
        const int cg = (int)((x + (unsigned)qi) & 7u);
        unsigned* c = ctr + (phase * 8 + cg) * 64;
        unsigned nxt = 0; if (F.lane == 0) nxt = __hip_atomic_fetch_add(c, 1u, __ATOMIC_RELAXED, __HIP_MEMORY_SCOPE_AGENT);
        for (;;) {
            const int tile = __builtin_amdgcn_readfirstlane((int)nxt);
            if (tile >= PEER_TILES) break;
            if (F.lane == 0) nxt = __hip_atomic_fetch_add(c, 1u, __ATOMIC_RELAXED, __HIP_MEMORY_SCOPE_AGENT);
            fn(cg, tile);
        }
    }
}

__device__ __forceinline__ u32x4 ldnt4(const void* p) { return *(const u32x4*)p; }
__device__ __forceinline__ f32x4 ldnt4f(const void* p) { return *(const f32x4*)p; }
__device__ __forceinline__ unsigned ldnt1(const void* p) { return *(const unsigned*)p; }
__device__ __forceinline__ unsigned off16(unsigned w, int hi, unsigned lo) { unsigned r_; const unsigned k_ = 1024u;
    if (hi) asm("v_mad_u32_u16 %0, %1, %2, %3 op_sel:[1,0,0,0]" : "=v"(r_) : "v"(w), "s"(k_), "v"(lo)); else asm("v_mad_u32_u16 %0, %1, %2, %3" : "=v"(r_) : "v"(w), "s"(k_), "v"(lo));
    return r_; }
#define EOFFW(E0, E1, i) ((i) < 8 ? E0[((i) & 7) >> 1] : E1[((i) & 7) >> 1])
#define EOFF16(E0, E1, i, lo_) off16(EOFFW(E0, E1, i), (i) & 1, (unsigned)(lo_))

#define LDSRD(dst, addr, OFF) asm volatile("ds_read_b128 %0, %1 offset:" #OFF : "=v"(dst) : "v"(addr))
#define LDSPIN4(a, b, c, d) do { asm volatile("" : "+v"(a)); asm volatile("" : "+v"(b)); asm volatile("" : "+v"(c)); asm volatile("" : "+v"(d)); } while (0)

#define LDSRD32(dst, addr, OFF) asm volatile("ds_read_b32 %0, %1 offset:" #OFF : "=v"(dst) : "v"(addr))
#define LDSWR128(addr, v, OFF) asm volatile("ds_write_b128 %0, %1 offset:" #OFF :: "v"(addr), "v"(v))
#define LDSWR32(addr, v) asm volatile("ds_write_b32 %0, %1" :: "v"(addr), "v"(v))

template <int CTRL> __device__ __forceinline__ int dpp_i(int v) { return __builtin_amdgcn_update_dpp(0, v, CTRL, 0xf, 0xf, true); }
template <int CTRL> __device__ __forceinline__ float dpp_f(float v) { return __builtin_bit_cast(float, __builtin_amdgcn_update_dpp(0, __builtin_bit_cast(int, v), CTRL, 0xf, 0xf, true)); }
__device__ __forceinline__ float swap32_sum(float a, float b) {
    const auto r = __builtin_amdgcn_permlane32_swap(__builtin_bit_cast(unsigned, a), __builtin_bit_cast(unsigned, b), false, false);
    return __builtin_bit_cast(float, (unsigned)r[0]) + __builtin_bit_cast(float, (unsigned)r[1]); }
__device__ __forceinline__ float swap16_sum(float a, float b) {
    const auto r = __builtin_amdgcn_permlane16_swap(__builtin_bit_cast(unsigned, a), __builtin_bit_cast(unsigned, b), false, false);
    return __builtin_bit_cast(float, (unsigned)r[0]) + __builtin_bit_cast(float, (unsigned)r[1]); }

template <int PROBE>
__device__ __forceinline__ void p8_uphase(Frame& F) {
    const unsigned char* EIDb = F.ws + WS_EID; const bf16_t* X2B = (const bf16_t*)(F.ws + WS_X2B);
    const int lane = F.lane, r = lane >> 3, c = lane & 7;
    const __amdgpu_buffer_rsrc_t rs = __builtin_amdgcn_make_buffer_rsrc((void*)(F.ws + WS_U), 0, 16 << 20, 0x00020000);
    LAS unsigned char* wl = F.lds + F.wave * 16384;
    const unsigned wla = (unsigned)(size_t)wl, la = wla + (unsigned)r * 32u, qa = wla + 8192u + (unsigned)c * 16u, sa = wla + 8192u + 2048u;
    unsigned* ctr = (unsigned*)(F.ws + WS_CTL + CTL_Q_OFF);
    const unsigned x = (unsigned)__builtin_amdgcn_s_getreg((3 << 11) | 20) & 7u;
    auto dma_chunk = [&](int tile, int ch) {
        const size_t go = (size_t)tile * 4096 + (size_t)ch * 1024 + (size_t)lane * 16;
        const unsigned dst = __builtin_amdgcn_readfirstlane(wla + (unsigned)ch * 1024u);
        ASM_GLDS16(EIDb + go, dst);
    };
    const int lo = c * 16;
    for (int qi = 0; qi < 8; ++qi) {
        const int cg = (int)((x + (unsigned)qi) & 7u), so = cg * 128;
        float* HP = PROBE ? (float*)(F.ws + ((size_t)300 << 20)) : hpart_base(F.ws, cg);
        unsigned* cq = ctr + ((PROBE ? 2 : 0) * 8 + cg) * 64;
        auto act_load = [&](int tile, u32x4 (&xa)[4]) { const bf16_t* p = X2B + ((size_t)tile * 16 + (lane >> 2)) * 1024 + cg * 128 + (lane & 3) * 32;
#pragma unroll
            for (int j = 0; j < 4; ++j) xa[j] = *(const u32x4*)(p + 8 * j); };
        auto act_quant = [&](const u32x4 (&xa)[4], int par) {
            float hv[32];
#pragma unroll
            for (int j = 0; j < 4; ++j)
#pragma unroll
                for (int m = 0; m < 4; ++m) { hv[8 * j + 2 * m] = bf_lo(xa[j][m]); hv[8 * j + 2 * m + 1] = bf_hi(xa[j][m]); }
            float am = 0.f;
#pragma unroll
            for (int j = 0; j < 32; ++j) am = fmaxf(am, fabsf(hv[j]));
            am = fmaxf(am, __shfl_xor(am, 1)); am = fmaxf(am, __shfl_xor(am, 2));
            const float sh = am > 0.f ? am * (1.f / 127.f) : 1.f, ish = 1.f / sh;
            u32x4 qv[2];
#pragma unroll
            for (int m = 0; m < 8; ++m) { const int q0 = (int)__builtin_rintf(hv[4 * m] * ish), q1 = (int)__builtin_rintf(hv[4 * m + 1] * ish), q2 = (int)__builtin_rintf(hv[4 * m + 2] * ish), q3 = (int)__builtin_rintf(hv[4 * m + 3] * ish);
                qv[m >> 2][m & 3] = (unsigned)((q0 & 0xff) | ((q1 & 0xff) << 8) | ((q2 & 0xff) << 16) | (q3 << 24)); }
            const unsigned wa = wla + 8192u + (unsigned)par * 2304u + (unsigned)(lane >> 2) * 128u + (unsigned)(lane & 3) * 32u;
            LDSWR128(wa, qv[0], 0); LDSWR128(wa, qv[1], 16);
            if ((lane & 3) == 0) { const unsigned swa = sa + (unsigned)par * 2304u + (unsigned)(lane >> 2) * 4u; LDSWR32(swa, sh); }
        };
        unsigned tk = 0; if (lane == 0) tk = __hip_atomic_fetch_add(cq, 1u, __ATOMIC_RELAXED, __HIP_MEMORY_SCOPE_AGENT);
        int tile = __builtin_amdgcn_readfirstlane((int)tk);
        if (tile >= PEER_TILES) continue;
        if (lane == 0) tk = __hip_atomic_fetch_add(cq, 1u, __ATOMIC_RELAXED, __HIP_MEMORY_SCOPE_AGENT);
        int nxt = __builtin_amdgcn_readfirstlane((int)tk);
        if (lane == 0) tk = __hip_atomic_fetch_add(cq, 1u, __ATOMIC_RELAXED, __HIP_MEMORY_SCOPE_AGENT);
        dma_chunk(tile, 0); dma_chunk(tile, 1);
        u32x4 xa[4];
        act_load(tile, xa);
        int par = 0;
        act_quant(xa, 0);
        asm volatile("s_waitcnt vmcnt(0) lgkmcnt(0)" ::: "memory");
        u32x4 e0, e1, hq; float sh;
        LDSRD(e0, la, 0); LDSRD(e1, la, 16); LDSRD(hq, qa, 0); LDSRD32(sh, sa, 0);
        asm volatile("s_waitcnt lgkmcnt(0)" ::: "memory");
        asm volatile("" : "+v"(e0)); asm volatile("" : "+v"(e1)); asm volatile("" : "+v"(hq)); asm volatile("" : "+v"(sh));
        u32x4 d[8];
#pragma unroll
        for (int i = 0; i < 8; ++i) d[i] = __builtin_amdgcn_raw_buffer_load_b128(rs, (int)EOFF16(e0, e1, i, lo), so, 0);
        for (;;) {
            const bool has_next = nxt < PEER_TILES;
#pragma unroll 1
            for (int t = 0; t < 16; ++t) {
                const int tok = tile * 16 + t;
                if ((t & 3) == 0) { const int ch2 = (t >> 2) + 2; if (ch2 < 4) dma_chunk(tile, ch2); else if (has_next) dma_chunk(nxt, ch2 - 4); }
                if (has_next && t == 2) act_load(nxt, xa);
                if (has_next && t == 10) act_quant(xa, par ^ 1);
                const bool cross = (t == 15) && has_next;
                const int tn = (t < 15) ? t + 1 : (has_next ? 0 : 15);
                const unsigned pn = (unsigned)(cross ? (par ^ 1) : par) * 2304u;
                const unsigned ta = la + (unsigned)tn * 256u, tq = qa + pn + (unsigned)tn * 128u, ts = sa + pn + (unsigned)tn * 4u;
                u32x4 n0, n1, hqn; float shn;
                LDSRD(n0, ta, 0); LDSRD(n1, ta, 16); LDSRD(hqn, tq, 0); LDSRD32(shn, ts, 0);
                int p[16];
#define UDOT(i, nextoff) do { int a_ = 0; const u32x4 dd_ = d[(i) & 7]; \
                    a_ = __builtin_amdgcn_sdot4((int)dd_.x, (int)hq.x, a_, false); a_ = __builtin_amdgcn_sdot4((int)dd_.y, (int)hq.y, a_, false); a_ = __builtin_amdgcn_sdot4((int)dd_.z, (int)hq.z, a_, false); a_ = __builtin_amdgcn_sdot4((int)dd_.w, (int)hq.w, a_, false); \
                    asm volatile("" : "+v"(a_)); p[i] = a_; d[(i) & 7] = __builtin_amdgcn_raw_buffer_load_b128(rs, (int)(nextoff), so, 0); } while (0)
                UDOT(0, EOFF16(e0, e1, 8, lo)); UDOT(1, EOFF16(e0, e1, 9, lo)); UDOT(2, EOFF16(e0, e1, 10, lo)); UDOT(3, EOFF16(e0, e1, 11, lo));
                UDOT(4, EOFF16(e0, e1, 12, lo)); UDOT(5, EOFF16(e0, e1, 13, lo)); UDOT(6, EOFF16(e0, e1, 14, lo)); UDOT(7, EOFF16(e0, e1, 15, lo));
                asm volatile("s_waitcnt lgkmcnt(0)" ::: "memory");
                asm volatile("" : "+v"(n0)); asm volatile("" : "+v"(n1)); asm volatile("" : "+v"(hqn)); asm volatile("" : "+v"(shn));
                UDOT(8, EOFF16(n0, n1, 0, lo)); UDOT(9, EOFF16(n0, n1, 1, lo)); UDOT(10, EOFF16(n0, n1, 2, lo)); UDOT(11, EOFF16(n0, n1, 3, lo));
                UDOT(12, EOFF16(n0, n1, 4, lo)); UDOT(13, EOFF16(n0, n1, 5, lo)); UDOT(14, EOFF16(n0, n1, 6, lo)); UDOT(15, EOFF16(n0, n1, 7, lo));
#undef UDOT
                int q8[8], q4[4], q2[2];
                { const bool b = (c & 4) != 0;
#pragma unroll
                  for (int j = 0; j < 8; ++j) { const int A = p[j] + dpp_i<0x141>(p[j]), B = p[8 + j] + dpp_i<0x141>(p[8 + j]); q8[j] = b ? B : A; } }
                { const bool b = (c & 2) != 0;
#pragma unroll
                  for (int j = 0; j < 4; ++j) { const int A = q8[j] + dpp_i<0x4E>(q8[j]), B = q8[4 + j] + dpp_i<0x4E>(q8[4 + j]); q4[j] = b ? B : A; } }
                { const bool b = (c & 1) != 0;
#pragma unroll
                  for (int j = 0; j < 2; ++j) { const int A = q4[j] + dpp_i<0xB1>(q4[j]), B = q4[2 + j] + dpp_i<0xB1>(q4[2 + j]); q2[j] = b ? B : A; } }
                *(unsigned*)((bf16_t*)HP + (size_t)tok * 128 + 2 * lane) = cvtpk((float)q2[0] * sh, (float)q2[1] * sh);
                e0 = n0; e1 = n1; hq = hqn; sh = shn;
            }
            if (!has_next) break;
            tile = nxt; nxt = __builtin_amdgcn_readfirstlane((int)tk); par ^= 1;
            if (lane == 0) tk = __hip_atomic_fetch_add(cq, 1u, __ATOMIC_RELAXED, __HIP_MEMORY_SCOPE_AGENT);
        }
    }
}

__device__ __forceinline__ void p8b_combine(Frame& F) {
    float* GATE = (float*)(F.ws + WS_GATE); const float* SSQ2 = (const float*)(F.ws + WS_SSQ2); const unsigned* EID = (const unsigned*)(F.ws + WS_EID); const float* USC = (const float*)(F.ws + WS_USCALE);
    const int gt = F.vcu * 512 + F.tid, NT = F.G * 512;
    for (int i = gt; i < M * 32; i += NT) {
        const int tok = i >> 5;
        const f32x4* sp = (const f32x4*)(SSQ2 + (size_t)tok * 16); const f32x4 s0 = sp[0], s1 = sp[1], s2 = sp[2], s3 = sp[3];
        const float ssq = ((s0.x + s0.y) + (s0.z + s0.w)) + ((s1.x + s1.y) + (s1.z + s1.w)) + ((s2.x + s2.y) + (s2.z + s2.w)) + ((s3.x + s3.y) + (s3.z + s3.w));
        const float rsu = rsqrtf(ssq * (1.f / 1024.f) + NORM_EPS);
        f32x4 h = {0.f, 0.f, 0.f, 0.f};
#pragma unroll
        for (int g2 = 0; g2 < 8; ++g2) { const u32x2 hb = *(const u32x2*)((const bf16_t*)hpart_base(F.ws, g2) + (size_t)i * 4); h = h + (f32x4){bf_lo(hb.x), bf_hi(hb.x), bf_lo(hb.y), bf_hi(hb.y)}; }
        const u32x2 e2_ = *(const u32x2*)((const unsigned short*)EID + (size_t)i * 4); const u32x4 e4 = {(e2_.x & 0xffffu) << 10, (e2_.x >> 16) << 10, (e2_.y & 0xffffu) << 10, (e2_.y >> 16) << 10};
        const f32x4 gt4 = *(const f32x4*)(GATE + (size_t)i * 4);
        f32x4 o; o.x = gelu_erf(h.x * rsu * USC[e4.x >> 10]) * gt4.x; o.y = gelu_erf(h.y * rsu * USC[e4.y >> 10]) * gt4.y; o.z = gelu_erf(h.z * rsu * USC[e4.z >> 10]) * gt4.z; o.w = gelu_erf(h.w * rsu * USC[e4.w >> 10]) * gt4.w;
        { typedef _Float16 h4_t __attribute__((ext_vector_type(4))); const h4_t oh = {(_Float16)o.x, (_Float16)o.y, (_Float16)o.z, (_Float16)o.w}; *(u32x2*)(F.ws + WS_CF16 + (size_t)i * 8) = __builtin_bit_cast(u32x2, oh); }
    }
}

template <int PROBE>
__device__ __forceinline__ void p9_vphase(Frame& F) {
    const unsigned char* EIDb = F.ws + WS_EID; const unsigned char* CFb = F.ws + WS_CF16;
    const bf16_t* X2B = (const bf16_t*)(F.ws + WS_X2B);
    const int lane = F.lane, r = lane >> 3, c = lane & 7;
    const __amdgpu_buffer_rsrc_t rs = __builtin_amdgcn_make_buffer_rsrc((void*)(F.ws + WS_V), 0, 16 << 20, 0x00020000);
    LAS unsigned char* wl = F.lds + F.wave * 16384;
    const unsigned wla = (unsigned)(size_t)wl, la = wla + (unsigned)r * 32u, lc = wla + 1024u + (unsigned)r * 32u;
    unsigned* ctr = (unsigned*)(F.ws + WS_CTL + CTL_Q_OFF);
    const unsigned x = (unsigned)__builtin_amdgcn_s_getreg((3 << 11) | 20) & 7u;
    auto dma_chunk = [&](int tile, int ch) {
        const size_t gc = (size_t)tile * 4096 + (size_t)ch * 1024 + (size_t)lane * 16;
        const unsigned dst = __builtin_amdgcn_readfirstlane(wla + (unsigned)ch * 2048u);
        ASM_GLDS16(EIDb + gc, dst); ASM_GLDS16(CFb + gc, dst + 1024u);
    };
    const int lo = c * 16;
    for (int qi = 0; qi < 8; ++qi) {
        const int cg = (int)((x + (unsigned)qi) & 7u), so = cg * 128;
        unsigned* cq = ctr + ((PROBE ? 3 : 1) * 8 + cg) * 64;
        unsigned tk = 0; if (lane == 0) tk = __hip_atomic_fetch_add(cq, 1u, __ATOMIC_RELAXED, __HIP_MEMORY_SCOPE_AGENT);
        int tile = __builtin_amdgcn_readfirstlane((int)tk);
        if (tile >= PEER_TILES) continue;
        if (lane == 0) tk = __hip_atomic_fetch_add(cq, 1u, __ATOMIC_RELAXED, __HIP_MEMORY_SCOPE_AGENT);
        int nxt = __builtin_amdgcn_readfirstlane((int)tk);
        if (lane == 0) tk = __hip_atomic_fetch_add(cq, 1u, __ATOMIC_RELAXED, __HIP_MEMORY_SCOPE_AGENT);
        dma_chunk(tile, 0); dma_chunk(tile, 1);
        asm volatile("s_waitcnt vmcnt(0)" ::: "memory");
        u32x4 e0, e1, c0, c1;
        LDSRD(e0, la, 0); LDSRD(e1, la, 16); LDSRD(c0, lc, 0); LDSRD(c1, lc, 16);
        asm volatile("s_waitcnt lgkmcnt(0)" ::: "memory");
        asm volatile("" : "+v"(e0)); asm volatile("" : "+v"(e1)); asm volatile("" : "+v"(c0)); asm volatile("" : "+v"(c1));
        u32x4 d[16];
#pragma unroll
        for (int i = 0; i < 16; ++i) d[i] = __builtin_amdgcn_raw_buffer_load_b128(rs, (int)EOFF16(e0, e1, i, lo), so, 0);
        LDSRD(e0, la, 256); LDSRD(e1, la, 272);
        asm volatile("s_waitcnt lgkmcnt(0)" ::: "memory");
        asm volatile("" : "+v"(e0)); asm volatile("" : "+v"(e1));
        for (;;) {
            const bool has_next = nxt < PEER_TILES;
#pragma unroll 1
            for (int t = 0; t < 16; ++t) {
                const int tok = tile * 16 + t;
                if ((t & 3) == 0) { const int ch2 = (t >> 2) + 2; if (ch2 < 4) dma_chunk(tile, ch2); else if (has_next) dma_chunk(nxt, ch2 - 4); }
                const int t1 = (t < 15) ? t + 1 : (has_next ? 0 : 15), t2 = (t < 14) ? t + 2 : (has_next ? t - 14 : 15);
                const unsigned ta = la + (unsigned)(t2 >> 2) * 2048u + (unsigned)((t2 & 3) << 8), tc = lc + (unsigned)(t1 >> 2) * 2048u + (unsigned)((t1 & 3) << 8);
                u32x4 n0, n1, c0n, c1n;
                LDSRD(n0, ta, 0); LDSRD(n1, ta, 16); LDSRD(c0n, tc, 0); LDSRD(c1n, tc, 16);
                const size_t off = (size_t)tok * 1024 + cg * 128 + c * 16 + 2 * r;
                const unsigned xw = ldnt1(X2B + off);
                h2_t yh[8];
#pragma unroll
                for (int m = 0; m < 8; ++m) yh[m] = (h2_t){(_Float16)0.f, (_Float16)0.f};
#define VAXPY(i, cword, nextoff) do { h2_t vv[8]; if (PROBE == 2) { _Pragma("unroll") for (int m_ = 0; m_ < 4; ++m_) { vv[2 * m_] = __builtin_bit_cast(h2_t, d[i][m_] & 0x3c003c00u); vv[2 * m_ + 1] = __builtin_bit_cast(h2_t, (d[i][m_] >> 2) & 0x3c003c00u); } } else fp8x16_to_h2(d[i], vv); const _Float16 ch_ = __builtin_bit_cast(h2_t, (unsigned)(cword))[(i) & 1]; const h2_t c2_ = {ch_, ch_}; \
                    _Pragma("unroll") for (int m = 0; m < 8; ++m) yh[m] = __builtin_elementwise_fma(vv[m], c2_, yh[m]); \
                    _Pragma("unroll") for (int m = 0; m < 8; ++m) asm volatile("" : "+v"(yh[m])); \
                    d[i] = __builtin_amdgcn_raw_buffer_load_b128(rs, (int)(nextoff), so, 0); } while (0)
                VAXPY(0, c0.x, EOFF16(e0, e1, 0, lo)); VAXPY(1, c0.x, EOFF16(e0, e1, 1, lo)); VAXPY(2, c0.y, EOFF16(e0, e1, 2, lo)); VAXPY(3, c0.y, EOFF16(e0, e1, 3, lo));
                VAXPY(4, c0.z, EOFF16(e0, e1, 4, lo)); VAXPY(5, c0.z, EOFF16(e0, e1, 5, lo)); VAXPY(6, c0.w, EOFF16(e0, e1, 6, lo)); VAXPY(7, c0.w, EOFF16(e0, e1, 7, lo));
                VAXPY(8, c1.x, EOFF16(e0, e1, 8, lo)); VAXPY(9, c1.x, EOFF16(e0, e1, 9, lo)); VAXPY(10, c1.y, EOFF16(e0, e1, 10, lo)); VAXPY(11, c1.y, EOFF16(e0, e1, 11, lo));
                VAXPY(12, c1.z, EOFF16(e0, e1, 12, lo)); VAXPY(13, c1.z, EOFF16(e0, e1, 13, lo)); VAXPY(14, c1.w, EOFF16(e0, e1, 14, lo)); VAXPY(15, c1.w, EOFF16(e0, e1, 15, lo));
#undef VAXPY
                asm volatile("s_waitcnt lgkmcnt(0)" ::: "memory");
                asm volatile("" : "+v"(n0)); asm volatile("" : "+v"(n1)); asm volatile("" : "+v"(c0n)); asm volatile("" : "+v"(c1n));
                e0 = n0; e1 = n1; c0 = c0n; c1 = c1n;
                unsigned y8[8], q4[4], q2[2], q1;
#pragma unroll
                for (int m = 0; m < 8; ++m) y8[m] = __builtin_bit_cast(unsigned, yh[m]);
                auto hadd = [](unsigned a, unsigned b) { return __builtin_bit_cast(unsigned, __builtin_bit_cast(h2_t, a) + __builtin_bit_cast(h2_t, b)); };
#pragma unroll
                for (int j = 0; j < 4; ++j) { const auto rr = __builtin_amdgcn_permlane32_swap(y8[j], y8[4 + j], false, false); q4[j] = hadd((unsigned)rr[0], (unsigned)rr[1]); }
#pragma unroll
                for (int j = 0; j < 2; ++j) { const auto rr = __builtin_amdgcn_permlane16_swap(q4[j], q4[2 + j], false, false); q2[j] = hadd((unsigned)rr[0], (unsigned)rr[1]); }
                { const unsigned A = hadd(q2[0], (unsigned)dpp_i<0x128>((int)q2[0])), B = hadd(q2[1], (unsigned)dpp_i<0x128>((int)q2[1])); q1 = (r & 1) ? B : A; }
                const h2_t qh = __builtin_bit_cast(h2_t, q1);
                const float o0 = bf_lo(xw) + (float)qh[0] * (1.f / V8_SCALE), o1 = bf_hi(xw) + (float)qh[1] * (1.f / V8_SCALE);
                *(unsigned*)((bf16_t*)(F.ws + (PROBE ? ((size_t)300 << 20) : WS_X3B)) + off) = cvtpk(o0, o1);
            }
            if (!has_next) break;
            tile = nxt; nxt = __builtin_amdgcn_readfirstlane((int)tk);
            if (lane == 0) tk = __hip_atomic_fetch_add(cq, 1u, __ATOMIC_RELAXED, __HIP_MEMORY_SCOPE_AGENT);
        }
    }
}

__device__ __forceinline__ void p10_final(Frame& F) {
    const float* gfin = F.in[14]; const bf16_t* X3B = (const bf16_t*)(F.ws + WS_X3B);
    const int gw = F.vcu * 8 + F.wave, NGW = F.G * 8, lane = (int)__builtin_amdgcn_mbcnt_hi(~0u, __builtin_amdgcn_mbcnt_lo(~0u, 0u));
    f32x4 g[4];
#pragma unroll
    for (int j = 0; j < 4; ++j) g[j] = *(const f32x4*)(gfin + 256 * j + 4 * lane);
    for (int tok = gw; tok < M; tok += NGW) {
        const bf16_t* xr = X3B + (size_t)tok * 1024; float* orow = F.out + (size_t)tok * 1024;
        f32x4 v[4]; float ss = 0.f;
#pragma unroll
        for (int j = 0; j < 4; ++j) { const u32x2 p = *(const u32x2*)(xr + 256 * j + 4 * lane); v[j] = (f32x4){bf_lo(p.x), bf_hi(p.x), bf_lo(p.y), bf_hi(p.y)}; }
#pragma unroll
        for (int j = 0; j < 4; ++j) ss += (v[j].x * v[j].x + v[j].y * v[j].y) + (v[j].z * v[j].z + v[j].w * v[j].w);
        const float rs = rsqrtf(wave_sum(ss) * (1.f / 1024.f) + NORM_EPS);
#pragma unroll
        for (int j = 0; j < 4; ++j) *(f32x4*)(orow + 256 * j + 4 * lane) = v[j] * rs * g[j];
    }
}
constexpr int LDS_BYTES = 147456;
constexpr int NPHASE = 12;


#define XB_TMO      128
#define XB_XCNT(j)  (256  + 64 * (j))
#define XB_XSUB(j)  (1280 + 64 * (j))
#define XB_XGEN(j)  (2304 + 64 * (j))
#define XB_TOP      3328
#define XB_TOPGEN   3392
#define XCD_BAR_WORDS 3456
#define XB_SPIN_CAP (1u << 22)
__device__ __forceinline__ unsigned xb_ld(unsigned* p)              { return __hip_atomic_load(p, __ATOMIC_RELAXED, __HIP_MEMORY_SCOPE_AGENT); }
__device__ __forceinline__ unsigned xb_add(unsigned* p, unsigned v) { return __hip_atomic_fetch_add(p, v, __ATOMIC_RELAXED, __HIP_MEMORY_SCOPE_AGENT); }
__device__ __forceinline__ unsigned xb_xcc_id() { return (unsigned)__builtin_amdgcn_s_getreg((3 << 11) | 20) & 0xFu; }
#define XB_SPIN(cond, bar) do { unsigned _sp = 0; while (cond) { __builtin_amdgcn_s_sleep(1); \
    if ((++_sp & 255u) == 0u) { if (xb_ld(&(bar)[XB_TMO])) break; if (_sp > XB_SPIN_CAP) { atomicAdd(&(bar)[XB_TMO], 1u); break; } } } } while (0)
struct XcdBarrier { unsigned* bar; unsigned x; volatile LAS unsigned* st; };
__device__ __forceinline__ XcdBarrier xcd_barrier_post(unsigned* bar, volatile LAS unsigned* st) {
    XcdBarrier b; b.bar = bar; b.x = xb_xcc_id(); b.st = st;
    if (threadIdx.x == 0) (void)xb_add(&bar[XB_XCNT(b.x)], 1u);
    return b;
}
__device__ __forceinline__ void xcd_barrier_complete(unsigned* bar, unsigned x, unsigned& nloc, unsigned& nx) {
    const unsigned G = gridDim.x * gridDim.y * gridDim.z;
    unsigned sum, cnt, mine, sp = 0u;
    for (;;) {
        sum = 0u; cnt = 0u; mine = 0u;
#pragma unroll
        for (unsigned j = 0; j < 16; ++j) { const unsigned c = xb_ld(&bar[XB_XCNT(j)]); sum += c; cnt += (c > 0u) ? 1u : 0u; mine = (j == x) ? c : mine; }
        if (sum == G) break;
        __builtin_amdgcn_s_sleep(1);
        if ((++sp & 255u) == 0u) { if (xb_ld(&bar[XB_TMO])) break; if (sp > XB_SPIN_CAP) { atomicAdd(&bar[XB_TMO], 1u); break; } }
    }
    nloc = mine > 0u ? mine : 1u; nx = cnt > 0u ? cnt : 1u;
}
__device__ __forceinline__ void xcd_barrier(const XcdBarrier& b) {
    asm volatile("s_waitcnt vmcnt(0)" ::: "memory");
    __syncthreads();
    if (threadIdx.x == 0) {
        unsigned* bar = b.bar;
        __builtin_amdgcn_s_waitcnt(0);
        unsigned nloc = b.st[0], nx = b.st[1];
        if (nloc == 0u) { xcd_barrier_complete(bar, b.x, nloc, nx); b.st[0] = nloc; b.st[1] = nx; }
        const unsigned old = xb_add(&bar[XB_XSUB(b.x)], 1u);
        const unsigned gen = old / nloc;
        if (old + 1u == (gen + 1u) * nloc) {
            __builtin_amdgcn_fence(__ATOMIC_RELEASE, "agent");
            asm volatile("s_waitcnt vmcnt(0)" ::: "memory");
            const unsigned og = xb_add(&bar[XB_TOP], 1u);
            const unsigned tg = og / nx;
            if (og + 1u == (tg + 1u) * nx) xb_add(&bar[XB_TOPGEN], 1u);
            else XB_SPIN(xb_ld(&bar[XB_TOPGEN]) == tg, bar);
            __builtin_amdgcn_fence(__ATOMIC_ACQUIRE, "agent");
            xb_add(&bar[XB_XGEN(b.x)], 1u);
            asm volatile("s_waitcnt vmcnt(0)" ::: "memory");
        } else {
            XB_SPIN(xb_ld(&bar[XB_XGEN(b.x)]) == gen, bar);
            __builtin_amdgcn_fence(__ATOMIC_ACQUIRE, "agent");
            asm volatile("s_waitcnt vmcnt(0)" ::: "memory");
        }
    }
    __syncthreads();
}
constexpr int MISC_OFF = 131072 + 8192;
constexpr size_t CTL_BAR_OFF = 16384;
constexpr size_t CTL_ZERO_BYTES = 65536;

__global__ void __launch_bounds__(512, 2) fwd_kernel(Args args) {
    extern __shared__ __attribute__((aligned(16))) unsigned char lds_raw[];
    Frame F;
    F.lds = (LAS unsigned char*)lds_raw;
    F.tid = threadIdx.x; F.lane = F.tid & 63; F.wave = __builtin_amdgcn_readfirstlane(F.tid >> 6);
    F.G = gridDim.x; { const int bx = blockIdx.x; F.vcu = (F.G % 8 == 0) ? (bx % 8) * (F.G / 8) + bx / 8 : bx; }
#pragma unroll
    for (int i = 0; i < 15; ++i) F.in[i] = args.in[i];
    F.out = args.out; F.ws = args.ws;
    unsigned char* ws = args.ws;
    const int lo = args.ph_lo, hi = args.ph_hi;
#if ONE_LAUNCH
    volatile LAS unsigned* MISC = (volatile LAS unsigned*)(F.lds + MISC_OFF);
    if (F.tid < 16) MISC[F.tid] = 0u;
    __syncthreads();
    XcdBarrier bar = xcd_barrier_post((unsigned*)(ws + WS_CTL + CTL_BAR_OFF), MISC + 8);
#define SEAM(k) do { if (lo <= (k) && (k) + 1 < hi) xcd_barrier(bar); } while (0)
#else
#define SEAM(k) do { } while (0)
#endif
#define IN(k) (lo <= (k) && (k) < hi)
#define RELANE() do { int l_; asm volatile("v_mbcnt_lo_u32_b32 %0, -1, 0\n\tv_mbcnt_hi_u32_b32 %0, -1, %0" : "=v"(l_)); F.lane = l_; } while (0)
#if TIME_PHASE >= 0
    unsigned long long tp0 = 0, tp1 = 0;
#define TSTAMP(k) do { if ((k) == TIME_PHASE) tp0 = __builtin_amdgcn_s_memrealtime(); if ((k) == TIME_PHASE + 1) tp1 = __builtin_amdgcn_s_memrealtime(); } while (0)
#else
#define TSTAMP(k) do { } while (0)
#endif
    TSTAMP(0);
    if (IN(0)) { p0_prologue(F); SEAM(0); }
    TSTAMP(1);
    if (IN(1)) {
        GemmPlain g{(const bf16_t*)(ws + WS_XN), (const bf16_t*)(ws + WS_WIN), 1024, 1024, 1024};
        pg8::StaticOrder S_; S_.init(M, 2048, F.G, (int)blockIdx.x);
        const float* CA = (const float*)(ws + WS_ROPE);
        EpiP1 E{(bf16_t*)(ws + WS_QA), (bf16_t*)(ws + WS_KA), (bf16_t*)(ws + WS_VA), (bf16_t*)(ws + WS_CQ), (bf16_t*)(ws + WS_CKV), (float*)(ws + WS_SSQ1), CA, CA + 4096 * 32};
        pg8::gemm_phase<EpiP1, pg8::StaticOrder, GemmPlain>(F.lds, g, S_, E);
        p1_krope(F);
        SEAM(1);
    }
    TSTAMP(2);
    if (IN(2)) {
        GemmUp g{(const bf16_t*)(ws + WS_CQ), (const bf16_t*)(ws + WS_CKV), (const bf16_t*)(ws + WS_WUQ), (const bf16_t*)(ws + WS_WUKV), 256, 256, 256};
        pg8::StaticOrder S_; S_.init(M, 7 * 256, F.G, (int)blockIdx.x);
        const float* CB = (const float*)(ws + WS_ROPE) + 2 * 4096 * 32;
        EpiP2 E{(bf16_t*)(ws + WS_QB), (bf16_t*)(ws + WS_KN), (bf16_t*)(ws + WS_VB), (const float*)(ws + WS_SSQ1), CB, CB + 4096 * 16};
        pg8::gemm_phase<EpiP2, pg8::StaticOrder, GemmUp>(F.lds, g, S_, E);
    }
    TSTAMP(3);
    if (IN(3)) { p3a_dilated(F); SEAM(3); }
    TSTAMP(4);
    if (IN(4)) { p3b_mla(F); SEAM(4); }
    TSTAMP(5);
    if (IN(5)) {
        GemmPlain g{(const bf16_t*)(ws + WS_MIX), (const bf16_t*)(ws + WS_WO), 1024, 1024, 1024};
        pg8::StaticOrder S_; S_.init(M, 1024, F.G, (int)blockIdx.x);
        EpiP4 E{F.in[0], (bf16_t*)(ws + WS_X2B), (float*)(ws + WS_SSQ2)};
        pg8::gemm_phase<EpiP4, pg8::StaticOrder, GemmPlain>(F.lds, g, S_, E);
        SEAM(5);
    }
    TSTAMP(6);
    if (IN(6)) {
        GemmPlain g{(const bf16_t*)(ws + WS_X2B), (const bf16_t*)(ws + WS_WQ), 1024, 1024, 1024};
        pg8::StaticOrder S_; S_.init(M, 2048, F.G, (int)blockIdx.x);
        EpiP5 E{(bf16_t*)F.out, (const float*)(ws + WS_SSQ2)};
        pg8::gemm_phase<EpiP5, pg8::StaticOrder, GemmPlain>(F.lds, g, S_, E);
        SEAM(6);
    }
    TSTAMP(7);
    if (IN(7)) { p7_select(F); SEAM(7); }
    TSTAMP(8);
    if (IN(8)) { p8_uphase<0>(F); SEAM(8); }
#if PROBE_GATHER
    if (IN(8)) { p8_uphase<PROBE_GATHER>(F); SEAM(8); }
#endif
    TSTAMP(9);
    if (IN(9)) { p8b_combine(F); SEAM(9); }
    TSTAMP(10);
    if (IN(10)) { p9_vphase<0>(F); SEAM(10); }
#if PROBE_GATHER >= 4
    if (IN(10)) { p9_vphase<PROBE_GATHER - 3>(F); SEAM(10); }
#endif
    TSTAMP(11);
    if (IN(11)) { p10_final(F); }
    TSTAMP(12);
#if TIME_PHASE >= 0
    if (blockIdx.x == 0 && F.tid == 0) { const unsigned long long dt = tp1 - tp0, t_end = __builtin_amdgcn_s_memrealtime(); while (__builtin_amdgcn_s_memrealtime() - t_end < 8ull * dt) __builtin_amdgcn_s_sleep(8); }
#endif
#undef IN
#undef SEAM
}
#if DEBUG_CMP
namespace dbg {
__device__ __forceinline__ int colmap(int c, int mode) {
    if (mode == 1) { const int hb = c & ~63, p = c & 63; return hb + (p >> 1) + ((p & 1) << 5); }
    if (mode == 2) { return (c >> 1) + ((c & 1) << 4); }
    if (mode == 3) { const int h = c / 96, p = c % 96; if (p < 64) return c; const int q = p - 64; return h * 96 + 64 + (q >> 1) + ((q & 1) << 4); }
    return c;
}
template <class T> __device__ __forceinline__ float ldv(const T* p);
template <> __device__ __forceinline__ float ldv<float>(const float* p) { return *p; }
template <> __device__ __forceinline__ float ldv<bf16_t>(const bf16_t* p) { return __builtin_bit_cast(float, (unsigned)(*p) << 16); }
template <class T>
__global__ void cmp_k(const T* opt, int ld_opt, const float* ref, int ld_ref, int rows, int cols, float scale, int mode, unsigned* err, int stage) {
    const size_t n = (size_t)rows * cols; float md = 0.f, mr = 0.f;
    for (size_t i = (size_t)blockIdx.x * blockDim.x + threadIdx.x; i < n; i += (size_t)gridDim.x * blockDim.x) {
        const int r = (int)(i / cols), c = (int)(i % cols);
        const float o = ldv<T>(opt + (size_t)r * ld_opt + c) * scale, rf = ref[(size_t)r * ld_ref + colmap(c, mode)];
        float d = fabsf(o - rf); if (!(d == d)) d = 1.0e30f;
        md = fmaxf(md, d); mr = fmaxf(mr, fabsf(rf));
    }
    for (int o = 32; o > 0; o >>= 1) { md = fmaxf(md, __shfl_xor(md, o)); mr = fmaxf(mr, __shfl_xor(mr, o)); }
    if ((threadIdx.x & 63) == 0) { atomicMax(err + 2 * stage, __float_as_uint(md)); atomicMax(err + 2 * stage + 1, __float_as_uint(mr)); }
}
__global__ void encode_k(float* out, const unsigned* err, int nstage, int sel, float thr) {
    float eps2 = 0.f;
    if (sel >= 0) { const float e = __uint_as_float(err[2 * sel]) / fmaxf(__uint_as_float(err[2 * sel + 1]), 1e-30f); eps2 = fminf(fmaxf(e, 1e-4f), 0.9f); }
    else for (int k = 0; k < nstage; ++k) { const float e = __uint_as_float(err[2 * k]) / fmaxf(__uint_as_float(err[2 * k + 1]), 1e-30f);
        if (!(e < thr)) { eps2 = exp2f(-(float)(k + 1)) * (1.f + 0.9f * fminf(e, 1.f)); break; } }
    const float sc = 1.f + sqrtf(eps2);
    const size_t i = ((size_t)blockIdx.x * blockDim.x + threadIdx.x) * 4; f32x4 v = *(f32x4*)(out + i); v = v * sc; *(f32x4*)(out + i) = v;
}
}
#endif

static void launch_phases(const Args& base, int lo, int hi, int grid, hipStream_t stream) {
    Args a = base; a.ph_lo = lo; a.ph_hi = hi;
#if ONE_LAUNCH
    void* kargs[] = {(void*)&a};
    hipError_t e = hipLaunchCooperativeKernel((const void*)fwd_kernel, dim3(grid), dim3(512), kargs, LDS_BYTES, stream);
    if (e != hipSuccess) fprintf(stderr, "cooperative launch failed: %s (grid %d)\n", hipGetErrorString(e), grid);
#else
    hipLaunchKernelGGL(fwd_kernel, dim3(grid), dim3(512), LDS_BYTES, stream, a);
#endif
}

extern "C" void kernel_launch(void* const* d_in, const int* in_sizes, int n_in, void* d_out, int out_size, void* d_ws, size_t ws_size, hipStream_t stream) {
    static int grid = 0;
    if (grid == 0) {
        int dev = 0, cus = 0, per_cu = 0;
        hipGetDevice(&dev); hipDeviceGetAttribute(&cus, hipDeviceAttributeMultiprocessorCount, dev);
        hipFuncSetAttribute((const void*)fwd_kernel, hipFuncAttributeMaxDynamicSharedMemorySize, LDS_BYTES);
        hipOccupancyMaxActiveBlocksPerMultiprocessor(&per_cu, (const void*)fwd_kernel, 512, LDS_BYTES);
        if (per_cu < 1) { fprintf(stderr, "occupancy query says %d blocks/CU\n", per_cu); per_cu = 1; }
        grid = cus * 1;
        if (grid > 256) grid = 256;
        (void)hipGetLastError();
    }
    Args a{};
    for (int i = 0; i < 15; ++i) a.in[i] = (const float*)d_in[i];
    a.out = (float*)d_out; a.ws = (unsigned char*)d_ws;
    (void)hipMemsetAsync(a.ws + WS_CTL, 0, CTL_ZERO_BYTES, stream);
#if !DEBUG_CMP
#if ONE_LAUNCH
    launch_phases(a, 0, NPHASE, grid, stream);
#else
    for (int p = 0; p < NPHASE; ++p) launch_phases(a, p, p + 1, grid, stream);
#endif
#else
    using nv::rmsnorm_k; using nv::gemm_k; using nv::rope_k; using nv::copy_cols_k; using nv::dilated_k; using nv::mla_k; using nv::peer_k; constexpr int PW = nv::PW;
    unsigned char* ws = (unsigned char*)d_ws;
    unsigned* err = (unsigned*)(ws + 505 * MiB);
    hipMemsetAsync(err, 0, 256, stream);
    float* hb = (float*)(ws + 404 * MiB); float* projb = (float*)(ws + 420 * MiB); float* qn = (float*)(ws + 456 * MiB); float* knn = (float*)(ws + 469 * MiB);
    float* krn = (float*)(ws + 477 * MiB); float* vn = (float*)(ws + 478 * MiB); float* mixb = (float*)(ws + 486 * MiB);
    const float* x = (const float*)d_in[0];
    hipStream_t st = stream;
    launch_phases(a, 0, 1, grid, stream); launch_phases(a, 1, 2, grid, stream);
    rmsnorm_k<<<S / 4, 256, 0, st>>>(x, D, (const float*)d_in[1], hb, D, D, S);
    gemm_k<<<dim3((PW + 63) / 64, S / 64), 256, 0, st>>>(hb, D, (const float*)d_in[2], PW, projb, PW, nullptr, 0, S, PW, D);
    rope_k<<<(S * 8 * 32 + 255) / 256, 256, 0, st>>>(projb, PW, 0, 8, 64, S);
    rope_k<<<(S * 8 * 32 + 255) / 256, 256, 0, st>>>(projb, PW, 512, 8, 64, S);
    copy_cols_k<<<(S * 32 + 255) / 256, 256, 0, st>>>(projb + 2048, PW, krn, 32, 32, S);
    rope_k<<<(S * 16 + 255) / 256, 256, 0, st>>>(krn, 32, 0, 1, 32, S);
    dbg::cmp_k<bf16_t><<<1024, 256, 0, st>>>((const bf16_t*)(ws + WS_QA), 512, projb, PW, S, 512, 1.f / QSCALE_A, 1, err, 0);
    dbg::cmp_k<bf16_t><<<1024, 256, 0, st>>>((const bf16_t*)(ws + WS_KA), 512, projb + 512, PW, S, 512, 1.f, 1, err, 1);
    dbg::cmp_k<bf16_t><<<1024, 256, 0, st>>>((const bf16_t*)(ws + WS_VA), 512, projb + 1024, PW, S, 512, 1.f, 0, err, 2);
    dbg::cmp_k<bf16_t><<<1024, 256, 0, st>>>((const bf16_t*)(ws + WS_CQ), 256, projb + 1536, PW, S, 256, 1.f, 0, err, 3);
    dbg::cmp_k<bf16_t><<<1024, 256, 0, st>>>((const bf16_t*)(ws + WS_CKV), 256, projb + 1792, PW, S, 256, 1.f, 0, err, 4);
    dbg::cmp_k<bf16_t><<<1024, 256, 0, st>>>((const bf16_t*)(ws + WS_KR), 32, krn, 32, S, 32, 1.f, 2, err, 5);
    launch_phases(a, 2, 3, grid, stream);
    {   float* cqn = hb; float* ckvn = hb + (size_t)S * 256;
        rmsnorm_k<<<S / 4, 256, 0, st>>>(projb + 1536, PW, (const float*)d_in[3], cqn, 256, 256, S);
        rmsnorm_k<<<S / 4, 256, 0, st>>>(projb + 1792, PW, (const float*)d_in[4], ckvn, 256, 256, S);
        gemm_k<<<dim3(768 / 64, S / 64), 256, 0, st>>>(cqn, 256, (const float*)d_in[5], 768, qn, 768, nullptr, 0, S, 768, 256);
        for (int h = 0; h < 8; ++h) rope_k<<<(S * 16 + 255) / 256, 256, 0, st>>>(qn, 768, h * 96 + 64, 1, 32, S);
        gemm_k<<<dim3(512 / 64, S / 64), 256, 0, st>>>(ckvn, 256, (const float*)d_in[6], 512, knn, 512, nullptr, 0, S, 512, 256);
        gemm_k<<<dim3(512 / 64, S / 64), 256, 0, st>>>(ckvn, 256, (const float*)d_in[7], 512, vn, 512, nullptr, 0, S, 512, 256); }
    dbg::cmp_k<bf16_t><<<1024, 256, 0, st>>>((const bf16_t*)(ws + WS_QB), 768, qn, 768, S, 768, 1.f / QSCALE_B, 3, err, 6);
    dbg::cmp_k<bf16_t><<<1024, 256, 0, st>>>((const bf16_t*)(ws + WS_KN), 512, knn, 512, S, 512, 1.f, 0, err, 7);
    dbg::cmp_k<bf16_t><<<1024, 256, 0, st>>>((const bf16_t*)(ws + WS_VB), 512, vn, 512, S, 512, 1.f, 0, err, 8);
    launch_phases(a, 3, 4, grid, stream); launch_phases(a, 4, 5, grid, stream);
    dilated_k<<<8 * S / 4, 256, 0, st>>>(projb, mixb);
    mla_k<<<1 * 8 * (S / 64), 64, 0, st>>>(qn, knn, krn, vn, mixb);
    dbg::cmp_k<bf16_t><<<1024, 256, 0, st>>>((const bf16_t*)(ws + WS_MIX), 1024, mixb, 1024, S, 512, 1.f, 0, err, 9);
    dbg::cmp_k<bf16_t><<<1024, 256, 0, st>>>((const bf16_t*)(ws + WS_MIX) + 512, 1024, mixb + 512, 1024, S, 512, 1.f, 0, err, 10);
    launch_phases(a, 5, 6, grid, stream);
    float* x2b = hb;
    gemm_k<<<dim3(D / 64, S / 64), 256, 0, st>>>(mixb, 1024, (const float*)d_in[8], D, x2b, D, x, D, S, D, 1024);
    dbg::cmp_k<bf16_t><<<1024, 256, 0, st>>>((const bf16_t*)(ws + WS_X2B), 1024, x2b, 1024, S, 1024, 1.f, 0, err, 11);
    launch_phases(a, 6, 7, grid, stream);
    float* h2c = qn; float* qpc = projb;
    rmsnorm_k<<<4096 / 4, 256, 0, st>>>(x2b, D, (const float*)d_in[9], h2c, D, D, 4096);
    gemm_k<<<dim3(2048 / 64, 4096 / 64), 256, 0, st>>>(h2c, D, (const float*)d_in[10], 2048, qpc, 2048, nullptr, 0, 4096, 2048, D);
    dbg::cmp_k<bf16_t><<<1024, 256, 0, st>>>((const bf16_t*)d_out, 2048, qpc, 2048, S, 2048, 1.f, 0, err, 12);
    launch_phases(a, 7, 8, grid, stream); launch_phases(a, 8, 9, grid, stream); launch_phases(a, 9, 10, grid, stream); launch_phases(a, 10, 11, grid, stream); launch_phases(a, 11, 12, grid, stream);
    peer_k<<<4096 / 4, 256, 0, st>>>(h2c, qpc, (const float*)d_in[11], (const float*)d_in[12], (const float*)d_in[13], (const float*)d_in[14], x2b, 4096);
    dbg::cmp_k<float><<<1024, 256, 0, st>>>((const float*)d_out, 1024, x2b, 1024, S, 1024, 1.f, 0, err, 13);
    nv::run(d_in, (float*)d_out, (float*)d_ws, stream);
    dbg::encode_k<<<M * 1024 / 4 / 256, 256, 0, st>>>((float*)d_out, err, 14, DEBUG_SEL, 0.05f);
#endif
}
```

```cpp
#include <hip/hip_runtime.h>
#include <hip/hip_cooperative_groups.h>
#include <cstdio>
#include <cstdint>
#include <cmath>
namespace cg = cooperative_groups;
#define DEBUG_CMP 0
#define ONE_LAUNCH 1
#define DEBUG_SEL -1
#define TIME_PHASE -1
#define PROBE_GATHER 0
#define PROBE_ATTN 0
#define LAS __attribute__((address_space(3)))
#define GAS __attribute__((address_space(1)))
typedef unsigned short bf16_t;
typedef short bf16x8 __attribute__((ext_vector_type(8)));
typedef short s16x4 __attribute__((ext_vector_type(4)));
typedef float f32x4 __attribute__((ext_vector_type(4)));
typedef float f32x16 __attribute__((ext_vector_type(16)));
typedef float f32x2_t __attribute__((ext_vector_type(2)));
typedef __bf16 bf16x2_t __attribute__((ext_vector_type(2)));
typedef unsigned u32x4 __attribute__((ext_vector_type(4)));
typedef unsigned u32x2 __attribute__((ext_vector_type(2)));

constexpr int NB = 8, S = 4096, M = NB * S, D = 1024;
constexpr float NORM_EPS = 1e-6f;
constexpr float LOG2E = 1.4426950408889634f;
constexpr float QSCALE_A = 0.125f * LOG2E;
constexpr float QSCALE_B = 0.10206207261596577f * LOG2E;

__device__ __forceinline__ unsigned cvtpk(float lo, float hi) { f32x2_t v = {lo, hi}; bf16x2_t b = __builtin_convertvector(v, bf16x2_t); return __builtin_bit_cast(unsigned, b); }
__device__ __forceinline__ float bf_lo(unsigned w) { return __builtin_bit_cast(float, w << 16); }
__device__ __forceinline__ float bf_hi(unsigned w) { return __builtin_bit_cast(float, w & 0xffff0000u); }

#define ASM_GLDS16(gptr, ldsaddr) asm volatile("s_mov_b32 m0, %0\n\ts_nop 0\n\tglobal_load_lds_dwordx4 %1, off" :: "s"(ldsaddr), "v"(gptr) : "m0")

namespace pg8 {
constexpr int BM = 256, BK = 64, HALF = 128, HTB = HALF * BK * 2, STAGE_BYTES = 8 * HTB, NXCD = 8, WGM = 8;
__host__ __device__ __forceinline__ int lds_byte(int r, int c) { const int st = (r >> 4) * 2 + (c >> 5), rr = r & 15, cc = c & 31, ob = rr * 64 + cc * 2; return st * 1024 + (ob ^ (((ob >> 9) & 1) << 5)); }
__host__ __device__ __forceinline__ void stage_rc(int b, int& R, int& C) { const int st = b / 1024, sb = b % 1024, swz = sb ^ (((sb >> 9) & 1) << 5); R = (st >> 1) * 16 + swz / 64; C = (st & 1) * 32 + (swz % 64) / 2; }
__host__ __device__ __forceinline__ int perm32(int rho) { const int n = rho >> 4, i = rho & 15; return 8 * (i >> 2) + 4 * n + (i & 3); }
struct Unit { int pm, pn; };
struct StaticOrder {
    int nM, nN, nwg, G, c;
    __device__ void init(int Mr, int N, int G_, int c_) { nM = Mr / BM; nN = N / BM; nwg = nM * nN; G = G_; c = c_; }
    __device__ bool next(int i, Unit& u) const {
        const long L = (long)i * G + c; if (L >= nwg) return false;
        int wgid = (int)L; { const int q = nwg / NXCD, r = nwg % NXCD, xcd = wgid % NXCD, off = wgid / NXCD; wgid = (xcd < r ? xcd * (q + 1) : r * (q + 1) + (xcd - r) * q) + off; }
        const int nig = WGM * nN, gid = wgid / nig, fm = gid * WGM, gsz = (nM - fm) < WGM ? (nM - fm) : WGM;
        u.pm = fm + ((wgid % nig) % gsz); u.pn = (wgid % nig) / gsz; return true;
    }
};
template <class Epi, class Sched, class G>
__device__ __forceinline__ void gemm_phase(LAS unsigned char* lds, const G g, const Sched& Sch, const Epi& E) {
    const int tid = threadIdx.x, wid = __builtin_amdgcn_readfirstlane(tid >> 6), lane = tid & 63, wr = wid >> 2, wc = wid & 3, fr = lane & 15, fq = lane >> 4;
    const int K = g.K, nt = K / BK;
    unsigned voffA[2], voffB[2];
#pragma unroll
    for (int i = 0; i < 2; ++i) { int R, C; stage_rc(tid * 16 + i * 8192, R, C); const int Rb = Epi::PERM ? ((R & ~31) + perm32(R & 31)) : R;
        voffA[i] = (unsigned)(R * g.lda + C) * 2u; voffB[i] = (unsigned)(Rb * g.ldb + C) * 2u; }
    const size_t kstep = (size_t)(BK * 2);
    const size_t hstepA = (size_t)HALF * g.lda * 2, hstepB = (size_t)HALF * g.ldb * 2;
    const unsigned ldsw = (unsigned)wid * 1024u;
    const int aoff = lds_byte(wr * 64 + fr, fq * 8), boff = lds_byte(wc * 32 + fr, fq * 8);
#define PG8_SA(b, h) (((b) * 2 + (h)) * HTB)
#define PG8_SB(b, h) ((4 + (b) * 2 + (h)) * HTB)
#define PG8_STAGE(bufoff, gbase, voff) do { _Pragma("unroll") for (int _i = 0; _i < 2; ++_i) \
        __builtin_amdgcn_global_load_lds((const unsigned*)((const char*)(gbase) + (voff)[_i]), (LAS unsigned*)(lds + (bufoff) + ldsw + _i * 8192), 16, 0, 0); } while (0)
#define PG8_LDA(dst, b, h) do { _Pragma("unroll") for (int m = 0; m < 4; ++m) _Pragma("unroll") for (int k = 0; k < 2; ++k) dst[m][k] = *(const LAS bf16x8*)(lds + PG8_SA(b, h) + aoff + m * 2048 + k * 1024); } while (0)
#define PG8_LDB(dst, b, h) do { _Pragma("unroll") for (int n = 0; n < 2; ++n) _Pragma("unroll") for (int k = 0; k < 2; ++k) dst[n][k] = *(const LAS bf16x8*)(lds + PG8_SB(b, h) + boff + n * 2048 + k * 1024); } while (0)
#define PG8_MMA(ai, bj, At, Bt) do { __builtin_amdgcn_s_setprio(1); _Pragma("unroll") for (int m = 0; m < 4; ++m) _Pragma("unroll") for (int n = 0; n < 2; ++n) _Pragma("unroll") for (int k = 0; k < 2; ++k) \
        acc[ai][bj][m][n] = __builtin_amdgcn_mfma_f32_16x16x32_bf16(Bt[n][k], At[m][k], acc[ai][bj][m][n], 0, 0, 0); __builtin_amdgcn_s_setprio(0); } while (0)
#define PG8_WAIT_V(n) asm volatile("s_waitcnt vmcnt(" #n ")" ::: "memory")
#define PG8_WAIT_L(n) asm volatile("s_waitcnt lgkmcnt(" #n ")" ::: "memory")
#define PG8_BAR __builtin_amdgcn_s_barrier()
#define PG8_SCHED __builtin_amdgcn_sched_barrier(0)
    Unit cur, nxt; int ui = 0;
    if (!Sch.next(0, cur)) return;
    f32x4 acc[2][2][4][2];
#pragma unroll
    for (int a = 0; a < 2; ++a)
#pragma unroll
        for (int b = 0; b < 2; ++b)
#pragma unroll
            for (int m = 0; m < 4; ++m)
#pragma unroll
                for (int n = 0; n < 2; ++n) acc[a][b][m][n] = (f32x4){0.f, 0.f, 0.f, 0.f};
    bf16x8 At[4][2], B0[2][2], B1[2][2];
    const char* cA = g.a_base(cur); const char* cB = g.b_base(cur);
    PG8_STAGE(PG8_SB(0, 0), cB, voffB); PG8_STAGE(PG8_SB(0, 1), cB + hstepB, voffB); PG8_STAGE(PG8_SA(0, 0), cA, voffA); PG8_STAGE(PG8_SA(0, 1), cA + hstepA, voffA);
    if (wr == 1) PG8_BAR;
    PG8_WAIT_V(2); PG8_BAR;
    PG8_STAGE(PG8_SB(1, 0), cB + kstep, voffB); PG8_STAGE(PG8_SA(1, 0), cA + kstep, voffA); PG8_STAGE(PG8_SB(1, 1), cB + hstepB + kstep, voffB);
    PG8_WAIT_V(6); PG8_BAR;
    for (;;) {
        const bool has_next = Sch.next(ui + 1, nxt);
        const char* nA = has_next ? g.a_base(nxt) : cA; const char* nB = has_next ? g.b_base(nxt) : cB;
        for (int t = 0; t < nt; t += 2) {
            const bool last = (t == nt - 2);
            const char* a1 = cA + (size_t)(t + 1) * kstep;
            const char* a2 = last ? nA : cA + (size_t)(t + 2) * kstep; const char* b2 = last ? nB : cB + (size_t)(t + 2) * kstep;
            const char* a3 = a2 + kstep; const char* b3 = b2 + kstep;
            PG8_LDB(B0, 0, 0); PG8_LDB(B1, 0, 1); PG8_SCHED; PG8_LDA(At, 0, 0); PG8_STAGE(PG8_SA(1, 1), a1 + hstepA, voffA);
            PG8_WAIT_V(8); PG8_WAIT_L(0); PG8_BAR; PG8_MMA(0, 0, At, B0); PG8_MMA(0, 1, At, B1); PG8_BAR; PG8_SCHED;
            PG8_LDA(At, 0, 1); PG8_STAGE(PG8_SB(0, 0), b2, voffB); PG8_STAGE(PG8_SB(0, 1), b2 + hstepB, voffB); PG8_STAGE(PG8_SA(0, 0), a2, voffA);
            PG8_WAIT_V(8); PG8_WAIT_L(0); PG8_BAR; PG8_MMA(1, 0, At, B0); PG8_MMA(1, 1, At, B1); PG8_BAR; PG8_SCHED;
            PG8_LDB(B0, 1, 0); PG8_LDB(B1, 1, 1); PG8_SCHED; PG8_LDA(At, 1, 0); PG8_STAGE(PG8_SA(0, 1), a2 + hstepA, voffA);
            PG8_WAIT_V(8); PG8_WAIT_L(0); PG8_BAR; PG8_MMA(0, 0, At, B0); PG8_MMA(0, 1, At, B1); PG8_BAR; PG8_SCHED;
            PG8_LDA(At, 1, 1); PG8_STAGE(PG8_SB(1, 0), b3, voffB); PG8_STAGE(PG8_SB(1, 1), b3 + hstepB, voffB); PG8_STAGE(PG8_SA(1, 0), a3, voffA);
            PG8_WAIT_V(8); PG8_WAIT_L(0); PG8_BAR; PG8_MMA(1, 0, At, B0); PG8_MMA(1, 1, At, B1); PG8_BAR; PG8_SCHED;
        }
        if (wr == 0) PG8_BAR;
        E(acc, cur, wr, wc, fr, fq);
        if (!has_next) break;
#pragma unroll
        for (int a = 0; a < 2; ++a)
#pragma unroll
            for (int b = 0; b < 2; ++b)
#pragma unroll
                for (int m = 0; m < 4; ++m)
#pragma unroll
                    for (int n = 0; n < 2; ++n) acc[a][b][m][n] = (f32x4){0.f, 0.f, 0.f, 0.f};
        cur = nxt; cA = nA; cB = nB; ++ui;
        if (wr == 1) PG8_BAR;
    }
    PG8_WAIT_V(0);
    PG8_BAR;
#undef PG8_SA
#undef PG8_SB
#undef PG8_STAGE
#undef PG8_LDA
#undef PG8_LDB
#undef PG8_MMA
#undef PG8_WAIT_V
#undef PG8_WAIT_L
#undef PG8_BAR
#undef PG8_SCHED
}
}
constexpr size_t MiB = 1u << 20;
constexpr size_t WS_CTL = 0;
constexpr size_t WS_WIN = 2 * MiB;
constexpr size_t WS_WKR = 6 * MiB;
constexpr size_t WS_WUQ = 7 * MiB;
constexpr size_t WS_WUKV = 8 * MiB;
constexpr size_t WS_WO = 9 * MiB;
constexpr size_t WS_WQ = 11 * MiB;
constexpr size_t WS_KEYS = 15 * MiB;
constexpr size_t WS_ROPE = 16 * MiB;
constexpr size_t WS_U = 18 * MiB;
constexpr size_t WS_V = 50 * MiB;
constexpr size_t WS_SSQ1 = 82 * MiB;
constexpr size_t WS_SSQ2 = 84 * MiB;
constexpr size_t WS_XN = 96 * MiB;
constexpr size_t WS_MIX = WS_XN;
constexpr size_t WS_QA = 160 * MiB, WS_KA = 192 * MiB, WS_VA = 224 * MiB;
constexpr size_t WS_X2B = 160 * MiB;
constexpr size_t WS_CQ = 256 * MiB, WS_CKV = 272 * MiB;
constexpr size_t WS_KR = 288 * MiB;
constexpr size_t WS_QB = 292 * MiB;
constexpr size_t WS_KN = 340 * MiB, WS_VB = 372 * MiB;
constexpr size_t WS_X2 = 292 * MiB;
constexpr size_t WS_END_OPT = 420 * MiB;
constexpr size_t DO_OP = 0, DO_LSE = 96 * MiB;

struct Args { const float* in[15]; float* out; unsigned char* ws; int ph_lo, ph_hi; };

struct Frame {
    LAS unsigned char* lds;
    int tid, lane, wave, vcu, G;
    const float* in[15]; float* out; unsigned char* ws;
};

__device__ __forceinline__ float wave_sum(float v) {
#pragma unroll
    for (int o = 1; o < 64; o <<= 1) v += __shfl_xor(v, o);
    return v;
}

__device__ __forceinline__ int perm_win(int np) {
    if (np < 1024) { const int hb = np & ~63, p = np & 63; return hb + (p >> 1) + ((p & 1) << 5); }
    return np;
}
__device__ __forceinline__ int perm_wkr(int np) { return 2048 + (np >> 1) + ((np & 1) << 4); }
__device__ __forceinline__ int perm_wuq(int np) { const int h = np / 96, p = np % 96; if (p < 64) return np; const int q = p - 64; return h * 96 + 64 + (q >> 1) + ((q & 1) << 4); }

template <int PERM>
__device__ __forceinline__ void transpose_item(const float* __restrict__ W, int K, int N, const float* __restrict__ gk, bf16_t* __restrict__ WT, int row_off, LAS float* scr, int item, int nblk, int lane) {
    const int kb = item / nblk, nb = item % nblk, k0 = 64 * kb, n0 = 32 * nb;
    const int npx = n0 + (lane & 31);
    const int nl = PERM == 1 ? perm_win(npx) : PERM == 2 ? perm_wkr(npx) : PERM == 3 ? perm_wuq(npx) : npx;
#pragma unroll 8
    for (int i = 0; i < 32; ++i) { const int kk = 2 * i + (lane >> 5); float v = W[(size_t)(k0 + kk) * N + nl]; if (gk) v *= gk[k0 + kk]; scr[kk * 33 + (lane & 31)] = v; }
    asm volatile("s_waitcnt lgkmcnt(0)" ::: "memory");
    const int c = lane & 7;
#pragma unroll
    for (int j = 0; j < 4; ++j) { const int n = (lane >> 3) + 8 * j; const LAS float* s = scr + (8 * c) * 33 + n;
        u32x4 o; o.x = cvtpk(s[0 * 33], s[1 * 33]); o.y = cvtpk(s[2 * 33], s[3 * 33]); o.z = cvtpk(s[4 * 33], s[5 * 33]); o.w = cvtpk(s[6 * 33], s[7 * 33]);
        *(u32x4*)(WT + (size_t)(row_off + n0 + n) * K + k0 + 8 * c) = o; }
    asm volatile("s_waitcnt lgkmcnt(0)" ::: "memory");
}

__device__ __forceinline__ void p0_prologue(Frame& F) {
    LAS float* scr = (LAS float*)(F.lds + F.wave * 16384);
    const int gw = F.vcu * 8 + F.wave, NGW = F.G * 8, lane = F.lane;
    unsigned char* ws = F.ws;
    constexpr int I_WIN = (1024 / 64) * (2048 / 32), I_WKR = (1024 / 64) * 1, I_WUQ = (256 / 64) * (768 / 32), I_WUK = (256 / 64) * (512 / 32), I_WO = (1024 / 64) * (1024 / 32), I_WQ = (1024 / 64) * (2048 / 32);
    constexpr int NIT = I_WIN + I_WKR + I_WUQ + 2 * I_WUK + I_WO + I_WQ;
    for (int it = gw; it < NIT; it += NGW) {
        int r = it;
        if (r < I_WIN) { transpose_item<1>(F.in[2], 1024, 2080, nullptr, (bf16_t*)(ws + WS_WIN), 0, scr, r, 2048 / 32, lane); continue; } r -= I_WIN;
        if (r < I_WKR) { transpose_item<2>(F.in[2], 1024, 2080, nullptr, (bf16_t*)(ws + WS_WKR), 0, scr, r, 1, lane); continue; } r -= I_WKR;
        if (r < I_WUQ) { transpose_item<3>(F.in[5], 256, 768, F.in[3], (bf16_t*)(ws + WS_WUQ), 0, scr, r, 768 / 32, lane); continue; } r -= I_WUQ;
        if (r < I_WUK) { transpose_item<0>(F.in[6], 256, 512, F.in[4], (bf16_t*)(ws + WS_WUKV), 0, scr, r, 512 / 32, lane); continue; } r -= I_WUK;
        if (r < I_WUK) { transpose_item<0>(F.in[7], 256, 512, F.in[4], (bf16_t*)(ws + WS_WUKV), 512, scr, r, 512 / 32, lane); continue; } r -= I_WUK;
        if (r < I_WO) { transpose_item<0>(F.in[8], 1024, 1024, nullptr, (bf16_t*)(ws + WS_WO), 0, scr, r, 1024 / 32, lane); continue; } r -= I_WO;
        transpose_item<0>(F.in[10], 1024, 2048, F.in[9], (bf16_t*)(ws + WS_WQ), 0, scr, r, 2048 / 32, lane);
    }
    {
        const float* g = F.in[1];
        f32x4 gg[4];
#pragma unroll
        for (int j = 0; j < 4; ++j) gg[j] = *(const f32x4*)(g + 256 * j + 4 * lane);
        auto ldrow = [&](int r, f32x4 (&v)[4]) { const float* sp = F.in[0] + (size_t)(r < M ? r : gw) * 1024;
#pragma unroll
            for (int j = 0; j < 4; ++j) v[j] = *(const f32x4*)(sp + 256 * j + 4 * lane); };
        f32x4 va[4], vb[4], na[4], nb[4];
        ldrow(gw, va); ldrow(gw + NGW, vb);
        for (int r0 = gw; r0 < M; r0 += 2 * NGW) {
            const int r1 = r0 + NGW; const bool two = r1 < M;
            ldrow(r0 + 2 * NGW, na); ldrow(r1 + 2 * NGW, nb);
            float ssa = 0.f, ssb = 0.f;
#pragma unroll
            for (int j = 0; j < 4; ++j) { ssa += (va[j].x * va[j].x + va[j].y * va[j].y) + (va[j].z * va[j].z + va[j].w * va[j].w); ssb += (vb[j].x * vb[j].x + vb[j].y * vb[j].y) + (vb[j].z * vb[j].z + vb[j].w * vb[j].w); }
            const float rsa = rsqrtf(wave_sum(ssa) * (1.f / 1024.f) + NORM_EPS), rsb = rsqrtf(wave_sum(ssb) * (1.f / 1024.f) + NORM_EPS);
            bf16_t* da = (bf16_t*)(ws + WS_XN) + (size_t)r0 * 1024; bf16_t* db = (bf16_t*)(ws + WS_XN) + (size_t)r1 * 1024;
#pragma unroll
            for (int j = 0; j < 4; ++j) {
                u32x2 o; o.x = cvtpk(va[j].x * rsa * gg[j].x, va[j].y * rsa * gg[j].y); o.y = cvtpk(va[j].z * rsa * gg[j].z, va[j].w * rsa * gg[j].w);
                *(u32x2*)(da + 256 * j + 4 * lane) = o;
                if (two) { u32x2 p; p.x = cvtpk(vb[j].x * rsb * gg[j].x, vb[j].y * rsb * gg[j].y); p.y = cvtpk(vb[j].z * rsb * gg[j].z, vb[j].w * rsb * gg[j].w); *(u32x2*)(db + 256 * j + 4 * lane) = p; } }
#pragma unroll
            for (int j = 0; j < 4; ++j) { va[j] = na[j]; vb[j] = nb[j]; }
        }
    }
    {
        const int gt = F.vcu * 512 + F.tid, NT = F.G * 512;
        for (int i = gt; i < 262144 / 8; i += NT) { const f32x4 a = *(const f32x4*)(F.in[11] + (size_t)i * 8), b = *(const f32x4*)(F.in[11] + (size_t)i * 8 + 4);
            u32x4 o; o.x = cvtpk(a.x, a.y); o.y = cvtpk(a.z, a.w); o.z = cvtpk(b.x, b.y); o.w = cvtpk(b.z, b.w); *(u32x4*)((bf16_t*)(ws + WS_KEYS) + (size_t)i * 8) = o; }
        float* CA = (float*)(ws + WS_ROPE); float* SA = CA + 4096 * 32; float* CB = SA + 4096 * 32; float* SB = CB + 4096 * 16;
        for (int i = gt; i < 4096 * 32; i += NT) { const int pos = i >> 5, k = i & 31; const float inv = 1.0f / powf(10000.0f, (float)(2 * k) / 64.0f); const float ang = (float)pos * inv; CA[i] = cosf(ang); SA[i] = sinf(ang); }
        for (int i = gt; i < 4096 * 16; i += NT) { const int pos = i >> 4, k = i & 15; const float inv = 1.0f / powf(10000.0f, (float)(2 * k) / 32.0f); const float ang = (float)pos * inv; CB[i] = cosf(ang); SB[i] = sinf(ang); }
    }
}

struct GemmPlain {
    const bf16_t* A; const bf16_t* Bt; int K, lda, ldb;
    __device__ __forceinline__ const char* a_base(const pg8::Unit& u) const { return (const char*)(A + (size_t)u.pm * 256 * lda); }
    __device__ __forceinline__ const char* b_base(const pg8::Unit& u) const { return (const char*)(Bt + (size_t)u.pn * 256 * ldb); }
};
struct GemmUp {
    const bf16_t* CQ; const bf16_t* CKV; const bf16_t* WUQ; const bf16_t* WUKV; int K, lda, ldb;
    __device__ __forceinline__ const char* a_base(const pg8::Unit& u) const { return (const char*)((u.pn < 3 ? CQ : CKV) + (size_t)u.pm * 256 * 256); }
    __device__ __forceinline__ const char* b_base(const pg8::Unit& u) const { return (const char*)(u.pn < 3 ? WUQ + (size_t)u.pn * 256 * 256 : WUKV + (size_t)(u.pn - 3) * 256 * 256); }
};

__device__ __forceinline__ void rope4(f32x4& v0, f32x4& v1, const f32x4 cs, const f32x4 sn) {
    const f32x4 a = v0, b = v1;
    v0.x = a.x * cs.x - a.y * sn.x; v0.y = a.y * cs.x + a.x * sn.x; v0.z = a.z * cs.y - a.w * sn.y; v0.w = a.w * cs.y + a.z * sn.y;
    v1.x = b.x * cs.z - b.y * sn.z; v1.y = b.y * cs.z + b.x * sn.z; v1.z = b.z * cs.w - b.w * sn.w; v1.w = b.w * cs.w + b.z * sn.w;
}
__device__ __forceinline__ void store8(bf16_t* p, const f32x4 v0, const f32x4 v1) { u32x4 w; w.x = cvtpk(v0.x, v0.y); w.y = cvtpk(v0.z, v0.w); w.z = cvtpk(v1.x, v1.y); w.w = cvtpk(v1.z, v1.w); *(u32x4*)p = w; }
__device__ __forceinline__ float dot4(const f32x4 v) { return (v.x * v.x + v.y * v.y) + (v.z * v.z + v.w * v.w); }

struct EpiP1 {
    static constexpr bool PERM = true;
    bf16_t *QA, *KA, *VA, *CQ, *CKV; float* SSQ1; const float *CA, *SA;
    __device__ __forceinline__ void operator()(const f32x4 (&acc)[2][2][4][2], const pg8::Unit& u, int wr, int wc, int fr, int fq) const {
        const int pn = u.pn, row0 = u.pm * 256 + wr * 64 + fr, cw = wc * 32 + 8 * fq;
        if (pn < 4) {
            bf16_t* base = pn < 2 ? QA : KA; const float sc = pn < 2 ? QSCALE_A : 1.f; const int colt = (pn & 1) * 256 + cw;
#pragma unroll
            for (int ai = 0; ai < 2; ++ai)
#pragma unroll
                for (int m = 0; m < 4; ++m) { const int row = row0 + ai * 128 + m * 16, pos = row & (S - 1);
#pragma unroll
                    for (int bj = 0; bj < 2; ++bj) { const int col = colt + bj * 128, i0 = (col & 63) >> 1;
                        const f32x4 cs = *(const f32x4*)(CA + pos * 32 + i0), sn = *(const f32x4*)(SA + pos * 32 + i0);
                        f32x4 v0 = acc[ai][bj][m][0] * sc, v1 = acc[ai][bj][m][1] * sc; rope4(v0, v1, cs, sn);
                        store8(base + (size_t)row * 512 + col, v0, v1); } }
        } else if (pn < 6) {
            const int colt = (pn & 1) * 256 + cw;
#pragma unroll
            for (int ai = 0; ai < 2; ++ai)
#pragma unroll
                for (int m = 0; m < 4; ++m) { const int row = row0 + ai * 128 + m * 16;
#pragma unroll
                    for (int bj = 0; bj < 2; ++bj) store8(VA + (size_t)row * 512 + colt + bj * 128, acc[ai][bj][m][0], acc[ai][bj][m][1]); }
        } else {
            bf16_t* base = pn == 6 ? CQ : CKV;
#pragma unroll
            for (int ai = 0; ai < 2; ++ai)
#pragma unroll
                for (int m = 0; m < 4; ++m) { const int row = row0 + ai * 128 + m * 16; float s = 0.f;
#pragma unroll
                    for (int bj = 0; bj < 2; ++bj) { store8(base + (size_t)row * 256 + cw + bj * 128, acc[ai][bj][m][0], acc[ai][bj][m][1]); s += dot4(acc[ai][bj][m][0]) + dot4(acc[ai][bj][m][1]); }
                    s += __shfl_xor(s, 16); s += __shfl_xor(s, 32);
                    if (fq == 0) SSQ1[(size_t)row * 8 + (pn - 6) * 4 + wc] = s; }
        }
    }
};
struct EpiP2 {
    static constexpr bool PERM = true;
    bf16_t *QB, *KN, *VB; const float* SSQ1; const float *CB, *SB;
    __device__ __forceinline__ void operator()(const f32x4 (&acc)[2][2][4][2], const pg8::Unit& u, int wr, int wc, int fr, int fq) const {
        const int pn = u.pn, row0 = u.pm * 256 + wr * 64 + fr, cw = wc * 32 + 8 * fq, grp = pn < 3 ? 0 : 1;
#pragma unroll
        for (int ai = 0; ai < 2; ++ai)
#pragma unroll
            for (int m = 0; m < 4; ++m) { const int row = row0 + ai * 128 + m * 16, pos = row & (S - 1);
                const f32x4 sq = *(const f32x4*)(SSQ1 + (size_t)row * 8 + grp * 4);
                const float rs = rsqrtf(((sq.x + sq.y) + (sq.z + sq.w)) * (1.f / 256.f) + NORM_EPS);
                if (pn < 3) {
#pragma unroll
                    for (int bj = 0; bj < 2; ++bj) { const int col = pn * 256 + bj * 128 + cw, p = col % 96; const float sc = rs * QSCALE_B;
                        f32x4 v0 = acc[ai][bj][m][0] * sc, v1 = acc[ai][bj][m][1] * sc;
                        if (p >= 64) { const int i0 = (p - 64) >> 1; const f32x4 cs = *(const f32x4*)(CB + pos * 16 + i0), sn = *(const f32x4*)(SB + pos * 16 + i0); rope4(v0, v1, cs, sn); }
                        store8(QB + (size_t)row * 768 + col, v0, v1); }
                } else {
                    bf16_t* base = pn < 5 ? KN : VB; const int colt = ((pn - 3) & 1) * 256 + cw;
#pragma unroll
                    for (int bj = 0; bj < 2; ++bj) store8(base + (size_t)row * 512 + colt + bj * 128, acc[ai][bj][m][0] * rs, acc[ai][bj][m][1] * rs);
                }
            }
    }
};
struct EpiP4 {
    static constexpr bool PERM = true;
    const float* X; bf16_t* X2B; float* SSQ2;
    __device__ __forceinline__ void operator()(const f32x4 (&acc)[2][2][4][2], const pg8::Unit& u, int wr, int wc, int fr, int fq) const {
        const int row0 = u.pm * 256 + wr * 64 + fr, colt = u.pn * 256 + wc * 32 + 8 * fq;
#pragma unroll
        for (int ai = 0; ai < 2; ++ai)
#pragma unroll
            for (int m = 0; m < 4; ++m) { const int row = row0 + ai * 128 + m * 16; float s = 0.f;
#pragma unroll
                for (int bj = 0; bj < 2; ++bj) { const size_t off = (size_t)row * 1024 + colt + bj * 128;
                    const f32x4 v0 = acc[ai][bj][m][0] + *(const f32x4*)(X + off), v1 = acc[ai][bj][m][1] + *(const f32x4*)(X + off + 4);
                    store8(X2B + off, v0, v1); s += dot4(v0) + dot4(v1); }
                s += __shfl_xor(s, 16); s += __shfl_xor(s, 32);
                if (fq == 0) SSQ2[(size_t)row * 16 + u.pn * 4 + wc] = s; }
    }
};
struct EpiP5 {
    static constexpr bool PERM = true;
    bf16_t* QP; const float* SSQ2;
    __device__ __forceinline__ void operator()(const f32x4 (&acc)[2][2][4][2], const pg8::Unit& u, int wr, int wc, int fr, int fq) const {
        const int row0 = u.pm * 256 + wr * 64 + fr, colt = u.pn * 256 + wc * 32 + 8 * fq;
#pragma unroll
        for (int ai = 0; ai < 2; ++ai)
#pragma unroll
            for (int m = 0; m < 4; ++m) { const int row = row0 + ai * 128 + m * 16;
                const f32x4* sp = (const f32x4*)(SSQ2 + (size_t)row * 16); const f32x4 a = sp[0], b = sp[1], c = sp[2], d = sp[3];
                const float ss = ((a.x + a.y) + (a.z + a.w)) + ((b.x + b.y) + (b.z + b.w)) + ((c.x + c.y) + (c.z + c.w)) + ((d.x + d.y) + (d.z + d.w));
                const float rs = rsqrtf(ss * (1.f / 1024.f) + NORM_EPS);
#pragma unroll
                for (int bj = 0; bj < 2; ++bj) store8(QP + (size_t)row * 2048 + colt + bj * 128, acc[ai][bj][m][0] * rs, acc[ai][bj][m][1] * rs); }
    }
};

__device__ __forceinline__ void p1_krope(Frame& F) {
    const bf16_t* XN = (const bf16_t*)(F.ws + WS_XN); const bf16_t* WK = (const bf16_t*)(F.ws + WS_WKR); bf16_t* KR = (bf16_t*)(F.ws + WS_KR);
    const float* CB = (const float*)(F.ws + WS_ROPE) + 2 * 4096 * 32; const float* SB = CB + 4096 * 16;
    const int lane = F.lane, fr = lane & 15, fq = lane >> 4;
    for (int blk = F.vcu; blk < M / 128; blk += F.G) {
        const int row0 = blk * 128 + F.wave * 16;
        f32x4 c0 = {0.f, 0.f, 0.f, 0.f}, c1 = {0.f, 0.f, 0.f, 0.f};
        const bf16_t* ap = XN + (size_t)(row0 + fr) * 1024 + 8 * fq;
        const bf16_t* b0p = WK + (size_t)fr * 1024 + 8 * fq; const bf16_t* b1p = WK + (size_t)(16 + fr) * 1024 + 8 * fq;
#pragma unroll 4
        for (int ks = 0; ks < 32; ++ks) {
            const bf16x8 a = *(const bf16x8*)(ap + ks * 32), b0 = *(const bf16x8*)(b0p + ks * 32), b1 = *(const bf16x8*)(b1p + ks * 32);
            c0 = __builtin_amdgcn_mfma_f32_16x16x32_bf16(b0, a, c0, 0, 0, 0);
            c1 = __builtin_amdgcn_mfma_f32_16x16x32_bf16(b1, a, c1, 0, 0, 0);
        }
        const int row = row0 + fr, pos = row & (S - 1);
        u32x2 w0, w1;
        { const int i = 2 * fq; const float ca = CB[pos * 16 + i], sa = SB[pos * 16 + i], cb = CB[pos * 16 + i + 1], sb = SB[pos * 16 + i + 1];
          w0.x = cvtpk(c0.x * ca - c0.y * sa, c0.y * ca + c0.x * sa); w0.y = cvtpk(c0.z * cb - c0.w * sb, c0.w * cb + c0.z * sb); }
        { const int i = 8 + 2 * fq; const float ca = CB[pos * 16 + i], sa = SB[pos * 16 + i], cb = CB[pos * 16 + i + 1], sb = SB[pos * 16 + i + 1];
          w1.x = cvtpk(c1.x * ca - c1.y * sa, c1.y * ca + c1.x * sa); w1.y = cvtpk(c1.z * cb - c1.w * sb, c1.w * cb + c1.z * sb); }
        *(u32x2*)(KR + (size_t)row * 32 + 4 * fq) = w0; *(u32x2*)(KR + (size_t)row * 32 + 16 + 4 * fq) = w1;
    }
}
constexpr int AT_SLOT = 20480, AT_KB = 0, AT_VB = 12288;
__device__ __forceinline__ int crow(int r, int hi) { return (r & 3) + 8 * (r >> 2) + 4 * hi; }
__device__ __forceinline__ s16x4 vtr(const LAS unsigned char* p) { return __builtin_bit_cast(s16x4, __builtin_amdgcn_ds_read_tr16_b64_v4i16((LAS s16x4*)p)); }

constexpr float RESC_THR = 8.f;
__device__ __forceinline__ float max3f(float a, float b, float c) { float r; asm("v_max3_f32 %0, %1, %2, %3" : "=v"(r) : "v"(a), "v"(b), "v"(c)); return r; }
template <int NKS>
struct AttnCore {
    bf16x8 qr[NKS]; f32x16 o0, o1, negm; float m, l; bool fresh;
    __device__ __forceinline__ void init() { m = 0.f; l = 0.f; fresh = true;
#pragma unroll
        for (int r = 0; r < 16; ++r) { o0[r] = 0.f; o1[r] = 0.f; negm[r] = 0.f; } }
    template <class MaskF>
    __device__ __forceinline__ void tile(const LAS unsigned char* slot, int lane, bool need_mask, const MaskF& valid) {
        const int r32 = lane & 31, hi = lane >> 5;
        f32x16 p0, p1;
        const LAS unsigned char* kn = slot + AT_KB + r32 * 128; const LAS unsigned char* kr = slot + AT_KB + 8192 + r32 * 64;
#pragma unroll
        for (int d0 = 0; d0 < NKS; ++d0) {
            bf16x8 b0, b1;
            if (d0 < 4) { const int po = ((2 * d0 + hi) ^ ((r32 >> 1) & 7)) * 16; b0 = *(const LAS bf16x8*)(kn + po); b1 = *(const LAS bf16x8*)(kn + 4096 + po); }
            else { const int po = ((2 * (d0 - 4) + hi) ^ ((r32 >> 2) & 3)) * 16; b0 = *(const LAS bf16x8*)(kr + po); b1 = *(const LAS bf16x8*)(kr + 2048 + po); }
            if (d0 == 0) { p0 = __builtin_amdgcn_mfma_f32_32x32x16_bf16(b0, qr[0], negm, 0, 0, 0); p1 = __builtin_amdgcn_mfma_f32_32x32x16_bf16(b1, qr[0], negm, 0, 0, 0); }
            else { p0 = __builtin_amdgcn_mfma_f32_32x32x16_bf16(b0, qr[d0], p0, 0, 0, 0); p1 = __builtin_amdgcn_mfma_f32_32x32x16_bf16(b1, qr[d0], p1, 0, 0, 0); }
        }
        if (need_mask) {
#pragma unroll
            for (int r = 0; r < 16; ++r) { const int kk = crow(r, hi); if (!valid(kk)) p0[r] = -INFINITY; if (!valid(kk + 32)) p1[r] = -INFINITY; }
        }
        float ma = max3f(p0[0], p0[1], p1[0]), mb = max3f(p0[2], p0[3], p1[1]);
        ma = max3f(ma, p1[2], p1[3]);
#pragma unroll
        for (int r = 4; r < 16; r += 4) { ma = max3f(ma, p0[r], p0[r + 1]); mb = max3f(mb, p0[r + 2], p0[r + 3]); ma = max3f(ma, p1[r], p1[r + 1]); mb = max3f(mb, p1[r + 2], p1[r + 3]); }
        float dx = fmaxf(ma, mb);
        dx = fmaxf(dx, __shfl_xor(dx, 32));
        if (fresh || __any(dx > RESC_THR)) {
            const float dl = fresh ? fmaxf(dx, -100.f) : fmaxf(dx, 0.f), alpha = __builtin_amdgcn_exp2f(-dl);
            fresh = false;
            m += dl; l *= alpha;
#pragma unroll
            for (int r = 0; r < 16; ++r) { o0[r] *= alpha; o1[r] *= alpha; p0[r] -= dl; p1[r] -= dl; negm[r] = -m; }
        }
        float sa = 0.f, sb = 0.f, sc = 0.f, sd = 0.f;
#pragma unroll
        for (int r = 0; r < 16; r += 2) { p0[r] = __builtin_amdgcn_exp2f(p0[r]); p0[r + 1] = __builtin_amdgcn_exp2f(p0[r + 1]); p1[r] = __builtin_amdgcn_exp2f(p1[r]); p1[r + 1] = __builtin_amdgcn_exp2f(p1[r + 1]);
            sa += p0[r]; sb += p0[r + 1]; sc += p1[r]; sd += p1[r + 1]; }
        l += (sa + sb) + (sc + sd);
        u32x4 pw[4];
        pw[0] = (u32x4){cvtpk(p0[0], p0[1]), cvtpk(p0[2], p0[3]), cvtpk(p0[4], p0[5]), cvtpk(p0[6], p0[7])};
        pw[1] = (u32x4){cvtpk(p0[8], p0[9]), cvtpk(p0[10], p0[11]), cvtpk(p0[12], p0[13]), cvtpk(p0[14], p0[15])};
        pw[2] = (u32x4){cvtpk(p1[0], p1[1]), cvtpk(p1[2], p1[3]), cvtpk(p1[4], p1[5]), cvtpk(p1[6], p1[7])};
        pw[3] = (u32x4){cvtpk(p1[8], p1[9]), cvtpk(p1[10], p1[11]), cvtpk(p1[12], p1[13]), cvtpk(p1[14], p1[15])};
        const int vq = 4 * hi + ((lane & 15) >> 2), vsw = ((vq >> 1) & 1) * 4, vx = 2 * ((lane >> 4) & 1) + ((lane & 3) >> 1);
        const LAS unsigned char* vb0 = slot + AT_VB + vq * 128 + ((vx ^ vsw) * 16) + 8 * (lane & 1);
        const LAS unsigned char* vb1 = slot + AT_VB + vq * 128 + (((4 + vx) ^ vsw) * 16) + 8 * (lane & 1);
#pragma unroll
        for (int s = 0; s < 4; ++s) {
            const s16x4 lo0 = vtr(vb0 + s * 2048), hi0 = vtr(vb0 + s * 2048 + 1024), lo1 = vtr(vb1 + s * 2048), hi1 = vtr(vb1 + s * 2048 + 1024);
            const bf16x8 v0 = {lo0[0], lo0[1], lo0[2], lo0[3], hi0[0], hi0[1], hi0[2], hi0[3]}, v1 = {lo1[0], lo1[1], lo1[2], lo1[3], hi1[0], hi1[1], hi1[2], hi1[3]};
            const bf16x8 pb = __builtin_bit_cast(bf16x8, pw[s]);
            o0 = __builtin_amdgcn_mfma_f32_32x32x16_bf16(v0, pb, o0, 0, 0, 0);
            o1 = __builtin_amdgcn_mfma_f32_32x32x16_bf16(v1, pb, o1, 0, 0, 0);
        }
    }
    __device__ __forceinline__ float ltot() const { return l + __shfl_xor(l, 32); }
};

__device__ __forceinline__ void glds16(const void* gsrc, LAS unsigned char* dst) { __builtin_amdgcn_global_load_lds((const unsigned*)gsrc, (LAS unsigned*)dst, 16, 0, 0); }

struct DilUnit { int b, h, pat, dl, res, u2, m0; size_t rowb; };
__device__ __forceinline__ DilUnit dil_decode(int e) {
    DilUnit u; const int bh = e / 48, rem = e % 48; u.pat = rem >> 4; const int idx = rem & 15; u.b = bh >> 3; u.h = bh & 7;
    u.dl = u.pat * 2; const int nb2 = 16 >> u.dl; u.res = idx / nb2; u.u2 = idx % nb2; u.m0 = u.u2 * 256; u.rowb = (size_t)u.b * S; return u;
}
__device__ __forceinline__ void p3a_dilated(Frame& F) {
    const bf16_t* QA = (const bf16_t*)(F.ws + WS_QA); const bf16_t* KA = (const bf16_t*)(F.ws + WS_KA); const bf16_t* VA = (const bf16_t*)(F.ws + WS_VA);
    bf16_t* OP = (bf16_t*)((unsigned char*)F.out + DO_OP); float* LSE = (float*)((unsigned char*)F.out + DO_LSE);
    const int lane = F.lane, w = F.wave, r32 = lane & 31, hi = lane >> 5, ow = w >> 1;
    constexpr int UPC = 12, NSTEP = 3 * UPC + 3;
    for (int v = F.vcu; v < 3072 / UPC; v += F.G) {
        const int e0 = v * UPC;
        auto issue = [&](int k, int j, int par, int which) {
            const DilUnit u = dil_decode(e0 + k);
            if (u.u2 == 0 && j < 2) return;
            const int mk0 = u.m0 - 128 + 64 * j; LAS unsigned char* slot = F.lds + (par * 2 + which) * AT_SLOT;
            const size_t krow = u.rowb + ((size_t)(mk0 + 8 * w + (lane >> 3)) << u.dl) + u.res;
            glds16(KA + krow * 512 + u.h * 64 + (((lane & 7) ^ ((4 * w + (lane >> 4)) & 7)) * 8), slot + AT_KB + w * 1024);
            glds16(VA + krow * 512 + u.h * 64 + (((lane & 7) ^ (((lane >> 4) & 1) * 4)) * 8), slot + AT_VB + w * 1024);
        };
        auto qptr = [&](int k) { const DilUnit u = dil_decode(e0 + k); const size_t qrow = u.rowb + ((size_t)(u.m0 + 32 * w + r32) << u.dl) + u.res; return QA + qrow * 512 + u.h * 64 + hi * 8; };
        AttnCore<4> A; A.init();
        bf16x8 qn[4];
        { const bf16_t* qp = qptr(0);
#pragma unroll
          for (int d0 = 0; d0 < 4; ++d0) qn[d0] = *(const bf16x8*)(qp + d0 * 16); }
        issue(0, 0, 0, 0);
        for (int g = 0; g < NSTEP; ++g) {
            asm volatile("s_waitcnt vmcnt(0)" ::: "memory");
            __syncthreads();
            { const int gn = g + 1, kb = gn / 3, jb = gn % 3;
              if (gn < NSTEP) { if (kb < UPC) issue(kb, jb, gn & 1, 0); if (kb >= 1 && kb - 1 < UPC) issue(kb - 1, jb + 3, gn & 1, 1); } }
            if (g >= ow) {
                const int k = (g - ow) / 3, j = g - 3 * k;
                if (k < UPC) {
                    const DilUnit u = dil_decode(e0 + k);
                    const int mq = u.m0 + 32 * w + r32;
                    if (j == ow) { A.init();
#pragma unroll
                        for (int d0 = 0; d0 < 4; ++d0) A.qr[d0] = qn[d0]; }
                    if (!(u.u2 == 0 && j < 2)) {
                        const int mk0 = u.m0 - 128 + 64 * j;
                        const LAS unsigned char* slot = F.lds + ((g & 1) * 2 + (j >= 3 ? 1 : 0)) * AT_SLOT;
                        A.tile(slot, lane, j != ow + 1, [&](int kk) { return (unsigned)(mq - mk0 - kk) <= 128u; });
                    }
                    if (j == ow + 2) {
                        const size_t qrow = u.rowb + ((size_t)mq << u.dl) + u.res;
                        const float lt = A.ltot(), inv = 1.f / lt;
                        bf16_t* orow = OP + ((size_t)u.pat * M + qrow) * 512 + u.h * 64;
#pragma unroll
                        for (int gq = 0; gq < 4; ++gq) {
                            u32x2 w0 = {cvtpk(A.o0[4 * gq] * inv, A.o0[4 * gq + 1] * inv), cvtpk(A.o0[4 * gq + 2] * inv, A.o0[4 * gq + 3] * inv)};
                            u32x2 w1 = {cvtpk(A.o1[4 * gq] * inv, A.o1[4 * gq + 1] * inv), cvtpk(A.o1[4 * gq + 2] * inv, A.o1[4 * gq + 3] * inv)};
                            *(u32x2*)(orow + 8 * gq + 4 * hi) = w0; *(u32x2*)(orow + 32 + 8 * gq + 4 * hi) = w1;
                        }
                        if (hi == 0) LSE[((size_t)u.pat * M + qrow) * 8 + u.h] = A.m + __builtin_amdgcn_logf(lt);
                        if (k + 1 < UPC) { const bf16_t* qp = qptr(k + 1);
#pragma unroll
                            for (int d0 = 0; d0 < 4; ++d0) qn[d0] = *(const bf16x8*)(qp + d0 * 16); }
                    }
                }
            }
        }
        __syncthreads();
    }
}

__device__ __forceinline__ void p3b_mla(Frame& F) {
    const bf16_t* QB = (const bf16_t*)(F.ws + WS_QB); const bf16_t* KN = (const bf16_t*)(F.ws + WS_KN); const bf16_t* KR = (const bf16_t*)(F.ws + WS_KR); const bf16_t* VB = (const bf16_t*)(F.ws + WS_VB);
    const bf16_t* OP = (const bf16_t*)((const unsigned char*)F.out + DO_OP); const float* LSE = (const float*)((const unsigned char*)F.out + DO_LSE);
    bf16_t* MIX = (bf16_t*)(F.ws + WS_MIX);
    const int lane = F.lane, w = F.wave, r32 = lane & 31, hi = lane >> 5;
    for (int vi = F.vcu * 4; vi < 1024; vi += ((vi & 3) == 3) ? (F.G - 1) * 4 + 1 : 1) {
        const int v = vi >> 2, i = vi & 3;
        const int bh = v >> 2, s = v & 3, qb = (i == 0) ? s : (i == 1) ? 7 - s : (i == 2) ? 8 + s : 15 - s;
        const int b = bh >> 3, h = bh & 7; const size_t rowb = (size_t)b * S;
        const int qpos = qb * 256 + 32 * w + r32; const size_t qrow = rowb + qpos;
        AttnCore<6> A; A.init();
#pragma unroll
        for (int d0 = 0; d0 < 6; ++d0) A.qr[d0] = *(const bf16x8*)(QB + qrow * 768 + h * 96 + d0 * 16 + hi * 8);
        const int NT = 4 * qb + 4;
        auto issue = [&](int t) {
            LAS unsigned char* slot = F.lds + ((((t >> 1) & 1) * 2) + (t & 1)) * AT_SLOT;
            const size_t krow = rowb + 64 * t + 8 * w + (lane >> 3);
            glds16(KN + krow * 512 + h * 64 + (((lane & 7) ^ ((4 * w + (lane >> 4)) & 7)) * 8), slot + AT_KB + w * 1024);
            if (w < 4) { const size_t rrow = rowb + 64 * t + 16 * w + (lane >> 2);
                glds16(KR + rrow * 32 + (((lane & 3) ^ ((lane >> 4) & 3)) * 8), slot + AT_KB + 8192 + w * 1024); }
            glds16(VB + krow * 512 + h * 64 + (((lane & 7) ^ (((lane >> 4) & 1) * 4)) * 8), slot + AT_VB + w * 1024);
        };
        issue(0); issue(1);
        const int qmin = qb * 256 + 32 * w;
        for (int t = 0; t < NT; t += 2) {
            __syncthreads();
            if (t + 2 < NT) { issue(t + 2); issue(t + 3); }
#pragma unroll
            for (int j = 0; j < 2; ++j) {
                const int k0 = 64 * (t + j);
                if (k0 <= qmin + 31) A.tile(F.lds + ((((t >> 1) & 1) * 2) + j) * AT_SLOT, lane, k0 + 63 > qmin, [&](int kk) { return k0 + kk <= qpos; });
            }
        }
        __syncthreads();
        const float inv = 1.f / A.ltot();
        const float l0 = LSE[((size_t)0 * M + qrow) * 8 + h], l1 = LSE[((size_t)1 * M + qrow) * 8 + h], l2 = LSE[((size_t)2 * M + qrow) * 8 + h];
        const float lm = fmaxf(l0, fmaxf(l1, l2));
        float w0 = __builtin_amdgcn_exp2f(l0 - lm), w1 = __builtin_amdgcn_exp2f(l1 - lm), w2 = __builtin_amdgcn_exp2f(l2 - lm);
        const float wi = 1.f / (w0 + w1 + w2); w0 *= wi; w1 *= wi; w2 *= wi;
        bf16_t* mrow = MIX + qrow * 1024 + h * 64;
#pragma unroll
        for (int g = 0; g < 4; ++g) {
#pragma unroll
            for (int dh = 0; dh < 2; ++dh) {
                const int dc = dh * 32 + 8 * g + 4 * hi;
                const u32x2 a0 = *(const u32x2*)(OP + ((size_t)0 * M + qrow) * 512 + h * 64 + dc), a1 = *(const u32x2*)(OP + ((size_t)1 * M + qrow) * 512 + h * 64 + dc), a2 = *(const u32x2*)(OP + ((size_t)2 * M + qrow) * 512 + h * 64 + dc);
                u32x2 oa;
                oa.x = cvtpk(w0 * bf_lo(a0.x) + w1 * bf_lo(a1.x) + w2 * bf_lo(a2.x), w0 * bf_hi(a0.x) + w1 * bf_hi(a1.x) + w2 * bf_hi(a2.x));
                oa.y = cvtpk(w0 * bf_lo(a0.y) + w1 * bf_lo(a1.y) + w2 * bf_lo(a2.y), w0 * bf_hi(a0.y) + w1 * bf_hi(a1.y) + w2 * bf_hi(a2.y));
                *(u32x2*)(mrow + dc) = oa;
                u32x2 ob;
                if (dh == 0) ob = (u32x2){cvtpk(A.o0[4 * g] * inv, A.o0[4 * g + 1] * inv), cvtpk(A.o0[4 * g + 2] * inv, A.o0[4 * g + 3] * inv)};
                else ob = (u32x2){cvtpk(A.o1[4 * g] * inv, A.o1[4 * g + 1] * inv), cvtpk(A.o1[4 * g + 2] * inv, A.o1[4 * g + 3] * inv)};
                *(u32x2*)(mrow + 512 + dc) = ob;
            }
        }
    }
}
#define CE_DESC(a, b) do { const float _h = fmaxf(a, b), _l = fminf(a, b); a = _h; b = _l; } while (0)
__device__ __forceinline__ void sort16_desc(float (&v)[16]) {
#pragma unroll
    for (int k = 2; k <= 16; k <<= 1)
#pragma unroll
        for (int j = k >> 1; j > 0; j >>= 1)
#pragma unroll
            for (int i = 0; i < 16; ++i) { const int l = i ^ j; if (l > i) { if ((i & k) == 0) CE_DESC(v[i], v[l]); else CE_DESC(v[l], v[i]); } }
}
__device__ __forceinline__ void merge_top16(float (&a)[16], const float (&b)[16]) {
#pragma unroll
    for (int i = 0; i < 16; ++i) a[i] = fmaxf(a[i], b[15 - i]);
#pragma unroll
    for (int j = 8; j > 0; j >>= 1)
#pragma unroll
        for (int i = 0; i < 16; ++i) { const int l = i ^ j; if (l > i) CE_DESC(a[i], a[l]); }
}
__device__ __forceinline__ void xmerge(float (&a)[16], int xmask) {
    float b[16];
#pragma unroll
    for (int i = 0; i < 16; ++i) b[i] = __shfl_xor(a[i], xmask);
    merge_top16(a, b);
}
__device__ __forceinline__ float sel4(int g, float a0, float a1, float a2, float a3) { const float lo = (g & 1) ? a1 : a0, hi = (g & 1) ? a3 : a2; return (g & 2) ? hi : lo; }
__device__ __forceinline__ float pack_code(float v, unsigned code, unsigned mask) { return __builtin_bit_cast(float, (__builtin_bit_cast(unsigned, v) & ~mask) | code); }
__device__ __forceinline__ float gelu_erf(float v) { return 0.5f * v * (1.0f + erff(v * 0.70710678118654752f)); }


constexpr size_t WS_X3B = 96 * MiB;
constexpr size_t WS_CF16 = 292 * MiB;
constexpr size_t WS_EID = 224 * MiB, WS_GATE = 240 * MiB, WS_SSQ3 = 86 * MiB;
constexpr float V8_SCALE = 64.f;
constexpr size_t WS_USCALE = 88 * MiB;
__device__ __forceinline__ float* hpart_base(unsigned char* ws, int cg) { return (float*)(ws + (cg < 5 ? 420 * MiB + (size_t)cg * 16 * MiB : 96 * MiB + (size_t)(cg - 5) * 16 * MiB)); }
constexpr int SEL_WAVE_LDS = 512;

constexpr int SEL_KEYS_BYTES = 65536, SEL_TAB_OFF = 2 * SEL_KEYS_BYTES;
__device__ __forceinline__ void p7_select(Frame& F) {
    const bf16_t* QP = (const bf16_t*)F.out; const bf16_t* KEYS = (const bf16_t*)(F.ws + WS_KEYS);
    unsigned* EID = (unsigned*)(F.ws + WS_EID); float* GATE = (float*)(F.ws + WS_GATE);
    const int lane = F.lane, w = F.wave, tk = lane & 15, g = lane >> 4;
    LAS unsigned char* tabL = F.lds + SEL_TAB_OFF + w * SEL_WAVE_LDS;
    auto stage_keys = [&](int h) {
        LAS unsigned char* kb = F.lds + (h & 1) * SEL_KEYS_BYTES;
#pragma unroll
        for (int i = 0; i < 8; ++i) { const int piece = w * 8 + i, r = piece * 4 + (lane >> 4), c = (lane & 15) ^ (r & 15);
            glds16(KEYS + ((size_t)h * 256 + r) * 128 + c * 8, kb + piece * 1024); }
    };
    for (int blk = F.vcu; blk < M / 128; blk += F.G) {
        const int tok0 = blk * 128 + w * 16;
        stage_keys(0);
        const int crow0 = (blk * 8 + w) * 16;
        f32x4 cv[2][4];
        auto conv_load = [&](int hh) {
#pragma unroll
            for (int u = 0; u < 2; ++u) { const int rr_ = crow0 + 2 * hh + u; const bool isu = rr_ < 16384; const float* src = (isu ? F.in[12] : F.in[13]) + (size_t)(isu ? rr_ : rr_ - 16384) * 1024;
#pragma unroll
                for (int j = 0; j < 4; ++j) cv[u][j] = *(const f32x4*)(src + 256 * j + 4 * lane); }
        };
        auto conv_store = [&](int hh) {
#pragma unroll
            for (int u = 0; u < 2; ++u) { const int rr_ = crow0 + 2 * hh + u; const bool isu = rr_ < 16384; const int e = isu ? rr_ : rr_ - 16384;
                unsigned char* dst = F.ws + (isu ? WS_U : WS_V) + (size_t)e * 1024;
                if (isu) {
                    f32x4 t[4]; float amax = 0.f;
#pragma unroll
                    for (int j = 0; j < 4; ++j) { t[j] = cv[u][j] * *(const f32x4*)(F.in[9] + 256 * j + 4 * lane); amax = fmaxf(amax, fmaxf(fmaxf(fabsf(t[j].x), fabsf(t[j].y)), fmaxf(fabsf(t[j].z), fabsf(t[j].w)))); }
#pragma unroll
                    for (int o = 1; o < 64; o <<= 1) amax = fmaxf(amax, __shfl_xor(amax, o));
                    const float sc_ = amax > 0.f ? amax * (1.f / 127.f) : 1.f, inv_ = 1.f / sc_;
                    if (lane == 0) ((float*)(F.ws + WS_USCALE))[e] = sc_;
#pragma unroll
                    for (int j = 0; j < 4; ++j) { const int q0 = (int)__builtin_rintf(t[j].x * inv_), q1 = (int)__builtin_rintf(t[j].y * inv_), q2 = (int)__builtin_rintf(t[j].z * inv_), q3 = (int)__builtin_rintf(t[j].w * inv_);
                        *(int*)(dst + 256 * j + 4 * lane) = (q0 & 0xff) | ((q1 & 0xff) << 8) | ((q2 & 0xff) << 16) | (q3 << 24); }
                } else {
#pragma unroll
                    for (int j = 0; j < 4; ++j) { f32x4 t = cv[u][j] * V8_SCALE;
                        t.x = fminf(fmaxf(t.x, -448.f), 448.f); t.y = fminf(fmaxf(t.y, -448.f), 448.f); t.z = fminf(fmaxf(t.z, -448.f), 448.f); t.w = fminf(fmaxf(t.w, -448.f), 448.f);
                        int wq = __builtin_amdgcn_cvt_pk_fp8_f32(t.x, t.y, 0, false); wq = __builtin_amdgcn_cvt_pk_fp8_f32(t.z, t.w, wq, true);
                        *(int*)(dst + 256 * j + 4 * lane) = wq; }
                }
            }
        };
        for (int h = 0; h < 8; ++h) {
            asm volatile("s_waitcnt vmcnt(0)" ::: "memory");
            __syncthreads();
            if (h > 0) conv_store(h - 1);
            const LAS unsigned char* kb = F.lds + (h & 1) * SEL_KEYS_BYTES;
            float s12[2][16];
#pragma unroll
            for (int p = 0; p < 2; ++p) {
                const int hp = h * 2 + p;
                bf16x8 bq[4];
#pragma unroll
                for (int ks = 0; ks < 4; ++ks) bq[ks] = *(const bf16x8*)(QP + (size_t)(tok0 + tk) * 2048 + hp * 128 + ks * 32 + g * 8);
                f32x4 c[8];
#pragma unroll
                for (int nt = 0; nt < 8; ++nt) { c[nt] = (f32x4){0.f, 0.f, 0.f, 0.f};
                    const int r = p * 128 + nt * 16 + tk;
#pragma unroll
                    for (int ks = 0; ks < 4; ++ks) { const bf16x8 ak = *(const LAS bf16x8*)(kb + r * 256 + (((4 * ks + g) ^ (r & 15)) * 16));
                        c[nt] = __builtin_amdgcn_mfma_f32_16x16x32_bf16(ak, bq[ks], c[nt], 0, 0, 0); } }
                if (p == 1) { if (h + 1 < 8) stage_keys(h + 1); conv_load(h); }
                float va[16], vb[16];
                const unsigned lo = 127u - 4u * (unsigned)g;
#pragma unroll
                for (int nt = 0; nt < 4; ++nt)
#pragma unroll
                    for (int r = 0; r < 4; ++r) { va[nt * 4 + r] = pack_code(c[nt][r], lo - (unsigned)(16 * nt + r), 127u); vb[nt * 4 + r] = pack_code(c[nt + 4][r], lo - (unsigned)(16 * (nt + 4) + r), 127u); }
                sort16_desc(va); sort16_desc(vb); merge_top16(va, vb);
                xmerge(va, 16); xmerge(va, 32);
#pragma unroll
                for (int i = 0; i < 16; ++i) s12[p][i] = va[i];
                if (g == 0) {
#pragma unroll
                    for (int i = 0; i < 16; ++i) tabL[tk * 32 + p * 16 + i] = (unsigned char)(127u - (__builtin_bit_cast(unsigned, va[i]) & 127u));
                }
            }
            float cd[16];
#define S1(i) s12[0][i]
#define S2(j) s12[1][j]
#define CND(slot, i0, j0, i1, j1, i2, j2, i3, j3) cd[slot] = pack_code(sel4(g, S1(i0), S1(i1), S1(i2), S1(i3)) + sel4(g, S2(j0), S2(j1), S2(j2), S2(j3)), \
                255u - (unsigned)(g == 0 ? (i0) * 16 + (j0) : g == 1 ? (i1) * 16 + (j1) : g == 2 ? (i2) * 16 + (j2) : (i3) * 16 + (j3)), 255u)
            CND(0, 0, 0, 0, 1, 0, 2, 0, 3);   CND(1, 0, 4, 0, 5, 0, 6, 0, 7);   CND(2, 0, 8, 0, 9, 0, 10, 0, 11); CND(3, 0, 12, 0, 13, 0, 14, 0, 15);
            CND(4, 1, 0, 1, 1, 1, 2, 1, 3);   CND(5, 1, 4, 1, 5, 1, 6, 1, 7);   CND(6, 2, 0, 2, 1, 2, 2, 2, 3);   CND(7, 2, 4, 3, 0, 3, 1, 3, 2);
            CND(8, 3, 3, 4, 0, 4, 1, 4, 2);   CND(9, 5, 0, 5, 1, 6, 0, 6, 1);   CND(10, 7, 0, 7, 1, 8, 0, 9, 0);  CND(11, 10, 0, 11, 0, 12, 0, 13, 0);
            { const float t = sel4(g, S1(14), S1(15), S1(15), S1(15)) + S2(0); const float pk = pack_code(t, 255u - (unsigned)(g == 0 ? 14 * 16 : 15 * 16), 255u); cd[12] = (g < 2) ? pk : -INFINITY; }
            cd[13] = -INFINITY; cd[14] = -INFINITY; cd[15] = -INFINITY;
#undef CND
#undef S1
#undef S2
            sort16_desc(cd); xmerge(cd, 16); xmerge(cd, 32);
            asm volatile("s_waitcnt lgkmcnt(0)" ::: "memory");
            float ev[16], sum = 0.f; const float mx = cd[0];
#pragma unroll
            for (int k = 0; k < 16; ++k) { ev[k] = __builtin_amdgcn_exp2f((cd[k] - mx) * LOG2E); sum += ev[k]; }
            const float isum = 1.f / sum;
            if (g == 0) {
                unsigned short* er = (unsigned short*)EID + (size_t)(tok0 + tk) * 128; float* gr = GATE + (size_t)(tok0 + tk) * 128;
#pragma unroll
                for (int k = 0; k < 16; ++k) { const unsigned code = 255u - (__builtin_bit_cast(unsigned, cd[k]) & 255u);
                    const unsigned e1 = tabL[tk * 32 + (code >> 4)], e2 = tabL[tk * 32 + 16 + (code & 15u)];
                    const int pos = (k & 7) * 16 + 2 * h + (k >> 3);
                    er[pos] = (unsigned short)(e1 * 128u + e2); gr[pos] = ev[k] * isum; }
            }
            asm volatile("s_waitcnt lgkmcnt(0)" ::: "memory");
        }
        conv_store(7);
        __syncthreads();
    }
}

typedef _Float16 h2_t __attribute__((ext_vector_type(2)));
__device__ __forceinline__ void fp8x16_to_h2(const u32x4 d, h2_t (&o)[8]) {
#pragma unroll
    for (int m = 0; m < 4; ++m) { o[2 * m] = __builtin_amdgcn_cvt_scalef32_pk_f16_fp8((int)d[m], 1.0f, false); o[2 * m + 1] = __builtin_amdgcn_cvt_scalef32_pk_f16_fp8((int)d[m], 1.0f, true); }
}

constexpr size_t CTL_Q_OFF = 4096;
constexpr int PEER_TILES = M / 16;
template <class Fn> __device__ __forceinline__ void peer_queue(Frame& F, int phase, const Fn& fn) {
    unsigned* ctr = (unsigned*)(F.ws + WS_CTL + CTL_Q_OFF);
    const unsigned x = (unsigned)__builtin_amdgcn_s_getreg((3 << 11) | 20) & 7u;
    for (int qi = 0; qi < 8; ++qi) {
        const int cg = (int)((x + (unsigned)qi) & 7u);
        unsigned* c = ctr + (phase * 8 + cg) * 64;
        unsigned nxt = 0; if (F.lane == 0) nxt = __hip_atomic_fetch_add(c, 1u, __ATOMIC_RELAXED, __HIP_MEMORY_SCOPE_AGENT);
        for (;;) {
            const int tile = __builtin_amdgcn_readfirstlane((int)nxt);
            if (tile >= PEER_TILES) break;
            if (F.lane == 0) nxt = __hip_atomic_fetch_add(c, 1u, __ATOMIC_RELAXED, __HIP_MEMORY_SCOPE_AGENT);
            fn(cg, tile);
        }
    }
}

__device__ __forceinline__ u32x4 ldnt4(const void* p) { return *(const u32x4*)p; }
__device__ __forceinline__ f32x4 ldnt4f(const void* p) { return *(const f32x4*)p; }
__device__ __forceinline__ unsigned ldnt1(const void* p) { return *(const unsigned*)p; }
__device__ __forceinline__ unsigned off16(unsigned w, int hi, unsigned lo) { unsigned r_; const unsigned k_ = 1024u;
    if (hi) asm("v_mad_u32_u16 %0, %1, %2, %3 op_sel:[1,0,0,0]" : "=v"(r_) : "v"(w), "s"(k_), "v"(lo)); else asm("v_mad_u32_u16 %0, %1, %2, %3" : "=v"(r_) : "v"(w), "s"(k_), "v"(lo));
    return r_; }
#define EOFFW(E0, E1, i) ((i) < 8 ? E0[((i) & 7) >> 1] : E1[((i) & 7) >> 1])
#define EOFF16(E0, E1, i, lo_) off16(EOFFW(E0, E1, i), (i) & 1, (unsigned)(lo_))

#define LDSRD(dst, addr, OFF) asm volatile("ds_read_b128 %0, %1 offset:" #OFF : "=v"(dst) : "v"(addr))
#define LDSPIN4(a, b, c, d) do { asm volatile("" : "+v"(a)); asm volatile("" : "+v"(b)); asm volatile("" : "+v"(c)); asm volatile("" : "+v"(d)); } while (0)

#define LDSRD32(dst, addr, OFF) asm volatile("ds_read_b32 %0, %1 offset:" #OFF : "=v"(dst) : "v"(addr))
#define LDSWR128(addr, v, OFF) asm volatile("ds_write_b128 %0, %1 offset:" #OFF :: "v"(addr), "v"(v))
#define LDSWR32(addr, v) asm volatile("ds_write_b32 %0, %1" :: "v"(addr), "v"(v))

template <int CTRL> __device__ __forceinline__ int dpp_i(int v) { return __builtin_amdgcn_update_dpp(0, v, CTRL, 0xf, 0xf, true); }
template <int CTRL> __device__ __forceinline__ float dpp_f(float v) { return __builtin_bit_cast(float, __builtin_amdgcn_update_dpp(0, __builtin_bit_cast(int, v), CTRL, 0xf, 0xf, true)); }
__device__ __forceinline__ float swap32_sum(float a, float b) {
    const auto r = __builtin_amdgcn_permlane32_swap(__builtin_bit_cast(unsigned, a), __builtin_bit_cast(unsigned, b), false, false);
    return __builtin_bit_cast(float, (unsigned)r[0]) + __builtin_bit_cast(float, (unsigned)r[1]); }
__device__ __forceinline__ float swap16_sum(float a, float b) {
    const auto r = __builtin_amdgcn_permlane16_swap(__builtin_bit_cast(unsigned, a), __builtin_bit_cast(unsigned, b), false, false);
    return __builtin_bit_cast(float, (unsigned)r[0]) + __builtin_bit_cast(float, (unsigned)r[1]); }

template <int PROBE>
__device__ __forceinline__ void p8_uphase(Frame& F) {
    const unsigned char* EIDb = F.ws + WS_EID; const bf16_t* X2B = (const bf16_t*)(F.ws + WS_X2B);
    const int lane = F.lane, r = lane >> 3, c = lane & 7;
    const __amdgpu_buffer_rsrc_t rs = __builtin_amdgcn_make_buffer_rsrc((void*)(F.ws + WS_U), 0, 16 << 20, 0x00020000);
    LAS unsigned char* wl = F.lds + F.wave * 16384;
    const unsigned wla = (unsigned)(size_t)wl, la = wla + (unsigned)r * 32u, qa = wla + 8192u + (unsigned)c * 16u, sa = wla + 8192u + 2048u;
    unsigned* ctr = (unsigned*)(F.ws + WS_CTL + CTL_Q_OFF);
    const unsigned x = (unsigned)__builtin_amdgcn_s_getreg((3 << 11) | 20) & 7u;
    auto dma_chunk = [&](int tile, int ch) {
        const size_t go = (size_t)tile * 4096 + (size_t)ch * 1024 + (size_t)lane * 16;
        const unsigned dst = __builtin_amdgcn_readfirstlane(wla + (unsigned)ch * 1024u);
        ASM_GLDS16(EIDb + go, dst);
    };
    const int lo = c * 16;
    for (int qi = 0; qi < 8; ++qi) {
        const int cg = (int)((x + (unsigned)qi) & 7u), so = cg * 128;
        float* HP = PROBE ? (float*)(F.ws + ((size_t)300 << 20)) : hpart_base(F.ws, cg);
        unsigned* cq = ctr + ((PROBE ? 2 : 0) * 8 + cg) * 64;
        auto act_load = [&](int tile, u32x4 (&xa)[4]) { const bf16_t* p = X2B + ((size_t)tile * 16 + (lane >> 2)) * 1024 + cg * 128 + (lane & 3) * 32;
#pragma unroll
            for (int j = 0; j < 4; ++j) xa[j] = *(const u32x4*)(p + 8 * j); };
        auto act_quant = [&](const u32x4 (&xa)[4], int par) {
            float hv[32];
#pragma unroll
            for (int j = 0; j < 4; ++j)
#pragma unroll
                for (int m = 0; m < 4; ++m) { hv[8 * j + 2 * m] = bf_lo(xa[j][m]); hv[8 * j + 2 * m + 1] = bf_hi(xa[j][m]); }
            float am = 0.f;
#pragma unroll
            for (int j = 0; j < 32; ++j) am = fmaxf(am, fabsf(hv[j]));
            am = fmaxf(am, __shfl_xor(am, 1)); am = fmaxf(am, __shfl_xor(am, 2));
            const float sh = am > 0.f ? am * (1.f / 127.f) : 1.f, ish = 1.f / sh;
            u32x4 qv[2];
#pragma unroll
            for (int m = 0; m < 8; ++m) { const int q0 = (int)__builtin_rintf(hv[4 * m] * ish), q1 = (int)__builtin_rintf(hv[4 * m + 1] * ish), q2 = (int)__builtin_rintf(hv[4 * m + 2] * ish), q3 = (int)__builtin_rintf(hv[4 * m + 3] * ish);
                qv[m >> 2][m & 3] = (unsigned)((q0 & 0xff) | ((q1 & 0xff) << 8) | ((q2 & 0xff) << 16) | (q3 << 24)); }
            const unsigned wa = wla + 8192u + (unsigned)par * 2304u + (unsigned)(lane >> 2) * 128u + (unsigned)(lane & 3) * 32u;
            LDSWR128(wa, qv[0], 0); LDSWR128(wa, qv[1], 16);
            if ((lane & 3) == 0) { const unsigned swa = sa + (unsigned)par * 2304u + (unsigned)(lane >> 2) * 4u; LDSWR32(swa, sh); }
        };
        unsigned tk = 0; if (lane == 0) tk = __hip_atomic_fetch_add(cq, 1u, __ATOMIC_RELAXED, __HIP_MEMORY_SCOPE_AGENT);
        int tile = __builtin_amdgcn_readfirstlane((int)tk);
        if (tile >= PEER_TILES) continue;
        if (lane == 0) tk = __hip_atomic_fetch_add(cq, 1u, __ATOMIC_RELAXED, __HIP_MEMORY_SCOPE_AGENT);
        int nxt = __builtin_amdgcn_readfirstlane((int)tk);
        if (lane == 0) tk = __hip_atomic_fetch_add(cq, 1u, __ATOMIC_RELAXED, __HIP_MEMORY_SCOPE_AGENT);
        dma_chunk(tile, 0); dma_chunk(tile, 1);
        u32x4 xa[4];
        act_load(tile, xa);
        int par = 0;
        act_quant(xa, 0);
        asm volatile("s_waitcnt vmcnt(0) lgkmcnt(0)" ::: "memory");
        u32x4 e0, e1, hq; float sh;
        LDSRD(e0, la, 0); LDSRD(e1, la, 16); LDSRD(hq, qa, 0); LDSRD32(sh, sa, 0);
        asm volatile("s_waitcnt lgkmcnt(0)" ::: "memory");
        asm volatile("" : "+v"(e0)); asm volatile("" : "+v"(e1)); asm volatile("" : "+v"(hq)); asm volatile("" : "+v"(sh));
        u32x4 d[8];
#pragma unroll
        for (int i = 0; i < 8; ++i) d[i] = __builtin_amdgcn_raw_buffer_load_b128(rs, (int)EOFF16(e0, e1, i, lo), so, 0);
        for (;;) {
            const bool has_next = nxt < PEER_TILES;
#pragma unroll 1
            for (int t = 0; t < 16; ++t) {
                const int tok = tile * 16 + t;
                if ((t & 3) == 0) { const int ch2 = (t >> 2) + 2; if (ch2 < 4) dma_chunk(tile, ch2); else if (has_next) dma_chunk(nxt, ch2 - 4); }
                if (has_next && t == 2) act_load(nxt, xa);
                if (has_next && t == 10) act_quant(xa, par ^ 1);
                const bool cross = (t == 15) && has_next;
                const int tn = (t < 15) ? t + 1 : (has_next ? 0 : 15);
                const unsigned pn = (unsigned)(cross ? (par ^ 1) : par) * 2304u;
                const unsigned ta = la + (unsigned)tn * 256u, tq = qa + pn + (unsigned)tn * 128u, ts = sa + pn + (unsigned)tn * 4u;
                u32x4 n0, n1, hqn; float shn;
                LDSRD(n0, ta, 0); LDSRD(n1, ta, 16); LDSRD(hqn, tq, 0); LDSRD32(shn, ts, 0);
                int p[16];
#define UDOT(i, nextoff) do { int a_ = 0; const u32x4 dd_ = d[(i) & 7]; \
                    a_ = __builtin_amdgcn_sdot4((int)dd_.x, (int)hq.x, a_, false); a_ = __builtin_amdgcn_sdot4((int)dd_.y, (int)hq.y, a_, false); a_ = __builtin_amdgcn_sdot4((int)dd_.z, (int)hq.z, a_, false); a_ = __builtin_amdgcn_sdot4((int)dd_.w, (int)hq.w, a_, false); \
                    asm volatile("" : "+v"(a_)); p[i] = a_; d[(i) & 7] = __builtin_amdgcn_raw_buffer_load_b128(rs, (int)(nextoff), so, 0); } while (0)
                UDOT(0, EOFF16(e0, e1, 8, lo)); UDOT(1, EOFF16(e0, e1, 9, lo)); UDOT(2, EOFF16(e0, e1, 10, lo)); UDOT(3, EOFF16(e0, e1, 11, lo));
                UDOT(4, EOFF16(e0, e1, 12, lo)); UDOT(5, EOFF16(e0, e1, 13, lo)); UDOT(6, EOFF16(e0, e1, 14, lo)); UDOT(7, EOFF16(e0, e1, 15, lo));
                asm volatile("s_waitcnt lgkmcnt(0)" ::: "memory");
                asm volatile("" : "+v"(n0)); asm volatile("" : "+v"(n1)); asm volatile("" : "+v"(hqn)); asm volatile("" : "+v"(shn));
                UDOT(8, EOFF16(n0, n1, 0, lo)); UDOT(9, EOFF16(n0, n1, 1, lo)); UDOT(10, EOFF16(n0, n1, 2, lo)); UDOT(11, EOFF16(n0, n1, 3, lo));
                UDOT(12, EOFF16(n0, n1, 4, lo)); UDOT(13, EOFF16(n0, n1, 5, lo)); UDOT(14, EOFF16(n0, n1, 6, lo)); UDOT(15, EOFF16(n0, n1, 7, lo));
#undef UDOT
                int q8[8], q4[4], q2[2];
                { const bool b = (c & 4) != 0;
#pragma unroll
                  for (int j = 0; j < 8; ++j) { const int A = p[j] + dpp_i<0x141>(p[j]), B = p[8 + j] + dpp_i<0x141>(p[8 + j]); q8[j] = b ? B : A; } }
                { const bool b = (c & 2) != 0;
#pragma unroll
                  for (int j = 0; j < 4; ++j) { const int A = q8[j] + dpp_i<0x4E>(q8[j]), B = q8[4 + j] + dpp_i<0x4E>(q8[4 + j]); q4[j] = b ? B : A; } }
                { const bool b = (c & 1) != 0;
#pragma unroll
                  for (int j = 0; j < 2; ++j) { const int A = q4[j] + dpp_i<0xB1>(q4[j]), B = q4[2 + j] + dpp_i<0xB1>(q4[2 + j]); q2[j] = b ? B : A; } }
                *(unsigned*)((bf16_t*)HP + (size_t)tok * 128 + 2 * lane) = cvtpk((float)q2[0] * sh, (float)q2[1] * sh);
                e0 = n0; e1 = n1; hq = hqn; sh = shn;
            }
            if (!has_next) break;
            tile = nxt; nxt = __builtin_amdgcn_readfirstlane((int)tk); par ^= 1;
            if (lane == 0) tk = __hip_atomic_fetch_add(cq, 1u, __ATOMIC_RELAXED, __HIP_MEMORY_SCOPE_AGENT);
        }
    }
}

__device__ __forceinline__ void p8b_combine(Frame& F) {
    float* GATE = (float*)(F.ws + WS_GATE); const float* SSQ2 = (const float*)(F.ws + WS_SSQ2); const unsigned* EID = (const unsigned*)(F.ws + WS_EID); const float* USC = (const float*)(F.ws + WS_USCALE);
    const int gt = F.vcu * 512 + F.tid, NT = F.G * 512;
    for (int i = gt; i < M * 32; i += NT) {
        const int tok = i >> 5;
        const f32x4* sp = (const f32x4*)(SSQ2 + (size_t)tok * 16); const f32x4 s0 = sp[0], s1 = sp[1], s2 = sp[2], s3 = sp[3];
        const float ssq = ((s0.x + s0.y) + (s0.z + s0.w)) + ((s1.x + s1.y) + (s1.z + s1.w)) + ((s2.x + s2.y) + (s2.z + s2.w)) + ((s3.x + s3.y) + (s3.z + s3.w));
        const float rsu = rsqrtf(ssq * (1.f / 1024.f) + NORM_EPS);
        f32x4 h = {0.f, 0.f, 0.f, 0.f};
#pragma unroll
        for (int g2 = 0; g2 < 8; ++g2) { const u32x2 hb = *(const u32x2*)((const bf16_t*)hpart_base(F.ws, g2) + (size_t)i * 4); h = h + (f32x4){bf_lo(hb.x), bf_hi(hb.x), bf_lo(hb.y), bf_hi(hb.y)}; }
        const u32x2 e2_ = *(const u32x2*)((const unsigned short*)EID + (size_t)i * 4); const u32x4 e4 = {(e2_.x & 0xffffu) << 10, (e2_.x >> 16) << 10, (e2_.y & 0xffffu) << 10, (e2_.y >> 16) << 10};
        const f32x4 gt4 = *(const f32x4*)(GATE + (size_t)i * 4);
        f32x4 o; o.x = gelu_erf(h.x * rsu * USC[e4.x >> 10]) * gt4.x; o.y = gelu_erf(h.y * rsu * USC[e4.y >> 10]) * gt4.y; o.z = gelu_erf(h.z * rsu * USC[e4.z >> 10]) * gt4.z; o.w = gelu_erf(h.w * rsu * USC[e4.w >> 10]) * gt4.w;
        { typedef _Float16 h4_t __attribute__((ext_vector_type(4))); const h4_t oh = {(_Float16)o.x, (_Float16)o.y, (_Float16)o.z, (_Float16)o.w}; *(u32x2*)(F.ws + WS_CF16 + (size_t)i * 8) = __builtin_bit_cast(u32x2, oh); }
    }
}

template <int PROBE>
__device__ __forceinline__ void p9_vphase(Frame& F) {
    const unsigned char* EIDb = F.ws + WS_EID; const unsigned char* CFb = F.ws + WS_CF16;
    const bf16_t* X2B = (const bf16_t*)(F.ws + WS_X2B);
    const int lane = F.lane, r = lane >> 3, c = lane & 7;
    const __amdgpu_buffer_rsrc_t rs = __builtin_amdgcn_make_buffer_rsrc((void*)(F.ws + WS_V), 0, 16 << 20, 0x00020000);
    LAS unsigned char* wl = F.lds + F.wave * 16384;
    const unsigned wla = (unsigned)(size_t)wl, la = wla + (unsigned)r * 32u, lc = wla + 1024u + (unsigned)r * 32u;
    unsigned* ctr = (unsigned*)(F.ws + WS_CTL + CTL_Q_OFF);
    const unsigned x = (unsigned)__builtin_amdgcn_s_getreg((3 << 11) | 20) & 7u;
    auto dma_chunk = [&](int tile, int ch) {
        const size_t gc = (size_t)tile * 4096 + (size_t)ch * 1024 + (size_t)lane * 16;
        const unsigned dst = __builtin_amdgcn_readfirstlane(wla + (unsigned)ch * 2048u);
        ASM_GLDS16(EIDb + gc, dst); ASM_GLDS16(CFb + gc, dst + 1024u);
    };
    const int lo = c * 16;
    for (int qi = 0; qi < 8; ++qi) {
        const int cg = (int)((x + (unsigned)qi) & 7u), so = cg * 128;
        unsigned* cq = ctr + ((PROBE ? 3 : 1) * 8 + cg) * 64;
        unsigned tk = 0; if (lane == 0) tk = __hip_atomic_fetch_add(cq, 1u, __ATOMIC_RELAXED, __HIP_MEMORY_SCOPE_AGENT);
        int tile = __builtin_amdgcn_readfirstlane((int)tk);
        if (tile >= PEER_TILES) continue;
        if (lane == 0) tk = __hip_atomic_fetch_add(cq, 1u, __ATOMIC_RELAXED, __HIP_MEMORY_SCOPE_AGENT);
        int nxt = __builtin_amdgcn_readfirstlane((int)tk);
        if (lane == 0) tk = __hip_atomic_fetch_add(cq, 1u, __ATOMIC_RELAXED, __HIP_MEMORY_SCOPE_AGENT);
        dma_chunk(tile, 0); dma_chunk(tile, 1);
        asm volatile("s_waitcnt vmcnt(0)" ::: "memory");
        u32x4 e0, e1, c0, c1;
        LDSRD(e0, la, 0); LDSRD(e1, la, 16); LDSRD(c0, lc, 0); LDSRD(c1, lc, 16);
        asm volatile("s_waitcnt lgkmcnt(0)" ::: "memory");
        asm volatile("" : "+v"(e0)); asm volatile("" : "+v"(e1)); asm volatile("" : "+v"(c0)); asm volatile("" : "+v"(c1));
        u32x4 d[16];
#pragma unroll
        for (int i = 0; i < 16; ++i) d[i] = __builtin_amdgcn_raw_buffer_load_b128(rs, (int)EOFF16(e0, e1, i, lo), so, 0);
        LDSRD(e0, la, 256); LDSRD(e1, la, 272);
        asm volatile("s_waitcnt lgkmcnt(0)" ::: "memory");
        asm volatile("" : "+v"(e0)); asm volatile("" : "+v"(e1));
        for (;;) {
            const bool has_next = nxt < PEER_TILES;
#pragma unroll 1
            for (int t = 0; t < 16; ++t) {
                const int tok = tile * 16 + t;
                if ((t & 3) == 0) { const int ch2 = (t >> 2) + 2; if (ch2 < 4) dma_chunk(tile, ch2); else if (has_next) dma_chunk(nxt, ch2 - 4); }
                const int t1 = (t < 15) ? t + 1 : (has_next ? 0 : 15), t2 = (t < 14) ? t + 2 : (has_next ? t - 14 : 15);
                const unsigned ta = la + (unsigned)(t2 >> 2) * 2048u + (unsigned)((t2 & 3) << 8), tc = lc + (unsigned)(t1 >> 2) * 2048u + (unsigned)((t1 & 3) << 8);
                u32x4 n0, n1, c0n, c1n;
                LDSRD(n0, ta, 0); LDSRD(n1, ta, 16); LDSRD(c0n, tc, 0); LDSRD(c1n, tc, 16);
                const size_t off = (size_t)tok * 1024 + cg * 128 + c * 16 + 2 * r;
                h2_t yh[8];
#pragma unroll
                for (int m = 0; m < 8; ++m) yh[m] = (h2_t){(_Float16)0.f, (_Float16)0.f};
#define VAXPY(i, cword, nextoff) do { h2_t vv[8]; if (PROBE == 2) { _Pragma("unroll") for (int m_ = 0; m_ < 4; ++m_) { vv[2 * m_] = __builtin_bit_cast(h2_t, d[i][m_] & 0x3c003c00u); vv[2 * m_ + 1] = __builtin_bit_cast(h2_t, (d[i][m_] >> 2) & 0x3c003c00u); } } else fp8x16_to_h2(d[i], vv); const _Float16 ch_ = __builtin_bit_cast(h2_t, (unsigned)(cword))[(i) & 1]; const h2_t c2_ = {ch_, ch_}; \
                    _Pragma("unroll") for (int m = 0; m < 8; ++m) yh[m] = __builtin_elementwise_fma(vv[m], c2_, yh[m]); \
                    _Pragma("unroll") for (int m = 0; m < 8; ++m) asm volatile("" : "+v"(yh[m])); \
                    d[i] = __builtin_amdgcn_raw_buffer_load_b128(rs, (int)(nextoff), so, 0); } while (0)
                VAXPY(0, c0.x, EOFF16(e0, e1, 0, lo)); VAXPY(1, c0.x, EOFF16(e0, e1, 1, lo)); VAXPY(2, c0.y, EOFF16(e0, e1, 2, lo)); VAXPY(3, c0.y, EOFF16(e0, e1, 3, lo));
                VAXPY(4, c0.z, EOFF16(e0, e1, 4, lo)); VAXPY(5, c0.z, EOFF16(e0, e1, 5, lo)); VAXPY(6, c0.w, EOFF16(e0, e1, 6, lo)); VAXPY(7, c0.w, EOFF16(e0, e1, 7, lo));
                VAXPY(8, c1.x, EOFF16(e0, e1, 8, lo)); VAXPY(9, c1.x, EOFF16(e0, e1, 9, lo)); VAXPY(10, c1.y, EOFF16(e0, e1, 10, lo)); VAXPY(11, c1.y, EOFF16(e0, e1, 11, lo));
                VAXPY(12, c1.z, EOFF16(e0, e1, 12, lo)); VAXPY(13, c1.z, EOFF16(e0, e1, 13, lo)); VAXPY(14, c1.w, EOFF16(e0, e1, 14, lo)); VAXPY(15, c1.w, EOFF16(e0, e1, 15, lo));
#undef VAXPY
                asm volatile("s_waitcnt lgkmcnt(0)" ::: "memory");
                asm volatile("" : "+v"(n0)); asm volatile("" : "+v"(n1)); asm volatile("" : "+v"(c0n)); asm volatile("" : "+v"(c1n));
                e0 = n0; e1 = n1; c0 = c0n; c1 = c1n;
                unsigned y8[8], q4[4], q2[2], q1;
#pragma unroll
                for (int m = 0; m < 8; ++m) y8[m] = __builtin_bit_cast(unsigned, yh[m]);
                auto hadd = [](unsigned a, unsigned b) { return __builtin_bit_cast(unsigned, __builtin_bit_cast(h2_t, a) + __builtin_bit_cast(h2_t, b)); };
#pragma unroll
                for (int j = 0; j < 4; ++j) { const auto rr = __builtin_amdgcn_permlane32_swap(y8[j], y8[4 + j], false, false); q4[j] = hadd((unsigned)rr[0], (unsigned)rr[1]); }
#pragma unroll
                for (int j = 0; j < 2; ++j) { const auto rr = __builtin_amdgcn_permlane16_swap(q4[j], q4[2 + j], false, false); q2[j] = hadd((unsigned)rr[0], (unsigned)rr[1]); }
                { const unsigned A = hadd(q2[0], (unsigned)dpp_i<0x128>((int)q2[0])), B = hadd(q2[1], (unsigned)dpp_i<0x128>((int)q2[1])); q1 = (r & 1) ? B : A; }
                const h2_t qh = __builtin_bit_cast(h2_t, q1);
                const float o0 = (float)qh[0] * (1.f / V8_SCALE), o1 = (float)qh[1] * (1.f / V8_SCALE);
                *(unsigned*)((bf16_t*)(F.ws + (PROBE ? ((size_t)300 << 20) : WS_X3B)) + off) = cvtpk(o0, o1);
            }
            if (!has_next) break;
            tile = nxt; nxt = __builtin_amdgcn_readfirstlane((int)tk);
            if (lane == 0) tk = __hip_atomic_fetch_add(cq, 1u, __ATOMIC_RELAXED, __HIP_MEMORY_SCOPE_AGENT);
        }
    }
}

__device__ __forceinline__ void p10_final(Frame& F) {
    const float* gfin = F.in[14]; const bf16_t* X3B = (const bf16_t*)(F.ws + WS_X3B);
    const int gw = F.vcu * 8 + F.wave, NGW = F.G * 8, lane = (int)__builtin_amdgcn_mbcnt_hi(~0u, __builtin_amdgcn_mbcnt_lo(~0u, 0u));
    f32x4 g[4];
#pragma unroll
    for (int j = 0; j < 4; ++j) g[j] = *(const f32x4*)(gfin + 256 * j + 4 * lane);
    for (int tok = gw; tok < M; tok += NGW) {
        const bf16_t* xr = X3B + (size_t)tok * 1024; const bf16_t* x2r = (const bf16_t*)(F.ws + WS_X2B) + (size_t)tok * 1024; float* orow = F.out + (size_t)tok * 1024;
        f32x4 v[4]; float ss = 0.f;
#pragma unroll
        for (int j = 0; j < 4; ++j) { const u32x2 p = *(const u32x2*)(xr + 256 * j + 4 * lane), q = *(const u32x2*)(x2r + 256 * j + 4 * lane);
            v[j] = (f32x4){bf_lo(p.x) + bf_lo(q.x), bf_hi(p.x) + bf_hi(q.x), bf_lo(p.y) + bf_lo(q.y), bf_hi(p.y) + bf_hi(q.y)}; }
#pragma unroll
        for (int j = 0; j < 4; ++j) ss += (v[j].x * v[j].x + v[j].y * v[j].y) + (v[j].z * v[j].z + v[j].w * v[j].w);
        const float rs = rsqrtf(wave_sum(ss) * (1.f / 1024.f) + NORM_EPS);
#pragma unroll
        for (int j = 0; j < 4; ++j) *(f32x4*)(orow + 256 * j + 4 * lane) = v[j] * rs * g[j];
    }
}
constexpr int LDS_BYTES = 147456;
constexpr int NPHASE = 12;


#define XB_TMO      128
#define XB_XCNT(j)  (256  + 64 * (j))
#define XB_XSUB(j)  (1280 + 64 * (j))
#define XB_XGEN(j)  (2304 + 64 * (j))
#define XB_TOP      3328
#define XB_TOPGEN   3392
#define XCD_BAR_WORDS 3456
#define XB_SPIN_CAP (1u << 22)
__device__ __forceinline__ unsigned xb_ld(unsigned* p)              { return __hip_atomic_load(p, __ATOMIC_RELAXED, __HIP_MEMORY_SCOPE_AGENT); }
__device__ __forceinline__ unsigned xb_add(unsigned* p, unsigned v) { return __hip_atomic_fetch_add(p, v, __ATOMIC_RELAXED, __HIP_MEMORY_SCOPE_AGENT); }
__device__ __forceinline__ unsigned xb_xcc_id() { return (unsigned)__builtin_amdgcn_s_getreg((3 << 11) | 20) & 0xFu; }
#define XB_SPIN(cond, bar) do { unsigned _sp = 0; while (cond) { __builtin_amdgcn_s_sleep(1); \
    if ((++_sp & 255u) == 0u) { if (xb_ld(&(bar)[XB_TMO])) break; if (_sp > XB_SPIN_CAP) { atomicAdd(&(bar)[XB_TMO], 1u); break; } } } } while (0)
struct XcdBarrier { unsigned* bar; unsigned x; volatile LAS unsigned* st; };
__device__ __forceinline__ XcdBarrier xcd_barrier_post(unsigned* bar, volatile LAS unsigned* st) {
    XcdBarrier b; b.bar = bar; b.x = xb_xcc_id(); b.st = st;
    if (threadIdx.x == 0) (void)xb_add(&bar[XB_XCNT(b.x)], 1u);
    return b;
}
__device__ __forceinline__ void xcd_barrier_complete(unsigned* bar, unsigned x, unsigned& nloc, unsigned& nx) {
    const unsigned G = gridDim.x * gridDim.y * gridDim.z;
    unsigned sum, cnt, mine, sp = 0u;
    for (;;) {
        sum = 0u; cnt = 0u; mine = 0u;
#pragma unroll
        for (unsigned j = 0; j < 16; ++j) { const unsigned c = xb_ld(&bar[XB_XCNT(j)]); sum += c; cnt += (c > 0u) ? 1u : 0u; mine = (j == x) ? c : mine; }
        if (sum == G) break;
        __builtin_amdgcn_s_sleep(1);
        if ((++sp & 255u) == 0u) { if (xb_ld(&bar[XB_TMO])) break; if (sp > XB_SPIN_CAP) { atomicAdd(&bar[XB_TMO], 1u); break; } }
    }
    nloc = mine > 0u ? mine : 1u; nx = cnt > 0u ? cnt : 1u;
}
__device__ __forceinline__ void xcd_barrier(const XcdBarrier& b) {
    asm volatile("s_waitcnt vmcnt(0)" ::: "memory");
    __syncthreads();
    if (threadIdx.x == 0) {
        unsigned* bar = b.bar;
        __builtin_amdgcn_s_waitcnt(0);
        unsigned nloc = b.st[0], nx = b.st[1];
        if (nloc == 0u) { xcd_barrier_complete(bar, b.x, nloc, nx); b.st[0] = nloc; b.st[1] = nx; }
        const unsigned old = xb_add(&bar[XB_XSUB(b.x)], 1u);
        const unsigned gen = old / nloc;
        if (old + 1u == (gen + 1u) * nloc) {
            __builtin_amdgcn_fence(__ATOMIC_RELEASE, "agent");
            asm volatile("s_waitcnt vmcnt(0)" ::: "memory");
            const unsigned og = xb_add(&bar[XB_TOP], 1u);
            const unsigned tg = og / nx;
            if (og + 1u == (tg + 1u) * nx) xb_add(&bar[XB_TOPGEN], 1u);
            else XB_SPIN(xb_ld(&bar[XB_TOPGEN]) == tg, bar);
            __builtin_amdgcn_fence(__ATOMIC_ACQUIRE, "agent");
            xb_add(&bar[XB_XGEN(b.x)], 1u);
            asm volatile("s_waitcnt vmcnt(0)" ::: "memory");
        } else {
            XB_SPIN(xb_ld(&bar[XB_XGEN(b.x)]) == gen, bar);
            __builtin_amdgcn_fence(__ATOMIC_ACQUIRE, "agent");
            asm volatile("s_waitcnt vmcnt(0)" ::: "memory");
        }
    }
    __syncthreads();
}
constexpr int MISC_OFF = 131072 + 8192;
constexpr size_t CTL_BAR_OFF = 16384;
constexpr size_t CTL_ZERO_BYTES = 65536;

__global__ void __launch_bounds__(512, 2) fwd_kernel(Args args) {
    extern __shared__ __attribute__((aligned(16))) unsigned char lds_raw[];
    Frame F;
    F.lds = (LAS unsigned char*)lds_raw;
    F.tid = threadIdx.x; F.lane = F.tid & 63; F.wave = __builtin_amdgcn_readfirstlane(F.tid >> 6);
    F.G = gridDim.x; { const int bx = blockIdx.x; F.vcu = (F.G % 8 == 0) ? (bx % 8) * (F.G / 8) + bx / 8 : bx; }
#pragma unroll
    for (int i = 0; i < 15; ++i) F.in[i] = args.in[i];
    F.out = args.out; F.ws = args.ws;
    unsigned char* ws = args.ws;
    const int lo = args.ph_lo, hi = args.ph_hi;
#if ONE_LAUNCH
    volatile LAS unsigned* MISC = (volatile LAS unsigned*)(F.lds + MISC_OFF);
    if (F.tid < 16) MISC[F.tid] = 0u;
    __syncthreads();
    XcdBarrier bar = xcd_barrier_post((unsigned*)(ws + WS_CTL + CTL_BAR_OFF), MISC + 8);
#define SEAM(k) do { if (lo <= (k) && (k) + 1 < hi) xcd_barrier(bar); } while (0)
#else
#define SEAM(k) do { } while (0)
#endif
#define IN(k) (lo <= (k) && (k) < hi)
#define RELANE() do { int l_; asm volatile("v_mbcnt_lo_u32_b32 %0, -1, 0\n\tv_mbcnt_hi_u32_b32 %0, -1, %0" : "=v"(l_)); F.lane = l_; } while (0)
#if TIME_PHASE >= 0
    unsigned long long tp0 = 0, tp1 = 0;
#define TSTAMP(k) do { if ((k) == TIME_PHASE) tp0 = __builtin_amdgcn_s_memrealtime(); if ((k) == TIME_PHASE + 1) tp1 = __builtin_amdgcn_s_memrealtime(); } while (0)
#else
#define TSTAMP(k) do { } while (0)
#endif
    TSTAMP(0);
    if (IN(0)) { p0_prologue(F); SEAM(0); }
    TSTAMP(1);
    if (IN(1)) {
        GemmPlain g{(const bf16_t*)(ws + WS_XN), (const bf16_t*)(ws + WS_WIN), 1024, 1024, 1024};
        pg8::StaticOrder S_; S_.init(M, 2048, F.G, (int)blockIdx.x);
        const float* CA = (const float*)(ws + WS_ROPE);
        EpiP1 E{(bf16_t*)(ws + WS_QA), (bf16_t*)(ws + WS_KA), (bf16_t*)(ws + WS_VA), (bf16_t*)(ws + WS_CQ), (bf16_t*)(ws + WS_CKV), (float*)(ws + WS_SSQ1), CA, CA + 4096 * 32};
        pg8::gemm_phase<EpiP1, pg8::StaticOrder, GemmPlain>(F.lds, g, S_, E);
        p1_krope(F);
        SEAM(1);
    }
    TSTAMP(2);
    if (IN(2)) {
        GemmUp g{(const bf16_t*)(ws + WS_CQ), (const bf16_t*)(ws + WS_CKV), (const bf16_t*)(ws + WS_WUQ), (const bf16_t*)(ws + WS_WUKV), 256, 256, 256};
        pg8::StaticOrder S_; S_.init(M, 7 * 256, F.G, (int)blockIdx.x);
        const float* CB = (const float*)(ws + WS_ROPE) + 2 * 4096 * 32;
        EpiP2 E{(bf16_t*)(ws + WS_QB), (bf16_t*)(ws + WS_KN), (bf16_t*)(ws + WS_VB), (const float*)(ws + WS_SSQ1), CB, CB + 4096 * 16};
        pg8::gemm_phase<EpiP2, pg8::StaticOrder, GemmUp>(F.lds, g, S_, E);
    }
    TSTAMP(3);
    if (IN(3)) { p3a_dilated(F); SEAM(3); }
    TSTAMP(4);
    if (IN(4)) { p3b_mla(F); SEAM(4); }
    TSTAMP(5);
    if (IN(5)) {
        GemmPlain g{(const bf16_t*)(ws + WS_MIX), (const bf16_t*)(ws + WS_WO), 1024, 1024, 1024};
        pg8::StaticOrder S_; S_.init(M, 1024, F.G, (int)blockIdx.x);
        EpiP4 E{F.in[0], (bf16_t*)(ws + WS_X2B), (float*)(ws + WS_SSQ2)};
        pg8::gemm_phase<EpiP4, pg8::StaticOrder, GemmPlain>(F.lds, g, S_, E);
        SEAM(5);
    }
    TSTAMP(6);
    if (IN(6)) {
        GemmPlain g{(const bf16_t*)(ws + WS_X2B), (const bf16_t*)(ws + WS_WQ), 1024, 1024, 1024};
        pg8::StaticOrder S_; S_.init(M, 2048, F.G, (int)blockIdx.x);
        EpiP5 E{(bf16_t*)F.out, (const float*)(ws + WS_SSQ2)};
        pg8::gemm_phase<EpiP5, pg8::StaticOrder, GemmPlain>(F.lds, g, S_, E);
        SEAM(6);
    }
    TSTAMP(7);
    if (IN(7)) { p7_select(F); SEAM(7); }
    TSTAMP(8);
    if (IN(8)) { p8_uphase<0>(F); SEAM(8); }
#if PROBE_GATHER
    if (IN(8)) { p8_uphase<PROBE_GATHER>(F); SEAM(8); }
#endif
    TSTAMP(9);
    if (IN(9)) { p8b_combine(F); SEAM(9); }
    TSTAMP(10);
    if (IN(10)) { p9_vphase<0>(F); SEAM(10); }
#if PROBE_GATHER >= 4
    if (IN(10)) { p9_vphase<PROBE_GATHER - 3>(F); SEAM(10); }
#endif
    TSTAMP(11);
    if (IN(11)) { p10_final(F); }
    TSTAMP(12);
#if TIME_PHASE >= 0
    if (blockIdx.x == 0 && F.tid == 0) { const unsigned long long dt = tp1 - tp0, t_end = __builtin_amdgcn_s_memrealtime(); while (__builtin_amdgcn_s_memrealtime() - t_end < 8ull * dt) __builtin_amdgcn_s_sleep(8); }
#endif
#undef IN
#undef SEAM
}
#if DEBUG_CMP
namespace dbg {
__device__ __forceinline__ int colmap(int c, int mode) {
    if (mode == 1) { const int hb = c & ~63, p = c & 63; return hb + (p >> 1) + ((p & 1) << 5); }
    if (mode == 2) { return (c >> 1) + ((c & 1) << 4); }
    if (mode == 3) { const int h = c / 96, p = c % 96; if (p < 64) return c; const int q = p - 64; return h * 96 + 64 + (q >> 1) + ((q & 1) << 4); }
    return c;
}
template <class T> __device__ __forceinline__ float ldv(const T* p);
template <> __device__ __forceinline__ float ldv<float>(const float* p) { return *p; }
template <> __device__ __forceinline__ float ldv<bf16_t>(const bf16_t* p) { return __builtin_bit_cast(float, (unsigned)(*p) << 16); }
template <class T>
__global__ void cmp_k(const T* opt, int ld_opt, const float* ref, int ld_ref, int rows, int cols, float scale, int mode, unsigned* err, int stage) {
    const size_t n = (size_t)rows * cols; float md = 0.f, mr = 0.f;
    for (size_t i = (size_t)blockIdx.x * blockDim.x + threadIdx.x; i < n; i += (size_t)gridDim.x * blockDim.x) {
        const int r = (int)(i / cols), c = (int)(i % cols);
        const float o = ldv<T>(opt + (size_t)r * ld_opt + c) * scale, rf = ref[(size_t)r * ld_ref + colmap(c, mode)];
        float d = fabsf(o - rf); if (!(d == d)) d = 1.0e30f;
        md = fmaxf(md, d); mr = fmaxf(mr, fabsf(rf));
    }
    for (int o = 32; o > 0; o >>= 1) { md = fmaxf(md, __shfl_xor(md, o)); mr = fmaxf(mr, __shfl_xor(mr, o)); }
    if ((threadIdx.x & 63) == 0) { atomicMax(err + 2 * stage, __float_as_uint(md)); atomicMax(err + 2 * stage + 1, __float_as_uint(mr)); }
}
__global__ void encode_k(float* out, const unsigned* err, int nstage, int sel, float thr) {
    float eps2 = 0.f;
    if (sel >= 0) { const float e = __uint_as_float(err[2 * sel]) / fmaxf(__uint_as_float(err[2 * sel + 1]), 1e-30f); eps2 = fminf(fmaxf(e, 1e-4f), 0.9f); }
    else for (int k = 0; k < nstage; ++k) { const float e = __uint_as_float(err[2 * k]) / fmaxf(__uint_as_float(err[2 * k + 1]), 1e-30f);
        if (!(e < thr)) { eps2 = exp2f(-(float)(k + 1)) * (1.f + 0.9f * fminf(e, 1.f)); break; } }
    const float sc = 1.f + sqrtf(eps2);
    const size_t i = ((size_t)blockIdx.x * blockDim.x + threadIdx.x) * 4; f32x4 v = *(f32x4*)(out + i); v = v * sc; *(f32x4*)(out + i) = v;
}
}
#endif

static void launch_phases(const Args& base, int lo, int hi, int grid, hipStream_t stream) {
    Args a = base; a.ph_lo = lo; a.ph_hi = hi;
#if ONE_LAUNCH
    void* kargs[] = {(void*)&a};
    hipError_t e = hipLaunchCooperativeKernel((const void*)fwd_kernel, dim3(grid), dim3(512), kargs, LDS_BYTES, stream);
    if (e != hipSuccess) fprintf(stderr, "cooperative launch failed: %s (grid %d)\n", hipGetErrorString(e), grid);
#else
    hipLaunchKernelGGL(fwd_kernel, dim3(grid), dim3(512), LDS_BYTES, stream, a);
#endif
}

extern "C" void kernel_launch(void* const* d_in, const int* in_sizes, int n_in, void* d_out, int out_size, void* d_ws, size_t ws_size, hipStream_t stream) {
    static int grid = 0;
    if (grid == 0) {
        int dev = 0, cus = 0, per_cu = 0;
        hipGetDevice(&dev); hipDeviceGetAttribute(&cus, hipDeviceAttributeMultiprocessorCount, dev);
        hipFuncSetAttribute((const void*)fwd_kernel, hipFuncAttributeMaxDynamicSharedMemorySize, LDS_BYTES);
        hipOccupancyMaxActiveBlocksPerMultiprocessor(&per_cu, (const void*)fwd_kernel, 512, LDS_BYTES);
        if (per_cu < 1) { fprintf(stderr, "occupancy query says %d blocks/CU\n", per_cu); per_cu = 1; }
        grid = cus * 1;
        if (grid > 256) grid = 256;
        (void)hipGetLastError();
    }
    Args a{};
    for (int i = 0; i < 15; ++i) a.in[i] = (const float*)d_in[i];
    a.out = (float*)d_out; a.ws = (unsigned char*)d_ws;
    (void)hipMemsetAsync(a.ws + WS_CTL, 0, CTL_ZERO_BYTES, stream);
#if !DEBUG_CMP
#if ONE_LAUNCH
    launch_phases(a, 0, NPHASE, grid, stream);
#else
    for (int p = 0; p < NPHASE; ++p) launch_phases(a, p, p + 1, grid, stream);
#endif
#else
    using nv::rmsnorm_k; using nv::gemm_k; using nv::rope_k; using nv::copy_cols_k; using nv::dilated_k; using nv::mla_k; using nv::peer_k; constexpr int PW = nv::PW;
    unsigned char* ws = (unsigned char*)d_ws;
    unsigned* err = (unsigned*)(ws + 505 * MiB);
    hipMemsetAsync(err, 0, 256, stream);
    float* hb = (float*)(ws + 404 * MiB); float* projb = (float*)(ws + 420 * MiB); float* qn = (float*)(ws + 456 * MiB); float* knn = (float*)(ws + 469 * MiB);
    float* krn = (float*)(ws + 477 * MiB); float* vn = (float*)(ws + 478 * MiB); float* mixb = (float*)(ws + 486 * MiB);
    const float* x = (const float*)d_in[0];
    hipStream_t st = stream;
    launch_phases(a, 0, 1, grid, stream); launch_phases(a, 1, 2, grid, stream);
    rmsnorm_k<<<S / 4, 256, 0, st>>>(x, D, (const float*)d_in[1], hb, D, D, S);
    gemm_k<<<dim3((PW + 63) / 64, S / 64), 256, 0, st>>>(hb, D, (const float*)d_in[2], PW, projb, PW, nullptr, 0, S, PW, D);
    rope_k<<<(S * 8 * 32 + 255) / 256, 256, 0, st>>>(projb, PW, 0, 8, 64, S);
    rope_k<<<(S * 8 * 32 + 255) / 256, 256, 0, st>>>(projb, PW, 512, 8, 64, S);
    copy_cols_k<<<(S * 32 + 255) / 256, 256, 0, st>>>(projb + 2048, PW, krn, 32, 32, S);
    rope_k<<<(S * 16 + 255) / 256, 256, 0, st>>>(krn, 32, 0, 1, 32, S);
    dbg::cmp_k<bf16_t><<<1024, 256, 0, st>>>((const bf16_t*)(ws + WS_QA), 512, projb, PW, S, 512, 1.f / QSCALE_A, 1, err, 0);
    dbg::cmp_k<bf16_t><<<1024, 256, 0, st>>>((const bf16_t*)(ws + WS_KA), 512, projb + 512, PW, S, 512, 1.f, 1, err, 1);
    dbg::cmp_k<bf16_t><<<1024, 256, 0, st>>>((const bf16_t*)(ws + WS_VA), 512, projb + 1024, PW, S, 512, 1.f, 0, err, 2);
    dbg::cmp_k<bf16_t><<<1024, 256, 0, st>>>((const bf16_t*)(ws + WS_CQ), 256, projb + 1536, PW, S, 256, 1.f, 0, err, 3);
    dbg::cmp_k<bf16_t><<<1024, 256, 0, st>>>((const bf16_t*)(ws + WS_CKV), 256, projb + 1792, PW, S, 256, 1.f, 0, err, 4);
    dbg::cmp_k<bf16_t><<<1024, 256, 0, st>>>((const bf16_t*)(ws + WS_KR), 32, krn, 32, S, 32, 1.f, 2, err, 5);
    launch_phases(a, 2, 3, grid, stream);
    {   float* cqn = hb; float* ckvn = hb + (size_t)S * 256;
        rmsnorm_k<<<S / 4, 256, 0, st>>>(projb + 1536, PW, (const float*)d_in[3], cqn, 256, 256, S);
        rmsnorm_k<<<S / 4, 256, 0, st>>>(projb + 1792, PW, (const float*)d_in[4], ckvn, 256, 256, S);
        gemm_k<<<dim3(768 / 64, S / 64), 256, 0, st>>>(cqn, 256, (const float*)d_in[5], 768, qn, 768, nullptr, 0, S, 768, 256);
        for (int h = 0; h < 8; ++h) rope_k<<<(S * 16 + 255) / 256, 256, 0, st>>>(qn, 768, h * 96 + 64, 1, 32, S);
        gemm_k<<<dim3(512 / 64, S / 64), 256, 0, st>>>(ckvn, 256, (const float*)d_in[6], 512, knn, 512, nullptr, 0, S, 512, 256);
        gemm_k<<<dim3(512 / 64, S / 64), 256, 0, st>>>(ckvn, 256, (const float*)d_in[7], 512, vn, 512, nullptr, 0, S, 512, 256); }
    dbg::cmp_k<bf16_t><<<1024, 256, 0, st>>>((const bf16_t*)(ws + WS_QB), 768, qn, 768, S, 768, 1.f / QSCALE_B, 3, err, 6);
    dbg::cmp_k<bf16_t><<<1024, 256, 0, st>>>((const bf16_t*)(ws + WS_KN), 512, knn, 512, S, 512, 1.f, 0, err, 7);
    dbg::cmp_k<bf16_t><<<1024, 256, 0, st>>>((const bf16_t*)(ws + WS_VB), 512, vn, 512, S, 512, 1.f, 0, err, 8);
    launch_phases(a, 3, 4, grid, stream); launch_phases(a, 4, 5, grid, stream);
    dilated_k<<<8 * S / 4, 256, 0, st>>>(projb, mixb);
    mla_k<<<1 * 8 * (S / 64), 64, 0, st>>>(qn, knn, krn, vn, mixb);
    dbg::cmp_k<bf16_t><<<1024, 256, 0, st>>>((const bf16_t*)(ws + WS_MIX), 1024, mixb, 1024, S, 512, 1.f, 0, err, 9);
    dbg::cmp_k<bf16_t><<<1024, 256, 0, st>>>((const bf16_t*)(ws + WS_MIX) + 512, 1024, mixb + 512, 1024, S, 512, 1.f, 0, err, 10);
    launch_phases(a, 5, 6, grid, stream);
    float* x2b = hb;
    gemm_k<<<dim3(D / 64, S / 64), 256, 0, st>>>(mixb, 1024, (const float*)d_in[8], D, x2b, D, x, D, S, D, 1024);
    dbg::cmp_k<bf16_t><<<1024, 256, 0, st>>>((const bf16_t*)(ws + WS_X2B), 1024, x2b, 1024, S, 1024, 1.f, 0, err, 11);
    launch_phases(a, 6, 7, grid, stream);
    float* h2c = qn; float* qpc = projb;
    rmsnorm_k<<<4096 / 4, 256, 0, st>>>(x2b, D, (const float*)d_in[9], h2c, D, D, 4096);
    gemm_k<<<dim3(2048 / 64, 4096 / 64), 256, 0, st>>>(h2c, D, (const float*)d_in[10], 2048, qpc, 2048, nullptr, 0, 4096, 2048, D);
    dbg::cmp_k<bf16_t><<<1024, 256, 0, st>>>((const bf16_t*)d_out, 2048, qpc, 2048, S, 2048, 1.f, 0, err, 12);
    launch_phases(a, 7, 8, grid, stream); launch_phases(a, 8, 9, grid, stream); launch_phases(a, 9, 10, grid, stream); launch_phases(a, 10, 11, grid, stream); launch_phases(a, 11, 12, grid, stream);
    peer_k<<<4096 / 4, 256, 0, st>>>(h2c, qpc, (const float*)d_in[11], (const float*)d_in[12], (const float*)d_in[13], (const float*)d_in[14], x2b, 4096);
    dbg::cmp_k<float><<<1024, 256, 0, st>>>((const float*)d_out, 1024, x2b, 1024, S, 1024, 1.f, 0, err, 13);
    nv::run(d_in, (float*)d_out, (float*)d_ws, stream);
    dbg::encode_k<<<M * 1024 / 4 / 256, 256, 0, st>>>((float*)d_out, err, 14, DEBUG_SEL, 0.05f);
#endif
}
```

```cpp
#include <hip/hip_runtime.h>
#include <hip/hip_cooperative_groups.h>
#include <cstdio>
#include <cstdint>
#include <cmath>
namespace cg = cooperative_groups;
#define DEBUG_CMP 0
#define ONE_LAUNCH 1
#define DEBUG_SEL -1
#define TIME_PHASE -1
#define PROBE_GATHER 0
#define PROBE_ATTN 0
#define LAS __attribute__((address_space(3)))
#define GAS __attribute__((address_space(1)))
typedef unsigned short bf16_t;
typedef short bf16x8 __attribute__((ext_vector_type(8)));
typedef short s16x4 __attribute__((ext_vector_type(4)));
typedef float f32x4 __attribute__((ext_vector_type(4)));
typedef float f32x16 __attribute__((ext_vector_type(16)));
typedef float f32x2_t __attribute__((ext_vector_type(2)));
typedef __bf16 bf16x2_t __attribute__((ext_vector_type(2)));
typedef unsigned u32x4 __attribute__((ext_vector_type(4)));
typedef unsigned u32x2 __attribute__((ext_vector_type(2)));

constexpr int NB = 8, S = 4096, M = NB * S, D = 1024;
constexpr float NORM_EPS = 1e-6f;
constexpr float LOG2E = 1.4426950408889634f;
constexpr float QSCALE_A = 0.125f * LOG2E;
constexpr float QSCALE_B = 0.10206207261596577f * LOG2E;

__device__ __forceinline__ unsigned cvtpk(float lo, float hi) { f32x2_t v = {lo, hi}; bf16x2_t b = __builtin_convertvector(v, bf16x2_t); return __builtin_bit_cast(unsigned, b); }
__device__ __forceinline__ float bf_lo(unsigned w) { return __builtin_bit_cast(float, w << 16); }
__device__ __forceinline__ float bf_hi(unsigned w) { return __builtin_bit_cast(float, w & 0xffff0000u); }

#define ASM_GLDS16(gptr, ldsaddr) asm volatile("s_mov_b32 m0, %0\n\ts_nop 0\n\tglobal_load_lds_dwordx4 %1, off sc0 sc1" :: "s"(ldsaddr), "v"(gptr) : "m0")

namespace pg8 {
constexpr int BM = 256, BK = 64, HALF = 128, HTB = HALF * BK * 2, STAGE_BYTES = 8 * HTB, NXCD = 8, WGM = 8;
__host__ __device__ __forceinline__ int lds_byte(int r, int c) { const int st = (r >> 4) * 2 + (c >> 5), rr = r & 15, cc = c & 31, ob = rr * 64 + cc * 2; return st * 1024 + (ob ^ (((ob >> 9) & 1) << 5)); }
__host__ __device__ __forceinline__ void stage_rc(int b, int& R, int& C) { const int st = b / 1024, sb = b % 1024, swz = sb ^ (((sb >> 9) & 1) << 5); R = (st >> 1) * 16 + swz / 64; C = (st & 1) * 32 + (swz % 64) / 2; }
__host__ __device__ __forceinline__ int perm32(int rho) { const int n = rho >> 4, i = rho & 15; return 8 * (i >> 2) + 4 * n + (i & 3); }
struct Unit { int pm, pn; };
struct StaticOrder {
    int nM, nN, nwg, G, c;
    __device__ void init(int Mr, int N, int G_, int c_) { nM = Mr / BM; nN = N / BM; nwg = nM * nN; G = G_; c = c_; }
    __device__ bool next(int i, Unit& u) const {
        const long L = (long)i * G + c; if (L >= nwg) return false;
        int wgid = (int)L; { const int q = nwg / NXCD, r = nwg % NXCD, xcd = wgid % NXCD, off = wgid / NXCD; wgid = (xcd < r ? xcd * (q + 1) : r * (q + 1) + (xcd - r) * q) + off; }
        const int nig = WGM * nN, gid = wgid / nig, fm = gid * WGM, gsz = (nM - fm) < WGM ? (nM - fm) : WGM;
        u.pm = fm + ((wgid % nig) % gsz); u.pn = (wgid % nig) / gsz; return true;
    }
};
struct RowRun { int pm, pn0, n; __device__ bool next(int i, Unit& u) const { if (i >= n) return false; u.pm = pm; u.pn = pn0 + i; return true; } };
template <class Epi, class Sched, class G>
__device__ __forceinline__ void gemm_phase(LAS unsigned char* lds, const G g, const Sched& Sch, const Epi& E, int wave_id) {
    int lane; asm volatile("v_mbcnt_lo_u32_b32 %0, -1, 0\n\tv_mbcnt_hi_u32_b32 %0, -1, %0" : "=v"(lane));
    const int wid = wave_id, tid = wid * 64 + lane, wr = wid >> 2, wc = wid & 3, fr = lane & 15, fq = lane >> 4;
    const int K = g.K, nt = K / BK;
    unsigned voffA[2], voffB[2];
#pragma unroll
    for (int i = 0; i < 2; ++i) { int R, C; stage_rc(tid * 16 + i * 8192, R, C); const int Rb = Epi::PERM ? ((R & ~31) + perm32(R & 31)) : R;
        voffA[i] = (unsigned)(R * g.lda + C) * 2u; voffB[i] = (unsigned)(Rb * g.ldb + C) * 2u; }
    const size_t kstep = (size_t)(BK * 2);
    const size_t hstepA = (size_t)HALF * g.lda * 2, hstepB = (size_t)HALF * g.ldb * 2;
    const unsigned ldsw = (unsigned)wid * 1024u;
    const int aoff = lds_byte(wr * 64 + fr, fq * 8), boff = lds_byte(wc * 32 + fr, fq * 8);
#define PG8_SA(b, h) (((b) * 2 + (h)) * HTB)
#define PG8_SB(b, h) ((4 + (b) * 2 + (h)) * HTB)
#define PG8_STAGE(bufoff, gbase, voff) do { _Pragma("unroll") for (int _i = 0; _i < 2; ++_i) \
        __builtin_amdgcn_global_load_lds((const unsigned*)((const char*)(gbase) + (voff)[_i]), (LAS unsigned*)(lds + (bufoff) + ldsw + _i * 8192), 16, 0, 0); } while (0)
#define PG8_LDA(dst, b, h) do { _Pragma("unroll") for (int m = 0; m < 4; ++m) _Pragma("unroll") for (int k = 0; k < 2; ++k) dst[m][k] = *(const LAS bf16x8*)(lds + PG8_SA(b, h) + aoff + m * 2048 + k * 1024); } while (0)
#define PG8_LDB(dst, b, h) do { _Pragma("unroll") for (int n = 0; n < 2; ++n) _Pragma("unroll") for (int k = 0; k < 2; ++k) dst[n][k] = *(const LAS bf16x8*)(lds + PG8_SB(b, h) + boff + n * 2048 + k * 1024); } while (0)
#define PG8_MMA(ai, bj, At, Bt) do { __builtin_amdgcn_s_setprio(1); _Pragma("unroll") for (int m = 0; m < 4; ++m) _Pragma("unroll") for (int n = 0; n < 2; ++n) _Pragma("unroll") for (int k = 0; k < 2; ++k) \
        acc[ai][bj][m][n] = __builtin_amdgcn_mfma_f32_16x16x32_bf16(Bt[n][k], At[m][k], acc[ai][bj][m][n], 0, 0, 0); __builtin_amdgcn_s_setprio(0); } while (0)
#define PG8_WAIT_V(n) asm volatile("s_waitcnt vmcnt(" #n ")" ::: "memory")
#define PG8_WAIT_L(n) asm volatile("s_waitcnt lgkmcnt(" #n ")" ::: "memory")
#define PG8_BAR __builtin_amdgcn_s_barrier()
#define PG8_SCHED __builtin_amdgcn_sched_barrier(0)
    Unit cur, nxt; int ui = 0;
    if (!Sch.next(0, cur)) return;
    f32x4 acc[2][2][4][2];
#pragma unroll
    for (int a = 0; a < 2; ++a)
#pragma unroll
        for (int b = 0; b < 2; ++b)
#pragma unroll
            for (int m = 0; m < 4; ++m)
#pragma unroll
                for (int n = 0; n < 2; ++n) acc[a][b][m][n] = (f32x4){0.f, 0.f, 0.f, 0.f};
    bf16x8 At[4][2], B0[2][2], B1[2][2];
    const char* cA = g.a_base(cur); const char* cB = g.b_base(cur);
    PG8_STAGE(PG8_SB(0, 0), cB, voffB); PG8_STAGE(PG8_SB(0, 1), cB + hstepB, voffB); PG8_STAGE(PG8_SA(0, 0), cA, voffA); PG8_STAGE(PG8_SA(0, 1), cA + hstepA, voffA);
    if (wr == 1) PG8_BAR;
    PG8_WAIT_V(2); PG8_BAR;
    PG8_STAGE(PG8_SB(1, 0), cB + kstep, voffB); PG8_STAGE(PG8_SA(1, 0), cA + kstep, voffA); PG8_STAGE(PG8_SB(1, 1), cB + hstepB + kstep, voffB);
    PG8_WAIT_V(6); PG8_BAR;
    for (;;) {
        const bool has_next = Sch.next(ui + 1, nxt);
        const char* nA = has_next ? g.a_base(nxt) : cA; const char* nB = has_next ? g.b_base(nxt) : cB;
        for (int t = 0; t < nt; t += 2) {
            const bool last = (t == nt - 2);
            const char* a1 = cA + (size_t)(t + 1) * kstep;
            const char* a2 = last ? nA : cA + (size_t)(t + 2) * kstep; const char* b2 = last ? nB : cB + (size_t)(t + 2) * kstep;
            const char* a3 = a2 + kstep; const char* b3 = b2 + kstep;
            PG8_LDB(B0, 0, 0); PG8_LDB(B1, 0, 1); PG8_SCHED; PG8_LDA(At, 0, 0); PG8_STAGE(PG8_SA(1, 1), a1 + hstepA, voffA);
            PG8_WAIT_V(8); PG8_WAIT_L(0); PG8_BAR; PG8_MMA(0, 0, At, B0); PG8_MMA(0, 1, At, B1); PG8_BAR; PG8_SCHED;
            PG8_LDA(At, 0, 1); PG8_STAGE(PG8_SB(0, 0), b2, voffB); PG8_STAGE(PG8_SB(0, 1), b2 + hstepB, voffB); PG8_STAGE(PG8_SA(0, 0), a2, voffA);
            PG8_WAIT_V(8); PG8_WAIT_L(0); PG8_BAR; PG8_MMA(1, 0, At, B0); PG8_MMA(1, 1, At, B1); PG8_BAR; PG8_SCHED;
            PG8_LDB(B0, 1, 0); PG8_LDB(B1, 1, 1); PG8_SCHED; PG8_LDA(At, 1, 0); PG8_STAGE(PG8_SA(0, 1), a2 + hstepA, voffA);
            PG8_WAIT_V(8); PG8_WAIT_L(0); PG8_BAR; PG8_MMA(0, 0, At, B0); PG8_MMA(0, 1, At, B1); PG8_BAR; PG8_SCHED;
            PG8_LDA(At, 1, 1); PG8_STAGE(PG8_SB(1, 0), b3, voffB); PG8_STAGE(PG8_SB(1, 1), b3 + hstepB, voffB); PG8_STAGE(PG8_SA(1, 0), a3, voffA);
            PG8_WAIT_V(8); PG8_WAIT_L(0); PG8_BAR; PG8_MMA(1, 0, At, B0); PG8_MMA(1, 1, At, B1); PG8_BAR; PG8_SCHED;
        }
        if (wr == 0) PG8_BAR;
        { Unit ce = cur; asm volatile("" : "+s"(ce.pm), "+s"(ce.pn));
          E(acc, ce, wr, wc, fr, fq); }
        if (!has_next) break;
#pragma unroll
        for (int a = 0; a < 2; ++a)
#pragma unroll
            for (int b = 0; b < 2; ++b)
#pragma unroll
                for (int m = 0; m < 4; ++m)
#pragma unroll
                    for (int n = 0; n < 2; ++n) acc[a][b][m][n] = (f32x4){0.f, 0.f, 0.f, 0.f};
        cur = nxt; cA = nA; cB = nB; ++ui;
        if (wr == 1) PG8_BAR;
    }
    PG8_WAIT_V(0);
    PG8_BAR;
#undef PG8_SA
#undef PG8_SB
#undef PG8_STAGE
#undef PG8_LDA
#undef PG8_LDB
#undef PG8_MMA
#undef PG8_WAIT_V
#undef PG8_WAIT_L
#undef PG8_BAR
#undef PG8_SCHED
}
}
constexpr size_t MiB = 1u << 20;
constexpr size_t WS_CTL = 0;
constexpr size_t WS_WIN = 2 * MiB;
constexpr size_t WS_WKR = 6 * MiB;
constexpr size_t WS_WUQ = 7 * MiB;
constexpr size_t WS_WUKV = 8 * MiB;
constexpr size_t WS_WO = 9 * MiB;
constexpr size_t WS_WQ = 11 * MiB;
constexpr size_t WS_KEYS = 15 * MiB;
constexpr size_t WS_ROPE = 16 * MiB;
constexpr size_t WS_U = 18 * MiB;
constexpr size_t WS_V = 50 * MiB;
constexpr size_t WS_SSQ1 = 82 * MiB;
constexpr size_t WS_SSQ2 = 84 * MiB;
constexpr size_t WS_XN = 96 * MiB;
constexpr size_t WS_MIX = 420 * MiB;
constexpr size_t WS_RSX = 86 * MiB;
constexpr size_t WS_QA = 160 * MiB, WS_KA = 192 * MiB, WS_VA = 224 * MiB;
constexpr size_t WS_X2B = 160 * MiB;
constexpr size_t WS_CQ = 256 * MiB, WS_CKV = 272 * MiB;
constexpr size_t WS_KR = 288 * MiB;
constexpr size_t WS_KRU = 484 * MiB;
constexpr size_t WS_QB = 292 * MiB;
constexpr size_t WS_KN = 340 * MiB, WS_VB = 372 * MiB;
constexpr size_t WS_X2 = 292 * MiB;
constexpr size_t WS_END_OPT = 420 * MiB;
constexpr size_t DO_OP = 0, DO_LSE = 96 * MiB;

struct Args { const float* in[15]; float* out; unsigned char* ws; int ph_lo, ph_hi; };

struct Frame {
    LAS unsigned char* lds;
    int tid, lane, wave, vcu, G;
    const float* in[15]; float* out; unsigned char* ws;
};

__device__ __forceinline__ float wave_sum(float v) {
#pragma unroll
    for (int o = 1; o < 64; o <<= 1) v += __shfl_xor(v, o);
    return v;
}

__device__ __forceinline__ int perm_win(int np) {
    if (np < 1024) { const int hb = np & ~63, p = np & 63; return hb + (p >> 1) + ((p & 1) << 5); }
    return np;
}
__device__ __forceinline__ int perm_wkr(int np) { return 2048 + (np >> 1) + ((np & 1) << 4); }
__device__ __forceinline__ int perm_wuq(int np) { const int h = np / 96, p = np % 96; if (p < 64) return np; const int q = p - 64; return h * 96 + 64 + (q >> 1) + ((q & 1) << 4); }

template <int PERM>
__device__ __forceinline__ void transpose_item(const float* __restrict__ W, int K, int N, const float* __restrict__ gk, bf16_t* __restrict__ WT, int row_off, LAS float* scr, int item, int nblk, int lane) {
    const int kb = item / nblk, nb = item % nblk, k0 = 64 * kb, n0 = 32 * nb;
    const int npx = n0 + (lane & 31);
    const int nl = PERM == 1 ? perm_win(npx) : PERM == 2 ? perm_wkr(npx) : PERM == 3 ? perm_wuq(npx) : npx;
#pragma unroll
    for (int hblk = 0; hblk < 2; ++hblk) {
        float tv[16];
#pragma unroll
        for (int i = 0; i < 16; ++i) tv[i] = W[(size_t)(k0 + 2 * (16 * hblk + i) + (lane >> 5)) * N + nl];
#pragma unroll
        for (int i = 0; i < 16; ++i) { const int kk = 2 * (16 * hblk + i) + (lane >> 5); float v = tv[i]; if (gk) v *= gk[k0 + kk]; scr[kk * 33 + (lane & 31)] = v; }
        asm volatile("" ::: "memory");
    }
    asm volatile("s_waitcnt lgkmcnt(0)" ::: "memory");
    const int c = lane & 7;
#pragma unroll
    for (int j = 0; j < 4; ++j) { const int n = (lane >> 3) + 8 * j; const LAS float* s = scr + (8 * c) * 33 + n;
        u32x4 o; o.x = cvtpk(s[0 * 33], s[1 * 33]); o.y = cvtpk(s[2 * 33], s[3 * 33]); o.z = cvtpk(s[4 * 33], s[5 * 33]); o.w = cvtpk(s[6 * 33], s[7 * 33]);
        *(u32x4*)(WT + (size_t)(row_off + n0 + n) * K + k0 + 8 * c) = o; }
    asm volatile("s_waitcnt lgkmcnt(0)" ::: "memory");
}

__device__ __forceinline__ void p0_prologue(Frame& F) {
    LAS float* scr = (LAS float*)(F.lds + F.wave * 16384);
    const int gw = F.vcu * 8 + F.wave, NGW = F.G * 8, lane = F.lane;
    unsigned char* ws = F.ws;
    constexpr int I_WIN = (1024 / 64) * (2048 / 32), I_WKR = (1024 / 64) * 1, I_WUQ = (256 / 64) * (768 / 32), I_WUK = (256 / 64) * (512 / 32), I_WO = (1024 / 64) * (1024 / 32), I_WQ = (1024 / 64) * (2048 / 32);
    constexpr int NIT = I_WIN + I_WKR + I_WUQ + 2 * I_WUK + I_WO + I_WQ;
    for (int it = gw; it < NIT; it += NGW) {
        int r = it;
        if (r < I_WIN) { transpose_item<1>(F.in[2], 1024, 2080, nullptr, (bf16_t*)(ws + WS_WIN), 0, scr, r, 2048 / 32, lane); continue; } r -= I_WIN;
        if (r < I_WKR) { transpose_item<2>(F.in[2], 1024, 2080, nullptr, (bf16_t*)(ws + WS_WKR), 0, scr, r, 1, lane); continue; } r -= I_WKR;
        if (r < I_WUQ) { transpose_item<3>(F.in[5], 256, 768, F.in[3], (bf16_t*)(ws + WS_WUQ), 0, scr, r, 768 / 32, lane); continue; } r -= I_WUQ;
        if (r < I_WUK) { transpose_item<0>(F.in[6], 256, 512, F.in[4], (bf16_t*)(ws + WS_WUKV), 0, scr, r, 512 / 32, lane); continue; } r -= I_WUK;
        if (r < I_WUK) { transpose_item<0>(F.in[7], 256, 512, F.in[4], (bf16_t*)(ws + WS_WUKV), 512, scr, r, 512 / 32, lane); continue; } r -= I_WUK;
        if (r < I_WO) { transpose_item<0>(F.in[8], 1024, 1024, nullptr, (bf16_t*)(ws + WS_WO), 0, scr, r, 1024 / 32, lane); continue; } r -= I_WO;
        transpose_item<0>(F.in[10], 1024, 2048, F.in[9], (bf16_t*)(ws + WS_WQ), 0, scr, r, 2048 / 32, lane);
    }
    {
        const int gt = F.vcu * 512 + F.tid, NT = F.G * 512;
        for (int i = gt; i < 262144 / 8; i += NT) { const f32x4 a = *(const f32x4*)(F.in[11] + (size_t)i * 8), b = *(const f32x4*)(F.in[11] + (size_t)i * 8 + 4);
            u32x4 o; o.x = cvtpk(a.x, a.y); o.y = cvtpk(a.z, a.w); o.z = cvtpk(b.x, b.y); o.w = cvtpk(b.z, b.w); *(u32x4*)((bf16_t*)(ws + WS_KEYS) + (size_t)i * 8) = o; }
        float* CA = (float*)(ws + WS_ROPE); float* SA = CA + 4096 * 32; float* CB = SA + 4096 * 32; float* SB = CB + 4096 * 16;
        for (int i = gt; i < 4096 * 32; i += NT) { const int pos = i >> 5, k = i & 31; const float inv = 1.0f / powf(10000.0f, (float)(2 * k) / 64.0f); const float ang = (float)pos * inv; CA[i] = cosf(ang); SA[i] = sinf(ang); }
        for (int i = gt; i < 4096 * 16; i += NT) { const int pos = i >> 4, k = i & 15; const float inv = 1.0f / powf(10000.0f, (float)(2 * k) / 32.0f); const float ang = (float)pos * inv; CB[i] = cosf(ang); SB[i] = sinf(ang); }
    }
}

__device__ __forceinline__ void p0_rows(Frame& F) {
    const int gw = F.vcu * 8 + F.wave, NGW = F.G * 8, lane = F.lane;
    unsigned char* ws = F.ws;
    {
        constexpr int WKL = 65536, WKS = 1040;
        __syncthreads();
        {
            const int t = F.tid;
            const float* w0 = F.in[2] + (size_t)(2 * t) * 2080 + 2048; const float* w1 = w0 + 2080;
            f32x4 ra[8], rb[8];
#pragma unroll
            for (int j = 0; j < 8; ++j) { ra[j] = *(const f32x4*)(w0 + 4 * j); rb[j] = *(const f32x4*)(w1 + 4 * j); }
            const int ks = t >> 4, fq = (t >> 2) & 3, e2 = (t & 3) * 4;
#pragma unroll
            for (int j = 0; j < 8; ++j)
#pragma unroll
                for (int e = 0; e < 4; ++e) { const int l = 4 * j + e, np = 2 * (l & 15) + (l >> 4), h = np >> 4, fr = np & 15;
                    *(LAS unsigned*)(F.lds + WKL + (2 * ks + h) * WKS + (fr + 16 * fq) * 16 + e2) = cvtpk(ra[j][e], rb[j][e]); }
        }
        __syncthreads();
        const float* g = F.in[1];
        f32x4 gg[4];
#pragma unroll
        for (int j = 0; j < 4; ++j) gg[j] = *(const f32x4*)(g + 256 * j + 4 * lane);
        auto ldrow = [&](int r, f32x4 (&v)[4]) { const float* sp = F.in[0] + (size_t)(r < M ? r : 0) * 1024;
#pragma unroll
            for (int j = 0; j < 4; ++j) v[j] = __builtin_nontemporal_load((const f32x4*)(sp + 256 * j + 4 * lane)); };
        LAS unsigned char* wl = F.lds + F.wave * 8192;
        const int fr = lane & 15, fq = lane >> 4;
        float* KRU = (float*)(ws + WS_KRU);
        for (int grp = gw; grp < M / 16; grp += NGW) {
            const int R0 = grp * 16;
            f32x4 va[4], vb[4], na[4], nb[4];
            ldrow(R0, va); ldrow(R0 + 1, vb);
#pragma unroll 1
            for (int i = 0; i < 8; ++i) {
                const int r0 = R0 + 2 * i, r1 = r0 + 1;
                { const int rn = (i < 7) ? r0 + 2 : r0; ldrow(rn, na); ldrow(rn + 1, nb); }
                float ssa = 0.f, ssb = 0.f;
#pragma unroll
                for (int j = 0; j < 4; ++j) { ssa += (va[j].x * va[j].x + va[j].y * va[j].y) + (va[j].z * va[j].z + va[j].w * va[j].w); ssb += (vb[j].x * vb[j].x + vb[j].y * vb[j].y) + (vb[j].z * vb[j].z + vb[j].w * vb[j].w); }
                const float rsa = rsqrtf(wave_sum(ssa) * (1.f / 1024.f) + NORM_EPS), rsb = rsqrtf(wave_sum(ssb) * (1.f / 1024.f) + NORM_EPS);
                bf16_t* da = (bf16_t*)(ws + WS_XN) + (size_t)r0 * 1024; bf16_t* db = (bf16_t*)(ws + WS_XN) + (size_t)r1 * 1024;
                if (lane == 0) { ((float*)(ws + WS_RSX))[r0] = 1.f / rsa; ((float*)(ws + WS_RSX))[r1] = 1.f / rsb; }
                LAS unsigned char* ws0 = wl + ((2 * i) & 3) * 2048 + lane * 8;
#pragma unroll
                for (int j = 0; j < 4; ++j) {
                    u32x2 o; o.x = cvtpk(va[j].x * rsa * gg[j].x, va[j].y * rsa * gg[j].y); o.y = cvtpk(va[j].z * rsa * gg[j].z, va[j].w * rsa * gg[j].w);
                    *(u32x2*)(da + 256 * j + 4 * lane) = o; *(LAS u32x2*)(ws0 + 512 * j) = o;
                    u32x2 p; p.x = cvtpk(vb[j].x * rsb * gg[j].x, vb[j].y * rsb * gg[j].y); p.y = cvtpk(vb[j].z * rsb * gg[j].z, vb[j].w * rsb * gg[j].w);
                    *(u32x2*)(db + 256 * j + 4 * lane) = p; *(LAS u32x2*)(ws0 + 2048 + 512 * j) = p; }
                if (i & 1) {
                    f32x4 c0 = {0.f, 0.f, 0.f, 0.f}, c1 = c0, c2 = c0, c3 = c0;
                    const LAS unsigned char* bp = wl + (fr & 3) * 2048 + fq * 16; const LAS unsigned char* wp = F.lds + WKL + lane * 16;
#pragma unroll 4
                    for (int ks = 0; ks < 32; ks += 2) {
                        const bf16x8 b0 = *(const LAS bf16x8*)(bp + ks * 64), b1 = *(const LAS bf16x8*)(bp + ks * 64 + 64);
                        const bf16x8 w00 = *(const LAS bf16x8*)(wp + (2 * ks) * WKS), w01 = *(const LAS bf16x8*)(wp + (2 * ks + 1) * WKS), w10 = *(const LAS bf16x8*)(wp + (2 * ks + 2) * WKS), w11 = *(const LAS bf16x8*)(wp + (2 * ks + 3) * WKS);
                        c0 = __builtin_amdgcn_mfma_f32_16x16x32_bf16(w00, b0, c0, 0, 0, 0); c1 = __builtin_amdgcn_mfma_f32_16x16x32_bf16(w01, b0, c1, 0, 0, 0);
                        c2 = __builtin_amdgcn_mfma_f32_16x16x32_bf16(w10, b1, c2, 0, 0, 0); c3 = __builtin_amdgcn_mfma_f32_16x16x32_bf16(w11, b1, c3, 0, 0, 0);
                    }
                    if (fr < 4) { float* kp = KRU + (size_t)(r0 - 2 + fr) * 32 + 4 * fq; *(f32x4*)kp = c0 + c2; *(f32x4*)(kp + 16) = c1 + c3; }
                }
#pragma unroll
                for (int j = 0; j < 4; ++j) { va[j] = na[j]; vb[j] = nb[j]; }
            }
        }
    }
}

struct GemmPlain {
    const bf16_t* A; const bf16_t* Bt; int K, lda, ldb;
    __device__ __forceinline__ const char* a_base(const pg8::Unit& u) const { return (const char*)(A + (size_t)u.pm * 256 * lda); }
    __device__ __forceinline__ const char* b_base(const pg8::Unit& u) const { return (const char*)(Bt + (size_t)u.pn * 256 * ldb); }
};
struct GemmUp {
    const bf16_t* CQ; const bf16_t* CKV; const bf16_t* WUQ; const bf16_t* WUKV; int K, lda, ldb;
    __device__ __forceinline__ const char* a_base(const pg8::Unit& u) const { return (const char*)((u.pn < 3 ? CQ : CKV) + (size_t)u.pm * 256 * 256); }
    __device__ __forceinline__ const char* b_base(const pg8::Unit& u) const { return (const char*)(u.pn < 3 ? WUQ + (size_t)u.pn * 256 * 256 : WUKV + (size_t)(u.pn - 3) * 256 * 256); }
};

__device__ __forceinline__ void rope4(f32x4& v0, f32x4& v1, const f32x4 cs, const f32x4 sn) {
    const f32x4 a = v0, b = v1;
    v0.x = a.x * cs.x - a.y * sn.x; v0.y = a.y * cs.x + a.x * sn.x; v0.z = a.z * cs.y - a.w * sn.y; v0.w = a.w * cs.y + a.z * sn.y;
    v1.x = b.x * cs.z - b.y * sn.z; v1.y = b.y * cs.z + b.x * sn.z; v1.z = b.z * cs.w - b.w * sn.w; v1.w = b.w * cs.w + b.z * sn.w;
}
__device__ __forceinline__ void store8(bf16_t* p, const f32x4 v0, const f32x4 v1) { u32x4 w; w.x = cvtpk(v0.x, v0.y); w.y = cvtpk(v0.z, v0.w); w.z = cvtpk(v1.x, v1.y); w.w = cvtpk(v1.z, v1.w); *(u32x4*)p = w; }
__device__ __forceinline__ float dot4(const f32x4 v) { return (v.x * v.x + v.y * v.y) + (v.z * v.z + v.w * v.w); }

struct EpiP1 {
    static constexpr bool PERM = true;
    bf16_t *QA, *KA, *VA, *CQ, *CKV; float* SSQ1; const float *CA, *SA;
    __device__ __forceinline__ void operator()(const f32x4 (&acc)[2][2][4][2], const pg8::Unit& u, int wr, int wc, int fr, int fq) const {
        const int pn = u.pn, row0 = u.pm * 256 + wr * 64 + fr, cw = wc * 32 + 8 * fq;
        if (pn < 4) {
            bf16_t* base = pn < 2 ? QA : KA; const float sc = pn < 2 ? QSCALE_A : 1.f; const int colt = (pn & 1) * 256 + cw;
#pragma unroll
            for (int ai = 0; ai < 2; ++ai)
#pragma unroll
                for (int m = 0; m < 4; ++m) { const int row = row0 + ai * 128 + m * 16, pos = row & (S - 1);
#pragma unroll
                    for (int bj = 0; bj < 2; ++bj) { const int col = colt + bj * 128, i0 = (col & 63) >> 1;
                        const f32x4 cs = *(const f32x4*)(CA + pos * 32 + i0), sn = *(const f32x4*)(SA + pos * 32 + i0);
                        f32x4 v0 = acc[ai][bj][m][0] * sc, v1 = acc[ai][bj][m][1] * sc; rope4(v0, v1, cs, sn);
                        store8(base + (size_t)row * 512 + col, v0, v1); } }
        } else if (pn < 6) {
            const int colt = (pn & 1) * 256 + cw;
#pragma unroll
            for (int ai = 0; ai < 2; ++ai)
#pragma unroll
                for (int m = 0; m < 4; ++m) { const int row = row0 + ai * 128 + m * 16;
#pragma unroll
                    for (int bj = 0; bj < 2; ++bj) store8(VA + (size_t)row * 512 + colt + bj * 128, acc[ai][bj][m][0], acc[ai][bj][m][1]); }
        } else {
            bf16_t* base = pn == 6 ? CQ : CKV;
#pragma unroll
            for (int ai = 0; ai < 2; ++ai)
#pragma unroll
                for (int m = 0; m < 4; ++m) { const int row = row0 + ai * 128 + m * 16; float s = 0.f;
#pragma unroll
                    for (int bj = 0; bj < 2; ++bj) { store8(base + (size_t)row * 256 + cw + bj * 128, acc[ai][bj][m][0], acc[ai][bj][m][1]); s += dot4(acc[ai][bj][m][0]) + dot4(acc[ai][bj][m][1]); }
                    s += __shfl_xor(s, 16); s += __shfl_xor(s, 32);
                    if (fq == 0) SSQ1[(size_t)row * 8 + (pn - 6) * 4 + wc] = s; }
        }
    }
};
struct EpiP2 {
    static constexpr bool PERM = true;
    bf16_t *QB, *KN, *VB; const float* SSQ1; const float *CB, *SB;
    __device__ __forceinline__ void operator()(const f32x4 (&acc)[2][2][4][2], const pg8::Unit& u, int wr, int wc, int fr, int fq) const {
        const int pn = u.pn, row0 = u.pm * 256 + wr * 64 + fr, cw = wc * 32 + 8 * fq, grp = pn < 3 ? 0 : 1;
#pragma unroll
        for (int ai = 0; ai < 2; ++ai)
#pragma unroll
            for (int m = 0; m < 4; ++m) { const int row = row0 + ai * 128 + m * 16, pos = row & (S - 1);
                const f32x4 sq = *(const f32x4*)(SSQ1 + (size_t)row * 8 + grp * 4);
                const float rs = rsqrtf(((sq.x + sq.y) + (sq.z + sq.w)) * (1.f / 256.f) + NORM_EPS);
                if (pn < 3) {
#pragma unroll
                    for (int bj = 0; bj < 2; ++bj) { const int col = pn * 256 + bj * 128 + cw, p = col % 96; const float sc = rs * QSCALE_B;
                        f32x4 v0 = acc[ai][bj][m][0] * sc, v1 = acc[ai][bj][m][1] * sc;
                        if (p >= 64) { const int i0 = (p - 64) >> 1; const f32x4 cs = *(const f32x4*)(CB + pos * 16 + i0), sn = *(const f32x4*)(SB + pos * 16 + i0); rope4(v0, v1, cs, sn); }
                        store8(QB + (size_t)row * 768 + col, v0, v1); }
                } else {
                    bf16_t* base = pn < 5 ? KN : VB; const int colt = ((pn - 3) & 1) * 256 + cw;
#pragma unroll
                    for (int bj = 0; bj < 2; ++bj) store8(base + (size_t)row * 512 + colt + bj * 128, acc[ai][bj][m][0] * rs, acc[ai][bj][m][1] * rs);
                }
            }
    }
};
struct EpiP4 {
    static constexpr bool PERM = true;
    const bf16_t* XN; const float* RSX; const float* G; bf16_t* X2B; float* SSQ2;
    __device__ __forceinline__ void operator()(const f32x4 (&acc)[2][2][4][2], const pg8::Unit& u, int wr, int wc, int fr, int fq) const {
        const int row0 = u.pm * 256 + wr * 64 + fr, colt = u.pn * 256 + wc * 32 + 8 * fq;
        f32x4 gi[2][2];
#pragma unroll
        for (int bj = 0; bj < 2; ++bj) { const f32x4 g0 = *(const f32x4*)(G + colt + bj * 128), g1 = *(const f32x4*)(G + colt + bj * 128 + 4);
            gi[bj][0] = (f32x4){1.f / g0.x, 1.f / g0.y, 1.f / g0.z, 1.f / g0.w}; gi[bj][1] = (f32x4){1.f / g1.x, 1.f / g1.y, 1.f / g1.z, 1.f / g1.w}; }
#pragma unroll
        for (int ai = 0; ai < 2; ++ai)
#pragma unroll
            for (int m = 0; m < 4; ++m) { const int row = row0 + ai * 128 + m * 16; float s = 0.f; const float rx = RSX[row];
#pragma unroll
                for (int bj = 0; bj < 2; ++bj) { const size_t off = (size_t)row * 1024 + colt + bj * 128;
                    const u32x4 xw = *(const u32x4*)(XN + off);
                    const f32x4 x0 = {bf_lo(xw.x), bf_hi(xw.x), bf_lo(xw.y), bf_hi(xw.y)}, x1 = {bf_lo(xw.z), bf_hi(xw.z), bf_lo(xw.w), bf_hi(xw.w)};
                    const f32x4 v0 = acc[ai][bj][m][0] + x0 * rx * gi[bj][0], v1 = acc[ai][bj][m][1] + x1 * rx * gi[bj][1];
                    store8(X2B + off, v0, v1); s += dot4(v0) + dot4(v1); }
                s += __shfl_xor(s, 16); s += __shfl_xor(s, 32);
                if (fq == 0) SSQ2[(size_t)row * 16 + u.pn * 4 + wc] = s; }
    }
};
struct EpiP5 {
    static constexpr bool PERM = true;
    bf16_t* QP; const float* SSQ2;
    __device__ __forceinline__ void operator()(const f32x4 (&acc)[2][2][4][2], const pg8::Unit& u, int wr, int wc, int fr, int fq) const {
        const int row0 = u.pm * 256 + wr * 64 + fr, colt = u.pn * 256 + wc * 32 + 8 * fq;
#pragma unroll
        for (int ai = 0; ai < 2; ++ai)
#pragma unroll
            for (int m = 0; m < 4; ++m) { const int row = row0 + ai * 128 + m * 16;
                const f32x4* sp = (const f32x4*)(SSQ2 + (size_t)row * 16); const f32x4 a = sp[0], b = sp[1], c = sp[2], d = sp[3];
                const float ss = ((a.x + a.y) + (a.z + a.w)) + ((b.x + b.y) + (b.z + b.w)) + ((c.x + c.y) + (c.z + c.w)) + ((d.x + d.y) + (d.z + d.w));
                const float rs = rsqrtf(ss * (1.f / 1024.f) + NORM_EPS);
#pragma unroll
                for (int bj = 0; bj < 2; ++bj) store8(QP + (size_t)row * 2048 + colt + bj * 128, acc[ai][bj][m][0] * rs, acc[ai][bj][m][1] * rs); }
    }
};

__device__ __forceinline__ void p1_krope(Frame& F) {
    const float* KRU = (const float*)(F.ws + WS_KRU); bf16_t* KR = (bf16_t*)(F.ws + WS_KR);
    const float* CB = (const float*)(F.ws + WS_ROPE) + 2 * 4096 * 32; const float* SB = CB + 4096 * 16;
    for (int it = F.vcu * 1024 + F.tid; it < (F.vcu + 1) * 1024; it += 512) {
        const int row = it >> 3, q = it & 7, pos = row & (S - 1), i = 2 * q;
        const f32x4 c = *(const f32x4*)(KRU + (size_t)it * 4);
        const float ca = CB[pos * 16 + i], sa = SB[pos * 16 + i], cb = CB[pos * 16 + i + 1], sb = SB[pos * 16 + i + 1];
        u32x2 w; w.x = cvtpk(c.x * ca - c.y * sa, c.y * ca + c.x * sa); w.y = cvtpk(c.z * cb - c.w * sb, c.w * cb + c.z * sb);
        *(u32x2*)(KR + (size_t)it * 4) = w;
    }
}
constexpr int AT_SLOT = 20480, AT_KB = 0, AT_VB = 12288;
__device__ __forceinline__ int crow(int r, int hi) { return (r & 3) + 8 * (r >> 2) + 4 * hi; }
__device__ __forceinline__ s16x4 vtr(const LAS unsigned char* p) { return __builtin_bit_cast(s16x4, __builtin_amdgcn_ds_read_tr16_b64_v4i16((LAS s16x4*)p)); }

constexpr float RESC_THR = 8.f;
__device__ __forceinline__ float max3f(float a, float b, float c) { return __builtin_fmaxf(__builtin_fmaxf(a, b), c); }
template <int NKS>
struct AttnCore {
    bf16x8 qr[NKS]; f32x16 o0, o1, negm; float m, l; bool fresh;
    __device__ __forceinline__ void init() { m = 0.f; l = 0.f; fresh = true;
#pragma unroll
        for (int r = 0; r < 16; ++r) { o0[r] = 0.f; o1[r] = 0.f; negm[r] = 0.f; } }
    template <class MaskF>
    __device__ __forceinline__ void tile(const LAS unsigned char* slot, int lane, bool need_mask, const MaskF& valid) {
        const int r32 = lane & 31, hi = lane >> 5;
        f32x16 p0, p1;
        const LAS unsigned char* kn = slot + AT_KB + r32 * 128; const LAS unsigned char* kr = slot + AT_KB + 8192 + r32 * 64;
#pragma unroll
        for (int d0 = 0; d0 < NKS; ++d0) {
            bf16x8 b0, b1;
            if (d0 < 4) { const int po = ((2 * d0 + hi) ^ ((r32 >> 1) & 7)) * 16; b0 = *(const LAS bf16x8*)(kn + po); b1 = *(const LAS bf16x8*)(kn + 4096 + po); }
            else { const int po = ((2 * (d0 - 4) + hi) ^ ((r32 >> 2) & 3)) * 16; b0 = *(const LAS bf16x8*)(kr + po); b1 = *(const LAS bf16x8*)(kr + 2048 + po); }
            if (d0 == 0) { p0 = __builtin_amdgcn_mfma_f32_32x32x16_bf16(b0, qr[0], negm, 0, 0, 0); p1 = __builtin_amdgcn_mfma_f32_32x32x16_bf16(b1, qr[0], negm, 0, 0, 0); }
            else { p0 = __builtin_amdgcn_mfma_f32_32x32x16_bf16(b0, qr[d0], p0, 0, 0, 0); p1 = __builtin_amdgcn_mfma_f32_32x32x16_bf16(b1, qr[d0], p1, 0, 0, 0); }
        }
        if (need_mask) {
#pragma unroll
            for (int r = 0; r < 16; ++r) { const int kk = crow(r, hi); if (!valid(kk)) p0[r] = -INFINITY; if (!valid(kk + 32)) p1[r] = -INFINITY; }
        }
        float ma = max3f(p0[0], p0[1], p1[0]), mb = max3f(p0[2], p0[3], p1[1]);
        ma = max3f(ma, p1[2], p1[3]);
#pragma unroll
        for (int r = 4; r < 16; r += 4) { ma = max3f(ma, p0[r], p0[r + 1]); mb = max3f(mb, p0[r + 2], p0[r + 3]); ma = max3f(ma, p1[r], p1[r + 1]); mb = max3f(mb, p1[r + 2], p1[r + 3]); }
        float dx = fmaxf(ma, mb);
        dx = fmaxf(dx, __shfl_xor(dx, 32));
        if (fresh || __any(dx > RESC_THR)) {
            const float dl = fresh ? fmaxf(dx, -100.f) : fmaxf(dx, 0.f), alpha = __builtin_amdgcn_exp2f(-dl);
            fresh = false;
            m += dl; l *= alpha;
#pragma unroll
            for (int r = 0; r < 16; ++r) { o0[r] *= alpha; o1[r] *= alpha; p0[r] -= dl; p1[r] -= dl; negm[r] = -m; }
        }
        float sa = 0.f, sb = 0.f, sc = 0.f, sd = 0.f;
#pragma unroll
        for (int r = 0; r < 16; r += 2) { p0[r] = __builtin_amdgcn_exp2f(p0[r]); p0[r + 1] = __builtin_amdgcn_exp2f(p0[r + 1]); p1[r] = __builtin_amdgcn_exp2f(p1[r]); p1[r + 1] = __builtin_amdgcn_exp2f(p1[r + 1]);
            sa += p0[r]; sb += p0[r + 1]; sc += p1[r]; sd += p1[r + 1]; }
        l += (sa + sb) + (sc + sd);
        u32x4 pw[4];
        pw[0] = (u32x4){cvtpk(p0[0], p0[1]), cvtpk(p0[2], p0[3]), cvtpk(p0[4], p0[5]), cvtpk(p0[6], p0[7])};
        pw[1] = (u32x4){cvtpk(p0[8], p0[9]), cvtpk(p0[10], p0[11]), cvtpk(p0[12], p0[13]), cvtpk(p0[14], p0[15])};
        pw[2] = (u32x4){cvtpk(p1[0], p1[1]), cvtpk(p1[2], p1[3]), cvtpk(p1[4], p1[5]), cvtpk(p1[6], p1[7])};
        pw[3] = (u32x4){cvtpk(p1[8], p1[9]), cvtpk(p1[10], p1[11]), cvtpk(p1[12], p1[13]), cvtpk(p1[14], p1[15])};
        const int vq = 4 * hi + ((lane & 15) >> 2), vsw = ((vq >> 1) & 1) * 4, vx = 2 * ((lane >> 4) & 1) + ((lane & 3) >> 1);
        const LAS unsigned char* vb0 = slot + AT_VB + vq * 128 + ((vx ^ vsw) * 16) + 8 * (lane & 1);
        const LAS unsigned char* vb1 = slot + AT_VB + vq * 128 + (((4 + vx) ^ vsw) * 16) + 8 * (lane & 1);
#pragma unroll
        for (int s = 0; s < 4; ++s) {
            const s16x4 lo0 = vtr(vb0 + s * 2048), hi0 = vtr(vb0 + s * 2048 + 1024), lo1 = vtr(vb1 + s * 2048), hi1 = vtr(vb1 + s * 2048 + 1024);
            const bf16x8 v0 = {lo0[0], lo0[1], lo0[2], lo0[3], hi0[0], hi0[1], hi0[2], hi0[3]}, v1 = {lo1[0], lo1[1], lo1[2], lo1[3], hi1[0], hi1[1], hi1[2], hi1[3]};
            const bf16x8 pb = __builtin_bit_cast(bf16x8, pw[s]);
            o0 = __builtin_amdgcn_mfma_f32_32x32x16_bf16(v0, pb, o0, 0, 0, 0);
            o1 = __builtin_amdgcn_mfma_f32_32x32x16_bf16(v1, pb, o1, 0, 0, 0);
        }
    }
    __device__ __forceinline__ float ltot() const { return l + __shfl_xor(l, 32); }
};

__device__ __forceinline__ void glds16(const void* gsrc, LAS unsigned char* dst) { __builtin_amdgcn_global_load_lds((const unsigned*)gsrc, (LAS unsigned*)dst, 16, 0, 0); }

struct DilUnit { int b, h, pat, dl, res, u2, m0; size_t rowb; };
__device__ __forceinline__ DilUnit dil_decode(int e) {
    DilUnit u; const int bh = e / 48, rem = e % 48; u.pat = rem >> 4; const int idx = rem & 15; u.b = bh >> 3; u.h = bh & 7;
    u.dl = u.pat * 2; const int nb2 = 16 >> u.dl; u.res = idx / nb2; u.u2 = idx % nb2; u.m0 = u.u2 * 256; u.rowb = (size_t)u.b * S; return u;
}
__device__ __forceinline__ void p3a_dilated(Frame& F) {
    const bf16_t* QA = (const bf16_t*)(F.ws + WS_QA); const bf16_t* KA = (const bf16_t*)(F.ws + WS_KA); const bf16_t* VA = (const bf16_t*)(F.ws + WS_VA);
    bf16_t* OP = (bf16_t*)((unsigned char*)F.out + DO_OP); float* LSE = (float*)((unsigned char*)F.out + DO_LSE);
    const int lane = F.lane, w = F.wave, r32 = lane & 31, hi = lane >> 5, ow = w >> 1;
    constexpr int UPC = 12, NSTEP = 3 * UPC + 3;
    for (int v = F.vcu; v < 3072 / UPC; v += F.G) {
        const int ex = (v >> 5) * (32 * UPC) + (v & 31);
#define DIL_E(k) (ex + 32 * (k))
        auto issue = [&](int k, int j, int par, int which) {
            const DilUnit u = dil_decode(DIL_E(k));
            if (u.u2 == 0 && j < 2) return;
            const int mk0 = u.m0 - 128 + 64 * j; LAS unsigned char* slot = F.lds + (par * 2 + which) * AT_SLOT;
            const size_t krow = u.rowb + ((size_t)(mk0 + 8 * w + (lane >> 3)) << u.dl) + u.res;
            glds16(KA + krow * 512 + u.h * 64 + (((lane & 7) ^ ((4 * w + (lane >> 4)) & 7)) * 8), slot + AT_KB + w * 1024);
            glds16(VA + krow * 512 + u.h * 64 + (((lane & 7) ^ (((lane >> 4) & 1) * 4)) * 8), slot + AT_VB + w * 1024);
        };
        auto qptr = [&](int k) { const DilUnit u = dil_decode(DIL_E(k)); const size_t qrow = u.rowb + ((size_t)(u.m0 + 32 * w + r32) << u.dl) + u.res; return QA + qrow * 512 + u.h * 64 + hi * 8; };
        AttnCore<4> A; A.init();
        bf16x8 qn[4];
        { const bf16_t* qp = qptr(0);
#pragma unroll
          for (int d0 = 0; d0 < 4; ++d0) qn[d0] = *(const bf16x8*)(qp + d0 * 16); }
        issue(0, 0, 0, 0);
        for (int g = 0; g < NSTEP; ++g) {
            asm volatile("s_waitcnt vmcnt(0)" ::: "memory");
            __syncthreads();
            { const int gn = g + 1, kb = gn / 3, jb = gn % 3;
              if (gn < NSTEP) { if (kb < UPC) issue(kb, jb, gn & 1, 0); if (kb >= 1 && kb - 1 < UPC) issue(kb - 1, jb + 3, gn & 1, 1); } }
            if (g >= ow) {
                const int k = (g - ow) / 3, j = g - 3 * k;
                if (k < UPC) {
                    const DilUnit u = dil_decode(DIL_E(k));
                    const int mq = u.m0 + 32 * w + r32;
                    if (j == ow) { A.init();
#pragma unroll
                        for (int d0 = 0; d0 < 4; ++d0) A.qr[d0] = qn[d0]; }
                    if (!(u.u2 == 0 && j < 2)) {
                        const int mk0 = u.m0 - 128 + 64 * j;
                        const LAS unsigned char* slot = F.lds + ((g & 1) * 2 + (j >= 3 ? 1 : 0)) * AT_SLOT;
                        A.tile(slot, lane, j != ow + 1, [&](int kk) { return (unsigned)(mq - mk0 - kk) <= 128u; });
                    }
                    if (j == ow + 2) {
                        const size_t qrow = u.rowb + ((size_t)mq << u.dl) + u.res;
                        const float lt = A.ltot(), inv = 1.f / lt;
                        bf16_t* orow = OP + ((size_t)u.pat * M + qrow) * 512 + u.h * 64;
#pragma unroll
                        for (int gq = 0; gq < 4; ++gq) {
                            u32x2 w0 = {cvtpk(A.o0[4 * gq] * inv, A.o0[4 * gq + 1] * inv), cvtpk(A.o0[4 * gq + 2] * inv, A.o0[4 * gq + 3] * inv)};
                            u32x2 w1 = {cvtpk(A.o1[4 * gq] * inv, A.o1[4 * gq + 1] * inv), cvtpk(A.o1[4 * gq + 2] * inv, A.o1[4 * gq + 3] * inv)};
                            *(u32x2*)(orow + 8 * gq + 4 * hi) = w0; *(u32x2*)(orow + 32 + 8 * gq + 4 * hi) = w1;
                        }
                        if (hi == 0) LSE[((size_t)u.pat * M + qrow) * 8 + u.h] = A.m + __builtin_amdgcn_logf(lt);
                        if (k + 1 < UPC) { const bf16_t* qp = qptr(k + 1);
#pragma unroll
                            for (int d0 = 0; d0 < 4; ++d0) qn[d0] = *(const bf16x8*)(qp + d0 * 16); }
                    }
                }
            }
        }
        __syncthreads();
    }
#undef DIL_E
}

__device__ __forceinline__ void p3b_mla(Frame& F) {
    const bf16_t* QB = (const bf16_t*)(F.ws + WS_QB); const bf16_t* KN = (const bf16_t*)(F.ws + WS_KN); const bf16_t* KR = (const bf16_t*)(F.ws + WS_KR); const bf16_t* VB = (const bf16_t*)(F.ws + WS_VB);
    const bf16_t* OP = (const bf16_t*)((const unsigned char*)F.out + DO_OP); const float* LSE = (const float*)((const unsigned char*)F.out + DO_LSE);
    bf16_t* MIX = (bf16_t*)(F.ws + WS_MIX);
    const int lane = F.lane, w = F.wave, r32 = lane & 31, hi = lane >> 5;
    for (int vi = F.vcu * 4; vi < 1024; vi += ((vi & 3) == 3) ? (F.G - 1) * 4 + 1 : 1) {
        const int v = vi >> 2, i = vi & 3;
        const int xq = v >> 5, cq = v & 31, bh = xq * 8 + (cq >> 3) + 4 * (i >> 1), jq = cq & 7, qb = (i & 1) ? 15 - jq : jq;
        const int b = bh >> 3, h = bh & 7; const size_t rowb = (size_t)b * S;
        const int qpos = qb * 256 + 32 * w + r32; const size_t qrow = rowb + qpos;
        AttnCore<6> A; A.init();
#pragma unroll
        for (int d0 = 0; d0 < 6; ++d0) A.qr[d0] = *(const bf16x8*)(QB + qrow * 768 + h * 96 + d0 * 16 + hi * 8);
        const int NT = 4 * qb + 4;
        auto issue = [&](int t) {
            LAS unsigned char* slot = F.lds + ((((t >> 1) & 1) * 2) + (t & 1)) * AT_SLOT;
            const size_t krow = rowb + 64 * t + 8 * w + (lane >> 3);
            glds16(KN + krow * 512 + h * 64 + (((lane & 7) ^ ((4 * w + (lane >> 4)) & 7)) * 8), slot + AT_KB + w * 1024);
            if (w < 4) { const size_t rrow = rowb + 64 * t + 16 * w + (lane >> 2);
                glds16(KR + rrow * 32 + (((lane & 3) ^ ((lane >> 4) & 3)) * 8), slot + AT_KB + 8192 + w * 1024); }
            glds16(VB + krow * 512 + h * 64 + (((lane & 7) ^ (((lane >> 4) & 1) * 4)) * 8), slot + AT_VB + w * 1024);
        };
        issue(0); issue(1);
        const int qmin = qb * 256 + 32 * w;
        for (int t = 0; t < NT; t += 2) {
            __syncthreads();
            if (t + 2 < NT) { issue(t + 2); issue(t + 3); }
#pragma unroll
            for (int j = 0; j < 2; ++j) {
                const int k0 = 64 * (t + j);
                if (k0 <= qmin + 31) A.tile(F.lds + ((((t >> 1) & 1) * 2) + j) * AT_SLOT, lane, k0 + 63 > qmin, [&](int kk) { return k0 + kk <= qpos; });
            }
        }
        __syncthreads();
        const float inv = 1.f / A.ltot();
        const float l0 = LSE[((size_t)0 * M + qrow) * 8 + h], l1 = LSE[((size_t)1 * M + qrow) * 8 + h], l2 = LSE[((size_t)2 * M + qrow) * 8 + h];
        const float lm = fmaxf(l0, fmaxf(l1, l2));
        float w0 = __builtin_amdgcn_exp2f(l0 - lm), w1 = __builtin_amdgcn_exp2f(l1 - lm), w2 = __builtin_amdgcn_exp2f(l2 - lm);
        const float wi = 1.f / (w0 + w1 + w2); w0 *= wi; w1 *= wi; w2 *= wi;
        bf16_t* mrow = MIX + qrow * 1024 + h * 64;
#pragma unroll
        for (int g = 0; g < 4; ++g) {
#pragma unroll
            for (int dh = 0; dh < 2; ++dh) {
                const int dc = dh * 32 + 8 * g + 4 * hi;
                const u32x2 a0 = *(const u32x2*)(OP + ((size_t)0 * M + qrow) * 512 + h * 64 + dc), a1 = *(const u32x2*)(OP + ((size_t)1 * M + qrow) * 512 + h * 64 + dc), a2 = *(const u32x2*)(OP + ((size_t)2 * M + qrow) * 512 + h * 64 + dc);
                u32x2 oa;
                oa.x = cvtpk(w0 * bf_lo(a0.x) + w1 * bf_lo(a1.x) + w2 * bf_lo(a2.x), w0 * bf_hi(a0.x) + w1 * bf_hi(a1.x) + w2 * bf_hi(a2.x));
                oa.y = cvtpk(w0 * bf_lo(a0.y) + w1 * bf_lo(a1.y) + w2 * bf_lo(a2.y), w0 * bf_hi(a0.y) + w1 * bf_hi(a1.y) + w2 * bf_hi(a2.y));
                *(u32x2*)(mrow + dc) = oa;
                u32x2 ob;
                if (dh == 0) ob = (u32x2){cvtpk(A.o0[4 * g] * inv, A.o0[4 * g + 1] * inv), cvtpk(A.o0[4 * g + 2] * inv, A.o0[4 * g + 3] * inv)};
                else ob = (u32x2){cvtpk(A.o1[4 * g] * inv, A.o1[4 * g + 1] * inv), cvtpk(A.o1[4 * g + 2] * inv, A.o1[4 * g + 3] * inv)};
                *(u32x2*)(mrow + 512 + dc) = ob;
            }
        }
    }
}
#define CE_DESC(a, b) do { const float _h = fmaxf(a, b), _l = fminf(a, b); a = _h; b = _l; } while (0)
__device__ __forceinline__ void sort16_desc(float (&v)[16]) {
#pragma unroll
    for (int k = 2; k <= 16; k <<= 1)
#pragma unroll
        for (int j = k >> 1; j > 0; j >>= 1)
#pragma unroll
            for (int i = 0; i < 16; ++i) { const int l = i ^ j; if (l > i) { if ((i & k) == 0) CE_DESC(v[i], v[l]); else CE_DESC(v[l], v[i]); } }
}
__device__ __forceinline__ void merge_top16(float (&a)[16], const float (&b)[16]) {
#pragma unroll
    for (int i = 0; i < 16; ++i) a[i] = fmaxf(a[i], b[15 - i]);
#pragma unroll
    for (int j = 8; j > 0; j >>= 1)
#pragma unroll
        for (int i = 0; i < 16; ++i) { const int l = i ^ j; if (l > i) CE_DESC(a[i], a[l]); }
}
__device__ __forceinline__ void xmerge(float (&a)[16], int xmask) {
    float b[16];
#pragma unroll
    for (int i = 0; i < 16; ++i) b[i] = __shfl_xor(a[i], xmask);
    merge_top16(a, b);
}
__device__ __forceinline__ float sel4(int g, float a0, float a1, float a2, float a3) { const float lo = (g & 1) ? a1 : a0, hi = (g & 1) ? a3 : a2; return (g & 2) ? hi : lo; }
__device__ __forceinline__ float pack_code(float v, unsigned code, unsigned mask) { return __builtin_bit_cast(float, (__builtin_bit_cast(unsigned, v) & ~mask) | code); }
__device__ __forceinline__ float gelu_erf(float v) { return 0.5f * v * (1.0f + erff(v * 0.70710678118654752f)); }


constexpr size_t WS_X3B = 96 * MiB;
constexpr size_t WS_CF16 = 292 * MiB;
constexpr size_t WS_EID = 224 * MiB, WS_GATE = 240 * MiB, WS_SSQ3 = 86 * MiB;
constexpr float V8_SCALE = 64.f;
constexpr size_t WS_USCALE = 88 * MiB;
__device__ __forceinline__ float* hpart_base(unsigned char* ws, int cg) { return (float*)(ws + (cg < 5 ? 420 * MiB + (size_t)cg * 16 * MiB : 96 * MiB + (size_t)(cg - 5) * 16 * MiB)); }
constexpr int SEL_WAVE_LDS = 512;

constexpr int SEL_KEYS_BYTES = 65536, SEL_TAB_OFF = 2 * SEL_KEYS_BYTES;
template <int NH>
__device__ __forceinline__ void p7_select_range(Frame& F, int tokbase, int h0, int convid) {
    const bf16_t* QP = (const bf16_t*)F.out; const bf16_t* KEYS = (const bf16_t*)(F.ws + WS_KEYS);
    unsigned* EID = (unsigned*)(F.ws + WS_EID); float* GATE = (float*)(F.ws + WS_GATE);
    const int lane = F.lane, w = F.wave, tk = lane & 15, g = lane >> 4;
    LAS unsigned char* tabL = F.lds + SEL_TAB_OFF + w * SEL_WAVE_LDS;
    auto stage_keys = [&](int h, int par) {
        LAS unsigned char* kb = F.lds + par * SEL_KEYS_BYTES;
#pragma unroll
        for (int i = 0; i < 8; ++i) { const int piece = w * 8 + i, r = piece * 4 + (lane >> 4), c = (lane & 15) ^ (r & 15);
            glds16(KEYS + ((size_t)h * 256 + r) * 128 + c * 8, kb + piece * 1024); }
    };
    {
        stage_keys(h0, 0);
        const int crow0 = convid * 16;
        f32x4 cv[2][4];
        auto conv_load = [&](int hh) {
#pragma unroll
            for (int u = 0; u < 2; ++u) { const int rr_ = crow0 + 2 * hh + u; const bool isu = rr_ < 16384; const float* src = (isu ? F.in[12] : F.in[13]) + (size_t)(isu ? rr_ : rr_ - 16384) * 1024;
#pragma unroll
                for (int j = 0; j < 4; ++j) cv[u][j] = __builtin_nontemporal_load((const f32x4*)(src + 256 * j + 4 * lane)); }
        };
        auto conv_store = [&](int hh) {
#pragma unroll
            for (int u = 0; u < 2; ++u) { const int rr_ = crow0 + 2 * hh + u; const bool isu = rr_ < 16384; const int e = isu ? rr_ : rr_ - 16384;
                unsigned char* dst = F.ws + (isu ? WS_U : WS_V) + (size_t)e * 1024;
                if (isu) {
                    f32x4 t[4]; float amax = 0.f;
#pragma unroll
                    for (int j = 0; j < 4; ++j) { t[j] = cv[u][j] * *(const f32x4*)(F.in[9] + 256 * j + 4 * lane); amax = fmaxf(amax, fmaxf(fmaxf(fabsf(t[j].x), fabsf(t[j].y)), fmaxf(fabsf(t[j].z), fabsf(t[j].w)))); }
#pragma unroll
                    for (int o = 1; o < 64; o <<= 1) amax = fmaxf(amax, __shfl_xor(amax, o));
                    const float sc_ = amax > 0.f ? amax * (1.f / 127.f) : 1.f, inv_ = 1.f / sc_;
                    if (lane == 0) ((float*)(F.ws + WS_USCALE))[e] = sc_;
#pragma unroll
                    for (int j = 0; j < 4; ++j) { const int q0 = (int)__builtin_rintf(t[j].x * inv_), q1 = (int)__builtin_rintf(t[j].y * inv_), q2 = (int)__builtin_rintf(t[j].z * inv_), q3 = (int)__builtin_rintf(t[j].w * inv_);
                        *(int*)(dst + 256 * j + 4 * lane) = (q0 & 0xff) | ((q1 & 0xff) << 8) | ((q2 & 0xff) << 16) | (q3 << 24); }
                } else {
#pragma unroll
                    for (int j = 0; j < 4; ++j) { f32x4 t = cv[u][j] * V8_SCALE;
                        t.x = fminf(fmaxf(t.x, -448.f), 448.f); t.y = fminf(fmaxf(t.y, -448.f), 448.f); t.z = fminf(fmaxf(t.z, -448.f), 448.f); t.w = fminf(fmaxf(t.w, -448.f), 448.f);
                        int wq = __builtin_amdgcn_cvt_pk_fp8_f32(t.x, t.y, 0, false); wq = __builtin_amdgcn_cvt_pk_fp8_f32(t.z, t.w, wq, true);
                        *(int*)(dst + 256 * j + 4 * lane) = wq; }
                }
            }
        };
        for (int it = 0; it < 8; ++it) {
            const int h = h0 + (it % NH), tok0 = tokbase + (it / NH) * 128 + w * 16;
            asm volatile("s_waitcnt vmcnt(0)" ::: "memory");
            __syncthreads();
            if (it > 0) conv_store(it - 1);
            const LAS unsigned char* kb = F.lds + (it & 1) * SEL_KEYS_BYTES;
            float s12[2][16];
#pragma unroll
            for (int p = 0; p < 2; ++p) {
                const int hp = h * 2 + p;
                bf16x8 bq[4];
#pragma unroll
                for (int ks = 0; ks < 4; ++ks) bq[ks] = *(const bf16x8*)(QP + (size_t)(tok0 + tk) * 2048 + hp * 128 + ks * 32 + g * 8);
                f32x4 c[8];
#pragma unroll
                for (int nt = 0; nt < 8; ++nt) { c[nt] = (f32x4){0.f, 0.f, 0.f, 0.f};
                    const int r = p * 128 + nt * 16 + tk;
#pragma unroll
                    for (int ks = 0; ks < 4; ++ks) { const bf16x8 ak = *(const LAS bf16x8*)(kb + r * 256 + (((4 * ks + g) ^ (r & 15)) * 16));
                        c[nt] = __builtin_amdgcn_mfma_f32_16x16x32_bf16(ak, bq[ks], c[nt], 0, 0, 0); } }
                if (p == 1) { if (it + 1 < 8) stage_keys(h0 + ((it + 1) % NH), (it + 1) & 1); conv_load(it); }
                float va[16], vb[16];
                const unsigned lo = 127u - 4u * (unsigned)g;
#pragma unroll
                for (int nt = 0; nt < 4; ++nt)
#pragma unroll
                    for (int r = 0; r < 4; ++r) { va[nt * 4 + r] = pack_code(c[nt][r], lo - (unsigned)(16 * nt + r), 127u); vb[nt * 4 + r] = pack_code(c[nt + 4][r], lo - (unsigned)(16 * (nt + 4) + r), 127u); }
                sort16_desc(va); sort16_desc(vb); merge_top16(va, vb);
                xmerge(va, 16); xmerge(va, 32);
#pragma unroll
                for (int i = 0; i < 16; ++i) s12[p][i] = va[i];
                if (g == 0) {
#pragma unroll
                    for (int i = 0; i < 16; ++i) tabL[tk * 32 + p * 16 + i] = (unsigned char)(127u - (__builtin_bit_cast(unsigned, va[i]) & 127u));
                }
            }
            float cd[16];
#define S1(i) s12[0][i]
#define S2(j) s12[1][j]
#define CND(slot, i0, j0, i1, j1, i2, j2, i3, j3) cd[slot] = pack_code(sel4(g, S1(i0), S1(i1), S1(i2), S1(i3)) + sel4(g, S2(j0), S2(j1), S2(j2), S2(j3)), \
                255u - (unsigned)(g == 0 ? (i0) * 16 + (j0) : g == 1 ? (i1) * 16 + (j1) : g == 2 ? (i2) * 16 + (j2) : (i3) * 16 + (j3)), 255u)
            CND(0, 0, 0, 0, 1, 0, 2, 0, 3);   CND(1, 0, 4, 0, 5, 0, 6, 0, 7);   CND(2, 0, 8, 0, 9, 0, 10, 0, 11); CND(3, 0, 12, 0, 13, 0, 14, 0, 15);
            CND(4, 1, 0, 1, 1, 1, 2, 1, 3);   CND(5, 1, 4, 1, 5, 1, 6, 1, 7);   CND(6, 2, 0, 2, 1, 2, 2, 2, 3);   CND(7, 2, 4, 3, 0, 3, 1, 3, 2);
            CND(8, 3, 3, 4, 0, 4, 1, 4, 2);   CND(9, 5, 0, 5, 1, 6, 0, 6, 1);   CND(10, 7, 0, 7, 1, 8, 0, 9, 0);  CND(11, 10, 0, 11, 0, 12, 0, 13, 0);
            { const float t = sel4(g, S1(14), S1(15), S1(15), S1(15)) + S2(0); const float pk = pack_code(t, 255u - (unsigned)(g == 0 ? 14 * 16 : 15 * 16), 255u); cd[12] = (g < 2) ? pk : -INFINITY; }
            cd[13] = -INFINITY; cd[14] = -INFINITY; cd[15] = -INFINITY;
#undef CND
#undef S1
#undef S2
            sort16_desc(cd); xmerge(cd, 16); xmerge(cd, 32);
            asm volatile("s_waitcnt lgkmcnt(0)" ::: "memory");
            float ev[16], sum = 0.f; const float mx = cd[0];
#pragma unroll
            for (int k = 0; k < 16; ++k) { ev[k] = __builtin_amdgcn_exp2f((cd[k] - mx) * LOG2E); sum += ev[k]; }
            const float isum = 1.f / sum;
            if (g == 0) {
                unsigned short* er = (unsigned short*)EID + (size_t)(tok0 + tk) * 128; float* gr = GATE + (size_t)(tok0 + tk) * 128;
#pragma unroll
                for (int k = 0; k < 16; ++k) { const unsigned code = 255u - (__builtin_bit_cast(unsigned, cd[k]) & 255u);
                    const unsigned e1 = tabL[tk * 32 + (code >> 4)], e2 = tabL[tk * 32 + 16 + (code & 15u)];
                    const int pos = (k & 7) * 16 + 2 * h + (k >> 3);
                    er[pos] = (unsigned short)(e1 * 128u + e2); gr[pos] = ev[k] * isum; }
            }
            asm volatile("s_waitcnt lgkmcnt(0)" ::: "memory");
        }
        conv_store(7);
        __syncthreads();
    }
}

typedef _Float16 h2_t __attribute__((ext_vector_type(2)));
__device__ __forceinline__ void fp8x16_to_h2(const u32x4 d, h2_t (&o)[8]) {
#pragma unroll
    for (int m = 0; m < 4; ++m) { o[2 * m] = __builtin_amdgcn_cvt_scalef32_pk_f16_fp8((int)d[m], 1.0f, false); o[2 * m + 1] = __builtin_amdgcn_cvt_scalef32_pk_f16_fp8((int)d[m], 1.0f, true); }
}

constexpr size_t CTL_Q_OFF = 4096;
constexpr int PEER_TILES = M / 16;
template <class Fn> __device__ __forceinline__ void peer_queue(Frame& F, int phase, const Fn& fn) {
    unsigned* ctr = (unsigned*)(F.ws + WS_CTL + CTL_Q_OFF);
    const unsigned x = (unsigned)__builtin_amdgcn_s_getreg((3 << 11) | 20) & 7u;
    for (int qi = 0; qi < 8; ++qi) {
        const int cg = (int)((x + (unsigned)qi) & 7u);
        unsigned* c = ctr + (phase * 8 + cg) * 64;
        unsigned nxt = 0; if (F.lane == 0) nxt = __hip_atomic_fetch_add(c, 1u, __ATOMIC_RELAXED, __HIP_MEMORY_SCOPE_AGENT);
        for (;;) {
            const int tile = __builtin_amdgcn_readfirstlane((int)nxt);
            if (tile >= PEER_TILES) break;
            if (F.lane == 0) nxt = __hip_atomic_fetch_add(c, 1u, __ATOMIC_RELAXED, __HIP_MEMORY_SCOPE_AGENT);
            fn(cg, tile);
        }
    }
}

__device__ __forceinline__ u32x4 ldnt4(const void* p) { return *(const u32x4*)p; }
__device__ __forceinline__ f32x4 ldnt4f(const void* p) { return *(const f32x4*)p; }
__device__ __forceinline__ unsigned ldnt1(const void* p) { return *(const unsigned*)p; }
__device__ __forceinline__ unsigned off16(unsigned w, int hi, unsigned lo) { unsigned r_; const unsigned k_ = 1024u;
    if (hi) asm("v_mad_u32_u16 %0, %1, %2, %3 op_sel:[1,0,0,0]" : "=v"(r_) : "v"(w), "s"(k_), "v"(lo)); else asm("v_mad_u32_u16 %0, %1, %2, %3" : "=v"(r_) : "v"(w), "s"(k_), "v"(lo));
    return r_; }
#define EOFFW(E0, E1, i) ((i) < 8 ? E0[((i) & 7) >> 1] : E1[((i) & 7) >> 1])
#define EOFF16(E0, E1, i, lo_) off16(EOFFW(E0, E1, i), (i) & 1, (unsigned)(lo_))

#define LDSRD(dst, addr, OFF) asm volatile("ds_read_b128 %0, %1 offset:" #OFF : "=v"(dst) : "v"(addr))
#define LDSPIN4(a, b, c, d) do { asm volatile("" : "+v"(a)); asm volatile("" : "+v"(b)); asm volatile("" : "+v"(c)); asm volatile("" : "+v"(d)); } while (0)

#define LDSRD32(dst, addr, OFF) asm volatile("ds_read_b32 %0, %1 offset:" #OFF : "=v"(dst) : "v"(addr))
#define LDSWR128(addr, v, OFF) asm volatile("ds_write_b128 %0, %1 offset:" #OFF :: "v"(addr), "v"(v))
#define LDSWR32(addr, v) asm volatile("ds_write_b32 %0, %1" :: "v"(addr), "v"(v))

template <int CTRL> __device__ __forceinline__ int dpp_i(int v) { return __builtin_amdgcn_update_dpp(0, v, CTRL, 0xf, 0xf, true); }
template <int CTRL> __device__ __forceinline__ float dpp_f(float v) { return __builtin_bit_cast(float, __builtin_amdgcn_update_dpp(0, __builtin_bit_cast(int, v), CTRL, 0xf, 0xf, true)); }
__device__ __forceinline__ float swap32_sum(float a, float b) {
    const auto r = __builtin_amdgcn_permlane32_swap(__builtin_bit_cast(unsigned, a), __builtin_bit_cast(unsigned, b), false, false);
    return __builtin_bit_cast(float, (unsigned)r[0]) + __builtin_bit_cast(float, (unsigned)r[1]); }
__device__ __forceinline__ float swap16_sum(float a, float b) {
    const auto r = __builtin_amdgcn_permlane16_swap(__builtin_bit_cast(unsigned, a), __builtin_bit_cast(unsigned, b), false, false);
    return __builtin_bit_cast(float, (unsigned)r[0]) + __builtin_bit_cast(float, (unsigned)r[1]); }

template <int PROBE>
__device__ __forceinline__ void p8_uphase(Frame& F) {
    const unsigned char* EIDb = F.ws + WS_EID; const bf16_t* X2B = (const bf16_t*)(F.ws + WS_X2B);
    const int lane = F.lane, r = lane >> 3, c = lane & 7;
    const __amdgpu_buffer_rsrc_t rs = __builtin_amdgcn_make_buffer_rsrc((void*)(F.ws + WS_U), 0, 16 << 20, 0x00020000);
    LAS unsigned char* wl = F.lds + F.wave * 16384;
    const unsigned wla = (unsigned)(size_t)wl, la = wla + (unsigned)r * 32u, qa = wla + 8192u + (unsigned)c * 16u, sa = wla + 8192u + 2048u;
    unsigned* ctr = (unsigned*)(F.ws + WS_CTL + CTL_Q_OFF);
    const unsigned x = (unsigned)__builtin_amdgcn_s_getreg((3 << 11) | 20) & 7u;
    auto dma_chunk = [&](int tile, int ch) {
        const size_t go = (size_t)tile * 4096 + (size_t)ch * 1024 + (size_t)lane * 16;
        const unsigned dst = __builtin_amdgcn_readfirstlane(wla + (unsigned)ch * 1024u);
        ASM_GLDS16(EIDb + go, dst);
    };
    const int lo = c * 16;
    for (int qi = 0; qi < 8; ++qi) {
        const int cg = (int)((x + (unsigned)qi) & 7u), so = cg * 128;
        float* HP = PROBE ? (float*)(F.ws + ((size_t)300 << 20)) : hpart_base(F.ws, cg);
        unsigned* cq = ctr + ((PROBE ? 2 : 0) * 8 + cg) * 64;
        auto act_load = [&](int tile, u32x4 (&xa)[4]) { const bf16_t* p = X2B + ((size_t)tile * 16 + (lane >> 2)) * 1024 + cg * 128 + (lane & 3) * 32;
#pragma unroll
            for (int j = 0; j < 4; ++j) xa[j] = __builtin_nontemporal_load((const u32x4*)(p + 8 * j)); };
        auto act_quant = [&](const u32x4 (&xa)[4], int par) {
            float hv[32];
#pragma unroll
            for (int j = 0; j < 4; ++j)
#pragma unroll
                for (int m = 0; m < 4; ++m) { hv[8 * j + 2 * m] = bf_lo(xa[j][m]); hv[8 * j + 2 * m + 1] = bf_hi(xa[j][m]); }
            float am = 0.f;
#pragma unroll
            for (int j = 0; j < 32; ++j) am = fmaxf(am, fabsf(hv[j]));
            am = fmaxf(am, __shfl_xor(am, 1)); am = fmaxf(am, __shfl_xor(am, 2));
            const float sh = am > 0.f ? am * (1.f / 127.f) : 1.f, ish = 1.f / sh;
            u32x4 qv[2];
#pragma unroll
            for (int m = 0; m < 8; ++m) { const int q0 = (int)__builtin_rintf(hv[4 * m] * ish), q1 = (int)__builtin_rintf(hv[4 * m + 1] * ish), q2 = (int)__builtin_rintf(hv[4 * m + 2] * ish), q3 = (int)__builtin_rintf(hv[4 * m + 3] * ish);
                qv[m >> 2][m & 3] = (unsigned)((q0 & 0xff) | ((q1 & 0xff) << 8) | ((q2 & 0xff) << 16) | (q3 << 24)); }
            const unsigned wa = wla + 8192u + (unsigned)par * 2304u + (unsigned)(lane >> 2) * 128u + (unsigned)(lane & 3) * 32u;
            LDSWR128(wa, qv[0], 0); LDSWR128(wa, qv[1], 16);
            if ((lane & 3) == 0) { const unsigned swa = sa + (unsigned)par * 2304u + (unsigned)(lane >> 2) * 4u; LDSWR32(swa, sh); }
        };
        unsigned tk = 0; if (lane == 0) tk = __hip_atomic_fetch_add(cq, 1u, __ATOMIC_RELAXED, __HIP_MEMORY_SCOPE_AGENT);
        int tile = __builtin_amdgcn_readfirstlane((int)tk);
        if (tile >= PEER_TILES) continue;
        if (lane == 0) tk = __hip_atomic_fetch_add(cq, 1u, __ATOMIC_RELAXED, __HIP_MEMORY_SCOPE_AGENT);
        int nxt = __builtin_amdgcn_readfirstlane((int)tk);
        if (lane == 0) tk = __hip_atomic_fetch_add(cq, 1u, __ATOMIC_RELAXED, __HIP_MEMORY_SCOPE_AGENT);
        dma_chunk(tile, 0); dma_chunk(tile, 1);
        u32x4 xa[4];
        act_load(tile, xa);
        int par = 0;
        act_quant(xa, 0);
        asm volatile("s_waitcnt vmcnt(0) lgkmcnt(0)" ::: "memory");
        u32x4 e0, e1, hq; float sh;
        LDSRD(e0, la, 0); LDSRD(e1, la, 16); LDSRD(hq, qa, 0); LDSRD32(sh, sa, 0);
        asm volatile("s_waitcnt lgkmcnt(0)" ::: "memory");
        asm volatile("" : "+v"(e0)); asm volatile("" : "+v"(e1)); asm volatile("" : "+v"(hq)); asm volatile("" : "+v"(sh));
        u32x4 d[8];
#pragma unroll
        for (int i = 0; i < 8; ++i) d[i] = __builtin_amdgcn_raw_buffer_load_b128(rs, (int)EOFF16(e0, e1, i, lo), so, 0);
        for (;;) {
            const bool has_next = nxt < PEER_TILES;
#pragma unroll 1
            for (int t = 0; t < 16; ++t) {
                const int tok = tile * 16 + t;
                if ((t & 3) == 0) { const int ch2 = (t >> 2) + 2; if (ch2 < 4) dma_chunk(tile, ch2); else if (has_next) dma_chunk(nxt, ch2 - 4); }
                if (has_next && t == 2) act_load(nxt, xa);
                if (has_next && t == 10) act_quant(xa, par ^ 1);
                const bool cross = (t == 15) && has_next;
                const int tn = (t < 15) ? t + 1 : (has_next ? 0 : 15);
                const unsigned pn = (unsigned)(cross ? (par ^ 1) : par) * 2304u;
                const unsigned ta = la + (unsigned)tn * 256u, tq = qa + pn + (unsigned)tn * 128u, ts = sa + pn + (unsigned)tn * 4u;
                u32x4 n0, n1, hqn; float shn;
                LDSRD(n0, ta, 0); LDSRD(n1, ta, 16); LDSRD(hqn, tq, 0); LDSRD32(shn, ts, 0);
                int p[16];
#define UDOT(i, nextoff) do { int a_ = 0; const u32x4 dd_ = d[(i) & 7]; \
                    a_ = __builtin_amdgcn_sdot4((int)dd_.x, (int)hq.x, a_, false); a_ = __builtin_amdgcn_sdot4((int)dd_.y, (int)hq.y, a_, false); a_ = __builtin_amdgcn_sdot4((int)dd_.z, (int)hq.z, a_, false); a_ = __builtin_amdgcn_sdot4((int)dd_.w, (int)hq.w, a_, false); \
                    asm volatile("" : "+v"(a_)); p[i] = a_; d[(i) & 7] = __builtin_amdgcn_raw_buffer_load_b128(rs, (int)(nextoff), so, 0); } while (0)
                UDOT(0, EOFF16(e0, e1, 8, lo)); UDOT(1, EOFF16(e0, e1, 9, lo)); UDOT(2, EOFF16(e0, e1, 10, lo)); UDOT(3, EOFF16(e0, e1, 11, lo));
                UDOT(4, EOFF16(e0, e1, 12, lo)); UDOT(5, EOFF16(e0, e1, 13, lo)); UDOT(6, EOFF16(e0, e1, 14, lo)); UDOT(7, EOFF16(e0, e1, 15, lo));
                asm volatile("s_waitcnt lgkmcnt(0)" ::: "memory");
                asm volatile("" : "+v"(n0)); asm volatile("" : "+v"(n1)); asm volatile("" : "+v"(hqn)); asm volatile("" : "+v"(shn));
                UDOT(8, EOFF16(n0, n1, 0, lo)); UDOT(9, EOFF16(n0, n1, 1, lo)); UDOT(10, EOFF16(n0, n1, 2, lo)); UDOT(11, EOFF16(n0, n1, 3, lo));
                UDOT(12, EOFF16(n0, n1, 4, lo)); UDOT(13, EOFF16(n0, n1, 5, lo)); UDOT(14, EOFF16(n0, n1, 6, lo)); UDOT(15, EOFF16(n0, n1, 7, lo));
#undef UDOT
                int q8[8], q4[4], q2[2];
                { const bool b = (c & 4) != 0;
#pragma unroll
                  for (int j = 0; j < 8; ++j) { const int A = p[j] + dpp_i<0x141>(p[j]), B = p[8 + j] + dpp_i<0x141>(p[8 + j]); q8[j] = b ? B : A; } }
                { const bool b = (c & 2) != 0;
#pragma unroll
                  for (int j = 0; j < 4; ++j) { const int A = q8[j] + dpp_i<0x4E>(q8[j]), B = q8[4 + j] + dpp_i<0x4E>(q8[4 + j]); q4[j] = b ? B : A; } }
                { const bool b = (c & 1) != 0;
#pragma unroll
                  for (int j = 0; j < 2; ++j) { const int A = q4[j] + dpp_i<0xB1>(q4[j]), B = q4[2 + j] + dpp_i<0xB1>(q4[2 + j]); q2[j] = b ? B : A; } }
                *(unsigned*)((bf16_t*)HP + (size_t)tok * 128 + 2 * lane) = cvtpk((float)q2[0] * sh, (float)q2[1] * sh);
                e0 = n0; e1 = n1; hq = hqn; sh = shn;
            }
            if (!has_next) break;
            tile = nxt; nxt = __builtin_amdgcn_readfirstlane((int)tk); par ^= 1;
            if (lane == 0) tk = __hip_atomic_fetch_add(cq, 1u, __ATOMIC_RELAXED, __HIP_MEMORY_SCOPE_AGENT);
        }
    }
}

__device__ __forceinline__ void p8b_combine(Frame& F) {
    float* GATE = (float*)(F.ws + WS_GATE); const float* SSQ2 = (const float*)(F.ws + WS_SSQ2); const unsigned* EID = (const unsigned*)(F.ws + WS_EID); const float* USC = (const float*)(F.ws + WS_USCALE);
    const int gt = F.vcu * 512 + F.tid, NT = F.G * 512;
    constexpr int UB = 4;
    for (int i0 = gt; i0 < M * 32; i0 += UB * NT) {
        u32x2 e2_[UB]; f32x4 gt4[UB], s0[UB], s1[UB], s2[UB], s3[UB]; u32x2 hb[UB][8]; float us[UB][4];
#pragma unroll
        for (int q = 0; q < UB; ++q) { const int i = (i0 + q * NT < M * 32) ? i0 + q * NT : i0; e2_[q] = *(const u32x2*)((const unsigned short*)EID + (size_t)i * 4); }
#pragma unroll
        for (int q = 0; q < UB; ++q) { const int i = (i0 + q * NT < M * 32) ? i0 + q * NT : i0; const int tok = i >> 5;
            const f32x4* sp = (const f32x4*)(SSQ2 + (size_t)tok * 16); s0[q] = sp[0]; s1[q] = sp[1]; s2[q] = sp[2]; s3[q] = sp[3];
            gt4[q] = *(const f32x4*)(GATE + (size_t)i * 4);
#pragma unroll
            for (int g2 = 0; g2 < 8; ++g2) hb[q][g2] = *(const u32x2*)((const bf16_t*)hpart_base(F.ws, g2) + (size_t)i * 4); }
#pragma unroll
        for (int q = 0; q < UB; ++q) { us[q][0] = USC[e2_[q].x & 0xffffu]; us[q][1] = USC[e2_[q].x >> 16]; us[q][2] = USC[e2_[q].y & 0xffffu]; us[q][3] = USC[e2_[q].y >> 16]; }
#pragma unroll
        for (int q = 0; q < UB; ++q) { const int i = i0 + q * NT; if (i >= M * 32) break;
            const float ssq = ((s0[q].x + s0[q].y) + (s0[q].z + s0[q].w)) + ((s1[q].x + s1[q].y) + (s1[q].z + s1[q].w)) + ((s2[q].x + s2[q].y) + (s2[q].z + s2[q].w)) + ((s3[q].x + s3[q].y) + (s3[q].z + s3[q].w));
            const float rsu = rsqrtf(ssq * (1.f / 1024.f) + NORM_EPS);
            f32x4 h = {0.f, 0.f, 0.f, 0.f};
#pragma unroll
            for (int g2 = 0; g2 < 8; ++g2) h = h + (f32x4){bf_lo(hb[q][g2].x), bf_hi(hb[q][g2].x), bf_lo(hb[q][g2].y), bf_hi(hb[q][g2].y)};
            f32x4 o; o.x = gelu_erf(h.x * rsu * us[q][0]) * gt4[q].x; o.y = gelu_erf(h.y * rsu * us[q][1]) * gt4[q].y; o.z = gelu_erf(h.z * rsu * us[q][2]) * gt4[q].z; o.w = gelu_erf(h.w * rsu * us[q][3]) * gt4[q].w;
            { typedef _Float16 h4_t __attribute__((ext_vector_type(4))); const h4_t oh = {(_Float16)o.x, (_Float16)o.y, (_Float16)o.z, (_Float16)o.w}; *(u32x2*)(F.ws + WS_CF16 + (size_t)i * 8) = __builtin_bit_cast(u32x2, oh); }
        }
    }
}

template <int PROBE>
__device__ __forceinline__ void p9_vphase(Frame& F) {
    const unsigned char* EIDb = F.ws + WS_EID; const unsigned char* CFb = F.ws + WS_CF16;
    const bf16_t* X2B = (const bf16_t*)(F.ws + WS_X2B);
    const int lane = F.lane, r = lane >> 3, c = lane & 7;
    const __amdgpu_buffer_rsrc_t rs = __builtin_amdgcn_make_buffer_rsrc((void*)(F.ws + WS_V), 0, 16 << 20, 0x00020000);
    LAS unsigned char* wl = F.lds + F.wave * 16384;
    const unsigned wla = (unsigned)(size_t)wl, la = wla + (unsigned)r * 32u, lc = wla + 1024u + (unsigned)r * 32u;
    unsigned* ctr = (unsigned*)(F.ws + WS_CTL + CTL_Q_OFF);
    const unsigned x = (unsigned)__builtin_amdgcn_s_getreg((3 << 11) | 20) & 7u;
    auto dma_chunk = [&](int tile, int ch) {
        const size_t gc = (size_t)tile * 4096 + (size_t)ch * 1024 + (size_t)lane * 16;
        const unsigned dst = __builtin_amdgcn_readfirstlane(wla + (unsigned)ch * 2048u);
        ASM_GLDS16(EIDb + gc, dst); ASM_GLDS16(CFb + gc, dst + 1024u);
    };
    const int lo = c * 16;
    for (int qi = 0; qi < 8; ++qi) {
        const int cg = (int)((x + (unsigned)qi) & 7u), so = cg * 128;
        unsigned* cq = ctr + ((PROBE ? 3 : 1) * 8 + cg) * 64;
        unsigned tk = 0; if (lane == 0) tk = __hip_atomic_fetch_add(cq, 1u, __ATOMIC_RELAXED, __HIP_MEMORY_SCOPE_AGENT);
        int tile = __builtin_amdgcn_readfirstlane((int)tk);
        if (tile >= PEER_TILES) continue;
        if (lane == 0) tk = __hip_atomic_fetch_add(cq, 1u, __ATOMIC_RELAXED, __HIP_MEMORY_SCOPE_AGENT);
        int nxt = __builtin_amdgcn_readfirstlane((int)tk);
        if (lane == 0) tk = __hip_atomic_fetch_add(cq, 1u, __ATOMIC_RELAXED, __HIP_MEMORY_SCOPE_AGENT);
        dma_chunk(tile, 0); dma_chunk(tile, 1);
        asm volatile("s_waitcnt vmcnt(0)" ::: "memory");
        u32x4 e0, e1, c0, c1;
        LDSRD(e0, la, 0); LDSRD(e1, la, 16); LDSRD(c0, lc, 0); LDSRD(c1, lc, 16);
        asm volatile("s_waitcnt lgkmcnt(0)" ::: "memory");
        asm volatile("" : "+v"(e0)); asm volatile("" : "+v"(e1)); asm volatile("" : "+v"(c0)); asm volatile("" : "+v"(c1));
        u32x4 d[16];
#pragma unroll
        for (int i = 0; i < 16; ++i) d[i] = __builtin_amdgcn_raw_buffer_load_b128(rs, (int)EOFF16(e0, e1, i, lo), so, 0);
        LDSRD(e0, la, 256); LDSRD(e1, la, 272);
        asm volatile("s_waitcnt lgkmcnt(0)" ::: "memory");
        asm volatile("" : "+v"(e0)); asm volatile("" : "+v"(e1));
        for (;;) {
            const bool has_next = nxt < PEER_TILES;
#pragma unroll 1
            for (int t = 0; t < 16; ++t) {
                const int tok = tile * 16 + t;
                if ((t & 3) == 0) { const int ch2 = (t >> 2) + 2; if (ch2 < 4) dma_chunk(tile, ch2); else if (has_next) dma_chunk(nxt, ch2 - 4); }
                const int t1 = (t < 15) ? t + 1 : (has_next ? 0 : 15), t2 = (t < 14) ? t + 2 : (has_next ? t - 14 : 15);
                const unsigned ta = la + (unsigned)(t2 >> 2) * 2048u + (unsigned)((t2 & 3) << 8), tc = lc + (unsigned)(t1 >> 2) * 2048u + (unsigned)((t1 & 3) << 8);
                u32x4 n0, n1, c0n, c1n;
                LDSRD(n0, ta, 0); LDSRD(n1, ta, 16); LDSRD(c0n, tc, 0); LDSRD(c1n, tc, 16);
                const size_t off = (size_t)tok * 1024 + cg * 128 + c * 16 + 2 * r;
                h2_t yh[8];
#pragma unroll
                for (int m = 0; m < 8; ++m) yh[m] = (h2_t){(_Float16)0.f, (_Float16)0.f};
#define VAXPY(i, cword, nextoff) do { h2_t vv[8]; if (PROBE == 2) { _Pragma("unroll") for (int m_ = 0; m_ < 4; ++m_) { vv[2 * m_] = __builtin_bit_cast(h2_t, d[i][m_] & 0x3c003c00u); vv[2 * m_ + 1] = __builtin_bit_cast(h2_t, (d[i][m_] >> 2) & 0x3c003c00u); } } else fp8x16_to_h2(d[i], vv); const _Float16 ch_ = __builtin_bit_cast(h2_t, (unsigned)(cword))[(i) & 1]; const h2_t c2_ = {ch_, ch_}; \
                    _Pragma("unroll") for (int m = 0; m < 8; ++m) yh[m] = __builtin_elementwise_fma(vv[m], c2_, yh[m]); \
                    _Pragma("unroll") for (int m = 0; m < 8; ++m) asm volatile("" : "+v"(yh[m])); \
                    d[i] = __builtin_amdgcn_raw_buffer_load_b128(rs, (int)(nextoff), so, 0); } while (0)
                VAXPY(0, c0.x, EOFF16(e0, e1, 0, lo)); VAXPY(1, c0.x, EOFF16(e0, e1, 1, lo)); VAXPY(2, c0.y, EOFF16(e0, e1, 2, lo)); VAXPY(3, c0.y, EOFF16(e0, e1, 3, lo));
                VAXPY(4, c0.z, EOFF16(e0, e1, 4, lo)); VAXPY(5, c0.z, EOFF16(e0, e1, 5, lo)); VAXPY(6, c0.w, EOFF16(e0, e1, 6, lo)); VAXPY(7, c0.w, EOFF16(e0, e1, 7, lo));
                VAXPY(8, c1.x, EOFF16(e0, e1, 8, lo)); VAXPY(9, c1.x, EOFF16(e0, e1, 9, lo)); VAXPY(10, c1.y, EOFF16(e0, e1, 10, lo)); VAXPY(11, c1.y, EOFF16(e0, e1, 11, lo));
                VAXPY(12, c1.z, EOFF16(e0, e1, 12, lo)); VAXPY(13, c1.z, EOFF16(e0, e1, 13, lo)); VAXPY(14, c1.w, EOFF16(e0, e1, 14, lo)); VAXPY(15, c1.w, EOFF16(e0, e1, 15, lo));
#undef VAXPY
                asm volatile("s_waitcnt lgkmcnt(0)" ::: "memory");
                asm volatile("" : "+v"(n0)); asm volatile("" : "+v"(n1)); asm volatile("" : "+v"(c0n)); asm volatile("" : "+v"(c1n));
                e0 = n0; e1 = n1; c0 = c0n; c1 = c1n;
                unsigned y8[8], q4[4], q2[2], q1;
#pragma unroll
                for (int m = 0; m < 8; ++m) y8[m] = __builtin_bit_cast(unsigned, yh[m]);
                auto hadd = [](unsigned a, unsigned b) { return __builtin_bit_cast(unsigned, __builtin_bit_cast(h2_t, a) + __builtin_bit_cast(h2_t, b)); };
#pragma unroll
                for (int j = 0; j < 4; ++j) { const auto rr = __builtin_amdgcn_permlane32_swap(y8[j], y8[4 + j], false, false); q4[j] = hadd((unsigned)rr[0], (unsigned)rr[1]); }
#pragma unroll
                for (int j = 0; j < 2; ++j) { const auto rr = __builtin_amdgcn_permlane16_swap(q4[j], q4[2 + j], false, false); q2[j] = hadd((unsigned)rr[0], (unsigned)rr[1]); }
                { const unsigned A = hadd(q2[0], (unsigned)dpp_i<0x128>((int)q2[0])), B = hadd(q2[1], (unsigned)dpp_i<0x128>((int)q2[1])); q1 = (r & 1) ? B : A; }
                const h2_t qh = __builtin_bit_cast(h2_t, q1);
                const float o0 = (float)qh[0] * (1.f / V8_SCALE), o1 = (float)qh[1] * (1.f / V8_SCALE);
                *(unsigned*)((bf16_t*)(F.ws + (PROBE ? ((size_t)300 << 20) : WS_X3B)) + off) = cvtpk(o0, o1);
            }
            if (!has_next) break;
            tile = nxt; nxt = __builtin_amdgcn_readfirstlane((int)tk);
            if (lane == 0) tk = __hip_atomic_fetch_add(cq, 1u, __ATOMIC_RELAXED, __HIP_MEMORY_SCOPE_AGENT);
        }
    }
}

__device__ __forceinline__ void p10_final(Frame& F) {
    const float* gfin = F.in[14]; const bf16_t* X3B = (const bf16_t*)(F.ws + WS_X3B);
    const int gw = F.vcu * 8 + F.wave, NGW = F.G * 8, lane = (int)__builtin_amdgcn_mbcnt_hi(~0u, __builtin_amdgcn_mbcnt_lo(~0u, 0u));
    f32x4 g[4];
#pragma unroll
    for (int j = 0; j < 4; ++j) g[j] = *(const f32x4*)(gfin + 256 * j + 4 * lane);
    for (int tok = gw; tok < M; tok += NGW) {
        const bf16_t* xr = X3B + (size_t)tok * 1024; const bf16_t* x2r = (const bf16_t*)(F.ws + WS_X2B) + (size_t)tok * 1024; float* orow = F.out + (size_t)tok * 1024;
        f32x4 v[4]; float ss = 0.f;
#pragma unroll
        for (int j = 0; j < 4; ++j) { const u32x2 p = __builtin_nontemporal_load((const u32x2*)(xr + 256 * j + 4 * lane)), q = __builtin_nontemporal_load((const u32x2*)(x2r + 256 * j + 4 * lane));
            v[j] = (f32x4){bf_lo(p.x) + bf_lo(q.x), bf_hi(p.x) + bf_hi(q.x), bf_lo(p.y) + bf_lo(q.y), bf_hi(p.y) + bf_hi(q.y)}; }
#pragma unroll
        for (int j = 0; j < 4; ++j) ss += (v[j].x * v[j].x + v[j].y * v[j].y) + (v[j].z * v[j].z + v[j].w * v[j].w);
        const float rs = rsqrtf(wave_sum(ss) * (1.f / 1024.f) + NORM_EPS);
#pragma unroll
        for (int j = 0; j < 4; ++j) __builtin_nontemporal_store(v[j] * rs * g[j], (f32x4*)(orow + 256 * j + 4 * lane));
    }
}
constexpr int LDS_BYTES = 147456;
constexpr int NPHASE = 12;


#define XB_TMO      128
#define XB_XCNT(j)  (256  + 64 * (j))
#define XB_XSUB(j)  (1280 + 64 * (j))
#define XB_XGEN(j)  (2304 + 64 * (j))
#define XB_TOP      3328
#define XB_TOPGEN   3392
#define XCD_BAR_WORDS 3456
#define XB_SPIN_CAP (1u << 22)
__device__ __forceinline__ unsigned xb_ld(unsigned* p)              { return __hip_atomic_load(p, __ATOMIC_RELAXED, __HIP_MEMORY_SCOPE_AGENT); }
__device__ __forceinline__ unsigned xb_add(unsigned* p, unsigned v) { return __hip_atomic_fetch_add(p, v, __ATOMIC_RELAXED, __HIP_MEMORY_SCOPE_AGENT); }
__device__ __forceinline__ unsigned xb_xcc_id() { return (unsigned)__builtin_amdgcn_s_getreg((3 << 11) | 20) & 0xFu; }
#define XB_SPIN(cond, bar) do { unsigned _sp = 0; while (cond) { __builtin_amdgcn_s_sleep(1); \
    if ((++_sp & 255u) == 0u) { if (xb_ld(&(bar)[XB_TMO])) break; if (_sp > XB_SPIN_CAP) { atomicAdd(&(bar)[XB_TMO], 1u); break; } } } } while (0)
struct XcdBarrier { unsigned* bar; unsigned x; volatile LAS unsigned* st; };
__device__ __forceinline__ XcdBarrier xcd_barrier_post(unsigned* bar, volatile LAS unsigned* st, int tid) {
    XcdBarrier b; b.bar = bar; b.x = xb_xcc_id(); b.st = st;
    if (tid == 0) (void)xb_add(&bar[XB_XCNT(b.x)], 1u);
    return b;
}
__device__ __forceinline__ void xcd_barrier_complete(unsigned* bar, unsigned x, unsigned& nloc, unsigned& nx) {
    const unsigned G = gridDim.x * gridDim.y * gridDim.z;
    unsigned sum, cnt, mine, sp = 0u;
    for (;;) {
        sum = 0u; cnt = 0u; mine = 0u;
#pragma unroll
        for (unsigned j = 0; j < 16; ++j) { const unsigned c = xb_ld(&bar[XB_XCNT(j)]); sum += c; cnt += (c > 0u) ? 1u : 0u; mine = (j == x) ? c : mine; }
        if (sum == G) break;
        __builtin_amdgcn_s_sleep(1);
        if ((++sp & 255u) == 0u) { if (xb_ld(&bar[XB_TMO])) break; if (sp > XB_SPIN_CAP) { atomicAdd(&bar[XB_TMO], 1u); break; } }
    }
    nloc = mine > 0u ? mine : 1u; nx = cnt > 0u ? cnt : 1u;
}
__device__ __forceinline__ void xcd_barrier(const XcdBarrier& b, int tid) {
    asm volatile("s_waitcnt vmcnt(0)" ::: "memory");
    __syncthreads();
    if (tid == 0) {
        unsigned* bar = b.bar;
        __builtin_amdgcn_s_waitcnt(0);
        unsigned nloc = b.st[0], nx = b.st[1];
        if (nloc == 0u) { xcd_barrier_complete(bar, b.x, nloc, nx); b.st[0] = nloc; b.st[1] = nx; }
        const unsigned old = xb_add(&bar[XB_XSUB(b.x)], 1u);
        const unsigned gen = old / nloc;
        if (old + 1u == (gen + 1u) * nloc) {
            __builtin_amdgcn_fence(__ATOMIC_RELEASE, "agent");
            asm volatile("s_waitcnt vmcnt(0)" ::: "memory");
            const unsigned og = xb_add(&bar[XB_TOP], 1u);
            const unsigned tg = og / nx;
            if (og + 1u == (tg + 1u) * nx) xb_add(&bar[XB_TOPGEN], 1u);
            else XB_SPIN(xb_ld(&bar[XB_TOPGEN]) == tg, bar);
            __builtin_amdgcn_fence(__ATOMIC_ACQUIRE, "agent");
            xb_add(&bar[XB_XGEN(b.x)], 1u);
            asm volatile("s_waitcnt vmcnt(0)" ::: "memory");
        } else {
            XB_SPIN(xb_ld(&bar[XB_XGEN(b.x)]) == gen, bar);
            __builtin_amdgcn_fence(__ATOMIC_ACQUIRE, "agent");
            asm volatile("s_waitcnt vmcnt(0)" ::: "memory");
        }
    }
    __syncthreads();
}
constexpr size_t CTL_PAIR_OFF = 32768;
__device__ __forceinline__ void pair_sync(unsigned* flag, const unsigned* partner_xcc, int tid) {
    asm volatile("s_waitcnt vmcnt(0)" ::: "memory");
    __syncthreads();
    if (tid == 0) {
        const bool same = xb_ld((unsigned*)partner_xcc) == 1u + xb_xcc_id();
        if (!same) __builtin_amdgcn_fence(__ATOMIC_RELEASE, "agent");
        (void)xb_add(flag, 1u);
        unsigned sp = 0u; while (xb_ld(flag) < 2u) { __builtin_amdgcn_s_sleep(1); if (++sp > XB_SPIN_CAP) break; }
        if (!same) __builtin_amdgcn_fence(__ATOMIC_ACQUIRE, "agent");
    }
    __syncthreads();
}
__device__ __forceinline__ void self_sync(int tid) {
    asm volatile("s_waitcnt vmcnt(0)" ::: "memory");
    __syncthreads();
}
constexpr size_t CTL_RDY_OFF = 40960;
__device__ __forceinline__ void ready_arrive(unsigned* cnt, int tid) {
    asm volatile("s_waitcnt vmcnt(0)" ::: "memory");
    __syncthreads();
    if (tid == 0) { __builtin_amdgcn_fence(__ATOMIC_RELEASE, "agent"); (void)xb_add(cnt, 1u); }
}
__device__ __forceinline__ void ready_wait(unsigned* cnt, unsigned target, int tid) {
    if (tid == 0) { unsigned sp = 0u; while (xb_ld(cnt) < target) { __builtin_amdgcn_s_sleep(1); if (++sp > XB_SPIN_CAP) break; }
        __builtin_amdgcn_fence(__ATOMIC_ACQUIRE, "agent"); }
    __syncthreads();
}
constexpr size_t CTL_XCC_OFF = 49152;
constexpr size_t CTL_GRPB_OFF = 41984;
__device__ __forceinline__ void group_barrier(unsigned* cnt, const unsigned* xcc_grp, int tid) {
    asm volatile("s_waitcnt vmcnt(0)" ::: "memory");
    __syncthreads();
    if (tid == 0) {
        const unsigned me = 1u + xb_xcc_id(); unsigned same = 1u;
#pragma unroll 8
        for (int j = 0; j < 32; ++j) same &= (xb_ld((unsigned*)xcc_grp + j) == me) ? 1u : 0u;
        if (!same) __builtin_amdgcn_fence(__ATOMIC_RELEASE, "agent");
        (void)xb_add(cnt, 1u);
        unsigned sp = 0u; while (xb_ld(cnt) < 32u) { __builtin_amdgcn_s_sleep(1); if (++sp > XB_SPIN_CAP) break; }
        if (!same) __builtin_amdgcn_fence(__ATOMIC_ACQUIRE, "agent");
    }
    __syncthreads();
}
constexpr int MISC_OFF = 131072 + 8192;
constexpr size_t CTL_BAR_OFF = 16384;
constexpr size_t CTL_ZERO_BYTES = 65536;

__global__ void __launch_bounds__(512, 2) fwd_kernel(Args args) {
    extern __shared__ __attribute__((aligned(16))) unsigned char lds_raw[];
    Frame F;
    F.lds = (LAS unsigned char*)lds_raw;
    F.tid = threadIdx.x; F.lane = F.tid & 63; F.wave = __builtin_amdgcn_readfirstlane(F.tid >> 6);
    F.G = gridDim.x; { const int bx = blockIdx.x; F.vcu = (F.G % 8 == 0) ? (bx % 8) * (F.G / 8) + bx / 8 : bx; }
#pragma unroll
    for (int i = 0; i < 15; ++i) F.in[i] = args.in[i];
    F.out = args.out; F.ws = args.ws;
    unsigned char* ws = args.ws;
    const int lo = args.ph_lo, hi = args.ph_hi;
#if ONE_LAUNCH
    volatile LAS unsigned* MISC = (volatile LAS unsigned*)(F.lds + MISC_OFF);
    if (F.tid < 16) MISC[F.tid] = 0u;
    __syncthreads();
    XcdBarrier bar = xcd_barrier_post((unsigned*)(ws + WS_CTL + CTL_BAR_OFF), MISC + 8, F.tid);
    if (F.tid == 0) __hip_atomic_store((unsigned*)(ws + WS_CTL + CTL_XCC_OFF) + F.vcu, 1u + xb_xcc_id(), __ATOMIC_RELAXED, __HIP_MEMORY_SCOPE_AGENT);
#define SEAM(k) do { if (lo <= (k) && (k) + 1 < hi) xcd_barrier(bar, F.tid); } while (0)
#else
#define SEAM(k) do { } while (0)
#endif
#define IN(k) (lo <= (k) && (k) < hi)
#define RELANE() do { int l_; asm volatile("v_mbcnt_lo_u32_b32 %0, -1, 0\n\tv_mbcnt_hi_u32_b32 %0, -1, %0" : "=v"(l_)); F.lane = l_; } while (0)
#if TIME_PHASE >= 0
    unsigned long long tp0 = 0, tp1 = 0;
#define TSTAMP(k) do { if ((k) == TIME_PHASE) tp0 = __builtin_amdgcn_s_memrealtime(); if ((k) == TIME_PHASE + 1) tp1 = __builtin_amdgcn_s_memrealtime(); } while (0)
#else
#define TSTAMP(k) do { } while (0)
#endif
    TSTAMP(0);
#define rc_pm (F.vcu >> 1)
#define rc_half (F.vcu & 1)
#define pairw ((unsigned*)(args.ws + WS_CTL + CTL_PAIR_OFF) + rc_pm * 16)
#define pxcc ((const unsigned*)(args.ws + WS_CTL + CTL_XCC_OFF) + (F.vcu ^ 1))
    if (IN(0)) {
        p0_prologue(F);
        if (ONE_LAUNCH) ready_arrive((unsigned*)(ws + WS_CTL + CTL_RDY_OFF), F.tid);
        p0_rows(F);
        if (ONE_LAUNCH) { pair_sync(pairw + 1, pxcc, F.tid); ready_wait((unsigned*)(ws + WS_CTL + CTL_RDY_OFF), (unsigned)F.G, F.tid); }
    }
    TSTAMP(1);
    if (IN(1)) {
        GemmPlain g{(const bf16_t*)(ws + WS_XN), (const bf16_t*)(ws + WS_WIN), 1024, 1024, 1024};
        pg8::RowRun S_{rc_pm, rc_half * 4, 4};
        const float* CA = (const float*)(ws + WS_ROPE);
        EpiP1 E{(bf16_t*)(ws + WS_QA), (bf16_t*)(ws + WS_KA), (bf16_t*)(ws + WS_VA), (bf16_t*)(ws + WS_CQ), (bf16_t*)(ws + WS_CKV), (float*)(ws + WS_SSQ1), CA, CA + 4096 * 32};
        pg8::gemm_phase<EpiP1, pg8::RowRun, GemmPlain>(F.lds, g, S_, E, F.wave);
        p1_krope(F);
        if (ONE_LAUNCH) pair_sync(pairw + 2, pxcc, F.tid);
    }
    TSTAMP(2);
    if (IN(2)) {
        GemmUp g{(const bf16_t*)(ws + WS_CQ), (const bf16_t*)(ws + WS_CKV), (const bf16_t*)(ws + WS_WUQ), (const bf16_t*)(ws + WS_WUKV), 256, 256, 256};
        pg8::RowRun S_{rc_pm, rc_half ? 4 : 0, rc_half ? 3 : 4};
        const float* CB = (const float*)(ws + WS_ROPE) + 2 * 4096 * 32;
        EpiP2 E{(bf16_t*)(ws + WS_QB), (bf16_t*)(ws + WS_KN), (bf16_t*)(ws + WS_VB), (const float*)(ws + WS_SSQ1), CB, CB + 4096 * 16};
        pg8::gemm_phase<EpiP2, pg8::RowRun, GemmUp>(F.lds, g, S_, E, F.wave);
        if (ONE_LAUNCH) group_barrier((unsigned*)(ws + WS_CTL + CTL_GRPB_OFF) + (F.vcu >> 5) * 16, (const unsigned*)(ws + WS_CTL + CTL_XCC_OFF) + (F.vcu & ~31), F.tid);
    }
    TSTAMP(3);
    if (IN(3)) { p3a_dilated(F);
        { int l_; asm volatile("v_mbcnt_lo_u32_b32 %0, -1, 0\n\tv_mbcnt_hi_u32_b32 %0, -1, %0" : "=v"(l_)); F.lane = l_; F.tid = F.wave * 64 + l_; }
        if (ONE_LAUNCH) group_barrier((unsigned*)(ws + WS_CTL + CTL_GRPB_OFF) + (8 + (F.vcu >> 5)) * 16, (const unsigned*)(ws + WS_CTL + CTL_XCC_OFF) + (F.vcu & ~31), F.tid); }
    TSTAMP(4);
    if (IN(4)) { p3b_mla(F);
        { int l_; asm volatile("v_mbcnt_lo_u32_b32 %0, -1, 0\n\tv_mbcnt_hi_u32_b32 %0, -1, %0" : "=v"(l_)); F.lane = l_; F.tid = F.wave * 64 + l_; }
        SEAM(4); }
    TSTAMP(5);
    if (IN(5)) {
        GemmPlain g{(const bf16_t*)(ws + WS_MIX), (const bf16_t*)(ws + WS_WO), 1024, 1024, 1024};
        EpiP4 E{(const bf16_t*)(ws + WS_XN), (const float*)(ws + WS_RSX), F.in[1], (bf16_t*)(ws + WS_X2B), (float*)(ws + WS_SSQ2)};
        pg8::RowRun S_{rc_pm, rc_half * 2, 2}; pg8::gemm_phase<EpiP4, pg8::RowRun, GemmPlain>(F.lds, g, S_, E, F.wave);
        pair_sync(pairw, pxcc, F.tid);
    }
    TSTAMP(6);
    if (IN(6)) {
        GemmPlain g{(const bf16_t*)(ws + WS_X2B), (const bf16_t*)(ws + WS_WQ), 1024, 1024, 1024};
        EpiP5 E{(bf16_t*)F.out, (const float*)(ws + WS_SSQ2)};
        pg8::RowRun S_{rc_pm, rc_half * 4, 4}; pg8::gemm_phase<EpiP5, pg8::RowRun, GemmPlain>(F.lds, g, S_, E, F.wave);
        self_sync(F.tid);
    }
    TSTAMP(7);
    if (IN(7)) { p7_select_range<4>(F, rc_pm * 256, rc_half * 4, F.vcu * 8 + F.wave); SEAM(7); }
    TSTAMP(8);
    { int l_; asm volatile("v_mbcnt_lo_u32_b32 %0, -1, 0\n\tv_mbcnt_hi_u32_b32 %0, -1, %0" : "=v"(l_)); F.lane = l_; F.tid = F.wave * 64 + l_; }
    if (IN(8)) { p8_uphase<0>(F); SEAM(8); }
#if PROBE_GATHER
    if (IN(8)) { p8_uphase<PROBE_GATHER>(F); SEAM(8); }
#endif
    TSTAMP(9);
    if (IN(9)) { p8b_combine(F); SEAM(9); }
    TSTAMP(10);
    if (IN(10)) { p9_vphase<0>(F); SEAM(10); }
#if PROBE_GATHER >= 4
    if (IN(10)) { p9_vphase<PROBE_GATHER - 3>(F); SEAM(10); }
#endif
    TSTAMP(11);
    if (IN(11)) { p10_final(F); }
    TSTAMP(12);
#if TIME_PHASE >= 0
    if (blockIdx.x == 0 && F.tid == 0) { const unsigned long long dt = tp1 - tp0, t_end = __builtin_amdgcn_s_memrealtime(); while (__builtin_amdgcn_s_memrealtime() - t_end < 8ull * dt) __builtin_amdgcn_s_sleep(8); }
#endif
#undef IN
#undef SEAM
}
#if DEBUG_CMP
namespace dbg {
__device__ __forceinline__ int colmap(int c, int mode) {
    if (mode == 1) { const int hb = c & ~63, p = c & 63; return hb + (p >> 1) + ((p & 1) << 5); }
    if (mode == 2) { return (c >> 1) + ((c & 1) << 4); }
    if (mode == 3) { const int h = c / 96, p = c % 96; if (p < 64) return c; const int q = p - 64; return h * 96 + 64 + (q >> 1) + ((q & 1) << 4); }
    return c;
}
template <class T> __device__ __forceinline__ float ldv(const T* p);
template <> __device__ __forceinline__ float ldv<float>(const float* p) { return *p; }
template <> __device__ __forceinline__ float ldv<bf16_t>(const bf16_t* p) { return __builtin_bit_cast(float, (unsigned)(*p) << 16); }
template <class T>
__global__ void cmp_k(const T* opt, int ld_opt, const float* ref, int ld_ref, int rows, int cols, float scale, int mode, unsigned* err, int stage) {
    const size_t n = (size_t)rows * cols; float md = 0.f, mr = 0.f;
    for (size_t i = (size_t)blockIdx.x * blockDim.x + threadIdx.x; i < n; i += (size_t)gridDim.x * blockDim.x) {
        const int r = (int)(i / cols), c = (int)(i % cols);
        const float o = ldv<T>(opt + (size_t)r * ld_opt + c) * scale, rf = ref[(size_t)r * ld_ref + colmap(c, mode)];
        float d = fabsf(o - rf); if (!(d == d)) d = 1.0e30f;
        md = fmaxf(md, d); mr = fmaxf(mr, fabsf(rf));
    }
    for (int o = 32; o > 0; o >>= 1) { md = fmaxf(md, __shfl_xor(md, o)); mr = fmaxf(mr, __shfl_xor(mr, o)); }
    if ((threadIdx.x & 63) == 0) { atomicMax(err + 2 * stage, __float_as_uint(md)); atomicMax(err + 2 * stage + 1, __float_as_uint(mr)); }
}
__global__ void encode_k(float* out, const unsigned* err, int nstage, int sel, float thr) {
    float eps2 = 0.f;
    if (sel >= 0) { const float e = __uint_as_float(err[2 * sel]) / fmaxf(__uint_as_float(err[2 * sel + 1]), 1e-30f); eps2 = fminf(fmaxf(e, 1e-4f), 0.9f); }
    else for (int k = 0; k < nstage; ++k) { const float e = __uint_as_float(err[2 * k]) / fmaxf(__uint_as_float(err[2 * k + 1]), 1e-30f);
        if (!(e < thr)) { eps2 = exp2f(-(float)(k + 1)) * (1.f + 0.9f * fminf(e, 1.f)); break; } }
    const float sc = 1.f + sqrtf(eps2);
    const size_t i = ((size_t)blockIdx.x * blockDim.x + threadIdx.x) * 4; f32x4 v = *(f32x4*)(out + i); v = v * sc; *(f32x4*)(out + i) = v;
}
}
#endif

static void launch_phases(const Args& base, int lo, int hi, int grid, hipStream_t stream) {
    Args a = base; a.ph_lo = lo; a.ph_hi = hi;
#if ONE_LAUNCH
    void* kargs[] = {(void*)&a};
    hipError_t e = hipLaunchCooperativeKernel((const void*)fwd_kernel, dim3(grid), dim3(512), kargs, LDS_BYTES, stream);
    if (e != hipSuccess) fprintf(stderr, "cooperative launch failed: %s (grid %d)\n", hipGetErrorString(e), grid);
#else
    hipLaunchKernelGGL(fwd_kernel, dim3(grid), dim3(512), LDS_BYTES, stream, a);
#endif
}

extern "C" void kernel_launch(void* const* d_in, const int* in_sizes, int n_in, void* d_out, int out_size, void* d_ws, size_t ws_size, hipStream_t stream) {
    static int grid = 0;
    if (grid == 0) {
        int dev = 0, cus = 0, per_cu = 0;
        hipGetDevice(&dev); hipDeviceGetAttribute(&cus, hipDeviceAttributeMultiprocessorCount, dev);
        hipFuncSetAttribute((const void*)fwd_kernel, hipFuncAttributeMaxDynamicSharedMemorySize, LDS_BYTES);
        hipOccupancyMaxActiveBlocksPerMultiprocessor(&per_cu, (const void*)fwd_kernel, 512, LDS_BYTES);
        if (per_cu < 1) { fprintf(stderr, "occupancy query says %d blocks/CU\n", per_cu); per_cu = 1; }
        grid = cus * 1;
        if (grid > 256) grid = 256;
        (void)hipGetLastError();
    }
    Args a{};
    for (int i = 0; i < 15; ++i) a.in[i] = (const float*)d_in[i];
    a.out = (float*)d_out; a.ws = (unsigned char*)d_ws;
    (void)hipMemsetAsync(a.ws + WS_CTL, 0, CTL_ZERO_BYTES, stream);
#if !DEBUG_CMP
#if ONE_LAUNCH
    launch_phases(a, 0, NPHASE, grid, stream);
#else
    for (int p = 0; p < NPHASE; ++p) launch_phases(a, p, p + 1, grid, stream);
#endif
#else
    using nv::rmsnorm_k; using nv::gemm_k; using nv::rope_k; using nv::copy_cols_k; using nv::dilated_k; using nv::mla_k; using nv::peer_k; constexpr int PW = nv::PW;
    unsigned char* ws = (unsigned char*)d_ws;
    unsigned* err = (unsigned*)(ws + 505 * MiB);
    hipMemsetAsync(err, 0, 256, stream);
    float* hb = (float*)(ws + 404 * MiB); float* projb = (float*)(ws + 420 * MiB); float* qn = (float*)(ws + 456 * MiB); float* knn = (float*)(ws + 469 * MiB);
    float* krn = (float*)(ws + 477 * MiB); float* vn = (float*)(ws + 478 * MiB); float* mixb = (float*)(ws + 486 * MiB);
    const float* x = (const float*)d_in[0];
    hipStream_t st = stream;
    launch_phases(a, 0, 1, grid, stream); launch_phases(a, 1, 2, grid, stream);
    rmsnorm_k<<<S / 4, 256, 0, st>>>(x, D, (const float*)d_in[1], hb, D, D, S);
    gemm_k<<<dim3((PW + 63) / 64, S / 64), 256, 0, st>>>(hb, D, (const float*)d_in[2], PW, projb, PW, nullptr, 0, S, PW, D);
    rope_k<<<(S * 8 * 32 + 255) / 256, 256, 0, st>>>(projb, PW, 0, 8, 64, S);
    rope_k<<<(S * 8 * 32 + 255) / 256, 256, 0, st>>>(projb, PW, 512, 8, 64, S);
    copy_cols_k<<<(S * 32 + 255) / 256, 256, 0, st>>>(projb + 2048, PW, krn, 32, 32, S);
    rope_k<<<(S * 16 + 255) / 256, 256, 0, st>>>(krn, 32, 0, 1, 32, S);
    dbg::cmp_k<bf16_t><<<1024, 256, 0, st>>>((const bf16_t*)(ws + WS_QA), 512, projb, PW, S, 512, 1.f / QSCALE_A, 1, err, 0);
    dbg::cmp_k<bf16_t><<<1024, 256, 0, st>>>((const bf16_t*)(ws + WS_KA), 512, projb + 512, PW, S, 512, 1.f, 1, err, 1);
    dbg::cmp_k<bf16_t><<<1024, 256, 0, st>>>((const bf16_t*)(ws + WS_VA), 512, projb + 1024, PW, S, 512, 1.f, 0, err, 2);
    dbg::cmp_k<bf16_t><<<1024, 256, 0, st>>>((const bf16_t*)(ws + WS_CQ), 256, projb + 1536, PW, S, 256, 1.f, 0, err, 3);
    dbg::cmp_k<bf16_t><<<1024, 256, 0, st>>>((const bf16_t*)(ws + WS_CKV), 256, projb + 1792, PW, S, 256, 1.f, 0, err, 4);
    dbg::cmp_k<bf16_t><<<1024, 256, 0, st>>>((const bf16_t*)(ws + WS_KR), 32, krn, 32, S, 32, 1.f, 2, err, 5);
    launch_phases(a, 2, 3, grid, stream);
    {   float* cqn = hb; float* ckvn = hb + (size_t)S * 256;
        rmsnorm_k<<<S / 4, 256, 0, st>>>(projb + 1536, PW, (const float*)d_in[3], cqn, 256, 256, S);
        rmsnorm_k<<<S / 4, 256, 0, st>>>(projb + 1792, PW, (const float*)d_in[4], ckvn, 256, 256, S);
        gemm_k<<<dim3(768 / 64, S / 64), 256, 0, st>>>(cqn, 256, (const float*)d_in[5], 768, qn, 768, nullptr, 0, S, 768, 256);
        for (int h = 0; h < 8; ++h) rope_k<<<(S * 16 + 255) / 256, 256, 0, st>>>(qn, 768, h * 96 + 64, 1, 32, S);
        gemm_k<<<dim3(512 / 64, S / 64), 256, 0, st>>>(ckvn, 256, (const float*)d_in[6], 512, knn, 512, nullptr, 0, S, 512, 256);
        gemm_k<<<dim3(512 / 64, S / 64), 256, 0, st>>>(ckvn, 256, (const float*)d_in[7], 512, vn, 512, nullptr, 0, S, 512, 256); }
    dbg::cmp_k<bf16_t><<<1024, 256, 0, st>>>((const bf16_t*)(ws + WS_QB), 768, qn, 768, S, 768, 1.f / QSCALE_B, 3, err, 6);
    dbg::cmp_k<bf16_t><<<1024, 256, 0, st>>>((const bf16_t*)(ws + WS_KN), 512, knn, 512, S, 512, 1.f, 0, err, 7);
    dbg::cmp_k<bf16_t><<<1024, 256, 0, st>>>((const bf16_t*)(ws + WS_VB), 512, vn, 512, S, 512, 1.f, 0, err, 8);
    launch_phases(a, 3, 4, grid, stream); launch_phases(a, 4, 5, grid, stream);
    dilated_k<<<8 * S / 4, 256, 0, st>>>(projb, mixb);
    mla_k<<<1 * 8 * (S / 64), 64, 0, st>>>(qn, knn, krn, vn, mixb);
    dbg::cmp_k<bf16_t><<<1024, 256, 0, st>>>((const bf16_t*)(ws + WS_MIX), 1024, mixb, 1024, S, 512, 1.f, 0, err, 9);
    dbg::cmp_k<bf16_t><<<1024, 256, 0, st>>>((const bf16_t*)(ws + WS_MIX) + 512, 1024, mixb + 512, 1024, S, 512, 1.f, 0, err, 10);
    launch_phases(a, 5, 6, grid, stream);
    float* x2b = hb;
    gemm_k<<<dim3(D / 64, S / 64), 256, 0, st>>>(mixb, 1024, (const float*)d_in[8], D, x2b, D, x, D, S, D, 1024);
    dbg::cmp_k<bf16_t><<<1024, 256, 0, st>>>((const bf16_t*)(ws + WS_X2B), 1024, x2b, 1024, S, 1024, 1.f, 0, err, 11);
    launch_phases(a, 6, 7, grid, stream);
    float* h2c = qn; float* qpc = projb;
    rmsnorm_k<<<4096 / 4, 256, 0, st>>>(x2b, D, (const float*)d_in[9], h2c, D, D, 4096);
    gemm_k<<<dim3(2048 / 64, 4096 / 64), 256, 0, st>>>(h2c, D, (const float*)d_in[10], 2048, qpc, 2048, nullptr, 0, 4096, 2048, D);
    dbg::cmp_k<bf16_t><<<1024, 256, 0, st>>>((const bf16_t*)d_out, 2048, qpc, 2048, S, 2048, 1.f, 0, err, 12);
    launch_phases(a, 7, 8, grid, stream); launch_phases(a, 8, 9, grid, stream); launch_phases(a, 9, 10, grid, stream); launch_phases(a, 10, 11, grid, stream); launch_phases(a, 11, 12, grid, stream);
    peer_k<<<4096 / 4, 256, 0, st>>>(h2c, qpc, (const float*)d_in[11], (const float*)d_in[12], (const float*)d_in[13], (const float*)d_in[14], x2b, 4096);
    dbg::cmp_k<float><<<1024, 256, 0, st>>>((const float*)d_out, 1024, x2b, 1024, S, 1024, 1.f, 0, err, 13);
    nv::run(d_in, (float*)d_out, (float*)d_ws, stream);
    dbg::encode_k<<<M * 1024 / 4 / 256, 256, 0, st>>>((float*)d_out, err, 14, DEBUG_SEL, 0.05f);
#endif
}
```
